# Optimizing an MI355X kernel written in HIP

```python
import math
import jax, jax.numpy as jnp
from jax import lax
import numpy as np

D_MODEL = 1024
BATCH = 8
SEQ = 4096
DEPTH = 1

N_META = 16
BLOCK = 128
ROPE_THETA = 10000.0
EPS = 1e-6

A_HEADS = 4
A_HEAD_DIM = 64
A_V_DIM = 2 * A_HEAD_DIM
A_QK_WIDTH = A_HEADS * 2 * A_HEAD_DIM
A_OUT = A_HEADS * A_V_DIM

B_HEADS = 8
B_HEAD_DIM = 64
B_OUT = B_HEADS * B_HEAD_DIM
IDX_HEADS = 8
IDX_DIM = 64
IDX_ROPE_DIM = 32
TOPK_CAP = 256

PEER_HEADS = 8
N_KEYS = 128
N_EXPERTS = N_KEYS * N_KEYS
PEER_KEY_DIM = 128
PEER_HALF = PEER_KEY_DIM // 2
PEER_TOPK = 16

SPLIT_SIZES = (
    A_QK_WIDTH, A_QK_WIDTH, A_OUT,
    B_OUT, B_HEAD_DIM, B_HEAD_DIM,
    IDX_HEADS * IDX_DIM, IDX_DIM, IDX_HEADS,
    D_MODEL, D_MODEL,
)
IN_WIDTH = int(sum(SPLIT_SIZES))
SPLIT_POINTS = tuple(int(v) for v in np.cumsum(SPLIT_SIZES)[:-1])

kernel_name = "hybrid_diffattn_dsa_peer_block"


def rms_norm(x, gain):
    xf = x.astype(jnp.float32)
    y = xf * lax.rsqrt(jnp.mean(xf * xf, axis=-1, keepdims=True) + EPS)
    return (y * gain.astype(jnp.float32)).astype(x.dtype)


def rope_tables(t_len, dim):
    inv = ROPE_THETA ** (-jnp.arange(0, dim, 2, dtype=jnp.float32) / dim)
    ang = jnp.arange(t_len, dtype=jnp.float32)[:, None] * inv[None, :]
    return jnp.cos(ang), jnp.sin(ang)


def apply_rope(x, cos, sin):
    half = x.shape[-1] // 2
    x1, x2 = x[..., :half], x[..., half:]
    c = cos[None, :, None, :].astype(x.dtype)
    s = sin[None, :, None, :].astype(x.dtype)
    return jnp.concatenate([x1 * c - x2 * s, x2 * c + x1 * s], axis=-1)


def masked_softmax(scores, mask):
    s = jnp.where(mask, scores.astype(jnp.float32), -jnp.inf)
    return jax.nn.softmax(s, axis=-1)


def diff_attention(q1, q2, k1, k2, v, lam):
    bsz, t_len, n_h, dv = v.shape
    n_blocks = t_len // BLOCK
    scale = A_HEAD_DIM ** -0.5
    key_pos = jnp.arange(t_len)

    def one_block(i):
        start = i * BLOCK
        qb1 = lax.dynamic_slice_in_dim(q1, start, BLOCK, axis=1)
        qb2 = lax.dynamic_slice_in_dim(q2, start, BLOCK, axis=1)
        causal = key_pos[None, :] <= (start + jnp.arange(BLOCK))[:, None]
        p1 = masked_softmax(jnp.einsum('bqhd,bkhd->bhqk', qb1, k1) * scale, causal)
        p2 = masked_softmax(jnp.einsum('bqhd,bkhd->bhqk', qb2, k2) * scale, causal)
        return jnp.einsum('bhqk,bkhd->bqhd', (p1 - lam * p2).astype(v.dtype), v)

    out = lax.map(one_block, jnp.arange(n_blocks))
    return out.transpose(1, 0, 2, 3, 4).reshape(bsz, t_len, n_h, dv)


def dsa_attention(q, k, v, iq, ik, iw, k_sel):
    bsz, t_len, n_h, d = q.shape
    n_blocks = t_len // BLOCK
    scale = B_HEAD_DIM ** -0.5
    key_pos = jnp.arange(t_len)

    def one_block(i):
        start = i * BLOCK
        qpos = start + jnp.arange(BLOCK)
        qb = lax.dynamic_slice_in_dim(q, start, BLOCK, axis=1)
        iqb = lax.dynamic_slice_in_dim(iq, start, BLOCK, axis=1)
        iwb = lax.dynamic_slice_in_dim(iw, start, BLOCK, axis=1)
        causal = key_pos[None, :] <= qpos[:, None]
        logits = jax.nn.relu(jnp.einsum('bqhd,bkd->bqhk', iqb, ik))
        index_score = jnp.einsum('bqh,bqhk->bqk', iwb, logits)
        index_score = jnp.where(causal[None], index_score.astype(jnp.float32), -jnp.inf)
        _, top_idx = lax.top_k(index_score, k_sel)
        valid = top_idx <= qpos[None, :, None]
        flat = top_idx.reshape(bsz, BLOCK * k_sel)[..., None]
        ks = jnp.take_along_axis(k, flat, axis=1).reshape(bsz, BLOCK, k_sel, d)
        vs = jnp.take_along_axis(v, flat, axis=1).reshape(bsz, BLOCK, k_sel, d)
        p = masked_softmax(jnp.einsum('bqhd,bqkd->bqhk', qb, ks) * scale, valid[:, :, None, :])
        return jnp.einsum('bqhk,bqkd->bqhd', p.astype(v.dtype), vs)

    out = lax.map(one_block, jnp.arange(n_blocks))
    return out.transpose(1, 0, 2, 3, 4).reshape(bsz, t_len, n_h, d)


def peer_ffn(xn, w_query, sub_keys, u, v):
    n_tok, d_model = xn.shape

    def one_block(xb):
        q = (xb @ w_query).reshape(BLOCK, PEER_HEADS, 2, PEER_HALF)
        s = jnp.einsum('thcd,hckd->thck', q, sub_keys)
        s1, i1 = lax.top_k(s[:, :, 0], PEER_TOPK)
        s2, i2 = lax.top_k(s[:, :, 1], PEER_TOPK)
        cand_s = (s1[..., :, None] + s2[..., None, :]).reshape(BLOCK, PEER_HEADS, PEER_TOPK * PEER_TOPK)
        cand_i = (i1[..., :, None] * N_KEYS + i2[..., None, :]).reshape(BLOCK, PEER_HEADS, PEER_TOPK * PEER_TOPK)
        top_s, top_c = lax.top_k(cand_s, PEER_TOPK)
        expert = jnp.take_along_axis(cand_i, top_c, axis=-1)
        g = jax.nn.softmax(top_s.astype(jnp.float32), axis=-1).astype(xb.dtype)
        ue = jnp.take(u, expert, axis=0)
        ve = jnp.take(v, expert, axis=0)
        act = jax.nn.gelu(jnp.einsum('thkd,td->thk', ue, xb), approximate=False)
        return jnp.einsum('thk,thkd->td', g * act, ve)

    out = lax.map(one_block, xn.reshape(n_tok // BLOCK, BLOCK, d_model))
    return out.reshape(n_tok, d_model)


def setup_inputs(seed: int = 0) -> dict:
    key = jax.random.key(seed)
    ks = jax.random.split(key, 24)
    f32 = jnp.float32

    def nrm(k, shape, scale):
        return jax.random.normal(k, shape, f32) * scale

    def gain(k, shape):
        return 1.0 + 0.02 * jax.random.normal(k, shape, f32)

    return {
        "x": nrm(ks[0], (BATCH, SEQ, D_MODEL), 1.0),
        "meta_tokens": nrm(ks[1], (N_META, D_MODEL), 1.0),
        "mix_norm_gain": gain(ks[2], (DEPTH, D_MODEL)),
        "w_in": nrm(ks[3], (DEPTH, D_MODEL, IN_WIDTH), D_MODEL ** -0.5),
        "a_q_norm_gain": gain(ks[4], (DEPTH, A_HEAD_DIM)),
        "a_k_norm_gain": gain(ks[5], (DEPTH, A_HEAD_DIM)),
        "a_lambda_q1": nrm(ks[6], (DEPTH, A_HEAD_DIM), 0.1),
        "a_lambda_k1": nrm(ks[7], (DEPTH, A_HEAD_DIM), 0.1),
        "a_lambda_q2": nrm(ks[8], (DEPTH, A_HEAD_DIM), 0.1),
        "a_lambda_k2": nrm(ks[9], (DEPTH, A_HEAD_DIM), 0.1),
        "a_subln_gain": gain(ks[10], (DEPTH, A_V_DIM)),
        "w_branch_a": nrm(ks[11], (DEPTH, A_OUT, D_MODEL), A_OUT ** -0.5),
        "b_q_norm_gain": gain(ks[12], (DEPTH, B_HEAD_DIM)),
        "b_k_norm_gain": gain(ks[13], (DEPTH, B_HEAD_DIM)),
        "w_branch_b": nrm(ks[14], (DEPTH, B_OUT, D_MODEL), B_OUT ** -0.5),
        "w_out": nrm(ks[15], (DEPTH, D_MODEL, D_MODEL), D_MODEL ** -0.5),
        "ffn_norm_gain": gain(ks[16], (DEPTH, D_MODEL)),
        "peer_w_query": nrm(ks[17], (DEPTH, D_MODEL, PEER_HEADS * PEER_KEY_DIM), D_MODEL ** -0.5),
        "peer_sub_keys": nrm(ks[18], (DEPTH, PEER_HEADS, 2, N_KEYS, PEER_HALF), PEER_HALF ** -0.5),
        "peer_u": nrm(ks[19], (DEPTH, N_EXPERTS, D_MODEL), D_MODEL ** -0.5),
        "peer_v": nrm(ks[20], (DEPTH, N_EXPERTS, D_MODEL), (PEER_HEADS * PEER_TOPK) ** -0.5),
    }


def reference(x, meta_tokens, mix_norm_gain, w_in, a_q_norm_gain, a_k_norm_gain,
              a_lambda_q1, a_lambda_k1, a_lambda_q2, a_lambda_k2, a_subln_gain, w_branch_a,
              b_q_norm_gain, b_k_norm_gain, w_branch_b, w_out, ffn_norm_gain,
              peer_w_query, peer_sub_keys, peer_u, peer_v):
    bsz, seq, d_model = x.shape
    t_real = N_META + seq
    t_pad = ((t_real + BLOCK - 1) // BLOCK) * BLOCK
    k_sel = min(TOPK_CAP, seq // 4)

    meta = jnp.broadcast_to(meta_tokens.astype(x.dtype)[None], (bsz, N_META, d_model))
    pad = jnp.zeros((bsz, t_pad - t_real, d_model), x.dtype)
    h = jnp.concatenate([meta, x, pad], axis=1)

    cos, sin = rope_tables(t_pad, A_HEAD_DIM)
    icos, isin = rope_tables(t_pad, IDX_ROPE_DIM)

    for layer in range(DEPTH):
        lambda_init = 0.8 - 0.6 * math.exp(-0.3 * layer)
        xn = rms_norm(h, mix_norm_gain[layer])
        proj = xn @ w_in[layer]
        aq, ak, av, bq, bk, bv, iq, ik, iw, gate_a, gate_b = jnp.split(proj, SPLIT_POINTS, axis=-1)

        aq = apply_rope(rms_norm(aq.reshape(bsz, t_pad, 2 * A_HEADS, A_HEAD_DIM), a_q_norm_gain[layer]), cos, sin)
        ak = apply_rope(rms_norm(ak.reshape(bsz, t_pad, 2 * A_HEADS, A_HEAD_DIM), a_k_norm_gain[layer]), cos, sin)
        aq = aq.reshape(bsz, t_pad, A_HEADS, 2, A_HEAD_DIM)
        ak = ak.reshape(bsz, t_pad, A_HEADS, 2, A_HEAD_DIM)
        av = av.reshape(bsz, t_pad, A_HEADS, A_V_DIM)
        lam = (jnp.exp(jnp.sum(a_lambda_q1[layer].astype(jnp.float32) * a_lambda_k1[layer].astype(jnp.float32)))
               - jnp.exp(jnp.sum(a_lambda_q2[layer].astype(jnp.float32) * a_lambda_k2[layer].astype(jnp.float32)))
               + lambda_init)
        a_out = diff_attention(aq[..., 0, :], aq[..., 1, :], ak[..., 0, :], ak[..., 1, :], av, lam)
        a_out = rms_norm(a_out, a_subln_gain[layer]) * (1.0 - lambda_init)
        y_a = a_out.reshape(bsz, t_pad, A_OUT) @ w_branch_a[layer]

        bq = apply_rope(rms_norm(bq.reshape(bsz, t_pad, B_HEADS, B_HEAD_DIM), b_q_norm_gain[layer]), cos, sin)
        bk = apply_rope(rms_norm(bk.reshape(bsz, t_pad, 1, B_HEAD_DIM), b_k_norm_gain[layer]), cos, sin)[:, :, 0]
        iq = iq.reshape(bsz, t_pad, IDX_HEADS, IDX_DIM)
        iq = jnp.concatenate([apply_rope(iq[..., :IDX_ROPE_DIM], icos, isin), iq[..., IDX_ROPE_DIM:]], axis=-1)
        ik = ik[:, :, None, :]
        ik = jnp.concatenate([apply_rope(ik[..., :IDX_ROPE_DIM], icos, isin), ik[..., IDX_ROPE_DIM:]], axis=-1)[:, :, 0]
        iw = iw * (IDX_HEADS ** -0.5 * IDX_DIM ** -0.5)
        b_out = dsa_attention(bq, bk, bv, iq, ik, iw, k_sel)
        y_b = b_out.reshape(bsz, t_pad, B_OUT) @ w_branch_b[layer]

        mixed = jax.nn.sigmoid(gate_a) * y_a + jax.nn.sigmoid(gate_b) * y_b
        h = h + mixed @ w_out[layer]

        hn = rms_norm(h, ffn_norm_gain[layer]).reshape(bsz * t_pad, d_model)
        h = h + peer_ffn(hn, peer_w_query[layer], peer_sub_keys[layer], peer_u[layer], peer_v[layer]).reshape(bsz, t_pad, d_model)

    return h[:, N_META:N_META + seq]
```

```cpp
#include <hip/hip_runtime.h>
#include <hip/hip_cooperative_groups.h>
#include <cstdio>
#include <cstdint>
namespace cg = cooperative_groups;
#define UNR _Pragma("unroll")

#ifndef SPLIT_LAUNCH
#define SPLIT_LAUNCH 1
#endif

typedef unsigned short bf16_t;
typedef short bf16x8 __attribute__((ext_vector_type(8)));
typedef short s16x4 __attribute__((ext_vector_type(4)));
typedef float f32x16 __attribute__((ext_vector_type(16)));
typedef float f32x4 __attribute__((ext_vector_type(4)));
typedef float f32x2_t __attribute__((ext_vector_type(2)));
typedef __bf16 bf16x2_t __attribute__((ext_vector_type(2)));
typedef unsigned long long u64;

constexpr int BATCH = 8, SEQ = 4096, DM = 1024, NMETA = 16;
constexpr int TR = NMETA + SEQ;
constexpr int TP = 4224;
constexpr int R = BATCH * TP;
constexpr int NIN = 4864;
constexpr float EPS = 1e-6f;
constexpr int NTHREADS = 512;
constexpr int NEXP = 16384;
constexpr float LOG2E = 1.4426950408889634f;
constexpr float QSCALE = 0.125f * LOG2E;
constexpr int SMEM_BYTES = 135168;

constexpr size_t al(size_t x) { return (x + 255) & ~(size_t)255; }
constexpr size_t WS_CTL   = 0;
constexpr size_t WS_ROWSS = 4096;
constexpr size_t WS_COS64 = al(WS_ROWSS + (size_t)R * 4);
constexpr size_t WS_SIN64 = al(WS_COS64 + (size_t)TP * 32 * 4);
constexpr size_t WS_ICOS  = al(WS_SIN64 + (size_t)TP * 32 * 4);
constexpr size_t WS_ISIN  = al(WS_ICOS + (size_t)TP * 16 * 4);
constexpr size_t WS_WIN   = al(WS_ISIN + (size_t)TP * 16 * 4);
constexpr size_t WS_WA    = al(WS_WIN + (size_t)NIN * 1024 * 2);
constexpr size_t WS_WB    = al(WS_WA + (size_t)1024 * 512 * 2);
constexpr size_t WS_WO    = al(WS_WB + (size_t)1024 * 512 * 2);
constexpr size_t WS_WQ    = al(WS_WO + (size_t)1024 * 1024 * 2);
constexpr size_t WS_SUBK  = al(WS_WQ + (size_t)1024 * 1024 * 2);
constexpr size_t WS_BK    = al(WS_SUBK + (size_t)8 * 2 * 128 * 64 * 2);
constexpr size_t WS_BV    = al(WS_BK + (size_t)R * 64 * 2);
constexpr size_t WS_IK    = al(WS_BV + (size_t)R * 64 * 2);
constexpr size_t WS_IW    = al(WS_IK + (size_t)R * 64 * 2);
constexpr size_t WS_R1    = al(WS_IW + (size_t)R * 8 * 4);
constexpr size_t SZ_R1    = (size_t)R * 1024 * 2;
constexpr size_t WS_R2    = al(WS_R1 + SZ_R1);
constexpr size_t WS_R3    = al(WS_R2 + SZ_R1);
constexpr size_t WS_R4    = al(WS_R3 + SZ_R1);
constexpr size_t WS_R6    = al(WS_R4 + (size_t)R * 512 * 2);
constexpr size_t WS_END   = al(WS_R6 + (size_t)R * 1024 * 4);

struct Params {
    const float *x, *meta, *g_mix, *w_in, *g_aq, *g_ak, *lq1, *lk1, *lq2, *lk2, *g_sub, *w_a, *g_bq, *g_bk, *w_b, *w_o, *g_ffn, *w_q, *subk, *pu, *pv;
    float* out;
    char* ws;
};

__device__ __forceinline__ int opaque_tid() { int t = threadIdx.x; asm volatile("" : "+v"(t)); return t; }
__device__ __forceinline__ unsigned pk2(float lo, float hi) { f32x2_t v = {lo, hi}; bf16x2_t b = __builtin_convertvector(v, bf16x2_t); return __builtin_bit_cast(unsigned, b); }
__device__ __forceinline__ bf16_t f2bf(float x) { return (bf16_t)(pk2(x, 0.f) & 0xffffu); }
__device__ __forceinline__ float bf2f(unsigned x) { return __uint_as_float(x << 16); }
__device__ __forceinline__ int crow(int r, int hi) { return (r & 3) + 8 * (r >> 2) + 4 * hi; }
__device__ __forceinline__ f32x16 mfma32(bf16x8 a, bf16x8 b, f32x16 c) { return __builtin_amdgcn_mfma_f32_32x32x16_bf16(a, b, c, 0, 0, 0); }
__device__ __forceinline__ f32x4 mfma16(bf16x8 a, bf16x8 b, f32x4 c) { return __builtin_amdgcn_mfma_f32_16x16x32_bf16(a, b, c, 0, 0, 0); }
__device__ __forceinline__ float ex2(float x) { return __builtin_amdgcn_exp2f(x); }
__device__ __forceinline__ bf16x8 pack8(float a0, float a1, float a2, float a3, float a4, float a5, float a6, float a7) {
    uint4 u; u.x = pk2(a0, a1); u.y = pk2(a2, a3); u.z = pk2(a4, a5); u.w = pk2(a6, a7); return __builtin_bit_cast(bf16x8, u);
}
__device__ __forceinline__ f32x16 zero16() { f32x16 z; UNR for (int i = 0; i < 16; ++i) z[i] = 0.f; return z; }

__device__ void phase0(const Params& P, int bid, int nb) {
    const int tid = threadIdx.x, lane = tid & 63, w = tid >> 6;
    char* ws = P.ws;
    {
        bf16_t* XN = (bf16_t*)(ws + WS_R1);
        for (int row = bid * 8 + w; row < R; row += nb * 8) {
            const int b = row / TP, t = row - b * TP;
            f32x4 v[4];
            if (t < NMETA) { const float* src = P.meta + (size_t)t * DM; UNR for (int i = 0; i < 4; ++i) v[i] = *(const f32x4*)(src + i * 256 + lane * 4); }
            else if (t < TR) { const float* src = P.x + ((size_t)b * SEQ + (t - NMETA)) * DM; UNR for (int i = 0; i < 4; ++i) v[i] = *(const f32x4*)(src + i * 256 + lane * 4); }
            else { UNR for (int i = 0; i < 4; ++i) v[i] = (f32x4){0.f, 0.f, 0.f, 0.f}; }
            float ss = 0.f;
            UNR for (int i = 0; i < 4; ++i) ss += v[i][0] * v[i][0] + v[i][1] * v[i][1] + v[i][2] * v[i][2] + v[i][3] * v[i][3];
            for (int o = 32; o >= 1; o >>= 1) ss += __shfl_xor(ss, o);
            const float rinv = rsqrtf(ss * (1.0f / DM) + EPS);
            UNR for (int i = 0; i < 4; ++i) {
                const f32x4 g = *(const f32x4*)(P.g_mix + i * 256 + lane * 4);
                uint2 o; o.x = pk2(v[i][0] * rinv * g[0], v[i][1] * rinv * g[1]); o.y = pk2(v[i][2] * rinv * g[2], v[i][3] * rinv * g[3]);
                *(uint2*)(XN + (size_t)row * DM + i * 256 + lane * 4) = o;
            }
        }
    }
    const int gt = bid * NTHREADS + tid, gn = nb * NTHREADS;
    auto conv = [&](const float* W, int K, int Nsrc, int Ndst, bf16_t* Wt, bool remap) {
        const int items = Ndst * (K / 8);
        for (int it = gt; it < items; it += gn) {
            const int kc = it / Ndst, n = it - kc * Ndst;
            int ns = n; bool zero = false;
            if (remap) { if (n >= 2816) ns = n - 56; else if (n >= 2760) zero = true; }
            float f[8];
            UNR for (int j = 0; j < 8; ++j) f[j] = zero ? 0.f : W[(size_t)(kc * 8 + j) * Nsrc + ns];
            uint4 o; o.x = pk2(f[0], f[1]); o.y = pk2(f[2], f[3]); o.z = pk2(f[4], f[5]); o.w = pk2(f[6], f[7]);
            *(uint4*)(Wt + (size_t)n * K + kc * 8) = o;
        }
    };
    conv(P.w_in, 1024, 4808, NIN, (bf16_t*)(ws + WS_WIN), true);
    conv(P.w_a, 512, 1024, 1024, (bf16_t*)(ws + WS_WA), false);
    conv(P.w_b, 512, 1024, 1024, (bf16_t*)(ws + WS_WB), false);
    conv(P.w_o, 1024, 1024, 1024, (bf16_t*)(ws + WS_WO), false);
    conv(P.w_q, 1024, 1024, 1024, (bf16_t*)(ws + WS_WQ), false);
    { bf16_t* SK = (bf16_t*)(ws + WS_SUBK); for (int i = gt; i < 8 * 2 * 128 * 64; i += gn) SK[i] = f2bf(P.subk[i]); }
    {
        float* c64 = (float*)(ws + WS_COS64); float* s64 = (float*)(ws + WS_SIN64); float* ic = (float*)(ws + WS_ICOS); float* is = (float*)(ws + WS_ISIN);
        for (int i = gt; i < TP * 32; i += gn) { const int t = i >> 5, j = i & 31; const float inv = powf(10000.0f, -(float)(2 * j) / 64.0f); const float ang = (float)t * inv; c64[i] = (float)cos((double)ang); s64[i] = (float)sin((double)ang); }
        for (int i = gt; i < TP * 16; i += gn) { const int t = i >> 4, j = i & 15; const float inv = powf(10000.0f, -(float)(2 * j) / 32.0f); const float ang = (float)t * inv; ic[i] = (float)cos((double)ang); is[i] = (float)sin((double)ang); }
    }
    { float* rs = (float*)(ws + WS_ROWSS); for (int i = gt; i < R; i += gn) rs[i] = 0.f; }
    if (bid == 0 && w == 0) {
        float a = P.lq1[lane] * P.lk1[lane], b2 = P.lq2[lane] * P.lk2[lane];
        for (int o = 32; o >= 1; o >>= 1) { a += __shfl_xor(a, o); b2 += __shfl_xor(b2, o); }
        if (lane == 0) { ((unsigned*)(ws + WS_CTL))[0] = 0u; ((float*)(ws + WS_CTL))[4] = expf(a) - expf(b2) + 0.2f; }
    }
}

__device__ __forceinline__ void gemm_mainloop(const bf16_t* __restrict__ X, int ldx, const bf16_t* __restrict__ Wt, int ldw, int K, int m0, int n0, char* lds, f32x16 (&acc)[2][2]) {
    const int tid = opaque_tid(), lane = tid & 63, w = tid >> 6, wm = w >> 1, wn = w & 1, l31 = lane & 31, hi = lane >> 5;
    const int srow = tid >> 3, sch = tid & 7;
    const bf16_t* xg = X + (size_t)(m0 + srow) * ldx + sch * 8;
    const bf16_t* wg = Wt + (size_t)(n0 + srow) * ldw + sch * 8;
    const int soff = srow * 128 + ((sch ^ (srow & 7)) << 4);
    uint4 xr[4], wr[2];
    auto gload = [&](int k0) {
        UNR for (int i = 0; i < 4; ++i) xr[i] = *(const uint4*)(xg + (size_t)(i * 64) * ldx + k0);
        UNR for (int i = 0; i < 2; ++i) wr[i] = *(const uint4*)(wg + (size_t)(i * 64) * ldw + k0);
    };
    auto lstore = [&](int buf) {
        char* xb = lds + buf * 32768; char* wb = lds + 65536 + buf * 16384;
        UNR for (int i = 0; i < 4; ++i) *(uint4*)(xb + i * 8192 + soff) = xr[i];
        UNR for (int i = 0; i < 2; ++i) *(uint4*)(wb + i * 8192 + soff) = wr[i];
    };
    const int nk = K / 64;
    gload(0); lstore(0); __syncthreads();
    const int aoffb = (wn * 64 + l31) * 128, boffb = (wm * 64 + l31) * 128, sw = l31 & 7;
    for (int kt = 0; kt < nk; ++kt) {
        if (kt + 1 < nk) gload((kt + 1) * 64);
        const char* xb = lds + (kt & 1) * 32768; const char* wb = lds + 65536 + (kt & 1) * 16384;
        UNR for (int ks = 0; ks < 4; ++ks) {
            const int co = (((ks * 2 + hi) ^ sw) << 4);
            bf16x8 a[2], b[2];
            UNR for (int nt = 0; nt < 2; ++nt) a[nt] = *(const bf16x8*)(wb + aoffb + nt * 4096 + co);
            UNR for (int mt = 0; mt < 2; ++mt) b[mt] = *(const bf16x8*)(xb + boffb + mt * 4096 + co);
            UNR for (int mt = 0; mt < 2; ++mt) UNR for (int nt = 0; nt < 2; ++nt) acc[mt][nt] = mfma32(a[nt], b[mt], acc[mt][nt]);
        }
        if (kt + 1 < nk) lstore((kt + 1) & 1);
        __syncthreads();
    }
}

__device__ void phase1(const Params& P, int bid, int nb, char* lds) {
    const int tid = threadIdx.x, lane = tid & 63, w = tid >> 6, wm = w >> 1, wn = w & 1, l31 = lane & 31, hi = lane >> 5;
    char* ws = P.ws;
    const bf16_t* XN = (const bf16_t*)(ws + WS_R1); const bf16_t* WIN = (const bf16_t*)(ws + WS_WIN);
    bf16_t* AQ = (bf16_t*)(ws + WS_R2); bf16_t* AK = AQ + (size_t)8 * 8 * TP * 64;
    bf16_t* AVT = (bf16_t*)(ws + WS_R3); bf16_t* BQ = AVT + (size_t)8 * 4 * 128 * TP;
    bf16_t* BK = (bf16_t*)(ws + WS_BK); bf16_t* BV = (bf16_t*)(ws + WS_BV); bf16_t* IK = (bf16_t*)(ws + WS_IK); float* IW = (float*)(ws + WS_IW);
    bf16_t* IQ = (bf16_t*)(ws + WS_R4); bf16_t* GA = (bf16_t*)(ws + WS_R6); bf16_t* GB = GA + (size_t)R * 1024;
    const float* c64 = (const float*)(ws + WS_COS64); const float* s64 = (const float*)(ws + WS_SIN64); const float* ic = (const float*)(ws + WS_ICOS); const float* is = (const float*)(ws + WS_ISIN);
    constexpr int NTM = R / 256, NTN = NIN / 128;
    for (int tile = bid; tile < NTM * NTN; tile += nb) {
        const int tn = tile % NTN, tm = tile / NTN; const int m0 = tm * 256, n0 = tn * 128;
        f32x16 acc[2][2]; UNR for (int i = 0; i < 2; ++i) UNR for (int j = 0; j < 2; ++j) acc[i][j] = zero16();
        gemm_mainloop(XN, 1024, WIN, 1024, 1024, m0, n0, lds, acc);
        const int chunk = (n0 >> 6) + wn;
        UNR for (int mt = 0; mt < 2; ++mt) {
            const int m = m0 + wm * 64 + mt * 32 + l31; const int b = m / TP, t = m - b * TP;
            f32x16 x1 = acc[mt][0], x2 = acc[mt][1];
            const bool nr = (chunk < 16) || (chunk >= 24 && chunk <= 32);
            if (nr) {
                const float* gain; bf16_t* dst; float sc = 1.f;
                if (chunk < 8) { gain = P.g_aq; dst = AQ + ((size_t)(b * 8 + chunk) * TP + t) * 64; sc = QSCALE; }
                else if (chunk < 16) { gain = P.g_ak; dst = AK + ((size_t)(b * 8 + chunk - 8) * TP + t) * 64; }
                else if (chunk < 32) { gain = P.g_bq; dst = BQ + (size_t)m * 512 + (chunk - 24) * 64; sc = QSCALE; }
                else { gain = P.g_bk; dst = BK + (size_t)m * 64; }
                float ss = 0.f;
                UNR for (int r = 0; r < 16; ++r) ss += x1[r] * x1[r] + x2[r] * x2[r];
                ss += __shfl_xor(ss, 32);
                const float rinv = rsqrtf(ss * (1.0f / 64.0f) + EPS);
                UNR for (int g4 = 0; g4 < 4; ++g4) {
                    const int j = 8 * g4 + 4 * hi;
                    const f32x4 c = *(const f32x4*)(c64 + t * 32 + j), s = *(const f32x4*)(s64 + t * 32 + j);
                    const f32x4 g1 = *(const f32x4*)(gain + j), g2 = *(const f32x4*)(gain + 32 + j);
                    float o1[4], o2[4];
                    UNR for (int i = 0; i < 4; ++i) { const float y1 = x1[4 * g4 + i] * rinv * g1[i], y2 = x2[4 * g4 + i] * rinv * g2[i]; o1[i] = (y1 * c[i] - y2 * s[i]) * sc; o2[i] = (y2 * c[i] + y1 * s[i]) * sc; }
                    uint2 u1, u2; u1.x = pk2(o1[0], o1[1]); u1.y = pk2(o1[2], o1[3]); u2.x = pk2(o2[0], o2[1]); u2.y = pk2(o2[2], o2[3]);
                    *(uint2*)(dst + j) = u1; *(uint2*)(dst + 32 + j) = u2;
                }
            } else if (chunk < 24) {
                const int hd = (chunk - 16) >> 1, half = (chunk - 16) & 1;
                bf16_t* dst = AVT + ((size_t)(b * 4 + hd) * 128 + half * 64) * TP + t;
                UNR for (int r = 0; r < 16; ++r) { const int j = crow(r, hi); dst[(size_t)j * TP] = f2bf(x1[r]); dst[(size_t)(32 + j) * TP] = f2bf(x2[r]); }
            } else if (chunk == 33) {
                bf16_t* dst = BV + (size_t)m * 64;
                UNR for (int g4 = 0; g4 < 4; ++g4) { const int j = 8 * g4 + 4 * hi; uint2 u1, u2; u1.x = pk2(x1[4 * g4], x1[4 * g4 + 1]); u1.y = pk2(x1[4 * g4 + 2], x1[4 * g4 + 3]); u2.x = pk2(x2[4 * g4], x2[4 * g4 + 1]); u2.y = pk2(x2[4 * g4 + 2], x2[4 * g4 + 3]); *(uint2*)(dst + j) = u1; *(uint2*)(dst + 32 + j) = u2; }
            } else if (chunk <= 42) {
                bf16_t* dst = (chunk == 42) ? IK + (size_t)m * 64 : IQ + (size_t)m * 512 + (chunk - 34) * 64;
                float y[16];
                UNR for (int g4 = 0; g4 < 2; ++g4) {
                    const int j = 8 * g4 + 4 * hi;
                    const f32x4 c = *(const f32x4*)(ic + t * 16 + j), s = *(const f32x4*)(is + t * 16 + j);
                    UNR for (int i = 0; i < 4; ++i) { const float a = x1[4 * g4 + i], bb = x1[4 * g4 + i + 8]; y[4 * g4 + i] = a * c[i] - bb * s[i]; y[4 * g4 + i + 8] = bb * c[i] + a * s[i]; }
                }
                UNR for (int g4 = 0; g4 < 4; ++g4) { const int j = 8 * g4 + 4 * hi; uint2 u1, u2; u1.x = pk2(y[4 * g4], y[4 * g4 + 1]); u1.y = pk2(y[4 * g4 + 2], y[4 * g4 + 3]); u2.x = pk2(x2[4 * g4], x2[4 * g4 + 1]); u2.y = pk2(x2[4 * g4 + 2], x2[4 * g4 + 3]); *(uint2*)(dst + j) = u1; *(uint2*)(dst + 32 + j) = u2; }
            } else if (chunk == 43) {
                const float sc = 0.35355339059327373f * 0.125f;
                f32x4 o = {x1[0] * sc, x1[1] * sc, x1[2] * sc, x1[3] * sc};
                *(f32x4*)(IW + (size_t)m * 8 + 4 * hi) = o;
            } else {
                bf16_t* dst = (chunk < 60) ? GA + (size_t)m * 1024 + (chunk - 44) * 64 : GB + (size_t)m * 1024 + (chunk - 60) * 64;
                UNR for (int g4 = 0; g4 < 4; ++g4) {
                    const int j = 8 * g4 + 4 * hi; float o1[4], o2[4];
                    UNR for (int i = 0; i < 4; ++i) { o1[i] = 1.0f / (1.0f + __expf(-x1[4 * g4 + i])); o2[i] = 1.0f / (1.0f + __expf(-x2[4 * g4 + i])); }
                    uint2 u1, u2; u1.x = pk2(o1[0], o1[1]); u1.y = pk2(o1[2], o1[3]); u2.x = pk2(o2[0], o2[1]); u2.y = pk2(o2[2], o2[3]);
                    *(uint2*)(dst + j) = u1; *(uint2*)(dst + 32 + j) = u2;
                }
            }
        }
    }
}

__device__ void attnA_unit(const Params& P, int b, int head, int qb, char* lds) {
    const int tid = opaque_tid(), lane = tid & 63, w = tid >> 6, qg = w & 3, st = w >> 2, l31 = lane & 31, hi = lane >> 5;
    char* ws = P.ws;
    const bf16_t* AQ = (const bf16_t*)(ws + WS_R2); const bf16_t* AK = AQ + (size_t)8 * 8 * TP * 64; const bf16_t* AVT = (const bf16_t*)(ws + WS_R3);
    bf16_t* AOUT = (bf16_t*)(ws + WS_R1);
    const float lam = ((const float*)(ws + WS_CTL))[4];
    const int q0 = qb * 128 + qg * 32;
    const bf16_t* Qp = AQ + ((size_t)(b * 8 + head * 2 + st) * TP + q0 + l31) * 64;
    bf16x8 qf[4];
    UNR for (int ks = 0; ks < 4; ++ks) qf[ks] = *(const bf16x8*)(Qp + ks * 16 + hi * 8);
    const bf16_t* K0g = AK + (size_t)(b * 8 + head * 2) * TP * 64; const bf16_t* K1g = K0g + (size_t)TP * 64;
    const bf16_t* Vg = AVT + (size_t)(b * 4 + head) * 128 * TP;
    const int nkt = 2 * (qb + 1);
    const int srow = tid >> 3, sch = tid & 7;
    const int koff = srow * 128 + ((sch ^ (srow & 7)) << 4), voff = srow * 128 + ((sch ^ ((srow >> 1) & 7)) << 4);
    uint4 sr[4];
    auto gload = [&](int kt) {
        const int key0 = kt * 64;
        sr[0] = *(const uint4*)(K0g + (size_t)(key0 + srow) * 64 + sch * 8);
        sr[1] = *(const uint4*)(K1g + (size_t)(key0 + srow) * 64 + sch * 8);
        sr[2] = *(const uint4*)(Vg + (size_t)srow * TP + key0 + sch * 8);
        sr[3] = *(const uint4*)(Vg + (size_t)(srow + 64) * TP + key0 + sch * 8);
    };
    auto lstore = [&](int buf) {
        char* base = lds + buf * 32768;
        *(uint4*)(base + koff) = sr[0]; *(uint4*)(base + 8192 + koff) = sr[1];
        *(uint4*)(base + 16384 + voff) = sr[2]; *(uint4*)(base + 16384 + 8192 + voff) = sr[3];
    };
    f32x16 o[4]; UNR for (int i = 0; i < 4; ++i) o[i] = zero16();
    float mrun = -INFINITY, lrun = 0.f;
    gload(0); lstore(0); __syncthreads();
    const int qpos = q0 + l31;
    for (int kt = 0; kt < nkt; ++kt) {
        if (kt + 1 < nkt) gload(kt + 1);
        const char* base = lds + (kt & 1) * 32768; const char* Kb = base + st * 8192; const char* Vb = base + 16384;
        f32x16 s0 = zero16(), s1 = zero16();
        UNR for (int ks = 0; ks < 4; ++ks) {
            const int co = (((ks * 2 + hi) ^ (l31 & 7)) << 4);
            const bf16x8 a0 = *(const bf16x8*)(Kb + l31 * 128 + co), a1 = *(const bf16x8*)(Kb + (32 + l31) * 128 + co);
            s0 = mfma32(a0, qf[ks], s0); s1 = mfma32(a1, qf[ks], s1);
        }
        if (kt >= nkt - 2) {
            const int kbase = kt * 64;
            UNR for (int r = 0; r < 16; ++r) { const int key = kbase + crow(r, hi); if (key > qpos) s0[r] = -INFINITY; if (key + 32 > qpos) s1[r] = -INFINITY; }
        }
        float mx = s0[0];
        UNR for (int r = 1; r < 16; ++r) mx = fmaxf(mx, s0[r]);
        UNR for (int r = 0; r < 16; ++r) mx = fmaxf(mx, s1[r]);
        mx = fmaxf(mx, __shfl_xor(mx, 32));
        const float mn = fmaxf(mrun, mx);
        const float alpha = ex2(mrun - mn);
        mrun = mn;
        float ls = 0.f;
        UNR for (int r = 0; r < 16; ++r) { s0[r] = ex2(s0[r] - mn); s1[r] = ex2(s1[r] - mn); ls += s0[r] + s1[r]; }
        lrun = lrun * alpha + ls;
        if (!__all(alpha == 1.0f)) { UNR for (int mt = 0; mt < 4; ++mt) UNR for (int r = 0; r < 16; ++r) o[mt][r] *= alpha; }
        bf16x8 pb[2][2];
        pb[0][0] = pack8(s0[0], s0[1], s0[2], s0[3], s0[4], s0[5], s0[6], s0[7]); pb[0][1] = pack8(s0[8], s0[9], s0[10], s0[11], s0[12], s0[13], s0[14], s0[15]);
        pb[1][0] = pack8(s1[0], s1[1], s1[2], s1[3], s1[4], s1[5], s1[6], s1[7]); pb[1][1] = pack8(s1[8], s1[9], s1[10], s1[11], s1[12], s1[13], s1[14], s1[15]);
        UNR for (int mt = 0; mt < 4; ++mt) {
            const int d = mt * 32 + l31; const int sw = (d >> 1) & 7; const char* rowp = Vb + d * 128 + 8 * hi;
            UNR for (int k2 = 0; k2 < 2; ++k2)
                UNR for (int s = 0; s < 2; ++s) {
                    const int c0 = k2 * 4 + 2 * s;
                    const s16x4 lo = *(const s16x4*)(rowp + ((c0 ^ sw) << 4)), h4 = *(const s16x4*)(rowp + (((c0 + 1) ^ sw) << 4));
                    const bf16x8 a = {lo[0], lo[1], lo[2], lo[3], h4[0], h4[1], h4[2], h4[3]};
                    o[mt] = mfma32(a, pb[k2][s], o[mt]);
                }
        }
        if (kt + 1 < nkt) lstore((kt + 1) & 1);
        __syncthreads();
    }
    lrun += __shfl_xor(lrun, 32);
    const float inv = 1.0f / lrun;
    float* ex = (float*)lds + qg * 4096;
    if (st == 1) { const float f = inv * lam; UNR for (int mt = 0; mt < 4; ++mt) UNR for (int r = 0; r < 16; ++r) ex[(mt * 16 + r) * 64 + lane] = o[mt][r] * f; }
    __syncthreads();
    if (st == 0) {
        float ss = 0.f;
        UNR for (int mt = 0; mt < 4; ++mt) UNR for (int r = 0; r < 16; ++r) { const float v = o[mt][r] * inv - ex[(mt * 16 + r) * 64 + lane]; o[mt][r] = v; ss += v * v; }
        ss += __shfl_xor(ss, 32);
        const float rinv = rsqrtf(ss * (1.0f / 128.0f) + EPS) * 0.8f;
        bf16_t* dst = AOUT + (size_t)(b * TP + q0 + l31) * 512 + head * 128;
        UNR for (int mt = 0; mt < 4; ++mt) UNR for (int g4 = 0; g4 < 4; ++g4) {
            const int d = mt * 32 + 8 * g4 + 4 * hi; const f32x4 g = *(const f32x4*)(P.g_sub + d);
            uint2 u; u.x = pk2(o[mt][4 * g4] * rinv * g[0], o[mt][4 * g4 + 1] * rinv * g[1]); u.y = pk2(o[mt][4 * g4 + 2] * rinv * g[2], o[mt][4 * g4 + 3] * rinv * g[3]);
            *(uint2*)(dst + d) = u;
        }
    }
    __syncthreads();
}

constexpr int DSA_C = 448;
constexpr int DS_SEL = 0, DS_CAND = 8192, DS_VST = 65536, DS_STATE = 131072;
__device__ __forceinline__ unsigned ord32(float s) { const unsigned u = __float_as_uint(s); return (u & 0x80000000u) ? ~u : (u | 0x80000000u); }

__device__ void dsa_unit(const Params& P, int b, int q16, char* lds) {
    const int tid = opaque_tid(), lane = tid & 63, w = tid >> 6, n15 = lane & 15, g = lane >> 4;
    char* ws = P.ws;
    const bf16_t* BQ = (const bf16_t*)(ws + WS_R3) + (size_t)8 * 4 * 128 * TP;
    const bf16_t* BK = (const bf16_t*)(ws + WS_BK); const bf16_t* BV = (const bf16_t*)(ws + WS_BV); const bf16_t* IK = (const bf16_t*)(ws + WS_IK);
    const float* IW = (const float*)(ws + WS_IW); const bf16_t* IQ = (const bf16_t*)(ws + WS_R4);
    bf16_t* BOUT = (bf16_t*)(ws + WS_R1) + (size_t)R * 512;
    unsigned* HIST = (unsigned*)lds;
    unsigned short* SEL = (unsigned short*)(lds + DS_SEL); u64* CAND = (u64*)(lds + DS_CAND);
    u64* s_pfx = (u64*)(lds + DS_STATE); int* s_need = (int*)(lds + DS_STATE + 256); int* s_pop = (int*)(lds + DS_STATE + 384);
    unsigned* s_selcnt = (unsigned*)(lds + DS_STATE + 512); unsigned* s_candcnt = (unsigned*)(lds + DS_STATE + 640); int* s_all = (int*)(lds + DS_STATE + 768);
    const int q0 = q16 * 16; const int qpos = q0 + n15; const size_t qrow = (size_t)b * TP + qpos;
    const int nk = q16 + 1;
    bf16x8 iqf[8][2];
    UNR for (int h = 0; h < 8; ++h) UNR for (int s = 0; s < 2; ++s) iqf[h][s] = *(const bf16x8*)(IQ + qrow * 512 + h * 64 + s * 32 + g * 8);
    float iw[8];
    { const f32x4 a = *(const f32x4*)(IW + qrow * 8), c = *(const f32x4*)(IW + qrow * 8 + 4); iw[0] = a[0]; iw[1] = a[1]; iw[2] = a[2]; iw[3] = a[3]; iw[4] = c[0]; iw[5] = c[1]; iw[6] = c[2]; iw[7] = c[3]; }
    auto scores = [&](int kt, f32x4& sc) {
        const bf16_t* ikp = IK + ((size_t)b * TP + kt * 16 + n15) * 64 + g * 8;
        const bf16x8 k0 = *(const bf16x8*)ikp, k1 = *(const bf16x8*)(ikp + 32);
        sc = (f32x4){0.f, 0.f, 0.f, 0.f};
        UNR for (int h = 0; h < 8; ++h) {
            f32x4 a = {0.f, 0.f, 0.f, 0.f};
            a = mfma16(k0, iqf[h][0], a); a = mfma16(k1, iqf[h][1], a);
            UNR for (int e = 0; e < 4; ++e) sc[e] += iw[h] * fmaxf(a[e], 0.f);
        }
        UNR for (int e = 0; e < 4; ++e) sc[e] += 0.0f;
    };
    if (tid < 16) { s_pfx[tid] = 0ull; s_need[tid] = 256; s_pop[tid] = 0; s_all[tid] = 0; }
    int sh = 45;
    for (;;) {
        const int nbits = sh < 11 ? sh : 11; const int mask = (1 << nbits) - 1;
        { uint4 z = {0u, 0u, 0u, 0u}; for (int i = tid; i < 4096; i += NTHREADS) ((uint4*)lds)[i] = z; }
        __syncthreads();
        const u64 mypfx = s_pfx[n15]; const int myall = s_all[n15];
        for (int kt = w; kt < nk; kt += 8) {
            f32x4 sc; scores(kt, sc);
            const bool diag = (kt == nk - 1);
            UNR for (int e = 0; e < 4; ++e) {
                const int idx = kt * 16 + 4 * g + e;
                if ((!diag || idx <= qpos) && !myall) {
                    const u64 comp = ((u64)ord32(sc[e]) << 13) | (u64)(8191 - idx);
                    if ((comp >> sh) == mypfx) { const int ib = mask - (int)((comp >> (sh - nbits)) & (u64)mask); atomicAdd(&HIST[n15 * 1024 + (ib >> 1)], 1u << ((ib & 1) * 16)); }
                }
            }
        }
        __syncthreads();
        UNR for (int i = 0; i < 2; ++i) {
            const int ql = w * 2 + i;
            if (s_all[ql]) continue;
            const unsigned* hq = HIST + ql * 1024 + lane * 16;
            unsigned wd[16]; unsigned c = 0;
            UNR for (int j = 0; j < 16; ++j) { wd[j] = hq[j]; c += (wd[j] & 0xffffu) + (wd[j] >> 16); }
            unsigned pre = c;
            UNR for (int o = 1; o < 64; o <<= 1) { const unsigned t = __shfl_up(pre, o); if (lane >= o) pre += t; }
            const unsigned nd = (unsigned)s_need[ql];
            const u64 bal = __ballot(pre >= nd);
            if (bal == 0ull) { if (lane == 0) { s_all[ql] = 1; s_pop[ql] = 0; s_need[ql] = 0; } }
            else {
                const int Lc = __ffsll((long long)bal) - 1;
                if (lane == Lc) {
                    unsigned cum = pre - c; int ibs = -1; unsigned cntb = 0;
                    UNR for (int j = 0; j < 32; ++j) { const unsigned cnt = (wd[j >> 1] >> ((j & 1) * 16)) & 0xffffu; if (ibs < 0) { if (cum + cnt >= nd) { ibs = lane * 32 + j; cntb = cnt; } else cum += cnt; } }
                    s_pfx[ql] = (s_pfx[ql] << nbits) | (u64)(mask - ibs); s_need[ql] = (int)(nd - cum); s_pop[ql] = (int)cntb;
                }
            }
        }
        __syncthreads();
        sh -= nbits;
        int mp = 0; UNR for (int q = 0; q < 16; ++q) mp = max(mp, s_pop[q]);
        if (mp <= DSA_C || sh == 0) break;
    }
    if (tid < 16) { s_selcnt[tid] = 0u; s_candcnt[tid] = 0u; }
    __syncthreads();
    {
        const u64 mypfx = s_pfx[n15]; const int myall = s_all[n15];
        for (int kt = w; kt < nk; kt += 8) {
            f32x4 sc; scores(kt, sc);
            const bool diag = (kt == nk - 1);
            UNR for (int e = 0; e < 4; ++e) {
                const int idx = kt * 16 + 4 * g + e;
                if (!diag || idx <= qpos) {
                    const u64 comp = ((u64)ord32(sc[e]) << 13) | (u64)(8191 - idx); const u64 top = comp >> sh;
                    if (myall || top > mypfx) { const unsigned pos = atomicAdd(&s_selcnt[n15], 1u); if (pos < 256u) SEL[n15 * 256 + pos] = (unsigned short)idx; }
                    else if (top == mypfx) { const unsigned cp = atomicAdd(&s_candcnt[n15], 1u); if (cp < (unsigned)DSA_C) CAND[n15 * DSA_C + cp] = comp; }
                }
            }
        }
    }
    __syncthreads();
    UNR for (int i = 0; i < 2; ++i) {
        const int ql = w * 2 + i; const int n = min((int)s_candcnt[ql], DSA_C); const int nd = s_need[ql];
        for (int c = lane; c < n; c += 64) {
            const u64 ci = CAND[ql * DSA_C + c]; int rank = 0;
            for (int j = 0; j < n; ++j) rank += (CAND[ql * DSA_C + j] > ci) ? 1 : 0;
            if (rank < nd) { const unsigned pos = atomicAdd(&s_selcnt[ql], 1u); if (pos < 256u) SEL[ql * 256 + pos] = (unsigned short)(8191 - (int)(ci & 8191ull)); }
        }
    }
    __syncthreads();
    {
        typedef __attribute__((address_space(3))) s16x4 lds_s16x4;
        char* vl = lds + DS_VST + w * 8192;
        const int hq = n15 & 7;
        UNR for (int i = 0; i < 2; ++i) {
            const int ql = w * 2 + i; const size_t row = (size_t)b * TP + q0 + ql; const int nsel = min((int)s_selcnt[ql], 256);
            const unsigned short* sel = SEL + ql * 256;
            bf16x8 bqf[2];
            UNR for (int s = 0; s < 2; ++s) bqf[s] = *(const bf16x8*)(BQ + row * 512 + hq * 64 + s * 32 + g * 8);
            f32x4 S[16];
            UNR for (int c = 0; c < 4; ++c) {
                bf16x8 kf[4][2];
                UNR for (int t = 0; t < 4; ++t) { const int slot = c * 64 + t * 16 + n15; const int kid = slot < nsel ? (int)sel[slot] : 0; const bf16_t* kp = BK + ((size_t)b * TP + kid) * 64 + g * 8; kf[t][0] = *(const bf16x8*)kp; kf[t][1] = *(const bf16x8*)(kp + 32); }
                UNR for (int t = 0; t < 4; ++t) { f32x4 a = {0.f, 0.f, 0.f, 0.f}; a = mfma16(kf[t][0], bqf[0], a); a = mfma16(kf[t][1], bqf[1], a); S[c * 4 + t] = a; }
                __builtin_amdgcn_sched_barrier(0);
            }
            float mx = -INFINITY;
            UNR for (int t = 0; t < 16; ++t) UNR for (int e = 0; e < 4; ++e) { if (t * 16 + 4 * g + e >= nsel) S[t][e] = -INFINITY; mx = fmaxf(mx, S[t][e]); }
            mx = fmaxf(mx, __shfl_xor(mx, 16)); mx = fmaxf(mx, __shfl_xor(mx, 32));
            float ls = 0.f;
            UNR for (int t = 0; t < 16; ++t) UNR for (int e = 0; e < 4; ++e) { S[t][e] = ex2(S[t][e] - mx); ls += S[t][e]; }
            ls += __shfl_xor(ls, 16); ls += __shfl_xor(ls, 32);
            bf16x8 pb[8];
            UNR for (int u = 0; u < 8; ++u) pb[u] = pack8(S[2 * u][0], S[2 * u][1], S[2 * u][2], S[2 * u][3], S[2 * u + 1][0], S[2 * u + 1][1], S[2 * u + 1][2], S[2 * u + 1][3]);
            f32x4 o[4]; UNR for (int mt = 0; mt < 4; ++mt) o[mt] = (f32x4){0.f, 0.f, 0.f, 0.f};
            UNR for (int c = 0; c < 4; ++c) {
                uint4 vr[8];
                UNR for (int k = 0; k < 8; ++k) { const int rowl = k * 8 + (lane >> 3); const int slot = c * 64 + rowl; const int kid = slot < nsel ? (int)sel[slot] : 0; vr[k] = *(const uint4*)(BV + ((size_t)b * TP + kid) * 64 + (lane & 7) * 8); }
                UNR for (int k = 0; k < 8; ++k) { const int rowl = k * 8 + (lane >> 3); *(uint4*)(vl + rowl * 128 + ((((lane & 7)) ^ (((rowl >> 1) & 3) << 1)) << 4)) = vr[k]; }
                __builtin_amdgcn_s_waitcnt(0xc07f);
                const int qq = n15 >> 2, pp = n15 & 3;
                UNR for (int us = 0; us < 2; ++us) {
                    const int row0 = (2 * us) * 16 + 4 * g + qq, row1 = row0 + 16;
                    UNR for (int mt = 0; mt < 4; ++mt) {
                        const int ch = 2 * mt + (pp >> 1);
                        const char* a0 = vl + row0 * 128 + ((ch ^ (((row0 >> 1) & 3) << 1)) << 4) + 8 * (pp & 1);
                        const char* a1 = vl + row1 * 128 + ((ch ^ (((row1 >> 1) & 3) << 1)) << 4) + 8 * (pp & 1);
                        const s16x4 lo = __builtin_amdgcn_ds_read_tr16_b64_v4i16((lds_s16x4*)a0);
                        const s16x4 h4 = __builtin_amdgcn_ds_read_tr16_b64_v4i16((lds_s16x4*)a1);
                        const bf16x8 a = {lo[0], lo[1], lo[2], lo[3], h4[0], h4[1], h4[2], h4[3]};
                        o[mt] = mfma16(a, pb[2 * c + us], o[mt]);
                    }
                }
                __builtin_amdgcn_s_waitcnt(0xc07f);
                __builtin_amdgcn_sched_barrier(0);
            }
            const float inv = 1.0f / ls;
            if (n15 < 8) {
                bf16_t* dst = BOUT + row * 512 + n15 * 64;
                UNR for (int mt = 0; mt < 4; ++mt) { uint2 u; u.x = pk2(o[mt][0] * inv, o[mt][1] * inv); u.y = pk2(o[mt][2] * inv, o[mt][3] * inv); *(uint2*)(dst + mt * 16 + 4 * g) = u; }
            }
        }
    }
    __syncthreads();
}

__device__ void phase2(const Params& P, char* lds) {
    unsigned* ctr = (unsigned*)(P.ws + WS_CTL);
    int* s_u = (int*)(lds + DS_STATE + 1024);
    constexpr int NA = BATCH * 4 * 33, NB = BATCH * 257;
    for (;;) {
        if (threadIdx.x == 0) *s_u = (int)atomicAdd(ctr, 1u);
        __syncthreads();
        const int u = *s_u;
        __syncthreads();
        if (u >= NA + NB) break;
        if (u < NA) { const int qb = 32 - u / 32, rem = u % 32; attnA_unit(P, rem >> 2, rem & 3, qb, lds); }
        else { const int v = u - NA; dsa_unit(P, v % 8, 256 - v / 8, lds); }
    }
}

__device__ void phase3(const Params& P, int bid, int nb, char* lds) {
    const int tid = threadIdx.x, lane = tid & 63, w = tid >> 6, wm = w >> 1, wn = w & 1, l31 = lane & 31, hi = lane >> 5;
    char* ws = P.ws;
    const bf16_t* AOUT = (const bf16_t*)(ws + WS_R1); const bf16_t* BOUT = AOUT + (size_t)R * 512;
    const bf16_t* WA = (const bf16_t*)(ws + WS_WA); const bf16_t* WB = (const bf16_t*)(ws + WS_WB);
    const bf16_t* GA = (const bf16_t*)(ws + WS_R6); const bf16_t* GB = GA + (size_t)R * 1024;
    bf16_t* MIXED = (bf16_t*)(ws + WS_R2);
    constexpr int NTM = R / 256, NTN = 8;
    for (int tile = bid; tile < NTM * NTN; tile += nb) {
        const int tn = tile % NTN, tm = tile / NTN; const int m0 = tm * 256, n0 = tn * 128;
        f32x16 acc[2][2], tmp[2][2];
        UNR for (int i = 0; i < 2; ++i) UNR for (int j = 0; j < 2; ++j) acc[i][j] = zero16();
        gemm_mainloop(AOUT, 512, WA, 512, 512, m0, n0, lds, acc);
        UNR for (int mt = 0; mt < 2; ++mt) UNR for (int nt = 0; nt < 2; ++nt) {
            const bf16_t* gp = GA + (size_t)(m0 + wm * 64 + mt * 32 + l31) * 1024 + n0 + wn * 64 + nt * 32 + 4 * hi;
            UNR for (int g4 = 0; g4 < 4; ++g4) { const uint2 u = *(const uint2*)(gp + 8 * g4); tmp[mt][nt][4 * g4] = acc[mt][nt][4 * g4] * bf2f(u.x & 0xffffu); tmp[mt][nt][4 * g4 + 1] = acc[mt][nt][4 * g4 + 1] * bf2f(u.x >> 16); tmp[mt][nt][4 * g4 + 2] = acc[mt][nt][4 * g4 + 2] * bf2f(u.y & 0xffffu); tmp[mt][nt][4 * g4 + 3] = acc[mt][nt][4 * g4 + 3] * bf2f(u.y >> 16); }
            acc[mt][nt] = zero16();
        }
        gemm_mainloop(BOUT, 512, WB, 512, 512, m0, n0, lds, acc);
        UNR for (int mt = 0; mt < 2; ++mt) UNR for (int nt = 0; nt < 2; ++nt) {
            const size_t off = (size_t)(m0 + wm * 64 + mt * 32 + l31) * 1024 + n0 + wn * 64 + nt * 32 + 4 * hi;
            UNR for (int g4 = 0; g4 < 4; ++g4) {
                const uint2 u = *(const uint2*)(GB + off + 8 * g4);
                const float v0 = tmp[mt][nt][4 * g4] + acc[mt][nt][4 * g4] * bf2f(u.x & 0xffffu), v1 = tmp[mt][nt][4 * g4 + 1] + acc[mt][nt][4 * g4 + 1] * bf2f(u.x >> 16);
                const float v2 = tmp[mt][nt][4 * g4 + 2] + acc[mt][nt][4 * g4 + 2] * bf2f(u.y & 0xffffu), v3 = tmp[mt][nt][4 * g4 + 3] + acc[mt][nt][4 * g4 + 3] * bf2f(u.y >> 16);
                uint2 o; o.x = pk2(v0, v1); o.y = pk2(v2, v3); *(uint2*)(MIXED + off + 8 * g4) = o;
            }
        }
    }
    {
        bf16_t* UT = (bf16_t*)(ws + WS_R3); bf16_t* VT = UT + (size_t)NEXP * 1024;
        const size_t n4 = (size_t)NEXP * 1024 / 4;
        for (size_t i = (size_t)bid * NTHREADS + tid; i < n4; i += (size_t)nb * NTHREADS) {
            const f32x4 a = *(const f32x4*)(P.pu + i * 4), c = *(const f32x4*)(P.pv + i * 4);
            uint2 o; o.x = pk2(a[0], a[1]); o.y = pk2(a[2], a[3]); *(uint2*)(UT + i * 4) = o;
            o.x = pk2(c[0], c[1]); o.y = pk2(c[2], c[3]); *(uint2*)(VT + i * 4) = o;
        }
    }
}

__device__ void phase4(const Params& P, int bid, int nb, char* lds) {
    const int tid = threadIdx.x, lane = tid & 63, w = tid >> 6, wm = w >> 1, wn = w & 1, l31 = lane & 31, hi = lane >> 5;
    char* ws = P.ws;
    const bf16_t* MIXED = (const bf16_t*)(ws + WS_R2); const bf16_t* WO = (const bf16_t*)(ws + WS_WO);
    float* H2 = (float*)(ws + WS_R6); bf16_t* H2G = (bf16_t*)(ws + WS_R1); float* ROWSS = (float*)(ws + WS_ROWSS);
    constexpr int NTM = R / 256, NTN = 8;
    for (int tile = bid; tile < NTM * NTN; tile += nb) {
        const int tn = tile % NTN, tm = tile / NTN; const int m0 = tm * 256, n0 = tn * 128;
        f32x16 acc[2][2];
        UNR for (int i = 0; i < 2; ++i) UNR for (int j = 0; j < 2; ++j) acc[i][j] = zero16();
        gemm_mainloop(MIXED, 1024, WO, 1024, 1024, m0, n0, lds, acc);
        UNR for (int mt = 0; mt < 2; ++mt) {
            const int m = m0 + wm * 64 + mt * 32 + l31; const int b = m / TP, t = m - b * TP;
            const float* hsrc = (t < NMETA) ? P.meta + (size_t)t * DM : P.x + ((size_t)b * SEQ + (t - NMETA)) * DM;
            const bool real = t < TR;
            float ss = 0.f;
            UNR for (int nt = 0; nt < 2; ++nt) UNR for (int g4 = 0; g4 < 4; ++g4) {
                const int col = n0 + wn * 64 + nt * 32 + 8 * g4 + 4 * hi;
                f32x4 hv = {0.f, 0.f, 0.f, 0.f}; if (real) hv = *(const f32x4*)(hsrc + col);
                const f32x4 gg = *(const f32x4*)(P.g_ffn + col);
                f32x4 v; UNR for (int i = 0; i < 4; ++i) { v[i] = hv[i] + acc[mt][nt][4 * g4 + i]; ss += v[i] * v[i]; }
                *(f32x4*)(H2 + (size_t)m * 1024 + col) = v;
                uint2 o; o.x = pk2(v[0] * gg[0], v[1] * gg[1]); o.y = pk2(v[2] * gg[2], v[3] * gg[3]); *(uint2*)(H2G + (size_t)m * 1024 + col) = o;
            }
            ss += __shfl_xor(ss, 32);
            if (hi == 0) atomicAdd(ROWSS + m, ss);
        }
    }
}

__device__ __forceinline__ void ins16(float (&a)[16], float v) {
    float n[16]; n[0] = fmaxf(a[0], v);
    UNR for (int p = 1; p < 16; ++p) n[p] = __builtin_amdgcn_fmed3f(a[p - 1], a[p], v);
    UNR for (int p = 0; p < 16; ++p) a[p] = n[p];
}
constexpr int P6_TOPS = 98304;
__device__ void phase6(const Params& P, int bid, int nb, char* lds) {
    const int tid = threadIdx.x, lane = tid & 63, w = tid >> 6, wm = w >> 1, wn = w & 1, l31 = lane & 31, hi = lane >> 5;
    char* ws = P.ws;
    const bf16_t* H2G = (const bf16_t*)(ws + WS_R1); const bf16_t* WQ = (const bf16_t*)(ws + WS_WQ); const bf16_t* SUBK = (const bf16_t*)(ws + WS_SUBK);
    const float* ROWSS = (const float*)(ws + WS_ROWSS);
    int* EIDX = (int*)(ws + WS_R4); float* EG = (float*)(ws + WS_R4 + (size_t)R * 128 * 4);
    float* TOPS = (float*)(lds + P6_TOPS);
    constexpr int NTM = R / 256, NTN = 8;
    for (int tile = bid; tile < NTM * NTN; tile += nb) {
        const int head = tile % NTN, tm = tile / NTN; const int m0 = tm * 256, n0 = head * 128;
        f32x16 acc[2][2];
        UNR for (int i = 0; i < 2; ++i) UNR for (int j = 0; j < 2; ++j) acc[i][j] = zero16();
        gemm_mainloop(H2G, 1024, WQ, 1024, 1024, m0, n0, lds, acc);
        const bf16_t* sk = SUBK + (size_t)(head * 2 + wn) * 128 * 64;
        UNR for (int mt = 0; mt < 2; ++mt) {
            const int tl = wm * 64 + mt * 32 + l31; const int m = m0 + tl;
            const float rinv = rsqrtf(ROWSS[m] * (1.0f / DM) + EPS);
            bf16x8 qb[4];
            UNR for (int s = 0; s < 4; ++s) { const int nt = s >> 1, r0 = 8 * (s & 1); const f32x16& a = acc[mt][nt];
                qb[s] = pack8(a[r0] * rinv, a[r0 + 1] * rinv, a[r0 + 2] * rinv, a[r0 + 3] * rinv, a[r0 + 4] * rinv, a[r0 + 5] * rinv, a[r0 + 6] * rinv, a[r0 + 7] * rinv); }
            float top[16];
            UNR for (int p = 0; p < 16; ++p) top[p] = -INFINITY;
            UNR for (int kt = 0; kt < 4; ++kt) {
                f32x16 S = zero16();
                UNR for (int s = 0; s < 4; ++s) {
                    const bf16_t* kp = sk + (size_t)(kt * 32 + l31) * 64 + (s >> 1) * 32 + 16 * (s & 1) + 4 * hi;
                    const s16x4 lo = *(const s16x4*)kp, h4 = *(const s16x4*)(kp + 8);
                    const bf16x8 a = {lo[0], lo[1], lo[2], lo[3], h4[0], h4[1], h4[2], h4[3]};
                    S = mfma32(a, qb[s], S);
                }
                UNR for (int r = 0; r < 16; ++r) { const unsigned key = (unsigned)(kt * 32 + crow(r, hi)); ins16(top, __uint_as_float((__float_as_uint(S[r]) & ~127u) | key)); }
            }
            float oth[16];
            UNR for (int p = 0; p < 16; ++p) oth[p] = __shfl_xor(top[p], 32);
            UNR for (int p = 0; p < 16; ++p) ins16(top, oth[p]);
            if (hi == 0) { UNR for (int p = 0; p < 16; p += 4) *(f32x4*)(TOPS + (tl * 2 + wn) * 16 + p) = (f32x4){top[p], top[p + 1], top[p + 2], top[p + 3]}; }
        }
        __syncthreads();
        if (tid < 256) {
            const int tl = tid; const int m = m0 + tl;
            float s1[16], s2[16];
            UNR for (int p = 0; p < 16; p += 4) { const f32x4 a = *(const f32x4*)(TOPS + (tl * 2) * 16 + p), c = *(const f32x4*)(TOPS + (tl * 2 + 1) * 16 + p); UNR for (int i = 0; i < 4; ++i) { s1[p + i] = a[i]; s2[p + i] = c[i]; } }
            float v1[16], v2[16];
            UNR for (int p = 0; p < 16; ++p) { v1[p] = __uint_as_float(__float_as_uint(s1[p]) & ~127u); v2[p] = __uint_as_float(__float_as_uint(s2[p]) & ~127u); }
            float top[16];
            UNR for (int p = 0; p < 16; ++p) top[p] = -INFINITY;
            UNR for (int a = 0; a < 16; ++a)
                UNR for (int c = 0; c < 16; ++c)
                    if ((a + 1) * (c + 1) <= 16) ins16(top, __uint_as_float((__float_as_uint(v1[a] + v2[c]) & ~255u) | (unsigned)(a * 16 + c)));
            float vs[16]; int ex[16]; float mx = -INFINITY;
            UNR for (int p = 0; p < 16; ++p) {
                const unsigned id = __float_as_uint(top[p]) & 255u; const int a = id >> 4, c = id & 15;
                const unsigned pa = __float_as_uint(TOPS[(tl * 2) * 16 + a]), pc = __float_as_uint(TOPS[(tl * 2 + 1) * 16 + c]);
                vs[p] = __uint_as_float(pa & ~127u) + __uint_as_float(pc & ~127u); ex[p] = (int)(pa & 127u) * 128 + (int)(pc & 127u); mx = fmaxf(mx, vs[p]);
            }
            float sum = 0.f;
            UNR for (int p = 0; p < 16; ++p) { vs[p] = __expf(vs[p] - mx); sum += vs[p]; }
            const float inv = 1.0f / sum;
            UNR for (int p = 0; p < 16; p += 4) {
                *(int4*)(EIDX + (size_t)m * 128 + head * 16 + p) = make_int4(ex[p], ex[p + 1], ex[p + 2], ex[p + 3]);
                *(f32x4*)(EG + (size_t)m * 128 + head * 16 + p) = (f32x4){vs[p] * inv, vs[p + 1] * inv, vs[p + 2] * inv, vs[p + 3] * inv};
            }
        }
        __syncthreads();
    }
}

__device__ void phase7(const Params& P, int bid, int nb) {
    const int tid = threadIdx.x, lane = tid & 63, w = tid >> 6;
    char* ws = P.ws;
    const bf16_t* H2G = (const bf16_t*)(ws + WS_R1); const float* H2 = (const float*)(ws + WS_R6); const float* ROWSS = (const float*)(ws + WS_ROWSS);
    const int* EIDX = (const int*)(ws + WS_R4); const float* EG = (const float*)(ws + WS_R4 + (size_t)R * 128 * 4);
    const bf16_t* UT = (const bf16_t*)(ws + WS_R3); const bf16_t* VT = UT + (size_t)NEXP * 1024;
    for (int tok = bid * 8 + w; tok < BATCH * SEQ; tok += nb * 8) {
        const int b = tok / SEQ, s = tok - b * SEQ; const size_t m = (size_t)b * TP + NMETA + s;
        const float rinv = rsqrtf(ROWSS[m] * (1.0f / DM) + EPS);
        float xf[16];
        { const uint4 a = *(const uint4*)(H2G + m * 1024 + lane * 8), c = *(const uint4*)(H2G + m * 1024 + 512 + lane * 8);
          const unsigned ua[8] = {a.x, a.y, a.z, a.w, c.x, c.y, c.z, c.w};
          UNR for (int i = 0; i < 8; ++i) { xf[2 * i] = bf2f(ua[i] & 0xffffu) * rinv; xf[2 * i + 1] = bf2f(ua[i] >> 16) * rinv; } }
        const int e0 = EIDX[m * 128 + lane], e1 = EIDX[m * 128 + 64 + lane];
        const float g0 = EG[m * 128 + lane], g1 = EG[m * 128 + 64 + lane];
        float c0 = 0.f, c1 = 0.f;
        _Pragma("nounroll") for (int k0 = 0; k0 < 128; k0 += 8) {
            float part[8];
            UNR for (int j = 0; j < 8; ++j) {
                const int k = k0 + j; const int e = __builtin_amdgcn_readlane(k < 64 ? e0 : e1, k & 63);
                const uint4 a = *(const uint4*)(UT + (size_t)e * 1024 + lane * 8), c = *(const uint4*)(UT + (size_t)e * 1024 + 512 + lane * 8);
                const unsigned ua[8] = {a.x, a.y, a.z, a.w, c.x, c.y, c.z, c.w};
                float acc = 0.f;
                UNR for (int i = 0; i < 8; ++i) { acc += bf2f(ua[i] & 0xffffu) * xf[2 * i]; acc += bf2f(ua[i] >> 16) * xf[2 * i + 1]; }
                part[j] = acc;
            }
            UNR for (int j = 0; j < 8; ++j) {
                float v = part[j];
                for (int o = 32; o >= 1; o >>= 1) v += __shfl_xor(v, o);
                const float act = 0.5f * v * (1.0f + erff(v * 0.70710678118654752f));
                const int k = k0 + j;
                if (k < 64) { if (lane == k) c0 = act * g0; } else { if (lane == k - 64) c1 = act * g1; }
            }
        }
        float of[16];
        { const f32x4* hp = (const f32x4*)(H2 + m * 1024 + lane * 8); const f32x4* hp2 = (const f32x4*)(H2 + m * 1024 + 512 + lane * 8);
          const f32x4 a = hp[0], bq = hp[1], c = hp2[0], d = hp2[1];
          UNR for (int i = 0; i < 4; ++i) { of[i] = a[i]; of[4 + i] = bq[i]; of[8 + i] = c[i]; of[12 + i] = d[i]; } }
        _Pragma("nounroll") for (int k0 = 0; k0 < 128; k0 += 8) {
            UNR for (int j = 0; j < 8; ++j) {
                const int k = k0 + j; const int e = __builtin_amdgcn_readlane(k < 64 ? e0 : e1, k & 63);
                const float cf = __builtin_bit_cast(float, __builtin_amdgcn_readlane(__builtin_bit_cast(int, k < 64 ? c0 : c1), k & 63));
                const uint4 a = *(const uint4*)(VT + (size_t)e * 1024 + lane * 8), c = *(const uint4*)(VT + (size_t)e * 1024 + 512 + lane * 8);
                const unsigned ua[8] = {a.x, a.y, a.z, a.w, c.x, c.y, c.z, c.w};
                UNR for (int i = 0; i < 8; ++i) { of[2 * i] += cf * bf2f(ua[i] & 0xffffu); of[2 * i + 1] += cf * bf2f(ua[i] >> 16); }
            }
        }
        float* op = P.out + (size_t)tok * 1024;
        *(f32x4*)(op + lane * 8) = (f32x4){of[0], of[1], of[2], of[3]}; *(f32x4*)(op + lane * 8 + 4) = (f32x4){of[4], of[5], of[6], of[7]};
        *(f32x4*)(op + 512 + lane * 8) = (f32x4){of[8], of[9], of[10], of[11]}; *(f32x4*)(op + 512 + lane * 8 + 4) = (f32x4){of[12], of[13], of[14], of[15]};
    }
}

__device__ __forceinline__ void run_phase(const Params& P, int ph, char* lds) {
    const int bid = blockIdx.x, nb = gridDim.x;
    switch (ph) {
        case 0: phase0(P, bid, nb); break;
        case 1: phase1(P, bid, nb, lds); break;
        case 2: phase2(P, lds); break;
        case 3: phase3(P, bid, nb, lds); break;
        case 4: phase4(P, bid, nb, lds); break;
        case 5: phase6(P, bid, nb, lds); break;
        case 6: phase7(P, bid, nb); break;
    }
}
#if SPLIT_LAUNCH
template <int PH> __global__ void __launch_bounds__(NTHREADS) phase_kernel(Params P) {
    __shared__ __attribute__((aligned(16))) char smem[SMEM_BYTES];
    run_phase(P, PH, smem);
}
#else
__global__ void __launch_bounds__(NTHREADS) mega_kernel(Params P) {
    __shared__ __attribute__((aligned(16))) char smem[SMEM_BYTES];
    cg::grid_group grid = cg::this_grid();
    UNR for (int ph = 0; ph < 7; ++ph) { run_phase(P, ph, smem); if (ph < 6) grid.sync(); }
}
#endif

extern "C" void kernel_launch(void* const* d_in, const int* in_sizes, int n_in, void* d_out, int out_size, void* d_ws, size_t ws_size, hipStream_t stream) {
    Params P{};
    const float** pp = (const float**)&P;
    UNR for (int i = 0; i < 21; ++i) pp[i] = (const float*)d_in[i];
    P.out = (float*)d_out; P.ws = (char*)d_ws;
    if (ws_size < WS_END) { fprintf(stderr, "workspace too small: %zu < %zu\n", ws_size, (size_t)WS_END); return; }
#if SPLIT_LAUNCH
    phase_kernel<0><<<256, NTHREADS, 0, stream>>>(P);
    phase_kernel<1><<<256, NTHREADS, 0, stream>>>(P);
    phase_kernel<2><<<256, NTHREADS, 0, stream>>>(P);
    phase_kernel<3><<<256, NTHREADS, 0, stream>>>(P);
    phase_kernel<4><<<256, NTHREADS, 0, stream>>>(P);
    phase_kernel<5><<<256, NTHREADS, 0, stream>>>(P);
    phase_kernel<6><<<256, NTHREADS, 0, stream>>>(P);
#else
    static int grid_blocks = 0;
    if (!grid_blocks) {
        int dev = 0, cus = 0, per_cu = 0;
        hipGetDevice(&dev);
        hipDeviceGetAttribute(&cus, hipDeviceAttributeMultiprocessorCount, dev);
        hipOccupancyMaxActiveBlocksPerMultiprocessor(&per_cu, mega_kernel, NTHREADS, 0);
        if (per_cu > 1) per_cu = 1;
        grid_blocks = cus * per_cu;
    }
    void* args[] = {&P};
    hipError_t e = hipLaunchCooperativeKernel((void*)mega_kernel, dim3(grid_blocks), dim3(NTHREADS), args, 0, stream);
    if (e != hipSuccess) fprintf(stderr, "cooperative launch failed: %s (grid %d)\n", hipGetErrorString(e), grid_blocks);
#endif
}
```

```cpp
#include <hip/hip_runtime.h>
#include <hip/hip_cooperative_groups.h>
#include <cstdio>
#include <cstdint>
namespace cg = cooperative_groups;
#define UNR _Pragma("unroll")

#ifndef SPLIT_LAUNCH
#define SPLIT_LAUNCH 0
#endif

typedef unsigned short bf16_t;
typedef short bf16x8 __attribute__((ext_vector_type(8)));
typedef short s16x4 __attribute__((ext_vector_type(4)));
typedef float f32x16 __attribute__((ext_vector_type(16)));
typedef float f32x4 __attribute__((ext_vector_type(4)));
typedef float f32x2_t __attribute__((ext_vector_type(2)));
typedef __bf16 bf16x2_t __attribute__((ext_vector_type(2)));
typedef unsigned long long u64;

constexpr int BATCH = 8, SEQ = 4096, DM = 1024, NMETA = 16;
constexpr int TR = NMETA + SEQ;
constexpr int TP = 4224;
constexpr int R = BATCH * TP;
constexpr int NIN = 4864;
constexpr float EPS = 1e-6f;
constexpr int NTHREADS = 512;
constexpr int NEXP = 16384;
constexpr float LOG2E = 1.4426950408889634f;
constexpr float QSCALE = 0.125f * LOG2E;
constexpr int SMEM_BYTES = 135168;

constexpr size_t al(size_t x) { return (x + 255) & ~(size_t)255; }
constexpr size_t WS_CTL   = 0;
constexpr size_t WS_ROWSS = 4096;
constexpr size_t WS_COS64 = al(WS_ROWSS + (size_t)R * 4);
constexpr size_t WS_SIN64 = al(WS_COS64 + (size_t)TP * 32 * 4);
constexpr size_t WS_ICOS  = al(WS_SIN64 + (size_t)TP * 32 * 4);
constexpr size_t WS_ISIN  = al(WS_ICOS + (size_t)TP * 16 * 4);
constexpr size_t WS_WIN   = al(WS_ISIN + (size_t)TP * 16 * 4);
constexpr size_t WS_WA    = al(WS_WIN + (size_t)NIN * 1024 * 2);
constexpr size_t WS_WB    = al(WS_WA + (size_t)1024 * 512 * 2);
constexpr size_t WS_WO    = al(WS_WB + (size_t)1024 * 512 * 2);
constexpr size_t WS_WQ    = al(WS_WO + (size_t)1024 * 1024 * 2);
constexpr size_t WS_SUBK  = al(WS_WQ + (size_t)1024 * 1024 * 2);
constexpr size_t WS_BK    = al(WS_SUBK + (size_t)8 * 2 * 128 * 64 * 2);
constexpr size_t WS_BV    = al(WS_BK + (size_t)R * 64 * 2);
constexpr size_t WS_IK    = al(WS_BV + (size_t)R * 64 * 2);
constexpr size_t WS_IW    = al(WS_IK + (size_t)R * 64 * 2);
constexpr size_t WS_R1    = al(WS_IW + (size_t)R * 8 * 4);
constexpr size_t SZ_R1    = (size_t)R * 1024 * 2;
constexpr size_t WS_R2    = al(WS_R1 + SZ_R1);
constexpr size_t WS_R3    = al(WS_R2 + SZ_R1);
constexpr size_t WS_R4    = al(WS_R3 + SZ_R1);
constexpr size_t WS_R6    = al(WS_R4 + (size_t)R * 512 * 2);
constexpr size_t WS_END   = al(WS_R6 + (size_t)R * 1024 * 4);

struct Params {
    const float *x, *meta, *g_mix, *w_in, *g_aq, *g_ak, *lq1, *lk1, *lq2, *lk2, *g_sub, *w_a, *g_bq, *g_bk, *w_b, *w_o, *g_ffn, *w_q, *subk, *pu, *pv;
    float* out;
    char* ws;
};

__device__ __forceinline__ int opaque_tid() { int t = threadIdx.x; asm volatile("" : "+v"(t)); return t; }
__device__ __forceinline__ unsigned pk2(float lo, float hi) { f32x2_t v = {lo, hi}; bf16x2_t b = __builtin_convertvector(v, bf16x2_t); return __builtin_bit_cast(unsigned, b); }
__device__ __forceinline__ bf16_t f2bf(float x) { return (bf16_t)(pk2(x, 0.f) & 0xffffu); }
__device__ __forceinline__ float bf2f(unsigned x) { return __uint_as_float(x << 16); }
__device__ __forceinline__ int crow(int r, int hi) { return (r & 3) + 8 * (r >> 2) + 4 * hi; }
__device__ __forceinline__ f32x16 mfma32(bf16x8 a, bf16x8 b, f32x16 c) { return __builtin_amdgcn_mfma_f32_32x32x16_bf16(a, b, c, 0, 0, 0); }
__device__ __forceinline__ f32x4 mfma16(bf16x8 a, bf16x8 b, f32x4 c) { return __builtin_amdgcn_mfma_f32_16x16x32_bf16(a, b, c, 0, 0, 0); }
__device__ __forceinline__ float ex2(float x) { return __builtin_amdgcn_exp2f(x); }
__device__ __forceinline__ bf16x8 pack8(float a0, float a1, float a2, float a3, float a4, float a5, float a6, float a7) {
    uint4 u; u.x = pk2(a0, a1); u.y = pk2(a2, a3); u.z = pk2(a4, a5); u.w = pk2(a6, a7); return __builtin_bit_cast(bf16x8, u);
}
__device__ __forceinline__ f32x16 zero16() { f32x16 z; UNR for (int i = 0; i < 16; ++i) z[i] = 0.f; return z; }

__device__ void phase0(const Params& P, int bid, int nb) {
    const int tid = threadIdx.x, lane = tid & 63, w = tid >> 6;
    char* ws = P.ws;
    {
        bf16_t* XN = (bf16_t*)(ws + WS_R1);
        for (int row = bid * 8 + w; row < R; row += nb * 8) {
            const int b = row / TP, t = row - b * TP;
            f32x4 v[4];
            if (t < NMETA) { const float* src = P.meta + (size_t)t * DM; UNR for (int i = 0; i < 4; ++i) v[i] = *(const f32x4*)(src + i * 256 + lane * 4); }
            else if (t < TR) { const float* src = P.x + ((size_t)b * SEQ + (t - NMETA)) * DM; UNR for (int i = 0; i < 4; ++i) v[i] = *(const f32x4*)(src + i * 256 + lane * 4); }
            else { UNR for (int i = 0; i < 4; ++i) v[i] = (f32x4){0.f, 0.f, 0.f, 0.f}; }
            float ss = 0.f;
            UNR for (int i = 0; i < 4; ++i) ss += v[i][0] * v[i][0] + v[i][1] * v[i][1] + v[i][2] * v[i][2] + v[i][3] * v[i][3];
            for (int o = 32; o >= 1; o >>= 1) ss += __shfl_xor(ss, o);
            const float rinv = rsqrtf(ss * (1.0f / DM) + EPS);
            UNR for (int i = 0; i < 4; ++i) {
                const f32x4 g = *(const f32x4*)(P.g_mix + i * 256 + lane * 4);
                uint2 o; o.x = pk2(v[i][0] * rinv * g[0], v[i][1] * rinv * g[1]); o.y = pk2(v[i][2] * rinv * g[2], v[i][3] * rinv * g[3]);
                *(uint2*)(XN + (size_t)row * DM + i * 256 + lane * 4) = o;
            }
        }
    }
    const int gt = bid * NTHREADS + tid, gn = nb * NTHREADS;
    auto conv = [&](const float* W, int K, int Nsrc, int Ndst, bf16_t* Wt, bool remap) {
        const int items = Ndst * (K / 8);
        for (int it = gt; it < items; it += gn) {
            const int kc = it / Ndst, n = it - kc * Ndst;
            int ns = n; bool zero = false;
            if (remap) { if (n >= 2816) ns = n - 56; else if (n >= 2760) zero = true; }
            float f[8];
            UNR for (int j = 0; j < 8; ++j) f[j] = zero ? 0.f : W[(size_t)(kc * 8 + j) * Nsrc + ns];
            uint4 o; o.x = pk2(f[0], f[1]); o.y = pk2(f[2], f[3]); o.z = pk2(f[4], f[5]); o.w = pk2(f[6], f[7]);
            *(uint4*)(Wt + (size_t)n * K + kc * 8) = o;
        }
    };
    conv(P.w_in, 1024, 4808, NIN, (bf16_t*)(ws + WS_WIN), true);
    conv(P.w_a, 512, 1024, 1024, (bf16_t*)(ws + WS_WA), false);
    conv(P.w_b, 512, 1024, 1024, (bf16_t*)(ws + WS_WB), false);
    conv(P.w_o, 1024, 1024, 1024, (bf16_t*)(ws + WS_WO), false);
    conv(P.w_q, 1024, 1024, 1024, (bf16_t*)(ws + WS_WQ), false);
    { bf16_t* SK = (bf16_t*)(ws + WS_SUBK); for (int i = gt; i < 8 * 2 * 128 * 64; i += gn) SK[i] = f2bf(P.subk[i]); }
    {
        float* c64 = (float*)(ws + WS_COS64); float* s64 = (float*)(ws + WS_SIN64); float* ic = (float*)(ws + WS_ICOS); float* is = (float*)(ws + WS_ISIN);
        for (int i = gt; i < TP * 32; i += gn) { const int t = i >> 5, j = i & 31; const float inv = powf(10000.0f, -(float)(2 * j) / 64.0f); const float ang = (float)t * inv; c64[i] = (float)cos((double)ang); s64[i] = (float)sin((double)ang); }
        for (int i = gt; i < TP * 16; i += gn) { const int t = i >> 4, j = i & 15; const float inv = powf(10000.0f, -(float)(2 * j) / 32.0f); const float ang = (float)t * inv; ic[i] = (float)cos((double)ang); is[i] = (float)sin((double)ang); }
    }
    { float* rs = (float*)(ws + WS_ROWSS); for (int i = gt; i < R; i += gn) rs[i] = 0.f; }
    if (bid == 0 && w == 0) {
        float a = P.lq1[lane] * P.lk1[lane], b2 = P.lq2[lane] * P.lk2[lane];
        for (int o = 32; o >= 1; o >>= 1) { a += __shfl_xor(a, o); b2 += __shfl_xor(b2, o); }
        if (lane == 0) { ((unsigned*)(ws + WS_CTL))[0] = 0u; ((float*)(ws + WS_CTL))[4] = expf(a) - expf(b2) + 0.2f; }
    }
}

__device__ __forceinline__ void gemm_mainloop(const bf16_t* __restrict__ X, int ldx, const bf16_t* __restrict__ Wt, int ldw, int K, int m0, int n0, char* lds, f32x16 (&acc)[2][2]) {
    const int tid = opaque_tid(), lane = tid & 63, w = tid >> 6, wm = w >> 1, wn = w & 1, l31 = lane & 31, hi = lane >> 5;
    const int srow = tid >> 3, sch = tid & 7;
    const bf16_t* xg = X + (size_t)(m0 + srow) * ldx + sch * 8;
    const bf16_t* wg = Wt + (size_t)(n0 + srow) * ldw + sch * 8;
    const int soff = srow * 128 + ((sch ^ (srow & 7)) << 4);
    uint4 xr[4], wr[2];
    auto gload = [&](int k0) {
        UNR for (int i = 0; i < 4; ++i) xr[i] = *(const uint4*)(xg + (size_t)(i * 64) * ldx + k0);
        UNR for (int i = 0; i < 2; ++i) wr[i] = *(const uint4*)(wg + (size_t)(i * 64) * ldw + k0);
    };
    auto lstore = [&](int buf) {
        char* xb = lds + buf * 32768; char* wb = lds + 65536 + buf * 16384;
        UNR for (int i = 0; i < 4; ++i) *(uint4*)(xb + i * 8192 + soff) = xr[i];
        UNR for (int i = 0; i < 2; ++i) *(uint4*)(wb + i * 8192 + soff) = wr[i];
    };
    const int nk = K / 64;
    gload(0); lstore(0); __syncthreads();
    const int aoffb = (wn * 64 + l31) * 128, boffb = (wm * 64 + l31) * 128, sw = l31 & 7;
    for (int kt = 0; kt < nk; ++kt) {
        if (kt + 1 < nk) gload((kt + 1) * 64);
        const char* xb = lds + (kt & 1) * 32768; const char* wb = lds + 65536 + (kt & 1) * 16384;
        UNR for (int ks = 0; ks < 4; ++ks) {
            const int co = (((ks * 2 + hi) ^ sw) << 4);
            bf16x8 a[2], b[2];
            UNR for (int nt = 0; nt < 2; ++nt) a[nt] = *(const bf16x8*)(wb + aoffb + nt * 4096 + co);
            UNR for (int mt = 0; mt < 2; ++mt) b[mt] = *(const bf16x8*)(xb + boffb + mt * 4096 + co);
            UNR for (int mt = 0; mt < 2; ++mt) UNR for (int nt = 0; nt < 2; ++nt) acc[mt][nt] = mfma32(a[nt], b[mt], acc[mt][nt]);
        }
        if (kt + 1 < nk) lstore((kt + 1) & 1);
        __syncthreads();
    }
}

__device__ void phase1(const Params& P, int bid, int nb, char* lds) {
    const int tid = threadIdx.x, lane = tid & 63, w = tid >> 6, wm = w >> 1, wn = w & 1, l31 = lane & 31, hi = lane >> 5;
    constexpr int NTM = R / 256, NTN = NIN / 128;
    for (int tile = bid; tile < NTM * NTN; tile += nb) {
        const int tn = tile % NTN, tm = tile / NTN; const int m0 = tm * 256, n0 = tn * 128;
        f32x16 acc[2][2]; UNR for (int i = 0; i < 2; ++i) UNR for (int j = 0; j < 2; ++j) acc[i][j] = zero16();
        { char* ws0 = P.ws; gemm_mainloop((const bf16_t*)(ws0 + WS_R1), 1024, (const bf16_t*)(ws0 + WS_WIN), 1024, 1024, m0, n0, lds, acc); }
        char* ws = P.ws; asm volatile("" : "+s"(ws));
        bf16_t* AQ = (bf16_t*)(ws + WS_R2); bf16_t* AK = AQ + (size_t)8 * 8 * TP * 64;
        bf16_t* AVT = (bf16_t*)(ws + WS_R3); bf16_t* BQ = AVT + (size_t)8 * 4 * 128 * TP;
        bf16_t* BK = (bf16_t*)(ws + WS_BK); bf16_t* BV = (bf16_t*)(ws + WS_BV); bf16_t* IK = (bf16_t*)(ws + WS_IK); float* IW = (float*)(ws + WS_IW);
        bf16_t* IQ = (bf16_t*)(ws + WS_R4); bf16_t* GA = (bf16_t*)(ws + WS_R6); bf16_t* GB = GA + (size_t)R * 1024;
        const float* c64 = (const float*)(ws + WS_COS64); const float* s64 = (const float*)(ws + WS_SIN64); const float* ic = (const float*)(ws + WS_ICOS); const float* is = (const float*)(ws + WS_ISIN);
        const int chunk = (n0 >> 6) + wn;
        UNR for (int mt = 0; mt < 2; ++mt) {
            const int m = m0 + wm * 64 + mt * 32 + l31; const int b = m / TP, t = m - b * TP;
            f32x16 x1 = acc[mt][0], x2 = acc[mt][1];
            const bool nr = (chunk < 16) || (chunk >= 24 && chunk <= 32);
            if (nr) {
                const float* gain; bf16_t* dst; float sc = 1.f;
                if (chunk < 8) { gain = P.g_aq; dst = AQ + ((size_t)(b * 8 + chunk) * TP + t) * 64; sc = QSCALE; }
                else if (chunk < 16) { gain = P.g_ak; dst = AK + ((size_t)(b * 8 + chunk - 8) * TP + t) * 64; }
                else if (chunk < 32) { gain = P.g_bq; dst = BQ + (size_t)m * 512 + (chunk - 24) * 64; sc = QSCALE; }
                else { gain = P.g_bk; dst = BK + (size_t)m * 64; }
                float ss = 0.f;
                UNR for (int r = 0; r < 16; ++r) ss += x1[r] * x1[r] + x2[r] * x2[r];
                ss += __shfl_xor(ss, 32);
                const float rinv = rsqrtf(ss * (1.0f / 64.0f) + EPS);
                UNR for (int g4 = 0; g4 < 4; ++g4) {
                    const int j = 8 * g4 + 4 * hi;
                    const f32x4 c = *(const f32x4*)(c64 + t * 32 + j), s = *(const f32x4*)(s64 + t * 32 + j);
                    const f32x4 g1 = *(const f32x4*)(gain + j), g2 = *(const f32x4*)(gain + 32 + j);
                    float o1[4], o2[4];
                    UNR for (int i = 0; i < 4; ++i) { const float y1 = x1[4 * g4 + i] * rinv * g1[i], y2 = x2[4 * g4 + i] * rinv * g2[i]; o1[i] = (y1 * c[i] - y2 * s[i]) * sc; o2[i] = (y2 * c[i] + y1 * s[i]) * sc; }
                    uint2 u1, u2; u1.x = pk2(o1[0], o1[1]); u1.y = pk2(o1[2], o1[3]); u2.x = pk2(o2[0], o2[1]); u2.y = pk2(o2[2], o2[3]);
                    *(uint2*)(dst + j) = u1; *(uint2*)(dst + 32 + j) = u2;
                }
            } else if (chunk < 24) {
                const int hd = (chunk - 16) >> 1, half = (chunk - 16) & 1;
                bf16_t* dst = AVT + ((size_t)(b * 4 + hd) * 128 + half * 64) * TP + t;
                UNR for (int r = 0; r < 16; ++r) { const int j = crow(r, hi); dst[(size_t)j * TP] = f2bf(x1[r]); dst[(size_t)(32 + j) * TP] = f2bf(x2[r]); }
            } else if (chunk == 33) {
                bf16_t* dst = BV + (size_t)m * 64;
                UNR for (int g4 = 0; g4 < 4; ++g4) { const int j = 8 * g4 + 4 * hi; uint2 u1, u2; u1.x = pk2(x1[4 * g4], x1[4 * g4 + 1]); u1.y = pk2(x1[4 * g4 + 2], x1[4 * g4 + 3]); u2.x = pk2(x2[4 * g4], x2[4 * g4 + 1]); u2.y = pk2(x2[4 * g4 + 2], x2[4 * g4 + 3]); *(uint2*)(dst + j) = u1; *(uint2*)(dst + 32 + j) = u2; }
            } else if (chunk <= 42) {
                bf16_t* dst = (chunk == 42) ? IK + (size_t)m * 64 : IQ + (size_t)m * 512 + (chunk - 34) * 64;
                float y[16];
                UNR for (int g4 = 0; g4 < 2; ++g4) {
                    const int j = 8 * g4 + 4 * hi;
                    const f32x4 c = *(const f32x4*)(ic + t * 16 + j), s = *(const f32x4*)(is + t * 16 + j);
                    UNR for (int i = 0; i < 4; ++i) { const float a = x1[4 * g4 + i], bb = x1[4 * g4 + i + 8]; y[4 * g4 + i] = a * c[i] - bb * s[i]; y[4 * g4 + i + 8] = bb * c[i] + a * s[i]; }
                }
                UNR for (int g4 = 0; g4 < 4; ++g4) { const int j = 8 * g4 + 4 * hi; uint2 u1, u2; u1.x = pk2(y[4 * g4], y[4 * g4 + 1]); u1.y = pk2(y[4 * g4 + 2], y[4 * g4 + 3]); u2.x = pk2(x2[4 * g4], x2[4 * g4 + 1]); u2.y = pk2(x2[4 * g4 + 2], x2[4 * g4 + 3]); *(uint2*)(dst + j) = u1; *(uint2*)(dst + 32 + j) = u2; }
            } else if (chunk == 43) {
                const float sc = 0.35355339059327373f * 0.125f;
                f32x4 o = {x1[0] * sc, x1[1] * sc, x1[2] * sc, x1[3] * sc};
                *(f32x4*)(IW + (size_t)m * 8 + 4 * hi) = o;
            } else {
                bf16_t* dst = (chunk < 60) ? GA + (size_t)m * 1024 + (chunk - 44) * 64 : GB + (size_t)m * 1024 + (chunk - 60) * 64;
                UNR for (int g4 = 0; g4 < 4; ++g4) {
                    const int j = 8 * g4 + 4 * hi; float o1[4], o2[4];
                    UNR for (int i = 0; i < 4; ++i) { o1[i] = 1.0f / (1.0f + __expf(-x1[4 * g4 + i])); o2[i] = 1.0f / (1.0f + __expf(-x2[4 * g4 + i])); }
                    uint2 u1, u2; u1.x = pk2(o1[0], o1[1]); u1.y = pk2(o1[2], o1[3]); u2.x = pk2(o2[0], o2[1]); u2.y = pk2(o2[2], o2[3]);
                    *(uint2*)(dst + j) = u1; *(uint2*)(dst + 32 + j) = u2;
                }
            }
        }
    }
}

__device__ void attnA_unit(const Params& P, int b, int head, int qb, char* lds) {
    const int tid = opaque_tid(), lane = tid & 63, w = tid >> 6, qg = w & 3, st = w >> 2, l31 = lane & 31, hi = lane >> 5;
    char* ws = P.ws;
    const bf16_t* AQ = (const bf16_t*)(ws + WS_R2); const bf16_t* AK = AQ + (size_t)8 * 8 * TP * 64; const bf16_t* AVT = (const bf16_t*)(ws + WS_R3);
    bf16_t* AOUT = (bf16_t*)(ws + WS_R1);
    const float lam = ((const float*)(ws + WS_CTL))[4];
    const int q0 = qb * 128 + qg * 32;
    const bf16_t* Qp = AQ + ((size_t)(b * 8 + head * 2 + st) * TP + q0 + l31) * 64;
    bf16x8 qf[4];
    UNR for (int ks = 0; ks < 4; ++ks) qf[ks] = *(const bf16x8*)(Qp + ks * 16 + hi * 8);
    const bf16_t* K0g = AK + (size_t)(b * 8 + head * 2) * TP * 64; const bf16_t* K1g = K0g + (size_t)TP * 64;
    const bf16_t* Vg = AVT + (size_t)(b * 4 + head) * 128 * TP;
    const int nkt = 2 * (qb + 1);
    const int srow = tid >> 3, sch = tid & 7;
    const int koff = srow * 128 + ((sch ^ (srow & 7)) << 4), voff = srow * 128 + ((sch ^ ((srow >> 1) & 7)) << 4);
    uint4 sr[4];
    auto gload = [&](int kt) {
        const int key0 = kt * 64;
        sr[0] = *(const uint4*)(K0g + (size_t)(key0 + srow) * 64 + sch * 8);
        sr[1] = *(const uint4*)(K1g + (size_t)(key0 + srow) * 64 + sch * 8);
        sr[2] = *(const uint4*)(Vg + (size_t)srow * TP + key0 + sch * 8);
        sr[3] = *(const uint4*)(Vg + (size_t)(srow + 64) * TP + key0 + sch * 8);
    };
    auto lstore = [&](int buf) {
        char* base = lds + buf * 32768;
        *(uint4*)(base + koff) = sr[0]; *(uint4*)(base + 8192 + koff) = sr[1];
        *(uint4*)(base + 16384 + voff) = sr[2]; *(uint4*)(base + 16384 + 8192 + voff) = sr[3];
    };
    f32x16 o[4]; UNR for (int i = 0; i < 4; ++i) o[i] = zero16();
    float mrun = -INFINITY, lrun = 0.f;
    gload(0); lstore(0); __syncthreads();
    const int qpos = q0 + l31;
    for (int kt = 0; kt < nkt; ++kt) {
        if (kt + 1 < nkt) gload(kt + 1);
        const char* base = lds + (kt & 1) * 32768; const char* Kb = base + st * 8192; const char* Vb = base + 16384;
        f32x16 s0 = zero16(), s1 = zero16();
        UNR for (int ks = 0; ks < 4; ++ks) {
            const int co = (((ks * 2 + hi) ^ (l31 & 7)) << 4);
            const bf16x8 a0 = *(const bf16x8*)(Kb + l31 * 128 + co), a1 = *(const bf16x8*)(Kb + (32 + l31) * 128 + co);
            s0 = mfma32(a0, qf[ks], s0); s1 = mfma32(a1, qf[ks], s1);
        }
        if (kt >= nkt - 2) {
            const int kbase = kt * 64;
            UNR for (int r = 0; r < 16; ++r) { const int key = kbase + crow(r, hi); if (key > qpos) s0[r] = -INFINITY; if (key + 32 > qpos) s1[r] = -INFINITY; }
        }
        float mx = s0[0];
        UNR for (int r = 1; r < 16; ++r) mx = fmaxf(mx, s0[r]);
        UNR for (int r = 0; r < 16; ++r) mx = fmaxf(mx, s1[r]);
        mx = fmaxf(mx, __shfl_xor(mx, 32));
        const float mn = fmaxf(mrun, mx);
        const float alpha = ex2(mrun - mn);
        mrun = mn;
        float ls = 0.f;
        UNR for (int r = 0; r < 16; ++r) { s0[r] = ex2(s0[r] - mn); s1[r] = ex2(s1[r] - mn); ls += s0[r] + s1[r]; }
        lrun = lrun * alpha + ls;
        if (!__all(alpha == 1.0f)) { UNR for (int mt = 0; mt < 4; ++mt) UNR for (int r = 0; r < 16; ++r) o[mt][r] *= alpha; }
        bf16x8 pb[2][2];
        pb[0][0] = pack8(s0[0], s0[1], s0[2], s0[3], s0[4], s0[5], s0[6], s0[7]); pb[0][1] = pack8(s0[8], s0[9], s0[10], s0[11], s0[12], s0[13], s0[14], s0[15]);
        pb[1][0] = pack8(s1[0], s1[1], s1[2], s1[3], s1[4], s1[5], s1[6], s1[7]); pb[1][1] = pack8(s1[8], s1[9], s1[10], s1[11], s1[12], s1[13], s1[14], s1[15]);
        UNR for (int mt = 0; mt < 4; ++mt) {
            const int d = mt * 32 + l31; const int sw = (d >> 1) & 7; const char* rowp = Vb + d * 128 + 8 * hi;
            UNR for (int k2 = 0; k2 < 2; ++k2)
                UNR for (int s = 0; s < 2; ++s) {
                    const int c0 = k2 * 4 + 2 * s;
                    const s16x4 lo = *(const s16x4*)(rowp + ((c0 ^ sw) << 4)), h4 = *(const s16x4*)(rowp + (((c0 + 1) ^ sw) << 4));
                    const bf16x8 a = {lo[0], lo[1], lo[2], lo[3], h4[0], h4[1], h4[2], h4[3]};
                    o[mt] = mfma32(a, pb[k2][s], o[mt]);
                }
        }
        if (kt + 1 < nkt) lstore((kt + 1) & 1);
        __syncthreads();
    }
    lrun += __shfl_xor(lrun, 32);
    const float inv = 1.0f / lrun;
    float* ex = (float*)lds + qg * 4096;
    if (st == 1) { const float f = inv * lam; UNR for (int mt = 0; mt < 4; ++mt) UNR for (int r = 0; r < 16; ++r) ex[(mt * 16 + r) * 64 + lane] = o[mt][r] * f; }
    __syncthreads();
    if (st == 0) {
        float ss = 0.f;
        UNR for (int mt = 0; mt < 4; ++mt) UNR for (int r = 0; r < 16; ++r) { const float v = o[mt][r] * inv - ex[(mt * 16 + r) * 64 + lane]; o[mt][r] = v; ss += v * v; }
        ss += __shfl_xor(ss, 32);
        const float rinv = rsqrtf(ss * (1.0f / 128.0f) + EPS) * 0.8f;
        bf16_t* dst = AOUT + (size_t)(b * TP + q0 + l31) * 512 + head * 128;
        UNR for (int mt = 0; mt < 4; ++mt) UNR for (int g4 = 0; g4 < 4; ++g4) {
            const int d = mt * 32 + 8 * g4 + 4 * hi; const f32x4 g = *(const f32x4*)(P.g_sub + d);
            uint2 u; u.x = pk2(o[mt][4 * g4] * rinv * g[0], o[mt][4 * g4 + 1] * rinv * g[1]); u.y = pk2(o[mt][4 * g4 + 2] * rinv * g[2], o[mt][4 * g4 + 3] * rinv * g[3]);
            *(uint2*)(dst + d) = u;
        }
    }
    __syncthreads();
}

constexpr int DSA_C = 448;
constexpr int DS_SEL = 0, DS_CAND = 8192, DS_VST = 65536, DS_STATE = 131072;
__device__ __forceinline__ unsigned ord32(float s) { const unsigned u = __float_as_uint(s); return (u & 0x80000000u) ? ~u : (u | 0x80000000u); }

__device__ void dsa_unit(const Params& P, int b, int q16, char* lds) {
    const int tid = opaque_tid(), lane = tid & 63, w = tid >> 6, n15 = lane & 15, g = lane >> 4;
    char* ws = P.ws;
    const bf16_t* BQ = (const bf16_t*)(ws + WS_R3) + (size_t)8 * 4 * 128 * TP;
    const bf16_t* BK = (const bf16_t*)(ws + WS_BK); const bf16_t* BV = (const bf16_t*)(ws + WS_BV); const bf16_t* IK = (const bf16_t*)(ws + WS_IK);
    const float* IW = (const float*)(ws + WS_IW); const bf16_t* IQ = (const bf16_t*)(ws + WS_R4);
    bf16_t* BOUT = (bf16_t*)(ws + WS_R1) + (size_t)R * 512;
    unsigned* HIST = (unsigned*)lds;
    unsigned short* SEL = (unsigned short*)(lds + DS_SEL); u64* CAND = (u64*)(lds + DS_CAND);
    u64* s_pfx = (u64*)(lds + DS_STATE); int* s_need = (int*)(lds + DS_STATE + 256); int* s_pop = (int*)(lds + DS_STATE + 384);
    unsigned* s_selcnt = (unsigned*)(lds + DS_STATE + 512); unsigned* s_candcnt = (unsigned*)(lds + DS_STATE + 640); int* s_all = (int*)(lds + DS_STATE + 768);
    const int q0 = q16 * 16; const int qpos = q0 + n15; const size_t qrow = (size_t)b * TP + qpos;
    const int nk = q16 + 1;
    bf16x8 iqf[8][2];
    UNR for (int h = 0; h < 8; ++h) UNR for (int s = 0; s < 2; ++s) iqf[h][s] = *(const bf16x8*)(IQ + qrow * 512 + h * 64 + s * 32 + g * 8);
    float iw[8];
    { const f32x4 a = *(const f32x4*)(IW + qrow * 8), c = *(const f32x4*)(IW + qrow * 8 + 4); iw[0] = a[0]; iw[1] = a[1]; iw[2] = a[2]; iw[3] = a[3]; iw[4] = c[0]; iw[5] = c[1]; iw[6] = c[2]; iw[7] = c[3]; }
    auto scores = [&](int kt, f32x4& sc) {
        const bf16_t* ikp = IK + ((size_t)b * TP + kt * 16 + n15) * 64 + g * 8;
        const bf16x8 k0 = *(const bf16x8*)ikp, k1 = *(const bf16x8*)(ikp + 32);
        sc = (f32x4){0.f, 0.f, 0.f, 0.f};
        UNR for (int h = 0; h < 8; ++h) {
            f32x4 a = {0.f, 0.f, 0.f, 0.f};
            a = mfma16(k0, iqf[h][0], a); a = mfma16(k1, iqf[h][1], a);
            UNR for (int e = 0; e < 4; ++e) sc[e] += iw[h] * fmaxf(a[e], 0.f);
        }
        UNR for (int e = 0; e < 4; ++e) sc[e] += 0.0f;
    };
    if (tid < 16) { unsigned z = 0u; asm volatile("" : "+v"(z)); ((unsigned*)s_pfx)[2 * tid] = z; ((unsigned*)s_pfx)[2 * tid + 1] = z; s_need[tid] = 256; s_pop[tid] = (int)z; s_all[tid] = (int)z; }
    int sh = 45;
    for (;;) {
        const int nbits = sh < 11 ? sh : 11; const int mask = (1 << nbits) - 1;
        { uint4 z = {0u, 0u, 0u, 0u}; for (int i = tid; i < 4096; i += NTHREADS) ((uint4*)lds)[i] = z; }
        __syncthreads();
        const u64 mypfx = s_pfx[n15]; const int myall = s_all[n15];
        for (int kt = w; kt < nk; kt += 8) {
            f32x4 sc; scores(kt, sc);
            const bool diag = (kt == nk - 1);
            UNR for (int e = 0; e < 4; ++e) {
                const int idx = kt * 16 + 4 * g + e;
                if ((!diag || idx <= qpos) && !myall) {
                    const u64 comp = ((u64)ord32(sc[e]) << 13) | (u64)(8191 - idx);
                    if ((comp >> sh) == mypfx) { const int ib = mask - (int)((comp >> (sh - nbits)) & (u64)mask); atomicAdd(&HIST[n15 * 1024 + (ib >> 1)], 1u << ((ib & 1) * 16)); }
                }
            }
        }
        __syncthreads();
        UNR for (int i = 0; i < 2; ++i) {
            const int ql = w * 2 + i;
            if (s_all[ql]) continue;
            const unsigned* hq = HIST + ql * 1024 + lane * 16;
            unsigned wd[16]; unsigned c = 0;
            UNR for (int j = 0; j < 16; ++j) { wd[j] = hq[j]; c += (wd[j] & 0xffffu) + (wd[j] >> 16); }
            unsigned pre = c;
            UNR for (int o = 1; o < 64; o <<= 1) { const unsigned t = __shfl_up(pre, o); if (lane >= o) pre += t; }
            const unsigned nd = (unsigned)s_need[ql];
            const u64 bal = __ballot(pre >= nd);
            if (bal == 0ull) { if (lane == 0) { s_all[ql] = 1; s_pop[ql] = 0; s_need[ql] = 0; } }
            else {
                const int Lc = __ffsll((long long)bal) - 1;
                if (lane == Lc) {
                    unsigned cum = pre - c; int ibs = -1; unsigned cntb = 0;
                    UNR for (int j = 0; j < 32; ++j) { const unsigned cnt = (wd[j >> 1] >> ((j & 1) * 16)) & 0xffffu; if (ibs < 0) { if (cum + cnt >= nd) { ibs = lane * 32 + j; cntb = cnt; } else cum += cnt; } }
                    s_pfx[ql] = (s_pfx[ql] << nbits) | (u64)(mask - ibs); s_need[ql] = (int)(nd - cum); s_pop[ql] = (int)cntb;
                }
            }
        }
        __syncthreads();
        sh -= nbits;
        int mp = 0; UNR for (int q = 0; q < 16; ++q) mp = max(mp, s_pop[q]);
        if (mp <= DSA_C || sh == 0) break;
    }
    if (tid < 16) { s_selcnt[tid] = 0u; s_candcnt[tid] = 0u; }
    __syncthreads();
    {
        const u64 mypfx = s_pfx[n15]; const int myall = s_all[n15];
        for (int kt = w; kt < nk; kt += 8) {
            f32x4 sc; scores(kt, sc);
            const bool diag = (kt == nk - 1);
            UNR for (int e = 0; e < 4; ++e) {
                const int idx = kt * 16 + 4 * g + e;
                if (!diag || idx <= qpos) {
                    const u64 comp = ((u64)ord32(sc[e]) << 13) | (u64)(8191 - idx); const u64 top = comp >> sh;
                    if (myall || top > mypfx) { const unsigned pos = atomicAdd(&s_selcnt[n15], 1u); if (pos < 256u) SEL[n15 * 256 + pos] = (unsigned short)idx; }
                    else if (top == mypfx) { const unsigned cp = atomicAdd(&s_candcnt[n15], 1u); if (cp < (unsigned)DSA_C) CAND[n15 * DSA_C + cp] = comp; }
                }
            }
        }
    }
    __syncthreads();
    UNR for (int i = 0; i < 2; ++i) {
        const int ql = w * 2 + i; const int n = min((int)s_candcnt[ql], DSA_C); const int nd = s_need[ql];
        for (int c = lane; c < n; c += 64) {
            const u64 ci = CAND[ql * DSA_C + c]; int rank = 0;
            for (int j = 0; j < n; ++j) rank += (CAND[ql * DSA_C + j] > ci) ? 1 : 0;
            if (rank < nd) { const unsigned pos = atomicAdd(&s_selcnt[ql], 1u); if (pos < 256u) SEL[ql * 256 + pos] = (unsigned short)(8191 - (int)(ci & 8191ull)); }
        }
    }
    __syncthreads();
    {
        typedef __attribute__((address_space(3))) s16x4 lds_s16x4;
        char* vl = lds + DS_VST + w * 8192;
        const int hq = n15 & 7;
        UNR for (int i = 0; i < 2; ++i) {
            const int ql = w * 2 + i; const size_t row = (size_t)b * TP + q0 + ql; const int nsel = min((int)s_selcnt[ql], 256);
            const unsigned short* sel = SEL + ql * 256;
            bf16x8 bqf[2];
            UNR for (int s = 0; s < 2; ++s) bqf[s] = *(const bf16x8*)(BQ + row * 512 + hq * 64 + s * 32 + g * 8);
            f32x4 S[16];
            UNR for (int c = 0; c < 4; ++c) {
                bf16x8 kf[4][2];
                UNR for (int t = 0; t < 4; ++t) { const int slot = c * 64 + t * 16 + n15; const int kid = slot < nsel ? (int)sel[slot] : 0; const bf16_t* kp = BK + ((size_t)b * TP + kid) * 64 + g * 8; kf[t][0] = *(const bf16x8*)kp; kf[t][1] = *(const bf16x8*)(kp + 32); }
                UNR for (int t = 0; t < 4; ++t) { f32x4 a = {0.f, 0.f, 0.f, 0.f}; a = mfma16(kf[t][0], bqf[0], a); a = mfma16(kf[t][1], bqf[1], a); S[c * 4 + t] = a; }
                __builtin_amdgcn_sched_barrier(0);
            }
            float mx = -INFINITY;
            UNR for (int t = 0; t < 16; ++t) UNR for (int e = 0; e < 4; ++e) { if (t * 16 + 4 * g + e >= nsel) S[t][e] = -INFINITY; mx = fmaxf(mx, S[t][e]); }
            mx = fmaxf(mx, __shfl_xor(mx, 16)); mx = fmaxf(mx, __shfl_xor(mx, 32));
            float ls = 0.f;
            UNR for (int t = 0; t < 16; ++t) UNR for (int e = 0; e < 4; ++e) { S[t][e] = ex2(S[t][e] - mx); ls += S[t][e]; }
            ls += __shfl_xor(ls, 16); ls += __shfl_xor(ls, 32);
            bf16x8 pb[8];
            UNR for (int u = 0; u < 8; ++u) pb[u] = pack8(S[2 * u][0], S[2 * u][1], S[2 * u][2], S[2 * u][3], S[2 * u + 1][0], S[2 * u + 1][1], S[2 * u + 1][2], S[2 * u + 1][3]);
            f32x4 o[4]; UNR for (int mt = 0; mt < 4; ++mt) o[mt] = (f32x4){0.f, 0.f, 0.f, 0.f};
            UNR for (int c = 0; c < 4; ++c) {
                uint4 vr[8];
                UNR for (int k = 0; k < 8; ++k) { const int rowl = k * 8 + (lane >> 3); const int slot = c * 64 + rowl; const int kid = slot < nsel ? (int)sel[slot] : 0; vr[k] = *(const uint4*)(BV + ((size_t)b * TP + kid) * 64 + (lane & 7) * 8); }
                UNR for (int k = 0; k < 8; ++k) { const int rowl = k * 8 + (lane >> 3); *(uint4*)(vl + rowl * 128 + ((((lane & 7)) ^ (((rowl >> 1) & 3) << 1)) << 4)) = vr[k]; }
                __builtin_amdgcn_s_waitcnt(0xc07f);
                const int qq = n15 >> 2, pp = n15 & 3;
                UNR for (int us = 0; us < 2; ++us) {
                    const int row0 = (2 * us) * 16 + 4 * g + qq, row1 = row0 + 16;
                    UNR for (int mt = 0; mt < 4; ++mt) {
                        const int ch = 2 * mt + (pp >> 1);
                        const char* a0 = vl + row0 * 128 + ((ch ^ (((row0 >> 1) & 3) << 1)) << 4) + 8 * (pp & 1);
                        const char* a1 = vl + row1 * 128 + ((ch ^ (((row1 >> 1) & 3) << 1)) << 4) + 8 * (pp & 1);
                        const s16x4 lo = __builtin_amdgcn_ds_read_tr16_b64_v4i16((lds_s16x4*)a0);
                        const s16x4 h4 = __builtin_amdgcn_ds_read_tr16_b64_v4i16((lds_s16x4*)a1);
                        const bf16x8 a = {lo[0], lo[1], lo[2], lo[3], h4[0], h4[1], h4[2], h4[3]};
                        o[mt] = mfma16(a, pb[2 * c + us], o[mt]);
                    }
                }
                __builtin_amdgcn_s_waitcnt(0xc07f);
                __builtin_amdgcn_sched_barrier(0);
            }
            const float inv = 1.0f / ls;
            if (n15 < 8) {
                bf16_t* dst = BOUT + row * 512 + n15 * 64;
                UNR for (int mt = 0; mt < 4; ++mt) { uint2 u; u.x = pk2(o[mt][0] * inv, o[mt][1] * inv); u.y = pk2(o[mt][2] * inv, o[mt][3] * inv); *(uint2*)(dst + mt * 16 + 4 * g) = u; }
            }
        }
    }
    __syncthreads();
}

__device__ void phase2(const Params& P, char* lds) {
    unsigned* ctr = (unsigned*)(P.ws + WS_CTL);
    int* s_u = (int*)(lds + DS_STATE + 1024);
    constexpr int NA = BATCH * 4 * 33, NB = BATCH * 257;
    for (;;) {
        if (threadIdx.x == 0) *s_u = (int)atomicAdd(ctr, 1u);
        __syncthreads();
        const int u = *s_u;
        __syncthreads();
        if (u >= NA + NB) break;
        if (u < NA) { const int qb = 32 - u / 32, rem = u % 32; attnA_unit(P, rem >> 2, rem & 3, qb, lds); }
        else { const int v = u - NA; dsa_unit(P, v % 8, 256 - v / 8, lds); }
    }
}

__device__ void phase3(const Params& P, int bid, int nb, char* lds) {
    const int tid = threadIdx.x, lane = tid & 63, w = tid >> 6, wm = w >> 1, wn = w & 1, l31 = lane & 31, hi = lane >> 5;
    char* ws = P.ws;
    const bf16_t* AOUT = (const bf16_t*)(ws + WS_R1); const bf16_t* BOUT = AOUT + (size_t)R * 512;
    const bf16_t* WA = (const bf16_t*)(ws + WS_WA); const bf16_t* WB = (const bf16_t*)(ws + WS_WB);
    const bf16_t* GA = (const bf16_t*)(ws + WS_R6); const bf16_t* GB = GA + (size_t)R * 1024;
    bf16_t* MIXED = (bf16_t*)(ws + WS_R2);
    constexpr int NTM = R / 256, NTN = 8;
    for (int tile = bid; tile < NTM * NTN; tile += nb) {
        const int tn = tile % NTN, tm = tile / NTN; const int m0 = tm * 256, n0 = tn * 128;
        f32x16 acc[2][2], tmp[2][2];
        UNR for (int i = 0; i < 2; ++i) UNR for (int j = 0; j < 2; ++j) acc[i][j] = zero16();
        gemm_mainloop(AOUT, 512, WA, 512, 512, m0, n0, lds, acc);
        UNR for (int mt = 0; mt < 2; ++mt) UNR for (int nt = 0; nt < 2; ++nt) {
            const bf16_t* gp = GA + (size_t)(m0 + wm * 64 + mt * 32 + l31) * 1024 + n0 + wn * 64 + nt * 32 + 4 * hi;
            UNR for (int g4 = 0; g4 < 4; ++g4) { const uint2 u = *(const uint2*)(gp + 8 * g4); tmp[mt][nt][4 * g4] = acc[mt][nt][4 * g4] * bf2f(u.x & 0xffffu); tmp[mt][nt][4 * g4 + 1] = acc[mt][nt][4 * g4 + 1] * bf2f(u.x >> 16); tmp[mt][nt][4 * g4 + 2] = acc[mt][nt][4 * g4 + 2] * bf2f(u.y & 0xffffu); tmp[mt][nt][4 * g4 + 3] = acc[mt][nt][4 * g4 + 3] * bf2f(u.y >> 16); }
            acc[mt][nt] = zero16();
        }
        gemm_mainloop(BOUT, 512, WB, 512, 512, m0, n0, lds, acc);
        UNR for (int mt = 0; mt < 2; ++mt) UNR for (int nt = 0; nt < 2; ++nt) {
            const size_t off = (size_t)(m0 + wm * 64 + mt * 32 + l31) * 1024 + n0 + wn * 64 + nt * 32 + 4 * hi;
            UNR for (int g4 = 0; g4 < 4; ++g4) {
                const uint2 u = *(const uint2*)(GB + off + 8 * g4);
                const float v0 = tmp[mt][nt][4 * g4] + acc[mt][nt][4 * g4] * bf2f(u.x & 0xffffu), v1 = tmp[mt][nt][4 * g4 + 1] + acc[mt][nt][4 * g4 + 1] * bf2f(u.x >> 16);
                const float v2 = tmp[mt][nt][4 * g4 + 2] + acc[mt][nt][4 * g4 + 2] * bf2f(u.y & 0xffffu), v3 = tmp[mt][nt][4 * g4 + 3] + acc[mt][nt][4 * g4 + 3] * bf2f(u.y >> 16);
                uint2 o; o.x = pk2(v0, v1); o.y = pk2(v2, v3); *(uint2*)(MIXED + off + 8 * g4) = o;
            }
        }
    }
    {
        bf16_t* UT = (bf16_t*)(ws + WS_R3); bf16_t* VT = UT + (size_t)NEXP * 1024;
        const size_t n4 = (size_t)NEXP * 1024 / 4;
        for (size_t i = (size_t)bid * NTHREADS + tid; i < n4; i += (size_t)nb * NTHREADS) {
            const f32x4 a = *(const f32x4*)(P.pu + i * 4), c = *(const f32x4*)(P.pv + i * 4);
            uint2 o; o.x = pk2(a[0], a[1]); o.y = pk2(a[2], a[3]); *(uint2*)(UT + i * 4) = o;
            o.x = pk2(c[0], c[1]); o.y = pk2(c[2], c[3]); *(uint2*)(VT + i * 4) = o;
        }
    }
}

__device__ void phase4(const Params& P, int bid, int nb, char* lds) {
    const int tid = threadIdx.x, lane = tid & 63, w = tid >> 6, wm = w >> 1, wn = w & 1, l31 = lane & 31, hi = lane >> 5;
    char* ws = P.ws;
    const bf16_t* MIXED = (const bf16_t*)(ws + WS_R2); const bf16_t* WO = (const bf16_t*)(ws + WS_WO);
    float* H2 = (float*)(ws + WS_R6); bf16_t* H2G = (bf16_t*)(ws + WS_R1); float* ROWSS = (float*)(ws + WS_ROWSS);
    constexpr int NTM = R / 256, NTN = 8;
    for (int tile = bid; tile < NTM * NTN; tile += nb) {
        const int tn = tile % NTN, tm = tile / NTN; const int m0 = tm * 256, n0 = tn * 128;
        f32x16 acc[2][2];
        UNR for (int i = 0; i < 2; ++i) UNR for (int j = 0; j < 2; ++j) acc[i][j] = zero16();
        gemm_mainloop(MIXED, 1024, WO, 1024, 1024, m0, n0, lds, acc);
        UNR for (int mt = 0; mt < 2; ++mt) {
            const int m = m0 + wm * 64 + mt * 32 + l31; const int b = m / TP, t = m - b * TP;
            const float* hsrc = (t < NMETA) ? P.meta + (size_t)t * DM : P.x + ((size_t)b * SEQ + (t - NMETA)) * DM;
            const bool real = t < TR;
            float ss = 0.f;
            UNR for (int nt = 0; nt < 2; ++nt) UNR for (int g4 = 0; g4 < 4; ++g4) {
                const int col = n0 + wn * 64 + nt * 32 + 8 * g4 + 4 * hi;
                f32x4 hv = {0.f, 0.f, 0.f, 0.f}; if (real) hv = *(const f32x4*)(hsrc + col);
                const f32x4 gg = *(const f32x4*)(P.g_ffn + col);
                f32x4 v; UNR for (int i = 0; i < 4; ++i) { v[i] = hv[i] + acc[mt][nt][4 * g4 + i]; ss += v[i] * v[i]; }
                *(f32x4*)(H2 + (size_t)m * 1024 + col) = v;
                uint2 o; o.x = pk2(v[0] * gg[0], v[1] * gg[1]); o.y = pk2(v[2] * gg[2], v[3] * gg[3]); *(uint2*)(H2G + (size_t)m * 1024 + col) = o;
            }
            ss += __shfl_xor(ss, 32);
            if (hi == 0) atomicAdd(ROWSS + m, ss);
        }
    }
}

__device__ __forceinline__ void ins16(float (&a)[16], float v) {
    float n[16]; n[0] = fmaxf(a[0], v);
    UNR for (int p = 1; p < 16; ++p) n[p] = __builtin_amdgcn_fmed3f(a[p - 1], a[p], v);
    UNR for (int p = 0; p < 16; ++p) a[p] = n[p];
}
constexpr int P6_TOPS = 98304;
__device__ void phase6(const Params& P, int bid, int nb, char* lds) {
    const int tid = threadIdx.x, lane = tid & 63, w = tid >> 6, wm = w >> 1, wn = w & 1, l31 = lane & 31, hi = lane >> 5;
    char* ws = P.ws;
    const bf16_t* H2G = (const bf16_t*)(ws + WS_R1); const bf16_t* WQ = (const bf16_t*)(ws + WS_WQ); const bf16_t* SUBK = (const bf16_t*)(ws + WS_SUBK);
    const float* ROWSS = (const float*)(ws + WS_ROWSS);
    int* EIDX = (int*)(ws + WS_R4); float* EG = (float*)(ws + WS_R4 + (size_t)R * 128 * 4);
    float* TOPS = (float*)(lds + P6_TOPS);
    constexpr int NTM = R / 256, NTN = 8;
    for (int tile = bid; tile < NTM * NTN; tile += nb) {
        const int head = tile % NTN, tm = tile / NTN; const int m0 = tm * 256, n0 = head * 128;
        f32x16 acc[2][2];
        UNR for (int i = 0; i < 2; ++i) UNR for (int j = 0; j < 2; ++j) acc[i][j] = zero16();
        gemm_mainloop(H2G, 1024, WQ, 1024, 1024, m0, n0, lds, acc);
        const bf16_t* sk = SUBK + (size_t)(head * 2 + wn) * 128 * 64;
        UNR for (int mt = 0; mt < 2; ++mt) {
            const int tl = wm * 64 + mt * 32 + l31; const int m = m0 + tl;
            const float rinv = rsqrtf(ROWSS[m] * (1.0f / DM) + EPS);
            bf16x8 qb[4];
            UNR for (int s = 0; s < 4; ++s) { const int nt = s >> 1, r0 = 8 * (s & 1); const f32x16& a = acc[mt][nt];
                qb[s] = pack8(a[r0] * rinv, a[r0 + 1] * rinv, a[r0 + 2] * rinv, a[r0 + 3] * rinv, a[r0 + 4] * rinv, a[r0 + 5] * rinv, a[r0 + 6] * rinv, a[r0 + 7] * rinv); }
            float top[16];
            UNR for (int p = 0; p < 16; ++p) top[p] = -INFINITY;
            UNR for (int kt = 0; kt < 4; ++kt) {
                f32x16 S = zero16();
                UNR for (int s = 0; s < 4; ++s) {
                    const bf16_t* kp = sk + (size_t)(kt * 32 + l31) * 64 + (s >> 1) * 32 + 16 * (s & 1) + 4 * hi;
                    const s16x4 lo = *(const s16x4*)kp, h4 = *(const s16x4*)(kp + 8);
                    const bf16x8 a = {lo[0], lo[1], lo[2], lo[3], h4[0], h4[1], h4[2], h4[3]};
                    S = mfma32(a, qb[s], S);
                }
                UNR for (int r = 0; r < 16; ++r) { const unsigned key = (unsigned)(kt * 32 + crow(r, hi)); ins16(top, __uint_as_float((__float_as_uint(S[r]) & ~127u) | key)); }
            }
            float oth[16];
            UNR for (int p = 0; p < 16; ++p) oth[p] = __shfl_xor(top[p], 32);
            UNR for (int p = 0; p < 16; ++p) ins16(top, oth[p]);
            if (hi == 0) { UNR for (int p = 0; p < 16; p += 4) *(f32x4*)(TOPS + (tl * 2 + wn) * 16 + p) = (f32x4){top[p], top[p + 1], top[p + 2], top[p + 3]}; }
        }
        __syncthreads();
        if (tid < 256) {
            const int tl = tid; const int m = m0 + tl;
            float s1[16], s2[16];
            UNR for (int p = 0; p < 16; p += 4) { const f32x4 a = *(const f32x4*)(TOPS + (tl * 2) * 16 + p), c = *(const f32x4*)(TOPS + (tl * 2 + 1) * 16 + p); UNR for (int i = 0; i < 4; ++i) { s1[p + i] = a[i]; s2[p + i] = c[i]; } }
            float v1[16], v2[16];
            UNR for (int p = 0; p < 16; ++p) { v1[p] = __uint_as_float(__float_as_uint(s1[p]) & ~127u); v2[p] = __uint_as_float(__float_as_uint(s2[p]) & ~127u); }
            float top[16];
            UNR for (int p = 0; p < 16; ++p) top[p] = -INFINITY;
            UNR for (int a = 0; a < 16; ++a)
                UNR for (int c = 0; c < 16; ++c)
                    if ((a + 1) * (c + 1) <= 16) ins16(top, __uint_as_float((__float_as_uint(v1[a] + v2[c]) & ~255u) | (unsigned)(a * 16 + c)));
            float vs[16]; int ex[16]; float mx = -INFINITY;
            UNR for (int p = 0; p < 16; ++p) {
                const unsigned id = __float_as_uint(top[p]) & 255u; const int a = id >> 4, c = id & 15;
                const unsigned pa = __float_as_uint(TOPS[(tl * 2) * 16 + a]), pc = __float_as_uint(TOPS[(tl * 2 + 1) * 16 + c]);
                vs[p] = __uint_as_float(pa & ~127u) + __uint_as_float(pc & ~127u); ex[p] = (int)(pa & 127u) * 128 + (int)(pc & 127u); mx = fmaxf(mx, vs[p]);
            }
            float sum = 0.f;
            UNR for (int p = 0; p < 16; ++p) { vs[p] = __expf(vs[p] - mx); sum += vs[p]; }
            const float inv = 1.0f / sum;
            UNR for (int p = 0; p < 16; p += 4) {
                *(int4*)(EIDX + (size_t)m * 128 + head * 16 + p) = make_int4(ex[p], ex[p + 1], ex[p + 2], ex[p + 3]);
                *(f32x4*)(EG + (size_t)m * 128 + head * 16 + p) = (f32x4){vs[p] * inv, vs[p + 1] * inv, vs[p + 2] * inv, vs[p + 3] * inv};
            }
        }
        __syncthreads();
    }
}

__device__ void phase7(const Params& P, int bid, int nb) {
    const int tid = threadIdx.x, lane = tid & 63, w = tid >> 6;
    char* ws = P.ws;
    const bf16_t* H2G = (const bf16_t*)(ws + WS_R1); const float* H2 = (const float*)(ws + WS_R6); const float* ROWSS = (const float*)(ws + WS_ROWSS);
    const int* EIDX = (const int*)(ws + WS_R4); const float* EG = (const float*)(ws + WS_R4 + (size_t)R * 128 * 4);
    const bf16_t* UT = (const bf16_t*)(ws + WS_R3); const bf16_t* VT = UT + (size_t)NEXP * 1024;
    for (int tok = bid * 8 + w; tok < BATCH * SEQ; tok += nb * 8) {
        const int b = tok / SEQ, s = tok - b * SEQ; const size_t m = (size_t)b * TP + NMETA + s;
        const float rinv = rsqrtf(ROWSS[m] * (1.0f / DM) + EPS);
        float xf[16];
        { const uint4 a = *(const uint4*)(H2G + m * 1024 + lane * 8), c = *(const uint4*)(H2G + m * 1024 + 512 + lane * 8);
          const unsigned ua[8] = {a.x, a.y, a.z, a.w, c.x, c.y, c.z, c.w};
          UNR for (int i = 0; i < 8; ++i) { xf[2 * i] = bf2f(ua[i] & 0xffffu) * rinv; xf[2 * i + 1] = bf2f(ua[i] >> 16) * rinv; } }
        const int e0 = EIDX[m * 128 + lane], e1 = EIDX[m * 128 + 64 + lane];
        const float g0 = EG[m * 128 + lane], g1 = EG[m * 128 + 64 + lane];
        float c0 = 0.f, c1 = 0.f;
        _Pragma("nounroll") for (int k0 = 0; k0 < 128; k0 += 8) {
            float part[8];
            UNR for (int j = 0; j < 8; ++j) {
                const int k = k0 + j; const int e = __builtin_amdgcn_readlane(k < 64 ? e0 : e1, k & 63);
                const uint4 a = *(const uint4*)(UT + (size_t)e * 1024 + lane * 8), c = *(const uint4*)(UT + (size_t)e * 1024 + 512 + lane * 8);
                const unsigned ua[8] = {a.x, a.y, a.z, a.w, c.x, c.y, c.z, c.w};
                float acc = 0.f;
                UNR for (int i = 0; i < 8; ++i) { acc += bf2f(ua[i] & 0xffffu) * xf[2 * i]; acc += bf2f(ua[i] >> 16) * xf[2 * i + 1]; }
                part[j] = acc;
            }
            UNR for (int j = 0; j < 8; ++j) {
                float v = part[j];
                for (int o = 32; o >= 1; o >>= 1) v += __shfl_xor(v, o);
                const float act = 0.5f * v * (1.0f + erff(v * 0.70710678118654752f));
                const int k = k0 + j;
                if (k < 64) { if (lane == k) c0 = act * g0; } else { if (lane == k - 64) c1 = act * g1; }
            }
        }
        float of[16];
        { const f32x4* hp = (const f32x4*)(H2 + m * 1024 + lane * 8); const f32x4* hp2 = (const f32x4*)(H2 + m * 1024 + 512 + lane * 8);
          const f32x4 a = hp[0], bq = hp[1], c = hp2[0], d = hp2[1];
          UNR for (int i = 0; i < 4; ++i) { of[i] = a[i]; of[4 + i] = bq[i]; of[8 + i] = c[i]; of[12 + i] = d[i]; } }
        _Pragma("nounroll") for (int k0 = 0; k0 < 128; k0 += 8) {
            UNR for (int j = 0; j < 8; ++j) {
                const int k = k0 + j; const int e = __builtin_amdgcn_readlane(k < 64 ? e0 : e1, k & 63);
                const float cf = __builtin_bit_cast(float, __builtin_amdgcn_readlane(__builtin_bit_cast(int, k < 64 ? c0 : c1), k & 63));
                const uint4 a = *(const uint4*)(VT + (size_t)e * 1024 + lane * 8), c = *(const uint4*)(VT + (size_t)e * 1024 + 512 + lane * 8);
                const unsigned ua[8] = {a.x, a.y, a.z, a.w, c.x, c.y, c.z, c.w};
                UNR for (int i = 0; i < 8; ++i) { of[2 * i] += cf * bf2f(ua[i] & 0xffffu); of[2 * i + 1] += cf * bf2f(ua[i] >> 16); }
            }
        }
        float* op = P.out + (size_t)tok * 1024;
        *(f32x4*)(op + lane * 8) = (f32x4){of[0], of[1], of[2], of[3]}; *(f32x4*)(op + lane * 8 + 4) = (f32x4){of[4], of[5], of[6], of[7]};
        *(f32x4*)(op + 512 + lane * 8) = (f32x4){of[8], of[9], of[10], of[11]}; *(f32x4*)(op + 512 + lane * 8 + 4) = (f32x4){of[12], of[13], of[14], of[15]};
    }
}

__device__ __forceinline__ void run_phase(const Params& P, int ph, char* lds) {
    const int bid = blockIdx.x, nb = gridDim.x;
    switch (ph) {
        case 0: phase0(P, bid, nb); break;
        case 1: phase1(P, bid, nb, lds); break;
        case 2: phase2(P, lds); break;
        case 3: phase3(P, bid, nb, lds); break;
        case 4: phase4(P, bid, nb, lds); break;
        case 5: phase6(P, bid, nb, lds); break;
        case 6: phase7(P, bid, nb); break;
    }
}
#if SPLIT_LAUNCH
template <int PH> __global__ void __launch_bounds__(NTHREADS) phase_kernel(Params P) {
    __shared__ __attribute__((aligned(16))) char smem[SMEM_BYTES];
    run_phase(P, PH, smem);
}
#else
__global__ void __launch_bounds__(NTHREADS) mega_kernel(Params P) {
    __shared__ __attribute__((aligned(16))) char smem[SMEM_BYTES];
    cg::grid_group grid = cg::this_grid();
    const int bid = blockIdx.x, nb = gridDim.x;
    phase0(P, bid, nb); grid.sync();
    phase1(P, bid, nb, smem); grid.sync();
    phase2(P, smem); grid.sync();
    phase3(P, bid, nb, smem); grid.sync();
    phase4(P, bid, nb, smem); grid.sync();
    phase6(P, bid, nb, smem); grid.sync();
    phase7(P, bid, nb);
}
#endif

extern "C" void kernel_launch(void* const* d_in, const int* in_sizes, int n_in, void* d_out, int out_size, void* d_ws, size_t ws_size, hipStream_t stream) {
    Params P{};
    const float** pp = (const float**)&P;
    UNR for (int i = 0; i < 21; ++i) pp[i] = (const float*)d_in[i];
    P.out = (float*)d_out; P.ws = (char*)d_ws;
    if (ws_size < WS_END) { fprintf(stderr, "workspace too small: %zu < %zu\n", ws_size, (size_t)WS_END); return; }
#if SPLIT_LAUNCH
    phase_kernel<0><<<256, NTHREADS, 0, stream>>>(P);
    phase_kernel<1><<<256, NTHREADS, 0, stream>>>(P);
    phase_kernel<2><<<256, NTHREADS, 0, stream>>>(P);
    phase_kernel<3><<<256, NTHREADS, 0, stream>>>(P);
    phase_kernel<4><<<256, NTHREADS, 0, stream>>>(P);
    phase_kernel<5><<<256, NTHREADS, 0, stream>>>(P);
    phase_kernel<6><<<256, NTHREADS, 0, stream>>>(P);
#else
    static int grid_blocks = 0;
    if (!grid_blocks) {
        int dev = 0, cus = 0, per_cu = 0;
        (void)hipGetDevice(&dev);
        (void)hipDeviceGetAttribute(&cus, hipDeviceAttributeMultiprocessorCount, dev);
        (void)hipOccupancyMaxActiveBlocksPerMultiprocessor(&per_cu, mega_kernel, NTHREADS, 0);
        if (per_cu > 1) per_cu = 1;
        grid_blocks = cus * per_cu;
    }
    void* args[] = {&P};
    hipError_t e = hipLaunchCooperativeKernel((void*)mega_kernel, dim3(grid_blocks), dim3(NTHREADS), args, 0, stream);
    if (e != hipSuccess) fprintf(stderr, "cooperative launch failed: %s (grid %d)\n", hipGetErrorString(e), grid_blocks);
#endif
}
```

```cpp
#include <hip/hip_runtime.h>
#include <hip/hip_cooperative_groups.h>
#include <cstdio>
#include <cstdint>
namespace cg = cooperative_groups;
#define UNR _Pragma("unroll")

#ifndef SPLIT_LAUNCH
#define SPLIT_LAUNCH 0
#endif

typedef unsigned short bf16_t;
typedef short bf16x8 __attribute__((ext_vector_type(8)));
typedef short s16x4 __attribute__((ext_vector_type(4)));
typedef float f32x16 __attribute__((ext_vector_type(16)));
typedef float f32x4 __attribute__((ext_vector_type(4)));
typedef float f32x2_t __attribute__((ext_vector_type(2)));
typedef __bf16 bf16x2_t __attribute__((ext_vector_type(2)));
typedef unsigned long long u64;

constexpr int BATCH = 8, SEQ = 4096, DM = 1024, NMETA = 16;
constexpr int TR = NMETA + SEQ;
constexpr int TP = 4224;
constexpr int R = BATCH * TP;
constexpr int NIN = 4864;
constexpr float EPS = 1e-6f;
constexpr int NTHREADS = 512;
constexpr int NEXP = 16384;
constexpr float LOG2E = 1.4426950408889634f;
constexpr float QSCALE = 0.125f * LOG2E;
constexpr int SMEM_BYTES = 135168;

constexpr size_t al(size_t x) { return (x + 255) & ~(size_t)255; }
constexpr size_t WS_CTL   = 0;
constexpr size_t WS_ROWSS = 4096;
constexpr size_t WS_COS64 = al(WS_ROWSS + (size_t)R * 4);
constexpr size_t WS_SIN64 = al(WS_COS64 + (size_t)TP * 32 * 4);
constexpr size_t WS_ICOS  = al(WS_SIN64 + (size_t)TP * 32 * 4);
constexpr size_t WS_ISIN  = al(WS_ICOS + (size_t)TP * 16 * 4);
constexpr size_t WS_WIN   = al(WS_ISIN + (size_t)TP * 16 * 4);
constexpr size_t WS_WA    = al(WS_WIN + (size_t)NIN * 1024 * 2);
constexpr size_t WS_WB    = al(WS_WA + (size_t)1024 * 512 * 2);
constexpr size_t WS_WO    = al(WS_WB + (size_t)1024 * 512 * 2);
constexpr size_t WS_WQ    = al(WS_WO + (size_t)1024 * 1024 * 2);
constexpr size_t WS_SUBK  = al(WS_WQ + (size_t)1024 * 1024 * 2);
constexpr size_t WS_BK    = al(WS_SUBK + (size_t)8 * 2 * 128 * 64 * 2);
constexpr size_t WS_BV    = al(WS_BK + (size_t)R * 64 * 2);
constexpr size_t WS_IK    = al(WS_BV + (size_t)R * 64 * 2);
constexpr size_t WS_IW    = al(WS_IK + (size_t)R * 64 * 2);
constexpr size_t WS_R1    = al(WS_IW + (size_t)R * 8 * 4);
constexpr size_t SZ_R1    = (size_t)R * 1024 * 2;
constexpr size_t WS_R2    = al(WS_R1 + SZ_R1);
constexpr size_t WS_R3    = al(WS_R2 + SZ_R1);
constexpr size_t WS_R4    = al(WS_R3 + SZ_R1);
constexpr size_t WS_R6    = al(WS_R4 + (size_t)R * 512 * 2);
constexpr size_t WS_END   = al(WS_R6 + (size_t)R * 1024 * 4);

struct Params {
    const float *x, *meta, *g_mix, *w_in, *g_aq, *g_ak, *lq1, *lk1, *lq2, *lk2, *g_sub, *w_a, *g_bq, *g_bk, *w_b, *w_o, *g_ffn, *w_q, *subk, *pu, *pv;
    float* out;
    char* ws;
};

__device__ __forceinline__ int opaque_tid() { int t = threadIdx.x; asm volatile("" : "+v"(t)); return t; }
__device__ __forceinline__ unsigned pk2(float lo, float hi) { f32x2_t v = {lo, hi}; bf16x2_t b = __builtin_convertvector(v, bf16x2_t); return __builtin_bit_cast(unsigned, b); }
__device__ __forceinline__ bf16_t f2bf(float x) { return (bf16_t)(pk2(x, 0.f) & 0xffffu); }
__device__ __forceinline__ float bf2f(unsigned x) { return __uint_as_float(x << 16); }
__device__ __forceinline__ unsigned xcc_id() { return (unsigned)__builtin_amdgcn_s_getreg((3 << 11) | 20) & 0xFu; }
__device__ __forceinline__ int crow(int r, int hi) { return (r & 3) + 8 * (r >> 2) + 4 * hi; }
__device__ __forceinline__ f32x16 mfma32(bf16x8 a, bf16x8 b, f32x16 c) { return __builtin_amdgcn_mfma_f32_32x32x16_bf16(a, b, c, 0, 0, 0); }
__device__ __forceinline__ f32x4 mfma16(bf16x8 a, bf16x8 b, f32x4 c) { return __builtin_amdgcn_mfma_f32_16x16x32_bf16(a, b, c, 0, 0, 0); }
__device__ __forceinline__ float ex2(float x) { return __builtin_amdgcn_exp2f(x); }
__device__ __forceinline__ bf16x8 pack8(float a0, float a1, float a2, float a3, float a4, float a5, float a6, float a7) {
    uint4 u; u.x = pk2(a0, a1); u.y = pk2(a2, a3); u.z = pk2(a4, a5); u.w = pk2(a6, a7); return __builtin_bit_cast(bf16x8, u);
}
__device__ __forceinline__ f32x16 zero16() { f32x16 z; UNR for (int i = 0; i < 16; ++i) z[i] = 0.f; return z; }

__device__ __forceinline__ void phase0(const Params& P, int bid, int nb) {
    const int tid = opaque_tid(), lane = tid & 63, w = tid >> 6;
    char* ws = P.ws;
    {
        bf16_t* XN = (bf16_t*)(ws + WS_R1);
        for (int row = bid * 8 + w; row < R; row += nb * 8) {
            const int b = row / TP, t = row - b * TP;
            f32x4 v[4];
            if (t < NMETA) { const float* src = P.meta + (size_t)t * DM; UNR for (int i = 0; i < 4; ++i) v[i] = *(const f32x4*)(src + i * 256 + lane * 4); }
            else if (t < TR) { const float* src = P.x + ((size_t)b * SEQ + (t - NMETA)) * DM; UNR for (int i = 0; i < 4; ++i) v[i] = *(const f32x4*)(src + i * 256 + lane * 4); }
            else { UNR for (int i = 0; i < 4; ++i) v[i] = (f32x4){0.f, 0.f, 0.f, 0.f}; }
            float ss = 0.f;
            UNR for (int i = 0; i < 4; ++i) ss += v[i][0] * v[i][0] + v[i][1] * v[i][1] + v[i][2] * v[i][2] + v[i][3] * v[i][3];
            for (int o = 32; o >= 1; o >>= 1) ss += __shfl_xor(ss, o);
            const float rinv = rsqrtf(ss * (1.0f / DM) + EPS);
            UNR for (int i = 0; i < 4; ++i) {
                const f32x4 g = *(const f32x4*)(P.g_mix + i * 256 + lane * 4);
                uint2 o; o.x = pk2(v[i][0] * rinv * g[0], v[i][1] * rinv * g[1]); o.y = pk2(v[i][2] * rinv * g[2], v[i][3] * rinv * g[3]);
                *(uint2*)(XN + (size_t)row * DM + i * 256 + lane * 4) = o;
            }
        }
    }
    const int gt = bid * NTHREADS + tid, gn = nb * NTHREADS;
    auto conv = [&](const float* W, int K, int Nsrc, int Ndst, bf16_t* Wt, bool remap) {
        const int items = Ndst * (K / 8);
        for (int it = gt; it < items; it += gn) {
            const int kc = it / Ndst, n = it - kc * Ndst;
            int ns = n; bool zero = false;
            if (remap) { if (n >= 2816) ns = n - 56; else if (n >= 2760) zero = true; }
            float f[8];
            UNR for (int j = 0; j < 8; ++j) f[j] = zero ? 0.f : W[(size_t)(kc * 8 + j) * Nsrc + ns];
            uint4 o; o.x = pk2(f[0], f[1]); o.y = pk2(f[2], f[3]); o.z = pk2(f[4], f[5]); o.w = pk2(f[6], f[7]);
            *(uint4*)(Wt + (size_t)n * K + kc * 8) = o;
        }
    };
    conv(P.w_in, 1024, 4808, NIN, (bf16_t*)(ws + WS_WIN), true);
    conv(P.w_a, 512, 1024, 1024, (bf16_t*)(ws + WS_WA), false);
    conv(P.w_b, 512, 1024, 1024, (bf16_t*)(ws + WS_WB), false);
    conv(P.w_o, 1024, 1024, 1024, (bf16_t*)(ws + WS_WO), false);
    conv(P.w_q, 1024, 1024, 1024, (bf16_t*)(ws + WS_WQ), false);
    { bf16_t* SK = (bf16_t*)(ws + WS_SUBK); for (int i = gt; i < 8 * 2 * 128 * 64; i += gn) SK[i] = f2bf(P.subk[i]); }
    {
        float* c64 = (float*)(ws + WS_COS64); float* s64 = (float*)(ws + WS_SIN64); float* ic = (float*)(ws + WS_ICOS); float* is = (float*)(ws + WS_ISIN);
        for (int i = gt; i < TP * 32; i += gn) { const int t = i >> 5, j = i & 31; const float inv = powf(10000.0f, -(float)(2 * j) / 64.0f); const float ang = (float)t * inv; c64[i] = (float)cos((double)ang); s64[i] = (float)sin((double)ang); }
        for (int i = gt; i < TP * 16; i += gn) { const int t = i >> 4, j = i & 15; const float inv = powf(10000.0f, -(float)(2 * j) / 32.0f); const float ang = (float)t * inv; ic[i] = (float)cos((double)ang); is[i] = (float)sin((double)ang); }
    }
    { float* rs = (float*)(ws + WS_ROWSS); for (int i = gt; i < R; i += gn) rs[i] = 0.f; }
    if (tid == 0) ((int*)(ws + WS_CTL + 2048))[bid] = (int)xcc_id();
    if (bid == 0 && w == 0) {
        float a = P.lq1[lane] * P.lk1[lane], b2 = P.lq2[lane] * P.lk2[lane];
        for (int o = 32; o >= 1; o >>= 1) { a += __shfl_xor(a, o); b2 += __shfl_xor(b2, o); }
        if (lane == 0) { ((unsigned*)(ws + WS_CTL))[0] = 0u; ((unsigned*)(ws + WS_CTL))[1] = 0u; ((unsigned*)(ws + WS_CTL))[2] = 0u; ((float*)(ws + WS_CTL))[4] = expf(a) - expf(b2) + 0.2f; }
    }
}

__device__ __forceinline__ void gemm_mainloop(const bf16_t* __restrict__ X, int ldx, const bf16_t* __restrict__ Wt, int ldw, int K, int m0, int n0, char* lds, f32x16 (&acc)[2][2]) {
    const int tid = opaque_tid(), lane = tid & 63, w = tid >> 6, wm = w >> 1, wn = w & 1, l31 = lane & 31, hi = lane >> 5;
    const int srow = tid >> 3, sch = tid & 7;
    const bf16_t* xg = X + (size_t)(m0 + srow) * ldx + sch * 8;
    const bf16_t* wg = Wt + (size_t)(n0 + srow) * ldw + sch * 8;
    const int soff = srow * 128 + ((sch ^ (srow & 7)) << 4);
    uint4 xr[4], wr[2];
    auto gload = [&](int k0) {
        UNR for (int i = 0; i < 4; ++i) xr[i] = *(const uint4*)(xg + (size_t)(i * 64) * ldx + k0);
        UNR for (int i = 0; i < 2; ++i) wr[i] = *(const uint4*)(wg + (size_t)(i * 64) * ldw + k0);
    };
    auto lstore = [&](int buf) {
        char* xb = lds + buf * 32768; char* wb = lds + 65536 + buf * 16384;
        UNR for (int i = 0; i < 4; ++i) *(uint4*)(xb + i * 8192 + soff) = xr[i];
        UNR for (int i = 0; i < 2; ++i) *(uint4*)(wb + i * 8192 + soff) = wr[i];
    };
    const int nk = K / 64;
    gload(0); lstore(0); __syncthreads();
    const int aoffb = (wn * 64 + l31) * 128, boffb = (wm * 64 + l31) * 128, sw = l31 & 7;
    for (int kt = 0; kt < nk; ++kt) {
        if (kt + 1 < nk) gload((kt + 1) * 64);
        const char* xb = lds + (kt & 1) * 32768; const char* wb = lds + 65536 + (kt & 1) * 16384;
        UNR for (int ks = 0; ks < 4; ++ks) {
            const int co = (((ks * 2 + hi) ^ sw) << 4);
            bf16x8 a[2], b[2];
            UNR for (int nt = 0; nt < 2; ++nt) a[nt] = *(const bf16x8*)(wb + aoffb + nt * 4096 + co);
            UNR for (int mt = 0; mt < 2; ++mt) b[mt] = *(const bf16x8*)(xb + boffb + mt * 4096 + co);
            UNR for (int mt = 0; mt < 2; ++mt) UNR for (int nt = 0; nt < 2; ++nt) acc[mt][nt] = mfma32(a[nt], b[mt], acc[mt][nt]);
        }
        if (kt + 1 < nk) lstore((kt + 1) & 1);
        __syncthreads();
    }
}

__device__ __forceinline__ void phase1(const Params& P, int bid, int nb, char* lds) {
    const int tid = opaque_tid(), lane = tid & 63, w = tid >> 6, wm = w >> 1, wn = w & 1, l31 = lane & 31, hi = lane >> 5;
    constexpr int NTM = R / 256, NTN = NIN / 128;
    for (int tile = bid; tile < NTM * NTN; tile += nb) {
        const int tn = tile % NTN, tm = tile / NTN; const int m0 = tm * 256, n0 = tn * 128;
        f32x16 acc[2][2]; UNR for (int i = 0; i < 2; ++i) UNR for (int j = 0; j < 2; ++j) acc[i][j] = zero16();
        { char* ws0 = P.ws; gemm_mainloop((const bf16_t*)(ws0 + WS_R1), 1024, (const bf16_t*)(ws0 + WS_WIN), 1024, 1024, m0, n0, lds, acc); }
        char* ws = P.ws; asm volatile("" : "+s"(ws));
        bf16_t* AQ = (bf16_t*)(ws + WS_R2); bf16_t* AK = AQ + (size_t)8 * 8 * TP * 64;
        bf16_t* AVT = (bf16_t*)(ws + WS_R3); bf16_t* BQ = AVT + (size_t)8 * 4 * 128 * TP;
        bf16_t* BK = (bf16_t*)(ws + WS_BK); bf16_t* BV = (bf16_t*)(ws + WS_BV); bf16_t* IK = (bf16_t*)(ws + WS_IK); float* IW = (float*)(ws + WS_IW);
        bf16_t* IQ = (bf16_t*)(ws + WS_R4); bf16_t* GA = (bf16_t*)(ws + WS_R6); bf16_t* GB = GA + (size_t)R * 1024;
        const float* c64 = (const float*)(ws + WS_COS64); const float* s64 = (const float*)(ws + WS_SIN64); const float* ic = (const float*)(ws + WS_ICOS); const float* is = (const float*)(ws + WS_ISIN);
        const int chunk = (n0 >> 6) + wn;
        UNR for (int mt = 0; mt < 2; ++mt) {
            const int m = m0 + wm * 64 + mt * 32 + l31; const int b = m / TP, t = m - b * TP;
            f32x16 x1 = acc[mt][0], x2 = acc[mt][1];
            const bool nr = (chunk < 16) || (chunk >= 24 && chunk <= 32);
            if (nr) {
                const float* gain; bf16_t* dst; float sc = 1.f;
                if (chunk < 8) { gain = P.g_aq; dst = AQ + ((size_t)(b * 8 + chunk) * TP + t) * 64; sc = QSCALE; }
                else if (chunk < 16) { gain = P.g_ak; dst = AK + ((size_t)(b * 8 + chunk - 8) * TP + t) * 64; }
                else if (chunk < 32) { gain = P.g_bq; dst = BQ + (size_t)m * 512 + (chunk - 24) * 64; sc = QSCALE; }
                else { gain = P.g_bk; dst = BK + (size_t)m * 64; }
                float ss = 0.f;
                UNR for (int r = 0; r < 16; ++r) ss += x1[r] * x1[r] + x2[r] * x2[r];
                ss += __shfl_xor(ss, 32);
                const float rinv = rsqrtf(ss * (1.0f / 64.0f) + EPS);
                UNR for (int g4 = 0; g4 < 4; ++g4) {
                    const int j = 8 * g4 + 4 * hi;
                    const f32x4 c = *(const f32x4*)(c64 + t * 32 + j), s = *(const f32x4*)(s64 + t * 32 + j);
                    const f32x4 g1 = *(const f32x4*)(gain + j), g2 = *(const f32x4*)(gain + 32 + j);
                    float o1[4], o2[4];
                    UNR for (int i = 0; i < 4; ++i) { const float y1 = x1[4 * g4 + i] * rinv * g1[i], y2 = x2[4 * g4 + i] * rinv * g2[i]; o1[i] = (y1 * c[i] - y2 * s[i]) * sc; o2[i] = (y2 * c[i] + y1 * s[i]) * sc; }
                    uint2 u1, u2; u1.x = pk2(o1[0], o1[1]); u1.y = pk2(o1[2], o1[3]); u2.x = pk2(o2[0], o2[1]); u2.y = pk2(o2[2], o2[3]);
                    *(uint2*)(dst + j) = u1; *(uint2*)(dst + 32 + j) = u2;
                }
            } else if (chunk < 24) {
                const int hd = (chunk - 16) >> 1, half = (chunk - 16) & 1;
                bf16_t* dst = AVT + ((size_t)(b * 4 + hd) * 128 + half * 64) * TP + t;
                UNR for (int r = 0; r < 16; ++r) { const int j = crow(r, hi); dst[(size_t)j * TP] = f2bf(x1[r]); dst[(size_t)(32 + j) * TP] = f2bf(x2[r]); }
            } else if (chunk == 33) {
                bf16_t* dst = BV + (size_t)m * 64;
                UNR for (int g4 = 0; g4 < 4; ++g4) { const int j = 8 * g4 + 4 * hi; uint2 u1, u2; u1.x = pk2(x1[4 * g4], x1[4 * g4 + 1]); u1.y = pk2(x1[4 * g4 + 2], x1[4 * g4 + 3]); u2.x = pk2(x2[4 * g4], x2[4 * g4 + 1]); u2.y = pk2(x2[4 * g4 + 2], x2[4 * g4 + 3]); *(uint2*)(dst + j) = u1; *(uint2*)(dst + 32 + j) = u2; }
            } else if (chunk <= 42) {
                bf16_t* dst = (chunk == 42) ? IK + (size_t)m * 64 : IQ + (size_t)m * 512 + (chunk - 34) * 64;
                float y[16];
                UNR for (int g4 = 0; g4 < 2; ++g4) {
                    const int j = 8 * g4 + 4 * hi;
                    const f32x4 c = *(const f32x4*)(ic + t * 16 + j), s = *(const f32x4*)(is + t * 16 + j);
                    UNR for (int i = 0; i < 4; ++i) { const float a = x1[4 * g4 + i], bb = x1[4 * g4 + i + 8]; y[4 * g4 + i] = a * c[i] - bb * s[i]; y[4 * g4 + i + 8] = bb * c[i] + a * s[i]; }
                }
                UNR for (int g4 = 0; g4 < 4; ++g4) { const int j = 8 * g4 + 4 * hi; uint2 u1, u2; u1.x = pk2(y[4 * g4], y[4 * g4 + 1]); u1.y = pk2(y[4 * g4 + 2], y[4 * g4 + 3]); u2.x = pk2(x2[4 * g4], x2[4 * g4 + 1]); u2.y = pk2(x2[4 * g4 + 2], x2[4 * g4 + 3]); *(uint2*)(dst + j) = u1; *(uint2*)(dst + 32 + j) = u2; }
            } else if (chunk == 43) {
                const float sc = 0.35355339059327373f * 0.125f;
                f32x4 o = {x1[0] * sc, x1[1] * sc, x1[2] * sc, x1[3] * sc};
                *(f32x4*)(IW + (size_t)m * 8 + 4 * hi) = o;
            } else {
                bf16_t* dst = (chunk < 60) ? GA + (size_t)m * 1024 + (chunk - 44) * 64 : GB + (size_t)m * 1024 + (chunk - 60) * 64;
                UNR for (int g4 = 0; g4 < 4; ++g4) {
                    const int j = 8 * g4 + 4 * hi; float o1[4], o2[4];
                    UNR for (int i = 0; i < 4; ++i) { o1[i] = 1.0f / (1.0f + __expf(-x1[4 * g4 + i])); o2[i] = 1.0f / (1.0f + __expf(-x2[4 * g4 + i])); }
                    uint2 u1, u2; u1.x = pk2(o1[0], o1[1]); u1.y = pk2(o1[2], o1[3]); u2.x = pk2(o2[0], o2[1]); u2.y = pk2(o2[2], o2[3]);
                    *(uint2*)(dst + j) = u1; *(uint2*)(dst + 32 + j) = u2;
                }
            }
        }
    }
}

__device__ __forceinline__ void attnA_unit(const Params& P, int b, int head, int qb, char* lds) {
    const int tid = opaque_tid(), lane = tid & 63, w = tid >> 6, qg = w & 3, st = w >> 2, l31 = lane & 31, hi = lane >> 5;
    char* ws = P.ws;
    const bf16_t* AQ = (const bf16_t*)(ws + WS_R2); const bf16_t* AK = AQ + (size_t)8 * 8 * TP * 64; const bf16_t* AVT = (const bf16_t*)(ws + WS_R3);
    bf16_t* AOUT = (bf16_t*)(ws + WS_R1);
    const float lam = ((const float*)(ws + WS_CTL))[4];
    const int q0 = qb * 128 + qg * 32;
    const bf16_t* Qp = AQ + ((size_t)(b * 8 + head * 2 + st) * TP + q0 + l31) * 64;
    bf16x8 qf[4];
    UNR for (int ks = 0; ks < 4; ++ks) qf[ks] = *(const bf16x8*)(Qp + ks * 16 + hi * 8);
    const bf16_t* K0g = AK + (size_t)(b * 8 + head * 2) * TP * 64; const bf16_t* K1g = K0g + (size_t)TP * 64;
    const bf16_t* Vg = AVT + (size_t)(b * 4 + head) * 128 * TP;
    const int nkt = 2 * (qb + 1);
    const int srow = tid >> 3, sch = tid & 7;
    const int koff = srow * 128 + ((sch ^ (srow & 7)) << 4), voff = srow * 128 + ((sch ^ ((srow >> 1) & 7)) << 4);
    uint4 sr[4];
    auto gload = [&](int kt) {
        const int key0 = kt * 64;
        sr[0] = *(const uint4*)(K0g + (size_t)(key0 + srow) * 64 + sch * 8);
        sr[1] = *(const uint4*)(K1g + (size_t)(key0 + srow) * 64 + sch * 8);
        sr[2] = *(const uint4*)(Vg + (size_t)srow * TP + key0 + sch * 8);
        sr[3] = *(const uint4*)(Vg + (size_t)(srow + 64) * TP + key0 + sch * 8);
    };
    auto lstore = [&](int buf) {
        char* base = lds + buf * 32768;
        *(uint4*)(base + koff) = sr[0]; *(uint4*)(base + 8192 + koff) = sr[1];
        *(uint4*)(base + 16384 + voff) = sr[2]; *(uint4*)(base + 16384 + 8192 + voff) = sr[3];
    };
    f32x16 o[4]; UNR for (int i = 0; i < 4; ++i) o[i] = zero16();
    float mrun = -INFINITY, lrun = 0.f;
    gload(0); lstore(0); __syncthreads();
    const int qpos = q0 + l31;
    for (int kt = 0; kt < nkt; ++kt) {
        if (kt + 1 < nkt) gload(kt + 1);
        const char* base = lds + (kt & 1) * 32768; const char* Kb = base + st * 8192; const char* Vb = base + 16384;
        f32x16 s0 = zero16(), s1 = zero16();
        UNR for (int ks = 0; ks < 4; ++ks) {
            const int co = (((ks * 2 + hi) ^ (l31 & 7)) << 4);
            const bf16x8 a0 = *(const bf16x8*)(Kb + l31 * 128 + co), a1 = *(const bf16x8*)(Kb + (32 + l31) * 128 + co);
            s0 = mfma32(a0, qf[ks], s0); s1 = mfma32(a1, qf[ks], s1);
        }
        if (kt >= nkt - 2) {
            const int kbase = kt * 64;
            UNR for (int r = 0; r < 16; ++r) { const int key = kbase + crow(r, hi); if (key > qpos) s0[r] = -INFINITY; if (key + 32 > qpos) s1[r] = -INFINITY; }
        }
        float mx = s0[0];
        UNR for (int r = 1; r < 16; ++r) mx = fmaxf(mx, s0[r]);
        UNR for (int r = 0; r < 16; ++r) mx = fmaxf(mx, s1[r]);
        mx = fmaxf(mx, __shfl_xor(mx, 32));
        const float mn = fmaxf(mrun, mx);
        const float alpha = ex2(mrun - mn);
        mrun = mn;
        float ls = 0.f;
        UNR for (int r = 0; r < 16; ++r) { s0[r] = ex2(s0[r] - mn); s1[r] = ex2(s1[r] - mn); ls += s0[r] + s1[r]; }
        lrun = lrun * alpha + ls;
        if (!__all(alpha == 1.0f)) { UNR for (int mt = 0; mt < 4; ++mt) UNR for (int r = 0; r < 16; ++r) o[mt][r] *= alpha; }
        bf16x8 pb[2][2];
        pb[0][0] = pack8(s0[0], s0[1], s0[2], s0[3], s0[4], s0[5], s0[6], s0[7]); pb[0][1] = pack8(s0[8], s0[9], s0[10], s0[11], s0[12], s0[13], s0[14], s0[15]);
        pb[1][0] = pack8(s1[0], s1[1], s1[2], s1[3], s1[4], s1[5], s1[6], s1[7]); pb[1][1] = pack8(s1[8], s1[9], s1[10], s1[11], s1[12], s1[13], s1[14], s1[15]);
        UNR for (int mt = 0; mt < 4; ++mt) {
            const int d = mt * 32 + l31; const int sw = (d >> 1) & 7; const char* rowp = Vb + d * 128 + 8 * hi;
            UNR for (int k2 = 0; k2 < 2; ++k2)
                UNR for (int s = 0; s < 2; ++s) {
                    const int c0 = k2 * 4 + 2 * s;
                    const s16x4 lo = *(const s16x4*)(rowp + ((c0 ^ sw) << 4)), h4 = *(const s16x4*)(rowp + (((c0 + 1) ^ sw) << 4));
                    const bf16x8 a = {lo[0], lo[1], lo[2], lo[3], h4[0], h4[1], h4[2], h4[3]};
                    o[mt] = mfma32(a, pb[k2][s], o[mt]);
                }
        }
        if (kt + 1 < nkt) lstore((kt + 1) & 1);
        __syncthreads();
    }
    lrun += __shfl_xor(lrun, 32);
    const float inv = 1.0f / lrun;
    float* ex = (float*)lds + qg * 4096;
    if (st == 1) { const float f = inv * lam; UNR for (int mt = 0; mt < 4; ++mt) UNR for (int r = 0; r < 16; ++r) ex[(mt * 16 + r) * 64 + lane] = o[mt][r] * f; }
    __syncthreads();
    if (st == 0) {
        float ss = 0.f;
        UNR for (int mt = 0; mt < 4; ++mt) UNR for (int r = 0; r < 16; ++r) { const float v = o[mt][r] * inv - ex[(mt * 16 + r) * 64 + lane]; o[mt][r] = v; ss += v * v; }
        ss += __shfl_xor(ss, 32);
        const float rinv = rsqrtf(ss * (1.0f / 128.0f) + EPS) * 0.8f;
        bf16_t* dst = AOUT + (size_t)(b * TP + q0 + l31) * 512 + head * 128;
        UNR for (int mt = 0; mt < 4; ++mt) UNR for (int g4 = 0; g4 < 4; ++g4) {
            const int d = mt * 32 + 8 * g4 + 4 * hi; const f32x4 g = *(const f32x4*)(P.g_sub + d);
            uint2 u; u.x = pk2(o[mt][4 * g4] * rinv * g[0], o[mt][4 * g4 + 1] * rinv * g[1]); u.y = pk2(o[mt][4 * g4 + 2] * rinv * g[2], o[mt][4 * g4 + 3] * rinv * g[3]);
            *(uint2*)(dst + d) = u;
        }
    }
    __syncthreads();
}

constexpr int DSA_C = 448;
constexpr int DS_SEL = 0, DS_CAND = 8192, DS_VST = 8192, DS_PART = 40960, DS_PML = 106496, DS_BMP = 110592, DS_STATE = 131072;
__device__ __forceinline__ unsigned ord32(float s) { const unsigned u = __float_as_uint(s); return (u & 0x80000000u) ? ~u : (u | 0x80000000u); }

__device__ __forceinline__ void dsa_unit(const Params& P, int b, int q16, char* lds) {
    const int tid = opaque_tid(), lane = tid & 63, w = tid >> 6, n15 = lane & 15, g = lane >> 4;
    char* ws = P.ws;
    const bf16_t* BQ = (const bf16_t*)(ws + WS_R3) + (size_t)8 * 4 * 128 * TP;
    const bf16_t* BK = (const bf16_t*)(ws + WS_BK); const bf16_t* BV = (const bf16_t*)(ws + WS_BV); const bf16_t* IK = (const bf16_t*)(ws + WS_IK);
    const float* IW = (const float*)(ws + WS_IW); const bf16_t* IQ = (const bf16_t*)(ws + WS_R4);
    bf16_t* BOUT = (bf16_t*)(ws + WS_R1) + (size_t)R * 512;
    unsigned* HIST = (unsigned*)lds;
    unsigned short* SEL = (unsigned short*)(lds + DS_SEL); u64* CAND = (u64*)(lds + DS_CAND);
    u64* s_pfx = (u64*)(lds + DS_STATE); int* s_need = (int*)(lds + DS_STATE + 256); int* s_pop = (int*)(lds + DS_STATE + 384);
    unsigned* s_selcnt = (unsigned*)(lds + DS_STATE + 512); unsigned* s_candcnt = (unsigned*)(lds + DS_STATE + 640); int* s_all = (int*)(lds + DS_STATE + 768);
    const int q0 = q16 * 16; const int qpos = q0 + n15; const size_t qrow = (size_t)b * TP + qpos;
    const int nk = q16 + 1;
    bf16x8 iqf[8][2];
    UNR for (int h = 0; h < 8; ++h) UNR for (int s = 0; s < 2; ++s) iqf[h][s] = *(const bf16x8*)(IQ + qrow * 512 + h * 64 + s * 32 + g * 8);
    float iw[8];
    { const f32x4 a = *(const f32x4*)(IW + qrow * 8), c = *(const f32x4*)(IW + qrow * 8 + 4); iw[0] = a[0]; iw[1] = a[1]; iw[2] = a[2]; iw[3] = a[3]; iw[4] = c[0]; iw[5] = c[1]; iw[6] = c[2]; iw[7] = c[3]; }
    auto loadk = [&](int kt, bf16x8& k0, bf16x8& k1) {
        const bf16_t* ikp = IK + ((size_t)b * TP + kt * 16 + n15) * 64 + g * 8;
        k0 = *(const bf16x8*)ikp; k1 = *(const bf16x8*)(ikp + 32);
    };
    auto load4 = [&](int kt0, bf16x8 (&k)[4][2]) { UNR for (int j = 0; j < 4; ++j) loadk(min(kt0 + 8 * j, nk - 1), k[j][0], k[j][1]); };
    auto compute = [&](const bf16x8& k0, const bf16x8& k1, f32x4& sc) {
        sc = (f32x4){0.f, 0.f, 0.f, 0.f};
        UNR for (int h = 0; h < 8; ++h) {
            f32x4 a = {0.f, 0.f, 0.f, 0.f};
            a = mfma16(k0, iqf[h][0], a); a = mfma16(k1, iqf[h][1], a);
            UNR for (int e = 0; e < 4; ++e) sc[e] = __builtin_fmaf(iw[h], __builtin_amdgcn_fmed3f(a[e], 0.f, INFINITY), sc[e]);
        }
        UNR for (int e = 0; e < 4; ++e) sc[e] += 0.0f;
    };
    if (tid < 16) { unsigned z = 0u; asm volatile("" : "+v"(z)); ((unsigned*)s_pfx)[2 * tid] = z; ((unsigned*)s_pfx)[2 * tid + 1] = z; s_need[tid] = 256; s_pop[tid] = (int)z; s_all[tid] = (int)z; }
    int sh = 45;
    for (;;) {
        const int nbits = sh < 11 ? sh : 11; const int mask = (1 << nbits) - 1;
        { uint4 z = {0u, 0u, 0u, 0u}; for (int i = tid; i < 4096; i += NTHREADS) ((uint4*)lds)[i] = z; }
        __syncthreads();
        const u64 mypfx = s_pfx[n15]; const int myall = s_all[n15];
        auto binit0 = [&](int kt, const f32x4& sc) {
            const bool diag = (kt == nk - 1);
            UNR for (int e = 0; e < 4; ++e) {
                const int idx = kt * 16 + 4 * g + e;
                if (!diag || idx <= qpos) {
                    const unsigned u = __float_as_uint(sc[e]); const unsigned t = u >> 21;
                    const unsigned ib = t ^ (~(unsigned)((int)u >> 31) & 1023u);
                    atomicAdd(&HIST[n15 * 1024 + (ib >> 1)], 1u << ((ib & 1) * 16));
                }
            }
        };
        auto binit = [&](int kt, const f32x4& sc) {
            const bool diag = (kt == nk - 1);
            UNR for (int e = 0; e < 4; ++e) {
                const int idx = kt * 16 + 4 * g + e;
                if ((!diag || idx <= qpos) && !myall) {
                    const u64 comp = ((u64)ord32(sc[e]) << 13) | (u64)(8191 - idx);
                    if ((comp >> sh) == mypfx) { const int ib = mask - (int)((comp >> (sh - nbits)) & (u64)mask); atomicAdd(&HIST[n15 * 1024 + (ib >> 1)], 1u << ((ib & 1) * 16)); }
                }
            }
        };
        {
            bf16x8 ka[4][2]; f32x4 sc;
            int kt = w; load4(kt, ka);
            if (sh == 45) {
                while (kt < nk) {
                    UNR for (int j = 0; j < 4; ++j) {
                        compute(ka[j][0], ka[j][1], sc);
                        loadk(min(kt + 32 + 8 * j, nk - 1), ka[j][0], ka[j][1]);
                        if (kt + 8 * j < nk) binit0(kt + 8 * j, sc);
                    }
                    kt += 32;
                }
            } else {
                while (kt < nk) {
                    UNR for (int j = 0; j < 4; ++j) {
                        compute(ka[j][0], ka[j][1], sc);
                        loadk(min(kt + 32 + 8 * j, nk - 1), ka[j][0], ka[j][1]);
                        if (kt + 8 * j < nk) binit(kt + 8 * j, sc);
                    }
                    kt += 32;
                }
            }
        }
        __syncthreads();
        UNR for (int i = 0; i < 2; ++i) {
            const int ql = w * 2 + i;
            if (s_all[ql]) continue;
            const unsigned* hq = HIST + ql * 1024 + lane * 16;
            unsigned wd[16]; unsigned c = 0;
            UNR for (int j = 0; j < 16; ++j) { wd[j] = hq[j]; c += (wd[j] & 0xffffu) + (wd[j] >> 16); }
            unsigned pre = c;
            UNR for (int o = 1; o < 64; o <<= 1) { const unsigned t = __shfl_up(pre, o); if (lane >= o) pre += t; }
            const unsigned nd = (unsigned)s_need[ql];
            const u64 bal = __ballot(pre >= nd);
            if (bal == 0ull) { if (lane == 0) { s_all[ql] = 1; s_pop[ql] = 0; s_need[ql] = 0; } }
            else {
                const int Lc = __ffsll((long long)bal) - 1;
                if (lane == Lc) {
                    unsigned cum = pre - c; int ibs = -1; unsigned cntb = 0;
                    UNR for (int j = 0; j < 32; ++j) { const unsigned cnt = (wd[j >> 1] >> ((j & 1) * 16)) & 0xffffu; if (ibs < 0) { if (cum + cnt >= nd) { ibs = lane * 32 + j; cntb = cnt; } else cum += cnt; } }
                    s_pfx[ql] = (s_pfx[ql] << nbits) | (u64)(mask - ibs); s_need[ql] = (int)(nd - cum); s_pop[ql] = (int)cntb;
                }
            }
        }
        __syncthreads();
        sh -= nbits;
        int mp = 0; UNR for (int q = 0; q < 16; ++q) mp = max(mp, s_pop[q]);
        if (mp <= DSA_C || sh == 0) break;
    }
    unsigned* BMP = (unsigned*)(lds + DS_BMP);
    if (tid < 16) { s_selcnt[tid] = 0u; s_candcnt[tid] = 0u; }
    for (int i = tid; i < 16 * 136; i += NTHREADS) BMP[i] = 0u;
    __syncthreads();
    {
        const int tid = opaque_tid(), lane = tid & 63, w = tid >> 6, n15 = lane & 15, g = lane >> 4; const int qpos = q0 + n15; (void)qpos; (void)g; (void)w;
        const u64 mypfx = s_pfx[n15]; const int myall = s_all[n15];
        const unsigned myib = 2047u - (unsigned)(mypfx & 2047ull);
        auto emit0 = [&](int kt, const f32x4& sc) {
            const bool diag = (kt == nk - 1);
            UNR for (int e = 0; e < 4; ++e) {
                const int idx = kt * 16 + 4 * g + e;
                if (!diag || idx <= qpos) {
                    const unsigned u = __float_as_uint(sc[e]); const unsigned t = u >> 21;
                    const unsigned ib = t ^ (~(unsigned)((int)u >> 31) & 1023u);
                    if (myall || ib < myib) atomicOr(&BMP[n15 * 136 + (idx >> 5)], 1u << (idx & 31));
                    else if (ib == myib) { const unsigned cp = atomicAdd(&s_candcnt[n15], 1u); if (cp < (unsigned)DSA_C) CAND[n15 * DSA_C + cp] = ((u64)ord32(sc[e]) << 13) | (u64)(8191 - idx); }
                }
            }
        };
        auto emit = [&](int kt, const f32x4& sc) {
            const bool diag = (kt == nk - 1);
            UNR for (int e = 0; e < 4; ++e) {
                const int idx = kt * 16 + 4 * g + e;
                if (!diag || idx <= qpos) {
                    const u64 comp = ((u64)ord32(sc[e]) << 13) | (u64)(8191 - idx); const u64 top = comp >> sh;
                    if (myall || top > mypfx) atomicOr(&BMP[n15 * 136 + (idx >> 5)], 1u << (idx & 31));
                    else if (top == mypfx) { const unsigned cp = atomicAdd(&s_candcnt[n15], 1u); if (cp < (unsigned)DSA_C) CAND[n15 * DSA_C + cp] = comp; }
                }
            }
        };
        bf16x8 ka[4][2]; f32x4 sc;
        int kt = w; load4(kt, ka);
        if (sh == 34) {
            while (kt < nk) {
                UNR for (int j = 0; j < 4; ++j) {
                    compute(ka[j][0], ka[j][1], sc);
                    loadk(min(kt + 32 + 8 * j, nk - 1), ka[j][0], ka[j][1]);
                    if (kt + 8 * j < nk) emit0(kt + 8 * j, sc);
                }
                kt += 32;
            }
        } else {
            while (kt < nk) {
                UNR for (int j = 0; j < 4; ++j) {
                    compute(ka[j][0], ka[j][1], sc);
                    loadk(min(kt + 32 + 8 * j, nk - 1), ka[j][0], ka[j][1]);
                    if (kt + 8 * j < nk) emit(kt + 8 * j, sc);
                }
                kt += 32;
            }
        }
    }
    __syncthreads();
    {
        const int tid = opaque_tid(), lane = tid & 63, w = tid >> 6, n15 = lane & 15, g = lane >> 4; const int qpos = q0 + n15; (void)qpos; (void)g; (void)w;
    UNR for (int i = 0; i < 2; ++i) {
        const int ql = w * 2 + i; const int n = min((int)s_candcnt[ql], DSA_C); const int nd = s_need[ql];
        if (n == 0 || nd <= 0) continue;
        u64 c[7];
        UNR for (int j = 0; j < 7; ++j) { const int ci = j * 64 + lane; c[j] = (ci < n) ? CAND[ql * DSA_C + ci] : 0ull; }
        u64 T = 0ull;
        for (int bit = 44; bit >= 0; --bit) {
            const u64 Tn = T | (1ull << bit); int cnt = 0;
            UNR for (int j = 0; j < 7; ++j) cnt += __popcll(__ballot(c[j] >= Tn));
            if (cnt >= nd) T = Tn;
        }
        UNR for (int j = 0; j < 7; ++j) { if (c[j] >= T && c[j] != 0ull) { const int idx = 8191 - (int)(c[j] & 8191ull); atomicOr(&BMP[ql * 136 + (idx >> 5)], 1u << (idx & 31)); } }
    }
    }
    __syncthreads();
    {
        const int tid = opaque_tid(), lane = tid & 63, w = tid >> 6, n15 = lane & 15, g = lane >> 4; const int qpos = q0 + n15; (void)qpos; (void)g; (void)w;
    for (int i = 0; i < 2; ++i) {
        const int ql = w * 2 + i;
        unsigned wd3[3]; int cnt = 0;
        UNR for (int j = 0; j < 3; ++j) { const int wi = lane * 3 + j; wd3[j] = (wi < 132) ? BMP[ql * 136 + wi] : 0u; cnt += __popc(wd3[j]); }
        int pre = cnt;
        UNR for (int o = 1; o < 64; o <<= 1) { const int t = __shfl_up(pre, o); if (lane >= o) pre += t; }
        int pos = pre - cnt;
        UNR for (int j = 0; j < 3; ++j) { unsigned m = wd3[j]; while (m) { const int bit = __ffs((int)m) - 1; m &= m - 1; if (pos < 256) SEL[ql * 256 + pos] = (unsigned short)((lane * 3 + j) * 32 + bit); ++pos; } }
        if (lane == 63) s_selcnt[ql] = (unsigned)pre;
    }
    }
    __syncthreads();
    {
        const int tid = opaque_tid(), lane = tid & 63, w = tid >> 6, n15 = lane & 15, g = lane >> 4; const int qpos = q0 + n15; (void)qpos; (void)g; (void)w;
        typedef __attribute__((address_space(3))) s16x4 lds_s16x4;
        char* vl = lds + DS_VST + w * 4096;
        float* PART = (float*)(lds + DS_PART);
        float* PML = (float*)(lds + DS_PML);
        const int hq = n15 & 7, qq = n15 >> 2, pp = n15 & 3;
        struct QB { bf16x8 kf[2][2]; uint4 vr[4]; bf16x8 bq[2]; };
        QB buf[3];
        auto issue = [&](int qi, QB& q) {
            const size_t row = (size_t)b * TP + q0 + qi; const int nsel = min((int)s_selcnt[qi], 256);
            const unsigned short* sel = SEL + qi * 256 + 32 * w;
            UNR for (int t = 0; t < 2; ++t) { const int slot = 32 * w + 16 * t + n15; const int kid = slot < nsel ? (int)sel[16 * t + n15] : 0; const bf16_t* kp = BK + ((size_t)b * TP + kid) * 64 + g * 8; q.kf[t][0] = *(const bf16x8*)kp; q.kf[t][1] = *(const bf16x8*)(kp + 32); }
            UNR for (int k = 0; k < 4; ++k) { const int rowl = k * 8 + (lane >> 3); const int slot = 32 * w + rowl; const int kid = slot < nsel ? (int)sel[rowl] : 0; q.vr[k] = *(const uint4*)(BV + ((size_t)b * TP + kid) * 64 + (lane & 7) * 8); }
            UNR for (int s = 0; s < 2; ++s) q.bq[s] = *(const bf16x8*)(BQ + row * 512 + hq * 64 + s * 32 + g * 8);
        };
        issue(0, buf[0]); issue(1, buf[1]);
        UNR for (int qi = 0; qi < 16; ++qi) {
            if (qi + 2 < 16) issue(qi + 2, buf[(qi + 2) % 3]);
            QB& q = buf[qi % 3];
            const int nsel = min((int)s_selcnt[qi], 256);
            f32x4 S[2];
            UNR for (int t = 0; t < 2; ++t) { f32x4 a = {0.f, 0.f, 0.f, 0.f}; a = mfma16(q.kf[t][0], q.bq[0], a); a = mfma16(q.kf[t][1], q.bq[1], a); S[t] = a; }
            float mx = -1.0e30f;
            UNR for (int t = 0; t < 2; ++t) UNR for (int e = 0; e < 4; ++e) { if (32 * w + 16 * t + 4 * g + e >= nsel) S[t][e] = -INFINITY; mx = fmaxf(mx, S[t][e]); }
            mx = fmaxf(mx, __shfl_xor(mx, 16)); mx = fmaxf(mx, __shfl_xor(mx, 32));
            float ls = 0.f;
            UNR for (int t = 0; t < 2; ++t) UNR for (int e = 0; e < 4; ++e) { S[t][e] = ex2(S[t][e] - mx); ls += S[t][e]; }
            ls += __shfl_xor(ls, 16); ls += __shfl_xor(ls, 32);
            const bf16x8 pb = pack8(S[0][0], S[0][1], S[0][2], S[0][3], S[1][0], S[1][1], S[1][2], S[1][3]);
            UNR for (int k = 0; k < 4; ++k) { const int rowl = k * 8 + (lane >> 3); *(uint4*)(vl + rowl * 128 + ((((lane & 7)) ^ (((rowl >> 1) & 3) << 1)) << 4)) = q.vr[k]; }
            __builtin_amdgcn_s_waitcnt(0xc07f);
            f32x4 o[4];
            const int row0 = 4 * g + qq, row1 = row0 + 16;
            UNR for (int mt = 0; mt < 4; ++mt) {
                const int ch = 2 * mt + (pp >> 1);
                const char* a0 = vl + row0 * 128 + ((ch ^ (((row0 >> 1) & 3) << 1)) << 4) + 8 * (pp & 1);
                const char* a1 = vl + row1 * 128 + ((ch ^ (((row1 >> 1) & 3) << 1)) << 4) + 8 * (pp & 1);
                const s16x4 lo = __builtin_amdgcn_ds_read_tr16_b64_v4i16((lds_s16x4*)a0);
                const s16x4 h4 = __builtin_amdgcn_ds_read_tr16_b64_v4i16((lds_s16x4*)a1);
                const bf16x8 a = {lo[0], lo[1], lo[2], lo[3], h4[0], h4[1], h4[2], h4[3]};
                o[mt] = mfma16(a, pb, (f32x4){0.f, 0.f, 0.f, 0.f});
            }
            __builtin_amdgcn_s_waitcnt(0xc07f);
            const int qs = qi & 3;
            if (n15 < 8) {
                float* pp_ = PART + ((qs * 8 + w) * 8 + n15) * 64;
                UNR for (int mt = 0; mt < 4; ++mt) *(f32x4*)(pp_ + mt * 16 + 4 * g) = o[mt];
                if (g == 0) { PML[((qs * 8 + w) * 8 + n15) * 2] = mx; PML[((qs * 8 + w) * 8 + n15) * 2 + 1] = ls; }
            }
            if (qs == 3) {
                __syncthreads();
                {
                    const int cq = tid >> 7, ch = (tid >> 4) & 7, dg = tid & 15;
                    float mw[8], lw[8]; float m = -1.0e30f;
                    UNR for (int ww = 0; ww < 8; ++ww) { mw[ww] = PML[((cq * 8 + ww) * 8 + ch) * 2]; lw[ww] = PML[((cq * 8 + ww) * 8 + ch) * 2 + 1]; m = fmaxf(m, mw[ww]); }
                    f32x4 acc = {0.f, 0.f, 0.f, 0.f}; float l = 0.f;
                    UNR for (int ww = 0; ww < 8; ++ww) { const float f = ex2(mw[ww] - m); l += lw[ww] * f; const f32x4 pv = *(const f32x4*)(PART + ((cq * 8 + ww) * 8 + ch) * 64 + dg * 4); acc += pv * f; }
                    const float inv = 1.0f / l;
                    const size_t orow = (size_t)b * TP + q0 + (qi - 3) + cq;
                    uint2 u; u.x = pk2(acc[0] * inv, acc[1] * inv); u.y = pk2(acc[2] * inv, acc[3] * inv);
                    *(uint2*)(BOUT + orow * 512 + ch * 64 + dg * 4) = u;
                }
                __syncthreads();
            }
        }
    }
}

template <int MODE> __device__ __forceinline__ void phase2(const Params& P, char* lds, int cidx) {
    unsigned* ctr = (unsigned*)(P.ws + WS_CTL) + cidx;
    int* s_u = (int*)(lds + DS_STATE + 1024);
    constexpr int NA = (MODE == 2) ? 0 : BATCH * 4 * 33, NB = (MODE == 1) ? 0 : BATCH * 257;
    for (;;) {
        if (threadIdx.x == 0) *s_u = (int)atomicAdd(ctr, 1u);
        __syncthreads();
        const int u = *s_u;
        __syncthreads();
        if (u >= NA + NB) break;
        if (u < NA) { const int bh = u / 33, qb = 32 - u % 33; attnA_unit(P, bh >> 2, bh & 3, qb, lds); }
        else { const int v = u - NA; dsa_unit(P, v / 257, 256 - v % 257, lds); }
    }
}

__device__ __forceinline__ void phase3(const Params& P, int bid, int nb, char* lds) {
    const int tid = opaque_tid(), lane = tid & 63, w = tid >> 6, wm = w >> 1, wn = w & 1, l31 = lane & 31, hi = lane >> 5;
    char* ws = P.ws;
    const bf16_t* AOUT = (const bf16_t*)(ws + WS_R1); const bf16_t* BOUT = AOUT + (size_t)R * 512;
    const bf16_t* WA = (const bf16_t*)(ws + WS_WA); const bf16_t* WB = (const bf16_t*)(ws + WS_WB);
    const bf16_t* GA = (const bf16_t*)(ws + WS_R6); const bf16_t* GB = GA + (size_t)R * 1024;
    bf16_t* MIXED = (bf16_t*)(ws + WS_R2);
    constexpr int NTM = R / 256, NTN = 8;
    for (int tile = bid; tile < NTM * NTN; tile += nb) {
        const int tn = tile % NTN, tm = tile / NTN; const int m0 = tm * 256, n0 = tn * 128;
        f32x16 acc[2][2], tmp[2][2];
        UNR for (int i = 0; i < 2; ++i) UNR for (int j = 0; j < 2; ++j) acc[i][j] = zero16();
        gemm_mainloop(AOUT, 512, WA, 512, 512, m0, n0, lds, acc);
        UNR for (int mt = 0; mt < 2; ++mt) UNR for (int nt = 0; nt < 2; ++nt) {
            const bf16_t* gp = GA + (size_t)(m0 + wm * 64 + mt * 32 + l31) * 1024 + n0 + wn * 64 + nt * 32 + 4 * hi;
            UNR for (int g4 = 0; g4 < 4; ++g4) { const uint2 u = *(const uint2*)(gp + 8 * g4); tmp[mt][nt][4 * g4] = acc[mt][nt][4 * g4] * bf2f(u.x & 0xffffu); tmp[mt][nt][4 * g4 + 1] = acc[mt][nt][4 * g4 + 1] * bf2f(u.x >> 16); tmp[mt][nt][4 * g4 + 2] = acc[mt][nt][4 * g4 + 2] * bf2f(u.y & 0xffffu); tmp[mt][nt][4 * g4 + 3] = acc[mt][nt][4 * g4 + 3] * bf2f(u.y >> 16); }
            acc[mt][nt] = zero16();
        }
        gemm_mainloop(BOUT, 512, WB, 512, 512, m0, n0, lds, acc);
        UNR for (int mt = 0; mt < 2; ++mt) UNR for (int nt = 0; nt < 2; ++nt) {
            const size_t off = (size_t)(m0 + wm * 64 + mt * 32 + l31) * 1024 + n0 + wn * 64 + nt * 32 + 4 * hi;
            UNR for (int g4 = 0; g4 < 4; ++g4) {
                const uint2 u = *(const uint2*)(GB + off + 8 * g4);
                const float v0 = tmp[mt][nt][4 * g4] + acc[mt][nt][4 * g4] * bf2f(u.x & 0xffffu), v1 = tmp[mt][nt][4 * g4 + 1] + acc[mt][nt][4 * g4 + 1] * bf2f(u.x >> 16);
                const float v2 = tmp[mt][nt][4 * g4 + 2] + acc[mt][nt][4 * g4 + 2] * bf2f(u.y & 0xffffu), v3 = tmp[mt][nt][4 * g4 + 3] + acc[mt][nt][4 * g4 + 3] * bf2f(u.y >> 16);
                uint2 o; o.x = pk2(v0, v1); o.y = pk2(v2, v3); *(uint2*)(MIXED + off + 8 * g4) = o;
            }
        }
    }
    {
        unsigned char* U8 = (unsigned char*)(ws + WS_R3); unsigned char* V8 = U8 + (size_t)NEXP * 1024;
        const int items = NEXP * 64;
        for (int it = bid * NTHREADS + tid; it < items; it += nb * NTHREADS) {
            const int e = it >> 6, seg = it & 63;
            const f32x4* up = (const f32x4*)(P.pu + (size_t)e * 1024 + seg * 16); const f32x4* vp = (const f32x4*)(P.pv + (size_t)e * 1024 + seg * 16);
            uint4 ou, ov; unsigned* pu4 = (unsigned*)&ou; unsigned* pv4 = (unsigned*)&ov;
            UNR for (int i = 0; i < 4; ++i) {
                const f32x4 a = up[i], c = vp[i]; int wu = 0, wv = 0;
                wu = __builtin_amdgcn_cvt_pk_fp8_f32(a[0] * 256.f, a[1] * 256.f, wu, false); wu = __builtin_amdgcn_cvt_pk_fp8_f32(a[2] * 256.f, a[3] * 256.f, wu, true);
                wv = __builtin_amdgcn_cvt_pk_fp8_f32(c[0] * 64.f, c[1] * 64.f, wv, false); wv = __builtin_amdgcn_cvt_pk_fp8_f32(c[2] * 64.f, c[3] * 64.f, wv, true);
                pu4[i] = (unsigned)wu; pv4[i] = (unsigned)wv;
            }
            *(uint4*)(U8 + (size_t)e * 1024 + seg * 16) = ou;
            *(uint4*)(V8 + ((size_t)(seg >> 3) * NEXP + e) * 128 + (seg & 7) * 16) = ov;
        }
    }
}

__device__ __forceinline__ void phase4(const Params& P, int bid, int nb, char* lds) {
    const int tid = opaque_tid(), lane = tid & 63, w = tid >> 6, wm = w >> 1, wn = w & 1, l31 = lane & 31, hi = lane >> 5;
    char* ws = P.ws;
    const bf16_t* MIXED = (const bf16_t*)(ws + WS_R2); const bf16_t* WO = (const bf16_t*)(ws + WS_WO);
    float* H2 = (float*)(ws + WS_R6); bf16_t* H2G = (bf16_t*)(ws + WS_R1); float* ROWSS = (float*)(ws + WS_ROWSS);
    constexpr int NTM = R / 256, NTN = 8;
    for (int tile = bid; tile < NTM * NTN; tile += nb) {
        const int tn = tile % NTN, tm = tile / NTN; const int m0 = tm * 256, n0 = tn * 128;
        f32x16 acc[2][2];
        UNR for (int i = 0; i < 2; ++i) UNR for (int j = 0; j < 2; ++j) acc[i][j] = zero16();
        gemm_mainloop(MIXED, 1024, WO, 1024, 1024, m0, n0, lds, acc);
        UNR for (int mt = 0; mt < 2; ++mt) {
            const int m = m0 + wm * 64 + mt * 32 + l31; const int b = m / TP, t = m - b * TP;
            const float* hsrc = (t < NMETA) ? P.meta + (size_t)t * DM : P.x + ((size_t)b * SEQ + (t - NMETA)) * DM;
            const bool real = t < TR;
            float ss = 0.f;
            UNR for (int nt = 0; nt < 2; ++nt) UNR for (int g4 = 0; g4 < 4; ++g4) {
                const int col = n0 + wn * 64 + nt * 32 + 8 * g4 + 4 * hi;
                f32x4 hv = {0.f, 0.f, 0.f, 0.f}; if (real) hv = *(const f32x4*)(hsrc + col);
                const f32x4 gg = *(const f32x4*)(P.g_ffn + col);
                f32x4 v; UNR for (int i = 0; i < 4; ++i) { v[i] = hv[i] + acc[mt][nt][4 * g4 + i]; ss += v[i] * v[i]; }
                *(f32x4*)(H2 + (size_t)m * 1024 + col) = v;
                uint2 o; o.x = pk2(v[0] * gg[0], v[1] * gg[1]); o.y = pk2(v[2] * gg[2], v[3] * gg[3]); *(uint2*)(H2G + (size_t)m * 1024 + col) = o;
            }
            ss += __shfl_xor(ss, 32);
            if (hi == 0) atomicAdd(ROWSS + m, ss);
        }
    }
}

__device__ __forceinline__ void ins16(float (&a)[16], float v) {
    float n[16]; n[0] = fmaxf(a[0], v);
    UNR for (int p = 1; p < 16; ++p) n[p] = __builtin_amdgcn_fmed3f(a[p - 1], a[p], v);
    UNR for (int p = 0; p < 16; ++p) a[p] = n[p];
}
constexpr int P6_TOPS = 98304;
__device__ __forceinline__ void phase6(const Params& P, int bid, int nb, char* lds) {
    const int tid = opaque_tid(), lane = tid & 63, w = tid >> 6, wm = w >> 1, wn = w & 1, l31 = lane & 31, hi = lane >> 5;
    char* ws = P.ws;
    const bf16_t* H2G = (const bf16_t*)(ws + WS_R1); const bf16_t* WQ = (const bf16_t*)(ws + WS_WQ); const bf16_t* SUBK = (const bf16_t*)(ws + WS_SUBK);
    const float* ROWSS = (const float*)(ws + WS_ROWSS);
    int* EIDX = (int*)(ws + WS_R4); float* EG = (float*)(ws + WS_R4 + (size_t)R * 128 * 4);
    float* TOPS = (float*)(lds + P6_TOPS);
    constexpr int NTM = R / 256, NTN = 8;
    for (int tile = bid; tile < NTM * NTN; tile += nb) {
        const int head = tile % NTN, tm = tile / NTN; const int m0 = tm * 256, n0 = head * 128;
        f32x16 acc[2][2];
        UNR for (int i = 0; i < 2; ++i) UNR for (int j = 0; j < 2; ++j) acc[i][j] = zero16();
        gemm_mainloop(H2G, 1024, WQ, 1024, 1024, m0, n0, lds, acc);
        const bf16_t* sk = SUBK + (size_t)(head * 2 + wn) * 128 * 64;
        UNR for (int mt = 0; mt < 2; ++mt) {
            const int tl = wm * 64 + mt * 32 + l31; const int m = m0 + tl;
            const float rinv = rsqrtf(ROWSS[m] * (1.0f / DM) + EPS);
            bf16x8 qb[4];
            UNR for (int s = 0; s < 4; ++s) { const int nt = s >> 1, r0 = 8 * (s & 1); const f32x16& a = acc[mt][nt];
                qb[s] = pack8(a[r0] * rinv, a[r0 + 1] * rinv, a[r0 + 2] * rinv, a[r0 + 3] * rinv, a[r0 + 4] * rinv, a[r0 + 5] * rinv, a[r0 + 6] * rinv, a[r0 + 7] * rinv); }
            float top[16];
            UNR for (int p = 0; p < 16; ++p) top[p] = -INFINITY;
            UNR for (int kt = 0; kt < 4; ++kt) {
                f32x16 S = zero16();
                UNR for (int s = 0; s < 4; ++s) {
                    const bf16_t* kp = sk + (size_t)(kt * 32 + l31) * 64 + (s >> 1) * 32 + 16 * (s & 1) + 4 * hi;
                    const s16x4 lo = *(const s16x4*)kp, h4 = *(const s16x4*)(kp + 8);
                    const bf16x8 a = {lo[0], lo[1], lo[2], lo[3], h4[0], h4[1], h4[2], h4[3]};
                    S = mfma32(a, qb[s], S);
                }
                UNR for (int r = 0; r < 16; ++r) { const unsigned key = (unsigned)(kt * 32 + crow(r, hi)); ins16(top, __uint_as_float((__float_as_uint(S[r]) & ~127u) | key)); }
            }
            float oth[16];
            UNR for (int p = 0; p < 16; ++p) oth[p] = __shfl_xor(top[p], 32);
            UNR for (int p = 0; p < 16; ++p) ins16(top, oth[p]);
            if (hi == 0) { UNR for (int p = 0; p < 16; p += 4) *(f32x4*)(TOPS + (tl * 2 + wn) * 16 + p) = (f32x4){top[p], top[p + 1], top[p + 2], top[p + 3]}; }
        }
        __syncthreads();
        if (tid < 256) {
            const int tl = tid; const int m = m0 + tl;
            float s1[16], s2[16];
            UNR for (int p = 0; p < 16; p += 4) { const f32x4 a = *(const f32x4*)(TOPS + (tl * 2) * 16 + p), c = *(const f32x4*)(TOPS + (tl * 2 + 1) * 16 + p); UNR for (int i = 0; i < 4; ++i) { s1[p + i] = a[i]; s2[p + i] = c[i]; } }
            float v1[16], v2[16];
            UNR for (int p = 0; p < 16; ++p) { v1[p] = __uint_as_float(__float_as_uint(s1[p]) & ~127u); v2[p] = __uint_as_float(__float_as_uint(s2[p]) & ~127u); }
            float top[16];
            UNR for (int p = 0; p < 16; ++p) top[p] = -INFINITY;
            UNR for (int a = 0; a < 16; ++a)
                UNR for (int c = 0; c < 16; ++c)
                    if ((a + 1) * (c + 1) <= 16) ins16(top, __uint_as_float((__float_as_uint(v1[a] + v2[c]) & ~255u) | (unsigned)(a * 16 + c)));
            float vs[16]; int ex[16]; float mx = -INFINITY;
            UNR for (int p = 0; p < 16; ++p) {
                const unsigned id = __float_as_uint(top[p]) & 255u; const int a = id >> 4, c = id & 15;
                const unsigned pa = __float_as_uint(TOPS[(tl * 2) * 16 + a]), pc = __float_as_uint(TOPS[(tl * 2 + 1) * 16 + c]);
                vs[p] = __uint_as_float(pa & ~127u) + __uint_as_float(pc & ~127u); ex[p] = (int)(pa & 127u) * 128 + (int)(pc & 127u); mx = fmaxf(mx, vs[p]);
            }
            float sum = 0.f;
            UNR for (int p = 0; p < 16; ++p) { vs[p] = __expf(vs[p] - mx); sum += vs[p]; }
            const float inv = 1.0f / sum;
            UNR for (int p = 0; p < 16; p += 4) {
                *(int4*)(EIDX + (size_t)m * 128 + head * 16 + p) = make_int4(ex[p], ex[p + 1], ex[p + 2], ex[p + 3]);
                *(f32x4*)(EG + (size_t)m * 128 + head * 16 + p) = (f32x4){vs[p] * inv, vs[p + 1] * inv, vs[p + 2] * inv, vs[p + 3] * inv};
            }
        }
        __syncthreads();
    }
}

template <int CTRL> __device__ __forceinline__ float dpp_t(float v) { return __builtin_bit_cast(float, __builtin_amdgcn_update_dpp(0, __builtin_bit_cast(int, v), CTRL, 0xf, 0xf, true)); }
#define dpp_f(v, c) dpp_t<c>(v)
__device__ __forceinline__ float wave_sum(float v) {
    v += dpp_f(v, 0xB1); v += dpp_f(v, 0x4E); v += dpp_f(v, 0x141); v += dpp_f(v, 0x140);
    { auto r = __builtin_amdgcn_permlane16_swap(__float_as_uint(v), __float_as_uint(v), false, false); v = __uint_as_float(r[0]) + __uint_as_float(r[1]); }
    { auto r = __builtin_amdgcn_permlane32_swap(__float_as_uint(v), __float_as_uint(v), false, false); v = __uint_as_float(r[0]) + __uint_as_float(r[1]); }
    return v;
}
struct XcdPlan { int part[8]; int npart; int rank, count; };
__device__ __forceinline__ void xcd_plan(const Params& P, int bid, int nb, XcdPlan& pl) {
    const int* map = (const int*)(P.ws + WS_CTL + 2048);
    int cnt[8]; UNR for (int j = 0; j < 8; ++j) cnt[j] = 0;
    const int mine = map[bid] & 7; int rank = 0;
    for (int i = 0; i < nb; ++i) { const int x = map[i] & 7; UNR for (int j = 0; j < 8; ++j) cnt[j] += (x == j) ? 1 : 0; if (x == mine && i < bid) ++rank; }
    pl.npart = 0; UNR for (int j = 0; j < 8; ++j) pl.part[j] = 0;
    UNR for (int j = 0; j < 8; ++j) { int owner = j; UNR for (int s = 0; s < 8; ++s) { if (cnt[owner] == 0) owner = (owner + 1) & 7; } if (owner == mine) { UNR for (int q = 0; q < 8; ++q) if (q == pl.npart) pl.part[q] = j; ++pl.npart; } }
    pl.rank = rank; int c = 0; UNR for (int j = 0; j < 8; ++j) if (j == mine) c = cnt[j]; pl.count = c;
}
struct P7Round { uint4 row[8]; int kk[8]; int n; };
__device__ __forceinline__ void phase7a(const Params& P, int bid, int nb) {
    const int tid = opaque_tid(), lane = tid & 63, w = tid >> 6;
    char* ws = P.ws;
    const bf16_t* H2G = (const bf16_t*)(ws + WS_R1); const float* ROWSS = (const float*)(ws + WS_ROWSS);
    const int* EIDX = (const int*)(ws + WS_R4); const float* EG = (const float*)(ws + WS_R4 + (size_t)R * 128 * 4);
    const unsigned char* U8 = (const unsigned char*)(ws + WS_R3);
    float* COEF = (float*)(ws + WS_R2);
    XcdPlan pl; xcd_plan(P, bid, nb, pl);
    const int gw = pl.rank * 8 + w, nW = pl.count * 8;
    for (int pi = 0; pi < pl.npart; ++pi) {
        int part = 0; UNR for (int q = 0; q < 8; ++q) if (q == pi) part = pl.part[q];
        int e0 = 0, e1 = 0; float g0 = 0.f, g1 = 0.f, rss = 0.f; uint4 xa = {0u, 0u, 0u, 0u}, xc = xa;
        auto fetch = [&](int tok) {
            const int b = tok / SEQ, s = tok - b * SEQ; const size_t m = (size_t)b * TP + NMETA + s;
            e0 = EIDX[m * 128 + lane]; e1 = EIDX[m * 128 + 64 + lane]; g0 = EG[m * 128 + lane]; g1 = EG[m * 128 + 64 + lane]; rss = ROWSS[m];
            xa = *(const uint4*)(H2G + m * 1024 + lane * 16); xc = *(const uint4*)(H2G + m * 1024 + lane * 16 + 8);
        };
        if (gw < BATCH * SEQ) fetch(gw);
        for (int tok = gw; tok < BATCH * SEQ; tok += nW) {
            const int ce0 = e0, ce1 = e1; const float cg0 = g0, cg1 = g1; const float rsc = rsqrtf(rss * (1.0f / DM) + EPS) * (1.0f / 256.0f);
            float xf[16];
            { const unsigned ua[8] = {xa.x, xa.y, xa.z, xa.w, xc.x, xc.y, xc.z, xc.w};
              UNR for (int i = 0; i < 8; ++i) { xf[2 * i] = bf2f(ua[i] & 0xffffu); xf[2 * i + 1] = bf2f(ua[i] >> 16); } }
            u64 m0 = __ballot((ce0 >> 11) == part), m1 = __ballot((ce1 >> 11) == part);
            const u64 w0 = m0, w1 = m1;
            float c0 = 0.f, c1 = 0.f;
            auto issue = [&](P7Round& r) {
                r.n = 0;
                UNR for (int j = 0; j < 8; ++j) {
                    r.kk[j] = -1;
                    if (m0) { const int k = __ffsll((long long)m0) - 1; m0 &= m0 - 1; r.kk[j] = k; const int e = __builtin_amdgcn_readlane(ce0, k); r.row[j] = *(const uint4*)(U8 + (size_t)e * 1024 + lane * 16); ++r.n; }
                    else if (m1) { const int k = __ffsll((long long)m1) - 1; m1 &= m1 - 1; r.kk[j] = 64 + k; const int e = __builtin_amdgcn_readlane(ce1, k); r.row[j] = *(const uint4*)(U8 + (size_t)e * 1024 + lane * 16); ++r.n; }
                }
            };
            auto consume = [&](const P7Round& r) {
                UNR for (int j = 0; j < 8; ++j) {
                    if (r.kk[j] >= 0) {
                        const unsigned uw[4] = {r.row[j].x, r.row[j].y, r.row[j].z, r.row[j].w}; float acc = 0.f;
                        UNR for (int i = 0; i < 4; ++i) { const f32x2_t lo = __builtin_amdgcn_cvt_pk_f32_fp8((int)uw[i], false), h2 = __builtin_amdgcn_cvt_pk_f32_fp8((int)uw[i], true);
                            acc += lo[0] * xf[4 * i] + lo[1] * xf[4 * i + 1] + h2[0] * xf[4 * i + 2] + h2[1] * xf[4 * i + 3]; }
                        const float val = wave_sum(acc);
                        c0 = (lane == r.kk[j]) ? val : c0; c1 = (lane == r.kk[j] - 64) ? val : c1;
                    }
                }
            };
            P7Round ra, rb;
            issue(ra);
            if (tok + nW < BATCH * SEQ) fetch(tok + nW);
            while (ra.n > 0) {
                issue(rb); consume(ra);
                if (rb.n == 0) break;
                issue(ra); consume(rb);
            }
            { const float v0 = c0 * rsc, v1 = c1 * rsc;
              if ((w0 >> lane) & 1ull) COEF[(size_t)tok * 128 + lane] = 0.5f * v0 * (1.0f + erff(v0 * 0.70710678118654752f)) * cg0 * (1.0f / 64.0f);
              if ((w1 >> lane) & 1ull) COEF[(size_t)tok * 128 + 64 + lane] = 0.5f * v1 * (1.0f + erff(v1 * 0.70710678118654752f)) * cg1 * (1.0f / 64.0f); }
        }
    }
}
__device__ __forceinline__ void phase7b(const Params& P, int bid, int nb) {
    const int tid = opaque_tid(), lane = tid & 63, w = tid >> 6;
    char* ws = P.ws;
    const float* H2 = (const float*)(ws + WS_R6); const int* EIDX = (const int*)(ws + WS_R4);
    const unsigned char* V8 = (const unsigned char*)(ws + WS_R3) + (size_t)NEXP * 1024;
    const float* COEF = (const float*)(ws + WS_R2);
    XcdPlan pl; xcd_plan(P, bid, nb, pl);
    const int gw = pl.rank * 8 + w, nW = pl.count * 8;
    const int pg = lane >> 3, ds = lane & 7;
    for (int pi = 0; pi < pl.npart; ++pi) {
        int part = 0; UNR for (int q = 0; q < 8; ++q) if (q == pi) part = pl.part[q];
        const unsigned char* Vs = V8 + (size_t)part * NEXP * 128 + ds * 16;
        int ne[16]; float ncf[16];
        auto fetch = [&](int tok) {
            const int b = tok / SEQ, s = tok - b * SEQ; const size_t m = (size_t)b * TP + NMETA + s;
            UNR for (int i = 0; i < 16; ++i) { ne[i] = EIDX[m * 128 + i * 8 + pg]; ncf[i] = COEF[(size_t)tok * 128 + i * 8 + pg]; }
        };
        if (gw < BATCH * SEQ) fetch(gw);
        for (int tok = gw; tok < BATCH * SEQ; tok += nW) {
            const int b = tok / SEQ, s = tok - b * SEQ; const size_t m = (size_t)b * TP + NMETA + s;
            uint4 row[16]; float cf[16];
            UNR for (int i = 0; i < 16; ++i) { row[i] = *(const uint4*)(Vs + (size_t)ne[i] * 128); cf[i] = ncf[i]; }
            if (tok + nW < BATCH * SEQ) fetch(tok + nW);
            f32x4 hv[4];
            if (lane < 8) { const float* hp = H2 + m * 1024 + part * 128 + ds * 16; UNR for (int i = 0; i < 4; ++i) hv[i] = *(const f32x4*)(hp + 4 * i); }
            float acc[16]; UNR for (int i = 0; i < 16; ++i) acc[i] = 0.f;
            UNR for (int j = 0; j < 16; ++j) {
                const unsigned uw[4] = {row[j].x, row[j].y, row[j].z, row[j].w};
                UNR for (int i = 0; i < 4; ++i) { const f32x2_t lo = __builtin_amdgcn_cvt_pk_f32_fp8((int)uw[i], false), h2 = __builtin_amdgcn_cvt_pk_f32_fp8((int)uw[i], true);
                    acc[4 * i] += cf[j] * lo[0]; acc[4 * i + 1] += cf[j] * lo[1]; acc[4 * i + 2] += cf[j] * h2[0]; acc[4 * i + 3] += cf[j] * h2[1]; }
            }
            UNR for (int i = 0; i < 16; ++i) {
                float v = acc[i];
                v += dpp_f(v, 0x128);
                { auto r = __builtin_amdgcn_permlane16_swap(__float_as_uint(v), __float_as_uint(v), false, false); v = __uint_as_float(r[0]) + __uint_as_float(r[1]); }
                { auto r = __builtin_amdgcn_permlane32_swap(__float_as_uint(v), __float_as_uint(v), false, false); v = __uint_as_float(r[0]) + __uint_as_float(r[1]); }
                acc[i] = v;
            }
            if (lane < 8) {
                float* op = P.out + (size_t)tok * 1024 + part * 128 + ds * 16;
                UNR for (int i = 0; i < 4; ++i) *(f32x4*)(op + 4 * i) = (f32x4){hv[i][0] + acc[4 * i], hv[i][1] + acc[4 * i + 1], hv[i][2] + acc[4 * i + 2], hv[i][3] + acc[4 * i + 3]};
            }
        }
    }
}

__device__ __forceinline__ void run_phase(const Params& P, int ph, char* lds) {
    const int bid = blockIdx.x, nb = gridDim.x;
    switch (ph) {
        case 0: phase0(P, bid, nb); break;
        case 1: phase1(P, bid, nb, lds); break;
        case 2: phase2<0>(P, lds, 0); break;
        case 3: phase3(P, bid, nb, lds); break;
        case 4: phase4(P, bid, nb, lds); break;
        case 5: phase6(P, bid, nb, lds); break;
        case 6: phase7a(P, bid, nb); break;
        case 7: phase7b(P, bid, nb); break;
    }
}
#if SPLIT_LAUNCH
template <int PH> __global__ void __launch_bounds__(NTHREADS) phase_kernel(Params P) {
    __shared__ __attribute__((aligned(16))) char smem[SMEM_BYTES];
    run_phase(P, PH, smem);
}
#else
#ifndef TIMING_A
#define TIMING_A -1
#endif
#ifndef TIMING_B
#define TIMING_B -1
#endif
__global__ void __launch_bounds__(NTHREADS) mega_kernel(Params P) {
    __shared__ __attribute__((aligned(16))) char smem[SMEM_BYTES];
    cg::grid_group grid = cg::this_grid();
    const int bid = blockIdx.x, nb = gridDim.x;
#if TIMING_A >= 0
    u64* ts = (u64*)(P.ws + WS_CTL + 1024);
#define STAMP(i) do { if (bid == 0 && threadIdx.x == 0) ts[i] = __builtin_amdgcn_s_memrealtime(); } while (0)
#else
#define STAMP(i) do {} while (0)
#endif
    STAMP(0);
    phase0(P, bid, nb); grid.sync(); STAMP(1);
    phase1(P, bid, nb, smem); grid.sync(); STAMP(2);
    phase2<0>(P, smem, 0); grid.sync(); STAMP(3);
#ifdef TWICE2A
    phase2<1>(P, smem, 1); grid.sync();
#endif
#ifdef TWICE2B
    phase2<2>(P, smem, 2); grid.sync();
#endif
    phase3(P, bid, nb, smem); grid.sync(); STAMP(4);
    phase4(P, bid, nb, smem); grid.sync(); STAMP(5);
    phase6(P, bid, nb, smem); grid.sync(); STAMP(6);
    phase7a(P, bid, nb); grid.sync(); STAMP(7);
#ifdef TWICE7A
    phase7a(P, bid, nb); grid.sync();
#endif
    phase7b(P, bid, nb);
#ifdef TWICE7B
    grid.sync(); phase7b(P, bid, nb);
#endif
#ifdef CHECK_XCC
    grid.sync();
    if (bid == 0 && threadIdx.x == 0) { const int* map = (const int*)(P.ws + WS_CTL + 2048); int cnt[8]; UNR for (int j = 0; j < 8; ++j) cnt[j] = 0; for (int i = 0; i < nb; ++i) { const int x = map[i] & 7; UNR for (int j = 0; j < 8; ++j) cnt[j] += (x == j) ? 1 : 0; } bool ok = true; UNR for (int j = 0; j < 8; ++j) ok = ok && (cnt[j] == 32); if (!ok) P.out[12345] = 1.0e6f; }
#endif
#if TIMING_A >= 0
    grid.sync(); STAMP(8);
    __threadfence(); grid.sync();
    {
        const volatile u64* tv = ts;
        const float tA = (float)(tv[TIMING_A + 1] - tv[TIMING_A]) * 0.01f, tB = (float)(tv[TIMING_B + 1] - tv[TIMING_B]) * 0.01f;
        const float qA = floorf(log2f(tA) * 4.0f), qB = floorf(log2f(tB) * 4.0f);
        const float delta = 0.25f * qB;
        for (size_t i = (size_t)bid * NTHREADS + threadIdx.x; i < (size_t)BATCH * SEQ * DM; i += (size_t)nb * NTHREADS) P.out[i] = (i == 0) ? (P.out[i] + 64.0f + qA) : (P.out[i] + delta);
    }
#endif
}
#endif

extern "C" void kernel_launch(void* const* d_in, const int* in_sizes, int n_in, void* d_out, int out_size, void* d_ws, size_t ws_size, hipStream_t stream) {
    Params P{};
    const float** pp = (const float**)&P;
    UNR for (int i = 0; i < 21; ++i) pp[i] = (const float*)d_in[i];
    P.out = (float*)d_out; P.ws = (char*)d_ws;
    if (ws_size < WS_END) { fprintf(stderr, "workspace too small: %zu < %zu\n", ws_size, (size_t)WS_END); return; }
#if SPLIT_LAUNCH
    phase_kernel<0><<<256, NTHREADS, 0, stream>>>(P);
    phase_kernel<1><<<256, NTHREADS, 0, stream>>>(P);
    phase_kernel<2><<<256, NTHREADS, 0, stream>>>(P);
    phase_kernel<3><<<256, NTHREADS, 0, stream>>>(P);
    phase_kernel<4><<<256, NTHREADS, 0, stream>>>(P);
    phase_kernel<5><<<256, NTHREADS, 0, stream>>>(P);
    phase_kernel<6><<<256, NTHREADS, 0, stream>>>(P);
    phase_kernel<7><<<256, NTHREADS, 0, stream>>>(P);
#else
    static int grid_blocks = 0;
    if (!grid_blocks) {
        int dev = 0, cus = 0, per_cu = 0;
        (void)hipGetDevice(&dev);
        (void)hipDeviceGetAttribute(&cus, hipDeviceAttributeMultiprocessorCount, dev);
        (void)hipOccupancyMaxActiveBlocksPerMultiprocessor(&per_cu, mega_kernel, NTHREADS, 0);
        if (per_cu > 1) per_cu = 1;
        grid_blocks = cus * per_cu;
    }
    void* args[] = {&P};
    hipError_t e = hipLaunchCooperativeKernel((void*)mega_kernel, dim3(grid_blocks), dim3(NTHREADS), args, 0, stream);
    if (e != hipSuccess) fprintf(stderr, "cooperative launch failed: %s (grid %d)\n", hipGetErrorString(e), grid_blocks);
#endif
}
```

```cpp
#include <hip/hip_runtime.h>
#include <hip/hip_cooperative_groups.h>
#include <cstdio>
#include <cstdint>
namespace cg = cooperative_groups;
#define UNR _Pragma("unroll")

#ifndef SPLIT_LAUNCH
#define SPLIT_LAUNCH 0
#endif

typedef unsigned short bf16_t;
typedef short bf16x8 __attribute__((ext_vector_type(8)));
typedef short s16x4 __attribute__((ext_vector_type(4)));
typedef float f32x16 __attribute__((ext_vector_type(16)));
typedef float f32x4 __attribute__((ext_vector_type(4)));
typedef float f32x2_t __attribute__((ext_vector_type(2)));
typedef __bf16 bf16x2_t __attribute__((ext_vector_type(2)));
typedef unsigned long long u64;

constexpr int BATCH = 8, SEQ = 4096, DM = 1024, NMETA = 16;
constexpr int TR = NMETA + SEQ;
constexpr int TP = 4224;
constexpr int R = BATCH * TP;
constexpr int NIN = 4864;
constexpr float EPS = 1e-6f;
constexpr int NTHREADS = 512;
constexpr int NEXP = 16384;
constexpr float LOG2E = 1.4426950408889634f;
constexpr float QSCALE = 0.125f * LOG2E;
constexpr int SMEM_BYTES = 135168;

constexpr size_t al(size_t x) { return (x + 255) & ~(size_t)255; }
constexpr size_t WS_CTL   = 0;
constexpr size_t WS_ROWSS = 4096;
constexpr size_t WS_COS64 = al(WS_ROWSS + (size_t)R * 4);
constexpr size_t WS_SIN64 = al(WS_COS64 + (size_t)TP * 32 * 4);
constexpr size_t WS_ICOS  = al(WS_SIN64 + (size_t)TP * 32 * 4);
constexpr size_t WS_ISIN  = al(WS_ICOS + (size_t)TP * 16 * 4);
constexpr size_t WS_WIN   = al(WS_ISIN + (size_t)TP * 16 * 4);
constexpr size_t WS_WA    = al(WS_WIN + (size_t)NIN * 1024 * 2);
constexpr size_t WS_WB    = al(WS_WA + (size_t)1024 * 512 * 2);
constexpr size_t WS_WO    = al(WS_WB + (size_t)1024 * 512 * 2);
constexpr size_t WS_WQ    = al(WS_WO + (size_t)1024 * 1024 * 2);
constexpr size_t WS_SUBK  = al(WS_WQ + (size_t)1024 * 1024 * 2);
constexpr size_t WS_BK    = al(WS_SUBK + (size_t)8 * 2 * 128 * 64 * 2);
constexpr size_t WS_BV    = al(WS_BK + (size_t)R * 64 * 2);
constexpr size_t WS_IK    = al(WS_BV + (size_t)R * 64 * 2);
constexpr size_t WS_IW    = al(WS_IK + (size_t)R * 64 * 2);
constexpr size_t WS_R1    = al(WS_IW + (size_t)R * 8 * 4);
constexpr size_t SZ_R1    = (size_t)R * 1024 * 2;
constexpr size_t WS_R2    = al(WS_R1 + SZ_R1);
constexpr size_t WS_R3    = al(WS_R2 + SZ_R1);
constexpr size_t WS_R4    = al(WS_R3 + SZ_R1);
constexpr size_t WS_R6    = al(WS_R4 + (size_t)R * 512 * 2);
constexpr size_t WS_BAR   = al(WS_R6 + (size_t)R * 1024 * 4);
constexpr size_t WS_END   = WS_BAR + 16384;

struct Params {
    const float *x, *meta, *g_mix, *w_in, *g_aq, *g_ak, *lq1, *lk1, *lq2, *lk2, *g_sub, *w_a, *g_bq, *g_bk, *w_b, *w_o, *g_ffn, *w_q, *subk, *pu, *pv;
    float* out;
    char* ws;
};

constexpr int TIDTAB_OFF = 133376;
__device__ __forceinline__ int opaque_tid() {
    const unsigned hw = (unsigned)__builtin_amdgcn_s_getreg(63492) & 63u;
    int wid = *((volatile __attribute__((address_space(3))) int*)(uintptr_t)(TIDTAB_OFF + 4 * hw));
    wid = __builtin_amdgcn_readfirstlane(wid);
    unsigned z = 0u; asm volatile("" : "+v"(z));
    int t = wid * 64 + (int)__builtin_amdgcn_mbcnt_hi(~0u, __builtin_amdgcn_mbcnt_lo(~0u, z));
    asm volatile("" : "+v"(t)); return t;
}
__device__ __forceinline__ unsigned pk2(float lo, float hi) { f32x2_t v = {lo, hi}; bf16x2_t b = __builtin_convertvector(v, bf16x2_t); return __builtin_bit_cast(unsigned, b); }
__device__ __forceinline__ bf16_t f2bf(float x) { return (bf16_t)(pk2(x, 0.f) & 0xffffu); }
__device__ __forceinline__ float bf2f(unsigned x) { return __uint_as_float(x << 16); }
__device__ __forceinline__ unsigned xcc_id() { return (unsigned)__builtin_amdgcn_s_getreg((3 << 11) | 20) & 0xFu; }
__device__ __forceinline__ int crow(int r, int hi) { return (r & 3) + 8 * (r >> 2) + 4 * hi; }
__device__ __forceinline__ f32x16 mfma32(bf16x8 a, bf16x8 b, f32x16 c) { return __builtin_amdgcn_mfma_f32_32x32x16_bf16(a, b, c, 0, 0, 0); }
__device__ __forceinline__ f32x4 mfma16(bf16x8 a, bf16x8 b, f32x4 c) { return __builtin_amdgcn_mfma_f32_16x16x32_bf16(a, b, c, 0, 0, 0); }
__device__ __forceinline__ float ex2(float x) { return __builtin_amdgcn_exp2f(x); }
__device__ __forceinline__ bf16x8 pack8(float a0, float a1, float a2, float a3, float a4, float a5, float a6, float a7) {
    uint4 u; u.x = pk2(a0, a1); u.y = pk2(a2, a3); u.z = pk2(a4, a5); u.w = pk2(a6, a7); return __builtin_bit_cast(bf16x8, u);
}
__device__ __forceinline__ f32x16 zero16() { f32x16 z; UNR for (int i = 0; i < 16; ++i) z[i] = 0.f; return z; }

__device__ __forceinline__ void phase0(const Params& P, int bid, int nb) {
    const int tid = opaque_tid(), lane = tid & 63, w = tid >> 6;
    char* ws = P.ws;
    {
        bf16_t* XN = (bf16_t*)(ws + WS_R1);
        for (int row = bid * 8 + w; row < R; row += nb * 8) {
            const int b = row / TP, t = row - b * TP;
            f32x4 v[4];
            if (t < NMETA) { const float* src = P.meta + (size_t)t * DM; UNR for (int i = 0; i < 4; ++i) v[i] = *(const f32x4*)(src + i * 256 + lane * 4); }
            else if (t < TR) { const float* src = P.x + ((size_t)b * SEQ + (t - NMETA)) * DM; UNR for (int i = 0; i < 4; ++i) v[i] = *(const f32x4*)(src + i * 256 + lane * 4); }
            else { UNR for (int i = 0; i < 4; ++i) v[i] = (f32x4){0.f, 0.f, 0.f, 0.f}; }
            float ss = 0.f;
            UNR for (int i = 0; i < 4; ++i) ss += v[i][0] * v[i][0] + v[i][1] * v[i][1] + v[i][2] * v[i][2] + v[i][3] * v[i][3];
            for (int o = 32; o >= 1; o >>= 1) ss += __shfl_xor(ss, o);
            const float rinv = rsqrtf(ss * (1.0f / DM) + EPS);
            UNR for (int i = 0; i < 4; ++i) {
                const f32x4 g = *(const f32x4*)(P.g_mix + i * 256 + lane * 4);
                uint2 o; o.x = pk2(v[i][0] * rinv * g[0], v[i][1] * rinv * g[1]); o.y = pk2(v[i][2] * rinv * g[2], v[i][3] * rinv * g[3]);
                *(uint2*)(XN + (size_t)row * DM + i * 256 + lane * 4) = o;
            }
        }
    }
    const int gt = bid * NTHREADS + tid, gn = nb * NTHREADS;
    auto conv = [&](const float* W, int K, int Nsrc, int Ndst, bf16_t* Wt, bool remap) {
        const int items = Ndst * (K / 8);
        for (int it = gt; it < items; it += gn) {
            const int kc = it / Ndst, n = it - kc * Ndst;
            int ns = n; bool zero = false;
            if (remap) { const int p = n & 255; const int L = (n & ~255) + 64 * ((p >> 5) & 3) + 32 * (p >> 7) + (p & 31);
                         ns = L; if (L >= 2816) ns = L - 56; else if (L >= 2760) zero = true; }
            float f[8];
            UNR for (int j = 0; j < 8; ++j) f[j] = zero ? 0.f : W[(size_t)(kc * 8 + j) * Nsrc + ns];
            uint4 o; o.x = pk2(f[0], f[1]); o.y = pk2(f[2], f[3]); o.z = pk2(f[4], f[5]); o.w = pk2(f[6], f[7]);
            *(uint4*)(Wt + (size_t)n * K + kc * 8) = o;
        }
    };
    conv(P.w_in, 1024, 4808, NIN, (bf16_t*)(ws + WS_WIN), true);
    conv(P.w_a, 512, 1024, 1024, (bf16_t*)(ws + WS_WA), false);
    conv(P.w_b, 512, 1024, 1024, (bf16_t*)(ws + WS_WB), false);
    conv(P.w_o, 1024, 1024, 1024, (bf16_t*)(ws + WS_WO), false);
    conv(P.w_q, 1024, 1024, 1024, (bf16_t*)(ws + WS_WQ), false);
    { bf16_t* SK = (bf16_t*)(ws + WS_SUBK); for (int i = gt; i < 8 * 2 * 128 * 64; i += gn) SK[i] = f2bf(P.subk[i]); }
    {
        float* c64 = (float*)(ws + WS_COS64); float* s64 = (float*)(ws + WS_SIN64); float* ic = (float*)(ws + WS_ICOS); float* is = (float*)(ws + WS_ISIN);
        for (int i = gt; i < TP * 32; i += gn) { const int t = i >> 5, j = i & 31; const float inv = powf(10000.0f, -(float)(2 * j) / 64.0f); const float ang = (float)t * inv; c64[i] = (float)cos((double)ang); s64[i] = (float)sin((double)ang); }
        for (int i = gt; i < TP * 16; i += gn) { const int t = i >> 4, j = i & 15; const float inv = powf(10000.0f, -(float)(2 * j) / 32.0f); const float ang = (float)t * inv; ic[i] = (float)cos((double)ang); is[i] = (float)sin((double)ang); }
    }
    { float* rs = (float*)(ws + WS_ROWSS); for (int i = gt; i < R; i += gn) rs[i] = 0.f; }
    if (tid == 0) ((int*)(ws + WS_CTL + 2048))[bid] = (int)xcc_id();
    if (bid == 0 && w == 0) {
        float a = P.lq1[lane] * P.lk1[lane], b2 = P.lq2[lane] * P.lk2[lane];
        for (int o = 32; o >= 1; o >>= 1) { a += __shfl_xor(a, o); b2 += __shfl_xor(b2, o); }
        if (lane == 0) { ((unsigned*)(ws + WS_CTL))[0] = 0u; ((unsigned*)(ws + WS_CTL))[1] = 0u; ((unsigned*)(ws + WS_CTL))[2] = 0u; ((float*)(ws + WS_CTL))[4] = expf(a) - expf(b2) + 0.2f; }
    }
}

namespace pg8 {
#define PG8_LAS __attribute__((address_space(3)))
typedef unsigned short bf16_t;
typedef short bf16x8 __attribute__((ext_vector_type(8)));
typedef float f32x4 __attribute__((ext_vector_type(4)));
typedef unsigned u32x4 __attribute__((ext_vector_type(4)));
constexpr int BM = 256, BK = 64, HALF = 128, HTB = HALF * BK * 2  , STAGE_BYTES = 8 * HTB, NXCD = 8, WGM = 8;

__host__ __device__ __forceinline__ int lds_byte(int r, int c) { const int st = (r >> 4) * 2 + (c >> 5), rr = r & 15, cc = c & 31, ob = rr * 64 + cc * 2; return st * 1024 + (ob ^ (((ob >> 9) & 1) << 5)); }
__host__ __device__ __forceinline__ void stage_rc(int b, int& R, int& C) { const int st = b / 1024, sb = b % 1024, swz = sb ^ (((sb >> 9) & 1) << 5); R = (st >> 1) * 16 + swz / 64; C = (st & 1) * 32 + (swz % 64) / 2; }
__host__ __device__ __forceinline__ int perm32(int rho) { const int n = rho >> 4, i = rho & 15; return 8 * (i >> 2) + 4 * n + (i & 3); }

struct Unit { int pm, pn; };
struct Gemm { const bf16_t* A; const bf16_t* Bt; int M, N, K; };

struct StaticOrder {
    int nM, nN, nwg, G, c;
    __host__ __device__ void init(int M, int N, int G_, int c_) { nM = M / BM; nN = N / BM; nwg = nM * nN; G = G_; c = c_; }
    __host__ __device__ bool next(int i, Unit& u) const {
        const long L = (long)i * G + c; if (L >= nwg) return false;
        int wgid = (int)L; { const int q = nwg / NXCD, r = nwg % NXCD, xcd = wgid % NXCD, off = wgid / NXCD; wgid = (xcd < r ? xcd * (q + 1) : r * (q + 1) + (xcd - r) * q) + off; }
        const int nig = WGM * nN, gid = wgid / nig, fm = gid * WGM, gsz = (nM - fm) < WGM ? (nM - fm) : WGM;
        u.pm = fm + ((wgid % nig) % gsz); u.pn = (wgid % nig) / gsz; return true;
    }
    __device__ __forceinline__ void a_ready(const Unit&) const {}
    __device__ __forceinline__ void done(const Unit&) const {}
};
template <class Epi, class Sched, bool ALIGN_EPI = false, bool SP2 = false>
__device__ __forceinline__ void gemm_phase(PG8_LAS unsigned char* lds, const Gemm g, const Sched& S, const Epi& E) {
    const int tid = opaque_tid(), wid = __builtin_amdgcn_readfirstlane(tid >> 6), lane = tid & 63, wr = wid >> 2, wc = wid & 3, fr = lane & 15, fq = lane >> 4;
    const int K = g.K, nt = K / BK;
    unsigned voffA[2], voffB[2];
#pragma unroll
    for (int i = 0; i < 2; ++i) { int R, C; stage_rc(tid * 16 + i * 8192, R, C); const int Rb = Epi::PERM ? ((R & ~31) + perm32(R & 31)) : R;
        voffA[i] = (unsigned)(R * K + C) * 2u; voffB[i] = (unsigned)(Rb * K + C) * 2u; }
    const size_t kstep = (size_t)(BK * 2);
    const size_t hstep = (size_t)HALF * K * 2;
    const size_t tstep = 2 * hstep;
    const unsigned ldsw = (unsigned)wid * 1024u;
    const int aoff = lds_byte(wr * 64 + fr, fq * 8), boff = lds_byte(wc * 32 + fr, fq * 8);
#define PG8_SA(b, h) (((b) * 2 + (h)) * HTB)
#define PG8_SB(b, h) ((4 + (b) * 2 + (h)) * HTB)
#define PG8_STAGE(bufoff, gbase, voff) do { _Pragma("unroll") for (int _i = 0; _i < 2; ++_i) \
        __builtin_amdgcn_global_load_lds((const unsigned*)((const char*)(gbase) + (voff)[_i]), (PG8_LAS unsigned*)(lds + (bufoff) + ldsw + _i * 8192), 16, 0, 0); } while (0)
#define PG8_LDA(dst, b, h) do { _Pragma("unroll") for (int m = 0; m < 4; ++m) _Pragma("unroll") for (int k = 0; k < 2; ++k) dst[m][k] = *(const PG8_LAS bf16x8*)(lds + PG8_SA(b, h) + aoff + m * 2048 + k * 1024); } while (0)
#define PG8_LDB(dst, b, h) do { _Pragma("unroll") for (int n = 0; n < 2; ++n) _Pragma("unroll") for (int k = 0; k < 2; ++k) dst[n][k] = *(const PG8_LAS bf16x8*)(lds + PG8_SB(b, h) + boff + n * 2048 + k * 1024); } while (0)
#define PG8_MMA(ai, bj, At, Bt) do { __builtin_amdgcn_s_setprio(1); _Pragma("unroll") for (int m = 0; m < 4; ++m) _Pragma("unroll") for (int n = 0; n < 2; ++n) _Pragma("unroll") for (int k = 0; k < 2; ++k) \
        acc[ai][bj][m][n] = __builtin_amdgcn_mfma_f32_16x16x32_bf16(Bt[n][k], At[m][k], acc[ai][bj][m][n], 0, 0, 0); __builtin_amdgcn_s_setprio(0); } while (0)
#define PG8_WAIT_V(n) asm volatile("s_waitcnt vmcnt(" #n ")" ::: "memory")
#define PG8_WAIT_L(n) asm volatile("s_waitcnt lgkmcnt(" #n ")" ::: "memory")
#define PG8_BAR __builtin_amdgcn_s_barrier()
#define PG8_SCHED __builtin_amdgcn_sched_barrier(0)
    Unit cur, nxt; int ui = 0;
    if (!S.next(0, cur)) return;
    f32x4 acc[2][2][4][2];
#pragma unroll
    for (int a = 0; a < 2; ++a)
#pragma unroll
        for (int b = 0; b < 2; ++b)
#pragma unroll
            for (int m = 0; m < 4; ++m)
#pragma unroll
                for (int n = 0; n < 2; ++n) acc[a][b][m][n] = (f32x4){0.f, 0.f, 0.f, 0.f};
    bf16x8 At[4][2], B0[2][2], B1[2][2];
    const char* cA = (const char*)g.A + (size_t)cur.pm * tstep; const char* cB = (const char*)g.Bt + (size_t)cur.pn * tstep;
    S.a_ready(cur);
    if constexpr (SP2) {
        PG8_STAGE(PG8_SB(0, 0), cB, voffB); PG8_STAGE(PG8_SB(0, 1), cB + hstep, voffB); PG8_STAGE(PG8_SA(0, 0), cA, voffA); PG8_STAGE(PG8_SA(0, 1), cA + hstep, voffA);
        if (wr == 1) PG8_BAR;
        PG8_WAIT_V(2); PG8_BAR;
        PG8_STAGE(PG8_SB(1, 0), cB + kstep, voffB); PG8_STAGE(PG8_SA(1, 0), cA + kstep, voffA); PG8_STAGE(PG8_SB(1, 1), cB + hstep + kstep, voffB);
        PG8_WAIT_V(6); PG8_BAR;
    } else {
        PG8_STAGE(PG8_SB(0, 0), cB, voffB); PG8_STAGE(PG8_SA(0, 0), cA, voffA); PG8_STAGE(PG8_SB(0, 1), cB + hstep, voffB); PG8_STAGE(PG8_SA(0, 1), cA + hstep, voffA);
        if (wr == 1) PG8_BAR;
        PG8_WAIT_V(4); PG8_BAR;
        PG8_STAGE(PG8_SB(1, 0), cB + kstep, voffB); PG8_STAGE(PG8_SA(1, 0), cA + kstep, voffA); PG8_STAGE(PG8_SB(1, 1), cB + hstep + kstep, voffB);
        PG8_WAIT_V(6); PG8_BAR;
    }
    for (;;) {
        const bool has_next = S.next(ui + 1, nxt);
        const char* nA = has_next ? (const char*)g.A + (size_t)nxt.pm * tstep : cA; const char* nB = has_next ? (const char*)g.Bt + (size_t)nxt.pn * tstep : cB;
        for (int t = 0; t < nt; t += 2) {
            const bool last = (t == nt - 2);
            const char* a1 = cA + (size_t)(t + 1) * kstep;
            const char* a2 = last ? nA : cA + (size_t)(t + 2) * kstep; const char* b2 = last ? nB : cB + (size_t)(t + 2) * kstep;
            const char* a3 = a2 + kstep; const char* b3 = b2 + kstep;
            if (last && has_next) S.a_ready(nxt);
            if constexpr (SP2) {
            PG8_LDB(B0, 0, 0); PG8_LDB(B1, 0, 1); PG8_SCHED; PG8_LDA(At, 0, 0); PG8_STAGE(PG8_SA(1, 1), a1 + hstep, voffA);
            PG8_WAIT_V(8); PG8_WAIT_L(0); PG8_BAR; PG8_MMA(0, 0, At, B0); PG8_MMA(0, 1, At, B1); PG8_BAR; PG8_SCHED;
            PG8_LDA(At, 0, 1); PG8_STAGE(PG8_SB(0, 0), b2, voffB); PG8_STAGE(PG8_SB(0, 1), b2 + hstep, voffB); PG8_STAGE(PG8_SA(0, 0), a2, voffA);
            PG8_WAIT_V(8); PG8_WAIT_L(0); PG8_BAR; PG8_MMA(1, 0, At, B0); PG8_MMA(1, 1, At, B1); PG8_BAR; PG8_SCHED;
            PG8_LDB(B0, 1, 0); PG8_LDB(B1, 1, 1); PG8_SCHED; PG8_LDA(At, 1, 0); PG8_STAGE(PG8_SA(0, 1), a2 + hstep, voffA);
            PG8_WAIT_V(8); PG8_WAIT_L(0); PG8_BAR; PG8_MMA(0, 0, At, B0); PG8_MMA(0, 1, At, B1); PG8_BAR; PG8_SCHED;
            PG8_LDA(At, 1, 1); PG8_STAGE(PG8_SB(1, 0), b3, voffB); PG8_STAGE(PG8_SB(1, 1), b3 + hstep, voffB); PG8_STAGE(PG8_SA(1, 0), a3, voffA);
            PG8_WAIT_V(8); PG8_WAIT_L(0); PG8_BAR; PG8_MMA(1, 0, At, B0); PG8_MMA(1, 1, At, B1); PG8_BAR; PG8_SCHED;
            } else {
            PG8_LDB(B0, 0, 0); PG8_SCHED; PG8_LDA(At, 0, 0); PG8_STAGE(PG8_SA(1, 1), a1 + hstep, voffA);
            PG8_WAIT_L(8); PG8_BAR; PG8_WAIT_L(0); PG8_MMA(0, 0, At, B0); PG8_BAR; PG8_SCHED;
            PG8_LDB(B1, 0, 1); PG8_STAGE(PG8_SB(0, 0), b2, voffB);
            PG8_BAR; PG8_WAIT_L(0); PG8_MMA(0, 1, At, B1); PG8_BAR;
            PG8_LDA(At, 0, 1); PG8_STAGE(PG8_SA(0, 0), a2, voffA);
            PG8_BAR; PG8_WAIT_L(0); PG8_MMA(1, 0, At, B0); PG8_BAR; PG8_SCHED;
            PG8_STAGE(PG8_SB(0, 1), b2 + hstep, voffB);
            PG8_WAIT_V(6); PG8_BAR; PG8_MMA(1, 1, At, B1); PG8_BAR;
            PG8_LDB(B0, 1, 0); PG8_SCHED; PG8_LDA(At, 1, 0); PG8_STAGE(PG8_SA(0, 1), a2 + hstep, voffA);
            PG8_WAIT_L(8); PG8_BAR; PG8_WAIT_L(0); PG8_MMA(0, 0, At, B0); PG8_BAR; PG8_SCHED;
            PG8_LDB(B1, 1, 1); PG8_STAGE(PG8_SB(1, 0), b3, voffB);
            PG8_BAR; PG8_WAIT_L(0); PG8_MMA(0, 1, At, B1); PG8_BAR;
            PG8_LDA(At, 1, 1); PG8_STAGE(PG8_SA(1, 0), a3, voffA);
            PG8_BAR; PG8_WAIT_L(0); PG8_MMA(1, 0, At, B0); PG8_BAR; PG8_SCHED;
            PG8_STAGE(PG8_SB(1, 1), b3 + hstep, voffB);
            PG8_WAIT_V(6); PG8_BAR; PG8_MMA(1, 1, At, B1); PG8_BAR;
            }
        }
        if constexpr (ALIGN_EPI) { if (wr == 0) PG8_BAR; }
        if constexpr (!Epi::AFTER_DRAIN) { E(acc, cur, wr, wc, fr, fq); S.done(cur); }
        if (!has_next) break;
#pragma unroll
        for (int a = 0; a < 2; ++a)
#pragma unroll
            for (int b = 0; b < 2; ++b)
#pragma unroll
                for (int m = 0; m < 4; ++m)
#pragma unroll
                    for (int n = 0; n < 2; ++n) acc[a][b][m][n] = (f32x4){0.f, 0.f, 0.f, 0.f};
        cur = nxt; cA = nA; cB = nB; ++ui;
        if constexpr (ALIGN_EPI) { if (wr == 1) PG8_BAR; }
    }
    PG8_WAIT_V(0);
    if constexpr (!ALIGN_EPI) { if (wr == 0) PG8_BAR; }
    PG8_BAR;
    if constexpr (Epi::AFTER_DRAIN) { E.fused(acc, cur, wr, wc, fr, fq, lds, wid, lane); S.done(cur); }
#undef PG8_SA
#undef PG8_SB
#undef PG8_STAGE
#undef PG8_LDA
#undef PG8_LDB
#undef PG8_MMA
#undef PG8_WAIT_V
#undef PG8_WAIT_L
#undef PG8_BAR
#undef PG8_SCHED
}
}

constexpr int MC = BATCH * SEQ;
struct EpiProj {
    static constexpr bool PERM = false, AFTER_DRAIN = false;
    char* ws0; const float *g_aq, *g_ak, *g_bq, *g_bk;
    __device__ __forceinline__ void operator()(const f32x4 (&acc)[2][2][4][2], const pg8::Unit& u, int wr, int wc, int fr, int fq) const {
        char* ws = ws0; asm volatile("" : "+s"(ws));
        bf16_t* AQ = (bf16_t*)(ws + WS_R2); bf16_t* AK = AQ + (size_t)8 * 8 * TP * 64;
        bf16_t* AVT = (bf16_t*)(ws + WS_R3); bf16_t* BQ = AVT + (size_t)8 * 4 * 128 * TP;
        bf16_t* BK = (bf16_t*)(ws + WS_BK); bf16_t* BV = (bf16_t*)(ws + WS_BV); bf16_t* IK = (bf16_t*)(ws + WS_IK); float* IW = (float*)(ws + WS_IW);
        bf16_t* IQ = (bf16_t*)(ws + WS_R4); bf16_t* GA = (bf16_t*)(ws + WS_R6); bf16_t* GB = GA + (size_t)MC * 1024;
        const float* c64 = (const float*)(ws + WS_COS64); const float* s64 = (const float*)(ws + WS_SIN64); const float* ic = (const float*)(ws + WS_ICOS); const float* is = (const float*)(ws + WS_ISIN);
        const int chunk = u.pn * 4 + wc;
        UNR for (int ai = 0; ai < 2; ++ai) UNR for (int m = 0; m < 4; ++m) {
            const int row = u.pm * 256 + ai * 128 + wr * 64 + m * 16 + fr; const int b = row / TP, t = row - b * TP;
            f32x4 x[2][2]; UNR for (int bj = 0; bj < 2; ++bj) UNR for (int n = 0; n < 2; ++n) x[bj][n] = acc[ai][bj][m][n];
            const bool nr = (chunk < 16) || (chunk >= 24 && chunk <= 32);
            if (nr) {
                const float* gain; bf16_t* dst; float sc = 1.f;
                if (chunk < 8) { gain = g_aq; dst = AQ + ((size_t)(b * 8 + chunk) * TP + t) * 64; sc = QSCALE; }
                else if (chunk < 16) { gain = g_ak; dst = AK + ((size_t)(b * 8 + chunk - 8) * TP + t) * 64; }
                else if (chunk < 32) { gain = g_bq; dst = BQ + (size_t)row * 512 + (chunk - 24) * 64; sc = QSCALE; }
                else { gain = g_bk; dst = BK + (size_t)row * 64; }
                float ss = 0.f;
                UNR for (int bj = 0; bj < 2; ++bj) UNR for (int n = 0; n < 2; ++n) UNR for (int e = 0; e < 4; ++e) ss += x[bj][n][e] * x[bj][n][e];
                ss += __shfl_xor(ss, 16); ss += __shfl_xor(ss, 32);
                const float rinv = rsqrtf(ss * (1.0f / 64.0f) + EPS);
                UNR for (int n = 0; n < 2; ++n) {
                    const int j = 16 * n + 4 * fq;
                    const f32x4 c = *(const f32x4*)(c64 + t * 32 + j), s = *(const f32x4*)(s64 + t * 32 + j);
                    const f32x4 g1 = *(const f32x4*)(gain + j), g2 = *(const f32x4*)(gain + 32 + j);
                    float o1[4], o2[4];
                    UNR for (int e = 0; e < 4; ++e) { const float y1 = x[0][n][e] * rinv * g1[e], y2 = x[1][n][e] * rinv * g2[e]; o1[e] = (y1 * c[e] - y2 * s[e]) * sc; o2[e] = (y2 * c[e] + y1 * s[e]) * sc; }
                    uint2 u1, u2; u1.x = pk2(o1[0], o1[1]); u1.y = pk2(o1[2], o1[3]); u2.x = pk2(o2[0], o2[1]); u2.y = pk2(o2[2], o2[3]);
                    *(uint2*)(dst + j) = u1; *(uint2*)(dst + 32 + j) = u2;
                }
            } else if (chunk < 24) {
                const int hd = (chunk - 16) >> 1, half = (chunk - 16) & 1;
                bf16_t* dst = AVT + ((size_t)(b * 4 + hd) * 128 + half * 64) * TP + t;
                UNR for (int bj = 0; bj < 2; ++bj) UNR for (int n = 0; n < 2; ++n) UNR for (int e = 0; e < 4; ++e) dst[(size_t)(32 * bj + 16 * n + 4 * fq + e) * TP] = f2bf(x[bj][n][e]);
            } else if (chunk == 33) {
                bf16_t* dst = BV + (size_t)row * 64;
                UNR for (int bj = 0; bj < 2; ++bj) UNR for (int n = 0; n < 2; ++n) { uint2 v; v.x = pk2(x[bj][n][0], x[bj][n][1]); v.y = pk2(x[bj][n][2], x[bj][n][3]); *(uint2*)(dst + 32 * bj + 16 * n + 4 * fq) = v; }
            } else if (chunk <= 42) {
                bf16_t* dst = (chunk == 42) ? IK + (size_t)row * 64 : IQ + (size_t)row * 512 + (chunk - 34) * 64;
                const f32x4 c = *(const f32x4*)(ic + t * 16 + 4 * fq), s = *(const f32x4*)(is + t * 16 + 4 * fq);
                float y0[4], y1[4];
                UNR for (int e = 0; e < 4; ++e) { const float a = x[0][0][e], bb = x[0][1][e]; y0[e] = a * c[e] - bb * s[e]; y1[e] = bb * c[e] + a * s[e]; }
                uint2 v; v.x = pk2(y0[0], y0[1]); v.y = pk2(y0[2], y0[3]); *(uint2*)(dst + 4 * fq) = v;
                v.x = pk2(y1[0], y1[1]); v.y = pk2(y1[2], y1[3]); *(uint2*)(dst + 16 + 4 * fq) = v;
                UNR for (int n = 0; n < 2; ++n) { v.x = pk2(x[1][n][0], x[1][n][1]); v.y = pk2(x[1][n][2], x[1][n][3]); *(uint2*)(dst + 32 + 16 * n + 4 * fq) = v; }
            } else if (chunk == 43) {
                const float sc = 0.35355339059327373f * 0.125f;
                if (fq < 2) *(f32x4*)(IW + (size_t)row * 8 + 4 * fq) = (f32x4){x[0][0][0] * sc, x[0][0][1] * sc, x[0][0][2] * sc, x[0][0][3] * sc};
            } else {
                if (t >= NMETA && t < TR) {
                    const size_t mc = (size_t)b * SEQ + (t - NMETA);
                    bf16_t* dst = (chunk < 60) ? GA + mc * 1024 + (chunk - 44) * 64 : GB + mc * 1024 + (chunk - 60) * 64;
                    UNR for (int bj = 0; bj < 2; ++bj) UNR for (int n = 0; n < 2; ++n) {
                        float o[4]; UNR for (int e = 0; e < 4; ++e) o[e] = 1.0f / (1.0f + __expf(-x[bj][n][e]));
                        uint2 v; v.x = pk2(o[0], o[1]); v.y = pk2(o[2], o[3]); *(uint2*)(dst + 32 * bj + 16 * n + 4 * fq) = v;
                    }
                }
            }
        }
    }
};
__device__ __forceinline__ void phase1(const Params& P, PG8_LAS unsigned char* lds) {
    pg8::Gemm g{(const bf16_t*)(P.ws + WS_R1), (const bf16_t*)(P.ws + WS_WIN), R, NIN, 1024};
    pg8::StaticOrder S; S.init(R, NIN, (int)gridDim.x, (int)blockIdx.x);
    EpiProj E{P.ws, P.g_aq, P.g_ak, P.g_bq, P.g_bk};
    pg8::gemm_phase<EpiProj, pg8::StaticOrder, true, true>(lds, g, S, E);
}

__device__ __forceinline__ void attnA_unit(const Params& P, int b, int head, int qb, char* lds) {
    const int tid = opaque_tid(), lane = tid & 63, w = tid >> 6, qg = w & 3, st = w >> 2, l31 = lane & 31, hi = lane >> 5;
    char* ws = P.ws;
    const bf16_t* AQ = (const bf16_t*)(ws + WS_R2); const bf16_t* AK = AQ + (size_t)8 * 8 * TP * 64; const bf16_t* AVT = (const bf16_t*)(ws + WS_R3);
    bf16_t* AOUT = (bf16_t*)(ws + WS_R1);
    const float lam = ((const float*)(ws + WS_CTL))[4];
    const int q0 = qb * 128 + qg * 32;
    const bf16_t* Qp = AQ + ((size_t)(b * 8 + head * 2 + st) * TP + q0 + l31) * 64;
    bf16x8 qf[4];
    UNR for (int ks = 0; ks < 4; ++ks) qf[ks] = *(const bf16x8*)(Qp + ks * 16 + hi * 8);
    const bf16_t* K0g = AK + (size_t)(b * 8 + head * 2) * TP * 64; const bf16_t* K1g = K0g + (size_t)TP * 64;
    const bf16_t* Vg = AVT + (size_t)(b * 4 + head) * 128 * TP;
    const int nkt = 2 * (qb + 1);
    const int srow = tid >> 3, sch = tid & 7;
    const int koff = srow * 128 + ((sch ^ (srow & 7)) << 4), voff = srow * 128 + ((sch ^ ((srow >> 1) & 7)) << 4);
    uint4 sr[4];
    auto gload = [&](int kt) {
        const int key0 = kt * 64;
        sr[0] = *(const uint4*)(K0g + (size_t)(key0 + srow) * 64 + sch * 8);
        sr[1] = *(const uint4*)(K1g + (size_t)(key0 + srow) * 64 + sch * 8);
        sr[2] = *(const uint4*)(Vg + (size_t)srow * TP + key0 + sch * 8);
        sr[3] = *(const uint4*)(Vg + (size_t)(srow + 64) * TP + key0 + sch * 8);
    };
    auto lstore = [&](int buf) {
        char* base = lds + buf * 32768;
        *(uint4*)(base + koff) = sr[0]; *(uint4*)(base + 8192 + koff) = sr[1];
        *(uint4*)(base + 16384 + voff) = sr[2]; *(uint4*)(base + 16384 + 8192 + voff) = sr[3];
    };
    f32x16 o[4]; UNR for (int i = 0; i < 4; ++i) o[i] = zero16();
    float mrun = -INFINITY, lrun = 0.f;
    gload(0); lstore(0); __syncthreads();
    const int qpos = q0 + l31;
    for (int kt = 0; kt < nkt; ++kt) {
        if (kt + 1 < nkt) gload(kt + 1);
        const char* base = lds + (kt & 1) * 32768; const char* Kb = base + st * 8192; const char* Vb = base + 16384;
        f32x16 s0 = zero16(), s1 = zero16();
        UNR for (int ks = 0; ks < 4; ++ks) {
            const int co = (((ks * 2 + hi) ^ (l31 & 7)) << 4);
            const bf16x8 a0 = *(const bf16x8*)(Kb + l31 * 128 + co), a1 = *(const bf16x8*)(Kb + (32 + l31) * 128 + co);
            s0 = mfma32(a0, qf[ks], s0); s1 = mfma32(a1, qf[ks], s1);
        }
        if (kt >= nkt - 2) {
            const int kbase = kt * 64;
            UNR for (int r = 0; r < 16; ++r) { const int key = kbase + crow(r, hi); if (key > qpos) s0[r] = -INFINITY; if (key + 32 > qpos) s1[r] = -INFINITY; }
        }
        float mx = s0[0];
        UNR for (int r = 1; r < 16; ++r) mx = fmaxf(mx, s0[r]);
        UNR for (int r = 0; r < 16; ++r) mx = fmaxf(mx, s1[r]);
        mx = fmaxf(mx, __shfl_xor(mx, 32));
        const float mn = fmaxf(mrun, mx);
        const float alpha = ex2(mrun - mn);
        mrun = mn;
        float ls = 0.f;
        UNR for (int r = 0; r < 16; ++r) { s0[r] = ex2(s0[r] - mn); s1[r] = ex2(s1[r] - mn); ls += s0[r] + s1[r]; }
        lrun = lrun * alpha + ls;
        if (!__all(alpha == 1.0f)) { UNR for (int mt = 0; mt < 4; ++mt) UNR for (int r = 0; r < 16; ++r) o[mt][r] *= alpha; }
        bf16x8 pb[2][2];
        pb[0][0] = pack8(s0[0], s0[1], s0[2], s0[3], s0[4], s0[5], s0[6], s0[7]); pb[0][1] = pack8(s0[8], s0[9], s0[10], s0[11], s0[12], s0[13], s0[14], s0[15]);
        pb[1][0] = pack8(s1[0], s1[1], s1[2], s1[3], s1[4], s1[5], s1[6], s1[7]); pb[1][1] = pack8(s1[8], s1[9], s1[10], s1[11], s1[12], s1[13], s1[14], s1[15]);
        UNR for (int mt = 0; mt < 4; ++mt) {
            const int d = mt * 32 + l31; const int sw = (d >> 1) & 7; const char* rowp = Vb + d * 128 + 8 * hi;
            UNR for (int k2 = 0; k2 < 2; ++k2)
                UNR for (int s = 0; s < 2; ++s) {
                    const int c0 = k2 * 4 + 2 * s;
                    const s16x4 lo = *(const s16x4*)(rowp + ((c0 ^ sw) << 4)), h4 = *(const s16x4*)(rowp + (((c0 + 1) ^ sw) << 4));
                    const bf16x8 a = {lo[0], lo[1], lo[2], lo[3], h4[0], h4[1], h4[2], h4[3]};
                    o[mt] = mfma32(a, pb[k2][s], o[mt]);
                }
        }
        if (kt + 1 < nkt) lstore((kt + 1) & 1);
        __syncthreads();
    }
    lrun += __shfl_xor(lrun, 32);
    const float inv = 1.0f / lrun;
    float* ex = (float*)lds + qg * 4096;
    if (st == 1) { const float f = inv * lam; UNR for (int mt = 0; mt < 4; ++mt) UNR for (int r = 0; r < 16; ++r) ex[(mt * 16 + r) * 64 + lane] = o[mt][r] * f; }
    __syncthreads();
    if (st == 0) {
        float ss = 0.f;
        UNR for (int mt = 0; mt < 4; ++mt) UNR for (int r = 0; r < 16; ++r) { const float v = o[mt][r] * inv - ex[(mt * 16 + r) * 64 + lane]; o[mt][r] = v; ss += v * v; }
        ss += __shfl_xor(ss, 32);
        const float rinv = rsqrtf(ss * (1.0f / 128.0f) + EPS) * 0.8f;
        const int tq = q0 + l31; const bool real = (tq >= NMETA && tq < TR);
        bf16_t* dst = AOUT + ((size_t)b * SEQ + (real ? tq - NMETA : 0)) * 512 + head * 128;
        if (real) UNR for (int mt = 0; mt < 4; ++mt) UNR for (int g4 = 0; g4 < 4; ++g4) {
            const int d = mt * 32 + 8 * g4 + 4 * hi; const f32x4 g = *(const f32x4*)(P.g_sub + d);
            uint2 u; u.x = pk2(o[mt][4 * g4] * rinv * g[0], o[mt][4 * g4 + 1] * rinv * g[1]); u.y = pk2(o[mt][4 * g4 + 2] * rinv * g[2], o[mt][4 * g4 + 3] * rinv * g[3]);
            *(uint2*)(dst + d) = u;
        }
    }
    __syncthreads();
}

constexpr int DSA_C = 448;
constexpr int DS_SEL = 0, DS_CAND = 8192, DS_VST = 8192, DS_PART = 40960, DS_PML = 106496, DS_BMP = 110592, DS_STATE = 131072;
__device__ __forceinline__ unsigned ord32(float s) { const unsigned u = __float_as_uint(s); return (u & 0x80000000u) ? ~u : (u | 0x80000000u); }

__device__ __forceinline__ void dsa_unit(const Params& P, int b, int q16, char* lds) {
    const int tid = opaque_tid(), lane = tid & 63, w = tid >> 6, n15 = lane & 15, g = lane >> 4;
    char* ws = P.ws;
    const bf16_t* BQ = (const bf16_t*)(ws + WS_R3) + (size_t)8 * 4 * 128 * TP;
    const bf16_t* BK = (const bf16_t*)(ws + WS_BK); const bf16_t* BV = (const bf16_t*)(ws + WS_BV); const bf16_t* IK = (const bf16_t*)(ws + WS_IK);
    const float* IW = (const float*)(ws + WS_IW); const bf16_t* IQ = (const bf16_t*)(ws + WS_R4);
    bf16_t* BOUT = (bf16_t*)(ws + WS_R1) + (size_t)MC * 512;
    unsigned* HIST = (unsigned*)lds;
    unsigned short* SEL = (unsigned short*)(lds + DS_SEL); u64* CAND = (u64*)(lds + DS_CAND);
    u64* s_pfx = (u64*)(lds + DS_STATE); int* s_need = (int*)(lds + DS_STATE + 256); int* s_pop = (int*)(lds + DS_STATE + 384);
    unsigned* s_selcnt = (unsigned*)(lds + DS_STATE + 512); unsigned* s_candcnt = (unsigned*)(lds + DS_STATE + 640); int* s_all = (int*)(lds + DS_STATE + 768);
    const int q0 = q16 * 16; const int qpos = q0 + n15; const size_t qrow = (size_t)b * TP + qpos;
    const int nk = q16 + 1;
    bf16x8 iqf[8][2];
    UNR for (int h = 0; h < 8; ++h) UNR for (int s = 0; s < 2; ++s) iqf[h][s] = *(const bf16x8*)(IQ + qrow * 512 + h * 64 + s * 32 + g * 8);
    float iw[8];
    { const f32x4 a = *(const f32x4*)(IW + qrow * 8), c = *(const f32x4*)(IW + qrow * 8 + 4); iw[0] = a[0]; iw[1] = a[1]; iw[2] = a[2]; iw[3] = a[3]; iw[4] = c[0]; iw[5] = c[1]; iw[6] = c[2]; iw[7] = c[3]; }
    auto loadk = [&](int kt, bf16x8& k0, bf16x8& k1) {
        const bf16_t* ikp = IK + ((size_t)b * TP + kt * 16 + n15) * 64 + g * 8;
        k0 = *(const bf16x8*)ikp; k1 = *(const bf16x8*)(ikp + 32);
    };
    auto load4 = [&](int kt0, bf16x8 (&k)[4][2]) { UNR for (int j = 0; j < 4; ++j) loadk(min(kt0 + 8 * j, nk - 1), k[j][0], k[j][1]); };
    auto compute = [&](const bf16x8& k0, const bf16x8& k1, f32x4& sc) {
        sc = (f32x4){0.f, 0.f, 0.f, 0.f};
        UNR for (int h = 0; h < 8; ++h) {
            f32x4 a = {0.f, 0.f, 0.f, 0.f};
            a = mfma16(k0, iqf[h][0], a); a = mfma16(k1, iqf[h][1], a);
            UNR for (int e = 0; e < 4; ++e) sc[e] = __builtin_fmaf(iw[h], __builtin_amdgcn_fmed3f(a[e], 0.f, INFINITY), sc[e]);
        }
        UNR for (int e = 0; e < 4; ++e) sc[e] += 0.0f;
    };
    if (tid < 16) { unsigned z = 0u; asm volatile("" : "+v"(z)); ((unsigned*)s_pfx)[2 * tid] = z; ((unsigned*)s_pfx)[2 * tid + 1] = z; s_need[tid] = 256; s_pop[tid] = (int)z; s_all[tid] = (int)z; }
    int sh = 45;
    for (;;) {
        const int nbits = sh < 11 ? sh : 11; const int mask = (1 << nbits) - 1;
        { uint4 z = {0u, 0u, 0u, 0u}; for (int i = tid; i < 4096; i += NTHREADS) ((uint4*)lds)[i] = z; }
        __syncthreads();
        const u64 mypfx = s_pfx[n15]; const int myall = s_all[n15];
        auto binit0 = [&](int kt, const f32x4& sc) {
            const bool diag = (kt == nk - 1);
            UNR for (int e = 0; e < 4; ++e) {
                const int idx = kt * 16 + 4 * g + e;
                if (!diag || idx <= qpos) {
                    const unsigned u = __float_as_uint(sc[e]); const unsigned t = u >> 21;
                    const unsigned ib = t ^ (~(unsigned)((int)u >> 31) & 1023u);
                    atomicAdd(&HIST[n15 * 1024 + (ib >> 1)], 1u << ((ib & 1) * 16));
                }
            }
        };
        auto binit = [&](int kt, const f32x4& sc) {
            const bool diag = (kt == nk - 1);
            UNR for (int e = 0; e < 4; ++e) {
                const int idx = kt * 16 + 4 * g + e;
                if ((!diag || idx <= qpos) && !myall) {
                    const u64 comp = ((u64)ord32(sc[e]) << 13) | (u64)(8191 - idx);
                    if ((comp >> sh) == mypfx) { const int ib = mask - (int)((comp >> (sh - nbits)) & (u64)mask); atomicAdd(&HIST[n15 * 1024 + (ib >> 1)], 1u << ((ib & 1) * 16)); }
                }
            }
        };
        {
            bf16x8 ka[4][2]; f32x4 sc;
            int kt = w; load4(kt, ka);
            if (sh == 45) {
                while (kt < nk) {
                    UNR for (int j = 0; j < 4; ++j) {
                        compute(ka[j][0], ka[j][1], sc);
                        loadk(min(kt + 32 + 8 * j, nk - 1), ka[j][0], ka[j][1]);
                        if (kt + 8 * j < nk) binit0(kt + 8 * j, sc);
                    }
                    kt += 32;
                }
            } else {
                while (kt < nk) {
                    UNR for (int j = 0; j < 4; ++j) {
                        compute(ka[j][0], ka[j][1], sc);
                        loadk(min(kt + 32 + 8 * j, nk - 1), ka[j][0], ka[j][1]);
                        if (kt + 8 * j < nk) binit(kt + 8 * j, sc);
                    }
                    kt += 32;
                }
            }
        }
        __syncthreads();
        UNR for (int i = 0; i < 2; ++i) {
            const int ql = w * 2 + i;
            if (s_all[ql]) continue;
            const unsigned* hq = HIST + ql * 1024 + lane * 16;
            unsigned wd[16]; unsigned c = 0;
            UNR for (int j = 0; j < 16; ++j) { wd[j] = hq[j]; c += (wd[j] & 0xffffu) + (wd[j] >> 16); }
            unsigned pre = c;
            UNR for (int o = 1; o < 64; o <<= 1) { const unsigned t = __shfl_up(pre, o); if (lane >= o) pre += t; }
            const unsigned nd = (unsigned)s_need[ql];
            const u64 bal = __ballot(pre >= nd);
            if (bal == 0ull) { if (lane == 0) { s_all[ql] = 1; s_pop[ql] = 0; s_need[ql] = 0; } }
            else {
                const int Lc = __ffsll((long long)bal) - 1;
                if (lane == Lc) {
                    unsigned cum = pre - c; int ibs = -1; unsigned cntb = 0;
                    UNR for (int j = 0; j < 32; ++j) { const unsigned cnt = (wd[j >> 1] >> ((j & 1) * 16)) & 0xffffu; if (ibs < 0) { if (cum + cnt >= nd) { ibs = lane * 32 + j; cntb = cnt; } else cum += cnt; } }
                    s_pfx[ql] = (s_pfx[ql] << nbits) | (u64)(mask - ibs); s_need[ql] = (int)(nd - cum); s_pop[ql] = (int)cntb;
                }
            }
        }
        __syncthreads();
        sh -= nbits;
        int mp = 0; UNR for (int q = 0; q < 16; ++q) mp = max(mp, s_pop[q]);
        if (mp <= DSA_C || sh == 0) break;
    }
    unsigned* BMP = (unsigned*)(lds + DS_BMP);
    if (tid < 16) { s_selcnt[tid] = 0u; s_candcnt[tid] = 0u; }
    for (int i = tid; i < 16 * 136; i += NTHREADS) BMP[i] = 0u;
    __syncthreads();
    {
        const int tid = opaque_tid(), lane = tid & 63, w = tid >> 6, n15 = lane & 15, g = lane >> 4; const int qpos = q0 + n15; (void)qpos; (void)g; (void)w;
        const u64 mypfx = s_pfx[n15]; const int myall = s_all[n15];
        const unsigned myib = 2047u - (unsigned)(mypfx & 2047ull);
        auto emit0 = [&](int kt, const f32x4& sc) {
            const bool diag = (kt == nk - 1);
            UNR for (int e = 0; e < 4; ++e) {
                const int idx = kt * 16 + 4 * g + e;
                if (!diag || idx <= qpos) {
                    const unsigned u = __float_as_uint(sc[e]); const unsigned t = u >> 21;
                    const unsigned ib = t ^ (~(unsigned)((int)u >> 31) & 1023u);
                    if (myall || ib < myib) atomicOr(&BMP[n15 * 136 + (idx >> 5)], 1u << (idx & 31));
                    else if (ib == myib) { const unsigned cp = atomicAdd(&s_candcnt[n15], 1u); if (cp < (unsigned)DSA_C) CAND[n15 * DSA_C + cp] = ((u64)ord32(sc[e]) << 13) | (u64)(8191 - idx); }
                }
            }
        };
        auto emit = [&](int kt, const f32x4& sc) {
            const bool diag = (kt == nk - 1);
            UNR for (int e = 0; e < 4; ++e) {
                const int idx = kt * 16 + 4 * g + e;
                if (!diag || idx <= qpos) {
                    const u64 comp = ((u64)ord32(sc[e]) << 13) | (u64)(8191 - idx); const u64 top = comp >> sh;
                    if (myall || top > mypfx) atomicOr(&BMP[n15 * 136 + (idx >> 5)], 1u << (idx & 31));
                    else if (top == mypfx) { const unsigned cp = atomicAdd(&s_candcnt[n15], 1u); if (cp < (unsigned)DSA_C) CAND[n15 * DSA_C + cp] = comp; }
                }
            }
        };
        bf16x8 ka[4][2]; f32x4 sc;
        int kt = w; load4(kt, ka);
        if (sh == 34) {
            while (kt < nk) {
                UNR for (int j = 0; j < 4; ++j) {
                    compute(ka[j][0], ka[j][1], sc);
                    loadk(min(kt + 32 + 8 * j, nk - 1), ka[j][0], ka[j][1]);
                    if (kt + 8 * j < nk) emit0(kt + 8 * j, sc);
                }
                kt += 32;
            }
        } else {
            while (kt < nk) {
                UNR for (int j = 0; j < 4; ++j) {
                    compute(ka[j][0], ka[j][1], sc);
                    loadk(min(kt + 32 + 8 * j, nk - 1), ka[j][0], ka[j][1]);
                    if (kt + 8 * j < nk) emit(kt + 8 * j, sc);
                }
                kt += 32;
            }
        }
    }
    __syncthreads();
    {
        const int tid = opaque_tid(), lane = tid & 63, w = tid >> 6, n15 = lane & 15, g = lane >> 4; const int qpos = q0 + n15; (void)qpos; (void)g; (void)w;
    UNR for (int i = 0; i < 2; ++i) {
        const int ql = w * 2 + i; const int n = min((int)s_candcnt[ql], DSA_C); const int nd = s_need[ql];
        if (n == 0 || nd <= 0) continue;
        u64 c[7];
        UNR for (int j = 0; j < 7; ++j) { const int ci = j * 64 + lane; c[j] = (ci < n) ? CAND[ql * DSA_C + ci] : 0ull; }
        u64 T = 0ull;
        for (int bit = 44; bit >= 0; --bit) {
            const u64 Tn = T | (1ull << bit); int cnt = 0;
            UNR for (int j = 0; j < 7; ++j) cnt += __popcll(__ballot(c[j] >= Tn));
            if (cnt >= nd) T = Tn;
        }
        UNR for (int j = 0; j < 7; ++j) { if (c[j] >= T && c[j] != 0ull) { const int idx = 8191 - (int)(c[j] & 8191ull); atomicOr(&BMP[ql * 136 + (idx >> 5)], 1u << (idx & 31)); } }
    }
    }
    __syncthreads();
    {
        const int tid = opaque_tid(), lane = tid & 63, w = tid >> 6, n15 = lane & 15, g = lane >> 4; const int qpos = q0 + n15; (void)qpos; (void)g; (void)w;
    for (int i = 0; i < 2; ++i) {
        const int ql = w * 2 + i;
        unsigned wd3[3]; int cnt = 0;
        UNR for (int j = 0; j < 3; ++j) { const int wi = lane * 3 + j; wd3[j] = (wi < 132) ? BMP[ql * 136 + wi] : 0u; cnt += __popc(wd3[j]); }
        int pre = cnt;
        UNR for (int o = 1; o < 64; o <<= 1) { const int t = __shfl_up(pre, o); if (lane >= o) pre += t; }
        int pos = pre - cnt;
        UNR for (int j = 0; j < 3; ++j) { unsigned m = wd3[j]; while (m) { const int bit = __ffs((int)m) - 1; m &= m - 1; if (pos < 256) SEL[ql * 256 + pos] = (unsigned short)((lane * 3 + j) * 32 + bit); ++pos; } }
        if (lane == 63) s_selcnt[ql] = (unsigned)pre;
    }
    }
    __syncthreads();
    {
        const int tid = opaque_tid(), lane = tid & 63, w = tid >> 6, n15 = lane & 15, g = lane >> 4; const int qpos = q0 + n15; (void)qpos; (void)g; (void)w;
        typedef __attribute__((address_space(3))) s16x4 lds_s16x4;
        char* vl = lds + DS_VST + w * 4096;
        float* PART = (float*)(lds + DS_PART);
        float* PML = (float*)(lds + DS_PML);
        const int hq = n15 & 7, qq = n15 >> 2, pp = n15 & 3;
        struct QB { bf16x8 kf[2][2]; uint4 vr[4]; bf16x8 bq[2]; };
        QB buf[3];
        auto issue = [&](int qi, QB& q) {
            const size_t row = (size_t)b * TP + q0 + qi; const int nsel = min((int)s_selcnt[qi], 256);
            const unsigned short* sel = SEL + qi * 256 + 32 * w;
            UNR for (int t = 0; t < 2; ++t) { const int slot = 32 * w + 16 * t + n15; const int kid = slot < nsel ? (int)sel[16 * t + n15] : 0; const bf16_t* kp = BK + ((size_t)b * TP + kid) * 64 + g * 8; q.kf[t][0] = *(const bf16x8*)kp; q.kf[t][1] = *(const bf16x8*)(kp + 32); }
            UNR for (int k = 0; k < 4; ++k) { const int rowl = k * 8 + (lane >> 3); const int slot = 32 * w + rowl; const int kid = slot < nsel ? (int)sel[rowl] : 0; q.vr[k] = *(const uint4*)(BV + ((size_t)b * TP + kid) * 64 + (lane & 7) * 8); }
            UNR for (int s = 0; s < 2; ++s) q.bq[s] = *(const bf16x8*)(BQ + row * 512 + hq * 64 + s * 32 + g * 8);
        };
        issue(0, buf[0]); issue(1, buf[1]);
        UNR for (int qi = 0; qi < 16; ++qi) {
            if (qi + 2 < 16) issue(qi + 2, buf[(qi + 2) % 3]);
            QB& q = buf[qi % 3];
            const int nsel = min((int)s_selcnt[qi], 256);
            f32x4 S[2];
            UNR for (int t = 0; t < 2; ++t) { f32x4 a = {0.f, 0.f, 0.f, 0.f}; a = mfma16(q.kf[t][0], q.bq[0], a); a = mfma16(q.kf[t][1], q.bq[1], a); S[t] = a; }
            float mx = -1.0e30f;
            UNR for (int t = 0; t < 2; ++t) UNR for (int e = 0; e < 4; ++e) { if (32 * w + 16 * t + 4 * g + e >= nsel) S[t][e] = -INFINITY; mx = fmaxf(mx, S[t][e]); }
            mx = fmaxf(mx, __shfl_xor(mx, 16)); mx = fmaxf(mx, __shfl_xor(mx, 32));
            float ls = 0.f;
            UNR for (int t = 0; t < 2; ++t) UNR for (int e = 0; e < 4; ++e) { S[t][e] = ex2(S[t][e] - mx); ls += S[t][e]; }
            ls += __shfl_xor(ls, 16); ls += __shfl_xor(ls, 32);
            const bf16x8 pb = pack8(S[0][0], S[0][1], S[0][2], S[0][3], S[1][0], S[1][1], S[1][2], S[1][3]);
            UNR for (int k = 0; k < 4; ++k) { const int rowl = k * 8 + (lane >> 3); *(uint4*)(vl + rowl * 128 + ((((lane & 7)) ^ (((rowl >> 1) & 3) << 1)) << 4)) = q.vr[k]; }
            __builtin_amdgcn_s_waitcnt(0xc07f);
            f32x4 o[4];
            const int row0 = 4 * g + qq, row1 = row0 + 16;
            UNR for (int mt = 0; mt < 4; ++mt) {
                const int ch = 2 * mt + (pp >> 1);
                const char* a0 = vl + row0 * 128 + ((ch ^ (((row0 >> 1) & 3) << 1)) << 4) + 8 * (pp & 1);
                const char* a1 = vl + row1 * 128 + ((ch ^ (((row1 >> 1) & 3) << 1)) << 4) + 8 * (pp & 1);
                const s16x4 lo = __builtin_amdgcn_ds_read_tr16_b64_v4i16((lds_s16x4*)a0);
                const s16x4 h4 = __builtin_amdgcn_ds_read_tr16_b64_v4i16((lds_s16x4*)a1);
                const bf16x8 a = {lo[0], lo[1], lo[2], lo[3], h4[0], h4[1], h4[2], h4[3]};
                o[mt] = mfma16(a, pb, (f32x4){0.f, 0.f, 0.f, 0.f});
            }
            __builtin_amdgcn_s_waitcnt(0xc07f);
            const int qs = qi & 3;
            if (n15 < 8) {
                float* pp_ = PART + ((qs * 8 + w) * 8 + n15) * 64;
                UNR for (int mt = 0; mt < 4; ++mt) *(f32x4*)(pp_ + mt * 16 + 4 * g) = o[mt];
                if (g == 0) { PML[((qs * 8 + w) * 8 + n15) * 2] = mx; PML[((qs * 8 + w) * 8 + n15) * 2 + 1] = ls; }
            }
            if (qs == 3) {
                __syncthreads();
                {
                    const int cq = tid >> 7, ch = (tid >> 4) & 7, dg = tid & 15;
                    float mw[8], lw[8]; float m = -1.0e30f;
                    UNR for (int ww = 0; ww < 8; ++ww) { mw[ww] = PML[((cq * 8 + ww) * 8 + ch) * 2]; lw[ww] = PML[((cq * 8 + ww) * 8 + ch) * 2 + 1]; m = fmaxf(m, mw[ww]); }
                    f32x4 acc = {0.f, 0.f, 0.f, 0.f}; float l = 0.f;
                    UNR for (int ww = 0; ww < 8; ++ww) { const float f = ex2(mw[ww] - m); l += lw[ww] * f; const f32x4 pv = *(const f32x4*)(PART + ((cq * 8 + ww) * 8 + ch) * 64 + dg * 4); acc += pv * f; }
                    const float inv = 1.0f / l;
                    const int tq = q0 + (qi - 3) + cq;
                    uint2 u; u.x = pk2(acc[0] * inv, acc[1] * inv); u.y = pk2(acc[2] * inv, acc[3] * inv);
                    if (tq >= NMETA && tq < TR) *(uint2*)(BOUT + ((size_t)b * SEQ + (tq - NMETA)) * 512 + ch * 64 + dg * 4) = u;
                }
                __syncthreads();
            }
        }
    }
}

template <int MODE> __device__ __forceinline__ void phase2(const Params& P, char* lds, int cidx) {
    unsigned* ctr = (unsigned*)(P.ws + WS_CTL) + cidx;
    int* s_u = (int*)(lds + DS_STATE + 1024);
    constexpr int NA = (MODE == 2) ? 0 : BATCH * 4 * 33, NB = (MODE == 1) ? 0 : BATCH * 256;
    for (;;) {
        if (opaque_tid() == 0) *s_u = (int)atomicAdd(ctr, 1u);
        __syncthreads();
        const int u = *s_u;
        __syncthreads();
        if (u >= NA + NB) break;
        if (u < NA) { const int bh = u / 33, qb = 32 - u % 33; attnA_unit(P, bh >> 2, bh & 3, qb, lds); }
        else { const int v = u - NA; dsa_unit(P, v / 256, 256 - v % 256, lds); }
    }
}

template <int SECOND> struct EpiGate {
    static constexpr bool PERM = false, AFTER_DRAIN = false;
    const bf16_t* G; bf16_t* MIXED;
    __device__ __forceinline__ void operator()(const f32x4 (&acc)[2][2][4][2], const pg8::Unit& u, int wr, int wc, int fr, int fq) const {
        UNR for (int ai = 0; ai < 2; ++ai) UNR for (int m = 0; m < 4; ++m) {
            const size_t row = (size_t)u.pm * 256 + ai * 128 + wr * 64 + m * 16 + fr;
            UNR for (int bj = 0; bj < 2; ++bj) UNR for (int n = 0; n < 2; ++n) {
                const size_t off = row * 1024 + u.pn * 256 + bj * 128 + wc * 32 + n * 16 + 4 * fq;
                const uint2 gg = *(const uint2*)(G + off); const f32x4 a = acc[ai][bj][m][n];
                float v0 = a[0] * bf2f(gg.x & 0xffffu), v1 = a[1] * bf2f(gg.x >> 16), v2 = a[2] * bf2f(gg.y & 0xffffu), v3 = a[3] * bf2f(gg.y >> 16);
                if (SECOND) { const uint2 mm = *(const uint2*)(MIXED + off); v0 += bf2f(mm.x & 0xffffu); v1 += bf2f(mm.x >> 16); v2 += bf2f(mm.y & 0xffffu); v3 += bf2f(mm.y >> 16); }
                uint2 o; o.x = pk2(v0, v1); o.y = pk2(v2, v3); *(uint2*)(MIXED + off) = o;
            }
        }
    }
};
__device__ __forceinline__ void phase3(const Params& P, int bid, int nb, PG8_LAS unsigned char* lds) {
    char* ws = P.ws;
    const bf16_t* AOUT = (const bf16_t*)(ws + WS_R1); const bf16_t* BOUT = AOUT + (size_t)MC * 512;
    const bf16_t* GA = (const bf16_t*)(ws + WS_R6); const bf16_t* GB = GA + (size_t)MC * 1024;
    bf16_t* MIXED = (bf16_t*)(ws + WS_R2);
    pg8::StaticOrder S; S.init(MC, 1024, (int)gridDim.x, (int)blockIdx.x);
    { pg8::Gemm g{AOUT, (const bf16_t*)(ws + WS_WA), MC, 1024, 512}; EpiGate<0> E{GA, MIXED}; pg8::gemm_phase<EpiGate<0>, pg8::StaticOrder, true, true>(lds, g, S, E); }
    asm volatile("s_waitcnt vmcnt(0)" ::: "memory"); __syncthreads();
    { pg8::Gemm g{BOUT, (const bf16_t*)(ws + WS_WB), MC, 1024, 512}; EpiGate<1> E{GB, MIXED}; pg8::gemm_phase<EpiGate<1>, pg8::StaticOrder, true, true>(lds, g, S, E); }
    {
        const int tid = opaque_tid();
        unsigned char* U8 = (unsigned char*)(ws + WS_R3); unsigned char* V8 = U8 + (size_t)NEXP * 1024;
        const int items = NEXP * 64;
        for (int it = bid * NTHREADS + tid; it < items; it += nb * NTHREADS) {
            const int e = it >> 6, seg = it & 63;
            const f32x4* up = (const f32x4*)(P.pu + (size_t)e * 1024 + seg * 16); const f32x4* vp = (const f32x4*)(P.pv + (size_t)e * 1024 + seg * 16);
            uint4 ou, ov; unsigned* pu4 = (unsigned*)&ou; unsigned* pv4 = (unsigned*)&ov;
            UNR for (int i = 0; i < 4; ++i) {
                const f32x4 a = up[i], c = vp[i]; int wu = 0, wv = 0;
                wu = __builtin_amdgcn_cvt_pk_fp8_f32(a[0] * 256.f, a[1] * 256.f, wu, false); wu = __builtin_amdgcn_cvt_pk_fp8_f32(a[2] * 256.f, a[3] * 256.f, wu, true);
                wv = __builtin_amdgcn_cvt_pk_fp8_f32(c[0] * 64.f, c[1] * 64.f, wv, false); wv = __builtin_amdgcn_cvt_pk_fp8_f32(c[2] * 64.f, c[3] * 64.f, wv, true);
                pu4[i] = (unsigned)wu; pv4[i] = (unsigned)wv;
            }
            *(uint4*)(U8 + (size_t)e * 1024 + seg * 16) = ou;
            *(uint4*)(V8 + ((size_t)(seg >> 3) * NEXP + e) * 128 + (seg & 7) * 16) = ov;
        }
    }
}

struct EpiRes {
    static constexpr bool PERM = false, AFTER_DRAIN = false;
    char* ws0; const float *x, *g_ffn;
    __device__ __forceinline__ void operator()(const f32x4 (&acc)[2][2][4][2], const pg8::Unit& u, int wr, int wc, int fr, int fq) const {
        char* ws = ws0; asm volatile("" : "+s"(ws));
        float* H2 = (float*)(ws + WS_R6); bf16_t* H2G = (bf16_t*)(ws + WS_R1); float* ROWSS = (float*)(ws + WS_ROWSS);
        UNR for (int ai = 0; ai < 2; ++ai) UNR for (int m = 0; m < 4; ++m) {
            const size_t row = (size_t)u.pm * 256 + ai * 128 + wr * 64 + m * 16 + fr;
            float ss = 0.f;
            UNR for (int bj = 0; bj < 2; ++bj) UNR for (int n = 0; n < 2; ++n) {
                const int col = u.pn * 256 + bj * 128 + wc * 32 + n * 16 + 4 * fq;
                const f32x4 hv = *(const f32x4*)(x + row * 1024 + col); const f32x4 gg = *(const f32x4*)(g_ffn + col);
                const f32x4 v = hv + acc[ai][bj][m][n];
                ss += v[0] * v[0] + v[1] * v[1] + v[2] * v[2] + v[3] * v[3];
                *(f32x4*)(H2 + row * 1024 + col) = v;
                uint2 o; o.x = pk2(v[0] * gg[0], v[1] * gg[1]); o.y = pk2(v[2] * gg[2], v[3] * gg[3]); *(uint2*)(H2G + row * 1024 + col) = o;
            }
            ss += __shfl_xor(ss, 16); ss += __shfl_xor(ss, 32);
            if (fq == 0) atomicAdd(ROWSS + row, ss);
        }
    }
};
__device__ __forceinline__ void phase4(const Params& P, PG8_LAS unsigned char* lds) {
    pg8::Gemm g{(const bf16_t*)(P.ws + WS_R2), (const bf16_t*)(P.ws + WS_WO), MC, 1024, 1024};
    pg8::StaticOrder S; S.init(MC, 1024, (int)gridDim.x, (int)blockIdx.x);
    EpiRes E{P.ws, P.x, P.g_ffn};
    pg8::gemm_phase<EpiRes, pg8::StaticOrder, true, true>(lds, g, S, E);
}

struct EpiQ {
    static constexpr bool PERM = false, AFTER_DRAIN = false;
    const float* ROWSS; bf16_t* Q;
    __device__ __forceinline__ void operator()(const f32x4 (&acc)[2][2][4][2], const pg8::Unit& u, int wr, int wc, int fr, int fq) const {
        UNR for (int ai = 0; ai < 2; ++ai) UNR for (int m = 0; m < 4; ++m) {
            const size_t row = (size_t)u.pm * 256 + ai * 128 + wr * 64 + m * 16 + fr;
            const float rinv = rsqrtf(ROWSS[row] * (1.0f / DM) + EPS);
            UNR for (int bj = 0; bj < 2; ++bj) UNR for (int n = 0; n < 2; ++n) {
                const f32x4 a = acc[ai][bj][m][n];
                uint2 o; o.x = pk2(a[0] * rinv, a[1] * rinv); o.y = pk2(a[2] * rinv, a[3] * rinv);
                *(uint2*)(Q + row * 1024 + u.pn * 256 + bj * 128 + wc * 32 + n * 16 + 4 * fq) = o;
            }
        }
    }
};
__device__ __forceinline__ void phase6a(const Params& P, PG8_LAS unsigned char* lds) {
    pg8::Gemm g{(const bf16_t*)(P.ws + WS_R1), (const bf16_t*)(P.ws + WS_WQ), MC, 1024, 1024};
    pg8::StaticOrder S; S.init(MC, 1024, (int)gridDim.x, (int)blockIdx.x);
    EpiQ E{(const float*)(P.ws + WS_ROWSS), (bf16_t*)(P.ws + WS_R2)};
    pg8::gemm_phase<EpiQ, pg8::StaticOrder, true, true>(lds, g, S, E);
}

__device__ __forceinline__ void ins16(float (&a)[16], float v) {
    float n[16]; n[0] = fmaxf(a[0], v);
    UNR for (int p = 1; p < 16; ++p) n[p] = __builtin_amdgcn_fmed3f(a[p - 1], a[p], v);
    UNR for (int p = 0; p < 16; ++p) a[p] = n[p];
}
__device__ __forceinline__ void phase6b(const Params& P, int bid, int nb, char* lds) {
    const int tid = opaque_tid(), lane = tid & 63, w = tid >> 6, wm = w >> 1, wn = w & 1, l31 = lane & 31, hi = lane >> 5;
    char* ws = P.ws;
    const bf16_t* Q = (const bf16_t*)(ws + WS_R2); const bf16_t* SUBK = (const bf16_t*)(ws + WS_SUBK);
    int* EIDX = (int*)(ws + WS_R4); float* EG = (float*)(ws + WS_R4 + (size_t)MC * 128 * 4);
    float* TOPS = (float*)lds;
    for (int unit = bid; unit < (MC / 256) * 8; unit += nb) {
        const int head = unit & 7, tm = unit >> 3; const int m0 = tm * 256;
        const bf16_t* sk = SUBK + (size_t)(head * 2 + wn) * 128 * 64;
        UNR for (int mt = 0; mt < 2; ++mt) {
            const int tl = wm * 64 + mt * 32 + l31; const size_t m = (size_t)m0 + tl;
            bf16x8 qb[4];
            UNR for (int s = 0; s < 4; ++s) qb[s] = *(const bf16x8*)(Q + m * 1024 + head * 128 + wn * 64 + 16 * s + 8 * hi);
            float top[16];
            UNR for (int p = 0; p < 16; ++p) top[p] = -INFINITY;
            UNR for (int kt = 0; kt < 4; ++kt) {
                f32x16 S = zero16();
                UNR for (int s = 0; s < 4; ++s) { const bf16x8 a = *(const bf16x8*)(sk + (size_t)(kt * 32 + l31) * 64 + 16 * s + 8 * hi); S = mfma32(a, qb[s], S); }
                UNR for (int r = 0; r < 16; ++r) { const unsigned key = (unsigned)(kt * 32 + crow(r, hi)); ins16(top, __uint_as_float((__float_as_uint(S[r]) & ~127u) | key)); }
            }
            float oth[16];
            UNR for (int p = 0; p < 16; ++p) oth[p] = __shfl_xor(top[p], 32);
            UNR for (int p = 0; p < 16; ++p) ins16(top, oth[p]);
            if (hi == 0) { UNR for (int p = 0; p < 16; p += 4) *(f32x4*)(TOPS + (tl * 2 + wn) * 16 + p) = (f32x4){top[p], top[p + 1], top[p + 2], top[p + 3]}; }
        }
        __syncthreads();
        if (tid < 256) {
            const int tl = tid; const size_t m = (size_t)m0 + tl;
            float s1[16], s2[16];
            UNR for (int p = 0; p < 16; p += 4) { const f32x4 a = *(const f32x4*)(TOPS + (tl * 2) * 16 + p), c = *(const f32x4*)(TOPS + (tl * 2 + 1) * 16 + p); UNR for (int i = 0; i < 4; ++i) { s1[p + i] = a[i]; s2[p + i] = c[i]; } }
            float v1[16], v2[16];
            UNR for (int p = 0; p < 16; ++p) { v1[p] = __uint_as_float(__float_as_uint(s1[p]) & ~127u); v2[p] = __uint_as_float(__float_as_uint(s2[p]) & ~127u); }
            float top[16];
            UNR for (int p = 0; p < 16; ++p) top[p] = -INFINITY;
            UNR for (int a = 0; a < 16; ++a)
                UNR for (int c = 0; c < 16; ++c)
                    if ((a + 1) * (c + 1) <= 16) ins16(top, __uint_as_float((__float_as_uint(v1[a] + v2[c]) & ~255u) | (unsigned)(a * 16 + c)));
            float vs[16]; int ex[16]; float mx = -INFINITY;
            UNR for (int p = 0; p < 16; ++p) {
                const unsigned id = __float_as_uint(top[p]) & 255u; const int a = id >> 4, c = id & 15;
                const unsigned pa = __float_as_uint(TOPS[(tl * 2) * 16 + a]), pc = __float_as_uint(TOPS[(tl * 2 + 1) * 16 + c]);
                vs[p] = __uint_as_float(pa & ~127u) + __uint_as_float(pc & ~127u); ex[p] = (int)(pa & 127u) * 128 + (int)(pc & 127u); mx = fmaxf(mx, vs[p]);
            }
            float sum = 0.f;
            UNR for (int p = 0; p < 16; ++p) { vs[p] = __expf(vs[p] - mx); sum += vs[p]; }
            const float inv = 1.0f / sum;
            UNR for (int p = 0; p < 16; p += 4) {
                *(int4*)(EIDX + m * 128 + head * 16 + p) = make_int4(ex[p], ex[p + 1], ex[p + 2], ex[p + 3]);
                *(f32x4*)(EG + m * 128 + head * 16 + p) = (f32x4){vs[p] * inv, vs[p + 1] * inv, vs[p + 2] * inv, vs[p + 3] * inv};
            }
        }
        __syncthreads();
    }
}

template <int CTRL> __device__ __forceinline__ float dpp_t(float v) { return __builtin_bit_cast(float, __builtin_amdgcn_update_dpp(0, __builtin_bit_cast(int, v), CTRL, 0xf, 0xf, true)); }
#define dpp_f(v, c) dpp_t<c>(v)
__device__ __forceinline__ float wave_sum(float v) {
    v += dpp_f(v, 0xB1); v += dpp_f(v, 0x4E); v += dpp_f(v, 0x141); v += dpp_f(v, 0x140);
    { auto r = __builtin_amdgcn_permlane16_swap(__float_as_uint(v), __float_as_uint(v), false, false); v = __uint_as_float(r[0]) + __uint_as_float(r[1]); }
    { auto r = __builtin_amdgcn_permlane32_swap(__float_as_uint(v), __float_as_uint(v), false, false); v = __uint_as_float(r[0]) + __uint_as_float(r[1]); }
    return v;
}
struct XcdPlan { int part[8]; int npart; int rank, count; };
__device__ __forceinline__ void xcd_plan(const Params& P, int bid, int nb, XcdPlan& pl) {
    const int* map = (const int*)(P.ws + WS_CTL + 2048);
    int cnt[8]; UNR for (int j = 0; j < 8; ++j) cnt[j] = 0;
    const int mine = map[bid] & 7; int rank = 0;
    for (int i = 0; i < nb; ++i) { const int x = map[i] & 7; UNR for (int j = 0; j < 8; ++j) cnt[j] += (x == j) ? 1 : 0; if (x == mine && i < bid) ++rank; }
    pl.npart = 0; UNR for (int j = 0; j < 8; ++j) pl.part[j] = 0;
    UNR for (int j = 0; j < 8; ++j) { int owner = j; UNR for (int s = 0; s < 8; ++s) { if (cnt[owner] == 0) owner = (owner + 1) & 7; } if (owner == mine) { UNR for (int q = 0; q < 8; ++q) if (q == pl.npart) pl.part[q] = j; ++pl.npart; } }
    pl.rank = rank; int c = 0; UNR for (int j = 0; j < 8; ++j) if (j == mine) c = cnt[j]; pl.count = c;
}
struct P7Round { uint4 row[8]; int kk[8]; int n; };
__device__ __forceinline__ void phase7a(const Params& P, int bid, int nb) {
    const int tid = opaque_tid(), lane = tid & 63, w = tid >> 6;
    char* ws = P.ws;
    const bf16_t* H2G = (const bf16_t*)(ws + WS_R1); const float* ROWSS = (const float*)(ws + WS_ROWSS);
    const int* EIDX = (const int*)(ws + WS_R4); const float* EG = (const float*)(ws + WS_R4 + (size_t)MC * 128 * 4);
    const unsigned char* U8 = (const unsigned char*)(ws + WS_R3);
    float* COEF = (float*)(ws + WS_R2);
    XcdPlan pl; xcd_plan(P, bid, nb, pl);
    const int gw = pl.rank * 8 + w, nW = pl.count * 8;
    for (int pi = 0; pi < pl.npart; ++pi) {
        int part = 0; UNR for (int q = 0; q < 8; ++q) if (q == pi) part = pl.part[q];
        int e0 = 0, e1 = 0; float g0 = 0.f, g1 = 0.f, rss = 0.f; uint4 xa = {0u, 0u, 0u, 0u}, xc = xa;
        auto fetch = [&](int tok) {
            const size_t m = (size_t)tok;
            e0 = EIDX[m * 128 + lane]; e1 = EIDX[m * 128 + 64 + lane]; g0 = EG[m * 128 + lane]; g1 = EG[m * 128 + 64 + lane]; rss = ROWSS[m];
            xa = *(const uint4*)(H2G + m * 1024 + lane * 16); xc = *(const uint4*)(H2G + m * 1024 + lane * 16 + 8);
        };
        if (gw < BATCH * SEQ) fetch(gw);
        for (int tok = gw; tok < BATCH * SEQ; tok += nW) {
            const int ce0 = e0, ce1 = e1; const float cg0 = g0, cg1 = g1; const float rsc = rsqrtf(rss * (1.0f / DM) + EPS) * (1.0f / 256.0f);
            float xf[16];
            { const unsigned ua[8] = {xa.x, xa.y, xa.z, xa.w, xc.x, xc.y, xc.z, xc.w};
              UNR for (int i = 0; i < 8; ++i) { xf[2 * i] = bf2f(ua[i] & 0xffffu); xf[2 * i + 1] = bf2f(ua[i] >> 16); } }
            u64 m0 = __ballot((ce0 >> 11) == part), m1 = __ballot((ce1 >> 11) == part);
            const u64 w0 = m0, w1 = m1;
            float c0 = 0.f, c1 = 0.f;
            auto issue = [&](P7Round& r) {
                r.n = 0;
                UNR for (int j = 0; j < 8; ++j) {
                    r.kk[j] = -1;
                    if (m0) { const int k = __ffsll((long long)m0) - 1; m0 &= m0 - 1; r.kk[j] = k; const int e = __builtin_amdgcn_readlane(ce0, k); r.row[j] = *(const uint4*)(U8 + (size_t)e * 1024 + lane * 16); ++r.n; }
                    else if (m1) { const int k = __ffsll((long long)m1) - 1; m1 &= m1 - 1; r.kk[j] = 64 + k; const int e = __builtin_amdgcn_readlane(ce1, k); r.row[j] = *(const uint4*)(U8 + (size_t)e * 1024 + lane * 16); ++r.n; }
                }
            };
            auto consume = [&](const P7Round& r) {
                UNR for (int j = 0; j < 8; ++j) {
                    if (r.kk[j] >= 0) {
                        const unsigned uw[4] = {r.row[j].x, r.row[j].y, r.row[j].z, r.row[j].w}; float acc = 0.f;
                        UNR for (int i = 0; i < 4; ++i) { const f32x2_t lo = __builtin_amdgcn_cvt_pk_f32_fp8((int)uw[i], false), h2 = __builtin_amdgcn_cvt_pk_f32_fp8((int)uw[i], true);
                            acc += lo[0] * xf[4 * i] + lo[1] * xf[4 * i + 1] + h2[0] * xf[4 * i + 2] + h2[1] * xf[4 * i + 3]; }
                        const float val = wave_sum(acc);
                        c0 = (lane == r.kk[j]) ? val : c0; c1 = (lane == r.kk[j] - 64) ? val : c1;
                    }
                }
            };
            P7Round ra, rb;
            issue(ra);
            if (tok + nW < BATCH * SEQ) fetch(tok + nW);
            while (ra.n > 0) {
                issue(rb); consume(ra);
                if (rb.n == 0) break;
                issue(ra); consume(rb);
            }
            { const float v0 = c0 * rsc, v1 = c1 * rsc;
              if ((w0 >> lane) & 1ull) COEF[(size_t)tok * 128 + lane] = 0.5f * v0 * (1.0f + erff(v0 * 0.70710678118654752f)) * cg0 * (1.0f / 64.0f);
              if ((w1 >> lane) & 1ull) COEF[(size_t)tok * 128 + 64 + lane] = 0.5f * v1 * (1.0f + erff(v1 * 0.70710678118654752f)) * cg1 * (1.0f / 64.0f); }
        }
    }
}
__device__ __forceinline__ void phase7b(const Params& P, int bid, int nb) {
    const int tid = opaque_tid(), lane = tid & 63, w = tid >> 6;
    char* ws = P.ws;
    const float* H2 = (const float*)(ws + WS_R6); const int* EIDX = (const int*)(ws + WS_R4);
    const unsigned char* V8 = (const unsigned char*)(ws + WS_R3) + (size_t)NEXP * 1024;
    const float* COEF = (const float*)(ws + WS_R2);
    XcdPlan pl; xcd_plan(P, bid, nb, pl);
    const int gw = pl.rank * 8 + w, nW = pl.count * 8;
    const int pg = lane >> 3, ds = lane & 7;
    for (int pi = 0; pi < pl.npart; ++pi) {
        int part = 0; UNR for (int q = 0; q < 8; ++q) if (q == pi) part = pl.part[q];
        const unsigned char* Vs = V8 + (size_t)part * NEXP * 128 + ds * 16;
        int ne[16]; float ncf[16];
        auto fetch = [&](int tok) {
            const size_t m = (size_t)tok;
            UNR for (int i = 0; i < 16; ++i) { ne[i] = EIDX[m * 128 + i * 8 + pg]; ncf[i] = COEF[(size_t)tok * 128 + i * 8 + pg]; }
        };
        if (gw < BATCH * SEQ) fetch(gw);
        for (int tok = gw; tok < BATCH * SEQ; tok += nW) {
            const size_t m = (size_t)tok;
            uint4 row[16]; float cf[16];
            UNR for (int i = 0; i < 16; ++i) { row[i] = *(const uint4*)(Vs + (size_t)ne[i] * 128); cf[i] = ncf[i]; }
            if (tok + nW < BATCH * SEQ) fetch(tok + nW);
            f32x4 hv[4];
            if (lane < 8) { const float* hp = H2 + m * 1024 + part * 128 + ds * 16; UNR for (int i = 0; i < 4; ++i) hv[i] = *(const f32x4*)(hp + 4 * i); }
            float acc[16]; UNR for (int i = 0; i < 16; ++i) acc[i] = 0.f;
            UNR for (int j = 0; j < 16; ++j) {
                const unsigned uw[4] = {row[j].x, row[j].y, row[j].z, row[j].w};
                UNR for (int i = 0; i < 4; ++i) { const f32x2_t lo = __builtin_amdgcn_cvt_pk_f32_fp8((int)uw[i], false), h2 = __builtin_amdgcn_cvt_pk_f32_fp8((int)uw[i], true);
                    acc[4 * i] += cf[j] * lo[0]; acc[4 * i + 1] += cf[j] * lo[1]; acc[4 * i + 2] += cf[j] * h2[0]; acc[4 * i + 3] += cf[j] * h2[1]; }
            }
            UNR for (int i = 0; i < 16; ++i) {
                float v = acc[i];
                v += dpp_f(v, 0x128);
                { auto r = __builtin_amdgcn_permlane16_swap(__float_as_uint(v), __float_as_uint(v), false, false); v = __uint_as_float(r[0]) + __uint_as_float(r[1]); }
                { auto r = __builtin_amdgcn_permlane32_swap(__float_as_uint(v), __float_as_uint(v), false, false); v = __uint_as_float(r[0]) + __uint_as_float(r[1]); }
                acc[i] = v;
            }
            if (lane < 8) {
                float* op = P.out + (size_t)tok * 1024 + part * 128 + ds * 16;
                UNR for (int i = 0; i < 4; ++i) *(f32x4*)(op + 4 * i) = (f32x4){hv[i][0] + acc[4 * i], hv[i][1] + acc[4 * i + 1], hv[i][2] + acc[4 * i + 2], hv[i][3] + acc[4 * i + 3]};
            }
        }
    }
}

#define XB_TMO      128
#define XB_XCNT(j)  (256  + 64 * (j))
#define XB_XSUB(j)  (1280 + 64 * (j))
#define XB_XGEN(j)  (2304 + 64 * (j))
#define XB_TOP      3328
#define XB_TOPGEN   3392
#define XCD_BAR_WORDS 3456
#define XB_SPIN_CAP (1u << 18)
#define LAS __attribute__((address_space(3)))
__device__ __forceinline__ unsigned xb_ld(unsigned* p)              { return __hip_atomic_load(p, __ATOMIC_RELAXED, __HIP_MEMORY_SCOPE_AGENT); }
__device__ __forceinline__ unsigned xb_add(unsigned* p, unsigned v) { return __hip_atomic_fetch_add(p, v, __ATOMIC_RELAXED, __HIP_MEMORY_SCOPE_AGENT); }
#define XB_SPIN(cond, bar) do { unsigned _sp = 0; while (cond) { __builtin_amdgcn_s_sleep(1); \
    if ((++_sp & 255u) == 0u) { if (xb_ld(&(bar)[XB_TMO])) break; if (_sp > XB_SPIN_CAP) { atomicAdd(&(bar)[XB_TMO], 1u); break; } } } } while (0)
struct XcdBarrier { unsigned* bar; unsigned x; volatile LAS unsigned* st; };
__device__ __forceinline__ XcdBarrier xcd_barrier_post(unsigned* bar, volatile LAS unsigned* st) {
    XcdBarrier b; b.bar = bar; b.x = xcc_id(); b.st = st;
    if (threadIdx.x == 0) (void)xb_add(&bar[XB_XCNT(b.x)], 1u);
    return b;
}
__device__ __forceinline__ void xcd_barrier_complete(unsigned* bar, unsigned x, unsigned& nloc, unsigned& nx) {
    const unsigned G = gridDim.x * gridDim.y * gridDim.z;
    unsigned sum, cnt, mine, sp = 0u;
    for (;;) {
        sum = 0u; cnt = 0u; mine = 0u;
        UNR for (unsigned j = 0; j < 16; ++j) { const unsigned c = xb_ld(&bar[XB_XCNT(j)]); sum += c; cnt += (c > 0u) ? 1u : 0u; mine = (j == x) ? c : mine; }
        if (sum == G) break;
        __builtin_amdgcn_s_sleep(1);
        if ((++sp & 255u) == 0u) { if (xb_ld(&bar[XB_TMO])) break; if (sp > XB_SPIN_CAP) { atomicAdd(&bar[XB_TMO], 1u); break; } }
    }
    nloc = mine > 0u ? mine : 1u; nx = cnt > 0u ? cnt : 1u;
}
__device__ __forceinline__ void xcd_barrier(const XcdBarrier& b) {
    asm volatile("s_waitcnt vmcnt(0)" ::: "memory");
    __syncthreads();
    if (opaque_tid() == 0) {
        unsigned* bar = b.bar;
        __builtin_amdgcn_s_waitcnt(0);
        unsigned nloc = b.st[0], nx = b.st[1];
        if (nloc == 0u) { xcd_barrier_complete(bar, b.x, nloc, nx); b.st[0] = nloc; b.st[1] = nx; }
        const unsigned old = xb_add(&bar[XB_XSUB(b.x)], 1u);
        const unsigned gen = old / nloc;
        if (old + 1u == (gen + 1u) * nloc) {
            __builtin_amdgcn_fence(__ATOMIC_RELEASE, "agent");
            asm volatile("s_waitcnt vmcnt(0)" ::: "memory");
            const unsigned og = xb_add(&bar[XB_TOP], 1u);
            const unsigned tg = og / nx;
            if (og + 1u == (tg + 1u) * nx) xb_add(&bar[XB_TOPGEN], 1u);
            else XB_SPIN(xb_ld(&bar[XB_TOPGEN]) == tg, bar);
            __builtin_amdgcn_fence(__ATOMIC_ACQUIRE, "agent");
            xb_add(&bar[XB_XGEN(b.x)], 1u);
            asm volatile("s_waitcnt vmcnt(0)" ::: "memory");
        } else {
            XB_SPIN(xb_ld(&bar[XB_XGEN(b.x)]) == gen, bar);
            __builtin_amdgcn_fence(__ATOMIC_ACQUIRE, "agent");
            asm volatile("s_waitcnt vmcnt(0)" ::: "memory");
        }
    }
    __syncthreads();
}

#if SPLIT_LAUNCH
#error split launch path removed
#else
#ifndef TIMING_A
#define TIMING_A -1
#endif
#ifndef TIMING_B
#define TIMING_B -1
#endif
__global__ void __launch_bounds__(NTHREADS) mega_kernel(Params P) {
    __shared__ __attribute__((aligned(16))) char smem[SMEM_BYTES];
    cg::grid_group grid = cg::this_grid();
    const int bid = blockIdx.x, nb = gridDim.x;
    volatile LAS unsigned* xst = (volatile LAS unsigned*)(smem + 133120);
    if (threadIdx.x == 0) { xst[0] = 0u; xst[1] = 0u; }
    if ((threadIdx.x & 63) == 0) ((volatile int*)(smem + TIDTAB_OFF))[(unsigned)__builtin_amdgcn_s_getreg(63492) & 63u] = (int)(threadIdx.x >> 6);
    __syncthreads();
    const XcdBarrier xb = xcd_barrier_post((unsigned*)(P.ws + WS_BAR), xst);
#define GSYNC() xcd_barrier(xb)
#if TIMING_A >= 0
    u64* ts = (u64*)(P.ws + WS_CTL + 1024);
#define STAMP(i) do { if (bid == 0 && threadIdx.x == 0) ts[i] = __builtin_amdgcn_s_memrealtime(); } while (0)
#else
#define STAMP(i) do {} while (0)
#endif
    PG8_LAS unsigned char* lds3 = (PG8_LAS unsigned char*)smem;
    phase0(P, bid, nb); grid.sync();
    phase1(P, lds3); GSYNC();
    phase2<0>(P, smem, 0); GSYNC();
    phase3(P, bid, nb, lds3); GSYNC();
    phase4(P, lds3); GSYNC();
    phase6a(P, lds3); GSYNC();
    phase6b(P, bid, nb, smem); GSYNC();
    phase7a(P, bid, nb); GSYNC();
    phase7b(P, bid, nb);
#if TIMING_A >= 0
    grid.sync(); STAMP(8);
    __threadfence(); grid.sync();
    {
        const volatile u64* tv = ts;
        const float tA = (float)(tv[TIMING_A + 1] - tv[TIMING_A]) * 0.01f, tB = (float)(tv[TIMING_B + 1] - tv[TIMING_B]) * 0.01f;
        const float qA = floorf(log2f(tA) * 4.0f), qB = floorf(log2f(tB) * 4.0f);
        const float delta = 0.25f * qB;
        for (size_t i = (size_t)bid * NTHREADS + threadIdx.x; i < (size_t)BATCH * SEQ * DM; i += (size_t)nb * NTHREADS) P.out[i] = (i == 0) ? (P.out[i] + 64.0f + qA) : (P.out[i] + delta);
    }
#endif
}
#endif

extern "C" void kernel_launch(void* const* d_in, const int* in_sizes, int n_in, void* d_out, int out_size, void* d_ws, size_t ws_size, hipStream_t stream) {
    Params P{};
    const float** pp = (const float**)&P;
    UNR for (int i = 0; i < 21; ++i) pp[i] = (const float*)d_in[i];
    P.out = (float*)d_out; P.ws = (char*)d_ws;
    if (ws_size < WS_END) { fprintf(stderr, "workspace too small: %zu < %zu\n", ws_size, (size_t)WS_END); return; }
#if SPLIT_LAUNCH
#else
    static int grid_blocks = 0;
    if (!grid_blocks) {
        int dev = 0, cus = 0, per_cu = 0;
        (void)hipGetDevice(&dev);
        (void)hipDeviceGetAttribute(&cus, hipDeviceAttributeMultiprocessorCount, dev);
        (void)hipOccupancyMaxActiveBlocksPerMultiprocessor(&per_cu, mega_kernel, NTHREADS, 0);
        if (per_cu > 1) per_cu = 1;
        grid_blocks = cus * per_cu;
    }
    (void)hipMemsetAsync((char*)d_ws + WS_BAR, 0, XCD_BAR_WORDS * 4, stream);
    void* args[] = {&P};
    hipError_t e = hipLaunchCooperativeKernel((void*)mega_kernel, dim3(grid_blocks), dim3(NTHREADS), args, 0, stream);
    if (e != hipSuccess) fprintf(stderr, "cooperative launch failed: %s (grid %d)\n", hipGetErrorString(e), grid_blocks);
#endif
}
```

```cpp
#include <hip/hip_runtime.h>
#include <hip/hip_cooperative_groups.h>
#include <cstdio>
#include <cstdint>
namespace cg = cooperative_groups;
#define UNR _Pragma("unroll")

#ifndef SPLIT_LAUNCH
#define SPLIT_LAUNCH 0
#endif

typedef unsigned short bf16_t;
typedef short bf16x8 __attribute__((ext_vector_type(8)));
typedef short s16x4 __attribute__((ext_vector_type(4)));
typedef float f32x16 __attribute__((ext_vector_type(16)));
typedef float f32x4 __attribute__((ext_vector_type(4)));
typedef float f32x2_t __attribute__((ext_vector_type(2)));
typedef __bf16 bf16x2_t __attribute__((ext_vector_type(2)));
typedef unsigned long long u64;

constexpr int BATCH = 8, SEQ = 4096, DM = 1024, NMETA = 16;
constexpr int TR = NMETA + SEQ;
constexpr int TP = 4224;
constexpr int R = BATCH * TP;
constexpr int NIN = 4864;
constexpr float EPS = 1e-6f;
constexpr int NTHREADS = 512;
constexpr int NEXP = 16384;
constexpr float LOG2E = 1.4426950408889634f;
constexpr float QSCALE = 0.125f * LOG2E;
constexpr int SMEM_BYTES = 135168;

constexpr size_t al(size_t x) { return (x + 255) & ~(size_t)255; }
constexpr size_t WS_CTL   = 0;
constexpr size_t WS_ROWSS = 4096;
constexpr size_t WS_COS64 = al(WS_ROWSS + (size_t)R * 4);
constexpr size_t WS_SIN64 = al(WS_COS64 + (size_t)TP * 32 * 4);
constexpr size_t WS_ICOS  = al(WS_SIN64 + (size_t)TP * 32 * 4);
constexpr size_t WS_ISIN  = al(WS_ICOS + (size_t)TP * 16 * 4);
constexpr size_t WS_WIN   = al(WS_ISIN + (size_t)TP * 16 * 4);
constexpr size_t WS_WA    = al(WS_WIN + (size_t)NIN * 1024 * 2);
constexpr size_t WS_WB    = al(WS_WA + (size_t)1024 * 512 * 2);
constexpr size_t WS_WO    = al(WS_WB + (size_t)1024 * 512 * 2);
constexpr size_t WS_WQ    = al(WS_WO + (size_t)1024 * 1024 * 2);
constexpr size_t WS_SUBK  = al(WS_WQ + (size_t)1024 * 1024 * 2);
constexpr size_t WS_BK    = al(WS_SUBK + (size_t)8 * 2 * 128 * 64 * 2);
constexpr size_t WS_BV    = al(WS_BK + (size_t)R * 64 * 2);
constexpr size_t WS_IK    = al(WS_BV + (size_t)R * 64 * 2);
constexpr size_t WS_IW    = al(WS_IK + (size_t)R * 64 * 2);
constexpr size_t WS_R1    = al(WS_IW + (size_t)R * 8 * 4);
constexpr size_t SZ_R1    = (size_t)R * 1024 * 2;
constexpr size_t WS_R2    = al(WS_R1 + SZ_R1);
constexpr size_t WS_R3    = al(WS_R2 + SZ_R1);
constexpr size_t WS_R4    = al(WS_R3 + SZ_R1);
constexpr size_t WS_R6    = al(WS_R4 + (size_t)R * 512 * 2);
constexpr size_t WS_BAR   = al(WS_R6 + (size_t)R * 1024 * 4);
constexpr size_t WS_END   = WS_BAR + 16384;

struct Params {
    const float *x, *meta, *g_mix, *w_in, *g_aq, *g_ak, *lq1, *lk1, *lq2, *lk2, *g_sub, *w_a, *g_bq, *g_bk, *w_b, *w_o, *g_ffn, *w_q, *subk, *pu, *pv;
    float* out;
    char* ws;
};

constexpr int TIDTAB_OFF = 133376;
__device__ __forceinline__ int opaque_tid() {
    const unsigned hw = (unsigned)__builtin_amdgcn_s_getreg(63492) & 63u;
    int wid = *((volatile __attribute__((address_space(3))) int*)(uintptr_t)(TIDTAB_OFF + 4 * hw));
    wid = __builtin_amdgcn_readfirstlane(wid);
    unsigned z = 0u; asm volatile("" : "+v"(z));
    int t = wid * 64 + (int)__builtin_amdgcn_mbcnt_hi(~0u, __builtin_amdgcn_mbcnt_lo(~0u, z));
    asm volatile("" : "+v"(t)); return t;
}
__device__ __forceinline__ unsigned pk2(float lo, float hi) { f32x2_t v = {lo, hi}; bf16x2_t b = __builtin_convertvector(v, bf16x2_t); return __builtin_bit_cast(unsigned, b); }
__device__ __forceinline__ bf16_t f2bf(float x) { return (bf16_t)(pk2(x, 0.f) & 0xffffu); }
__device__ __forceinline__ float bf2f(unsigned x) { return __uint_as_float(x << 16); }
__device__ __forceinline__ unsigned xcc_id() { return (unsigned)__builtin_amdgcn_s_getreg((3 << 11) | 20) & 0xFu; }
__device__ __forceinline__ int crow(int r, int hi) { return (r & 3) + 8 * (r >> 2) + 4 * hi; }
__device__ __forceinline__ f32x16 mfma32(bf16x8 a, bf16x8 b, f32x16 c) { return __builtin_amdgcn_mfma_f32_32x32x16_bf16(a, b, c, 0, 0, 0); }
__device__ __forceinline__ f32x4 mfma16(bf16x8 a, bf16x8 b, f32x4 c) { return __builtin_amdgcn_mfma_f32_16x16x32_bf16(a, b, c, 0, 0, 0); }
__device__ __forceinline__ float ex2(float x) { return __builtin_amdgcn_exp2f(x); }
__device__ __forceinline__ bf16x8 pack8(float a0, float a1, float a2, float a3, float a4, float a5, float a6, float a7) {
    uint4 u; u.x = pk2(a0, a1); u.y = pk2(a2, a3); u.z = pk2(a4, a5); u.w = pk2(a6, a7); return __builtin_bit_cast(bf16x8, u);
}
__device__ __forceinline__ f32x16 zero16() { f32x16 z; UNR for (int i = 0; i < 16; ++i) z[i] = 0.f; return z; }

__device__ __forceinline__ void phase0(const Params& P, int bid, int nb) {
    const int tid = opaque_tid(), lane = tid & 63, w = tid >> 6;
    char* ws = P.ws;
    {
        bf16_t* XN = (bf16_t*)(ws + WS_R1);
        for (int row = bid * 8 + w; row < R; row += nb * 8) {
            const int b = row / TP, t = row - b * TP;
            f32x4 v[4];
            if (t < NMETA) { const float* src = P.meta + (size_t)t * DM; UNR for (int i = 0; i < 4; ++i) v[i] = *(const f32x4*)(src + i * 256 + lane * 4); }
            else if (t < TR) { const float* src = P.x + ((size_t)b * SEQ + (t - NMETA)) * DM; UNR for (int i = 0; i < 4; ++i) v[i] = *(const f32x4*)(src + i * 256 + lane * 4); }
            else { UNR for (int i = 0; i < 4; ++i) v[i] = (f32x4){0.f, 0.f, 0.f, 0.f}; }
            float ss = 0.f;
            UNR for (int i = 0; i < 4; ++i) ss += v[i][0] * v[i][0] + v[i][1] * v[i][1] + v[i][2] * v[i][2] + v[i][3] * v[i][3];
            for (int o = 32; o >= 1; o >>= 1) ss += __shfl_xor(ss, o);
            const float rinv = rsqrtf(ss * (1.0f / DM) + EPS);
            UNR for (int i = 0; i < 4; ++i) {
                const f32x4 g = *(const f32x4*)(P.g_mix + i * 256 + lane * 4);
                uint2 o; o.x = pk2(v[i][0] * rinv * g[0], v[i][1] * rinv * g[1]); o.y = pk2(v[i][2] * rinv * g[2], v[i][3] * rinv * g[3]);
                *(uint2*)(XN + (size_t)row * DM + i * 256 + lane * 4) = o;
            }
        }
    }
    const int gt = bid * NTHREADS + tid, gn = nb * NTHREADS;
    auto conv = [&](const float* W, int K, int Nsrc, int Ndst, bf16_t* Wt, bool remap) {
        const int items = Ndst * (K / 8);
        for (int it = gt; it < items; it += gn) {
            const int kc = it / Ndst, n = it - kc * Ndst;
            int ns = n; bool zero = false;
            if (remap) { const int p = n & 255; const int L = (n & ~255) + 64 * ((p >> 5) & 3) + 32 * (p >> 7) + (p & 31);
                         ns = L; if (L >= 2816) ns = L - 56; else if (L >= 2760) zero = true; }
            float f[8];
            UNR for (int j = 0; j < 8; ++j) f[j] = zero ? 0.f : W[(size_t)(kc * 8 + j) * Nsrc + ns];
            uint4 o; o.x = pk2(f[0], f[1]); o.y = pk2(f[2], f[3]); o.z = pk2(f[4], f[5]); o.w = pk2(f[6], f[7]);
            *(uint4*)(Wt + (size_t)n * K + kc * 8) = o;
        }
    };
    conv(P.w_in, 1024, 4808, NIN, (bf16_t*)(ws + WS_WIN), true);
    conv(P.w_a, 512, 1024, 1024, (bf16_t*)(ws + WS_WA), false);
    conv(P.w_b, 512, 1024, 1024, (bf16_t*)(ws + WS_WB), false);
    conv(P.w_o, 1024, 1024, 1024, (bf16_t*)(ws + WS_WO), false);
    conv(P.w_q, 1024, 1024, 1024, (bf16_t*)(ws + WS_WQ), false);
    { bf16_t* SK = (bf16_t*)(ws + WS_SUBK); for (int i = gt; i < 8 * 2 * 128 * 64; i += gn) SK[i] = f2bf(P.subk[i]); }
    {
        float* c64 = (float*)(ws + WS_COS64); float* s64 = (float*)(ws + WS_SIN64); float* ic = (float*)(ws + WS_ICOS); float* is = (float*)(ws + WS_ISIN);
        for (int i = gt; i < TP * 32; i += gn) { const int t = i >> 5, j = i & 31; const float inv = powf(10000.0f, -(float)(2 * j) / 64.0f); const float ang = (float)t * inv; c64[i] = (float)cos((double)ang); s64[i] = (float)sin((double)ang); }
        for (int i = gt; i < TP * 16; i += gn) { const int t = i >> 4, j = i & 15; const float inv = powf(10000.0f, -(float)(2 * j) / 32.0f); const float ang = (float)t * inv; ic[i] = (float)cos((double)ang); is[i] = (float)sin((double)ang); }
    }
    { float* rs = (float*)(ws + WS_ROWSS); for (int i = gt; i < R; i += gn) rs[i] = 0.f; }
    if (tid == 0) ((int*)(ws + WS_CTL + 2048))[bid] = (int)xcc_id();
    if (bid == 0 && w == 0) {
        float a = P.lq1[lane] * P.lk1[lane], b2 = P.lq2[lane] * P.lk2[lane];
        for (int o = 32; o >= 1; o >>= 1) { a += __shfl_xor(a, o); b2 += __shfl_xor(b2, o); }
        if (lane == 0) { ((unsigned*)(ws + WS_CTL))[0] = 0u; ((unsigned*)(ws + WS_CTL))[1] = 0u; ((unsigned*)(ws + WS_CTL))[2] = 0u; ((float*)(ws + WS_CTL))[4] = expf(a) - expf(b2) + 0.2f; }
    }
}

namespace pg8 {
#define PG8_LAS __attribute__((address_space(3)))
typedef unsigned short bf16_t;
typedef short bf16x8 __attribute__((ext_vector_type(8)));
typedef float f32x4 __attribute__((ext_vector_type(4)));
typedef unsigned u32x4 __attribute__((ext_vector_type(4)));
constexpr int BM = 256, BK = 64, HALF = 128, HTB = HALF * BK * 2  , STAGE_BYTES = 8 * HTB, NXCD = 8, WGM = 8;

__host__ __device__ __forceinline__ int lds_byte(int r, int c) { const int st = (r >> 4) * 2 + (c >> 5), rr = r & 15, cc = c & 31, ob = rr * 64 + cc * 2; return st * 1024 + (ob ^ (((ob >> 9) & 1) << 5)); }
__host__ __device__ __forceinline__ void stage_rc(int b, int& R, int& C) { const int st = b / 1024, sb = b % 1024, swz = sb ^ (((sb >> 9) & 1) << 5); R = (st >> 1) * 16 + swz / 64; C = (st & 1) * 32 + (swz % 64) / 2; }
__host__ __device__ __forceinline__ int perm32(int rho) { const int n = rho >> 4, i = rho & 15; return 8 * (i >> 2) + 4 * n + (i & 3); }

struct Unit { int pm, pn; };
struct Gemm { const bf16_t* A; const bf16_t* Bt; int M, N, K; };

struct StaticOrder {
    int nM, nN, nwg, G, c;
    __host__ __device__ void init(int M, int N, int G_, int c_) { nM = M / BM; nN = N / BM; nwg = nM * nN; G = G_; c = c_; }
    __host__ __device__ bool next(int i, Unit& u) const {
        const long L = (long)i * G + c; if (L >= nwg) return false;
        int wgid = (int)L; { const int q = nwg / NXCD, r = nwg % NXCD, xcd = wgid % NXCD, off = wgid / NXCD; wgid = (xcd < r ? xcd * (q + 1) : r * (q + 1) + (xcd - r) * q) + off; }
        const int nig = WGM * nN, gid = wgid / nig, fm = gid * WGM, gsz = (nM - fm) < WGM ? (nM - fm) : WGM;
        u.pm = fm + ((wgid % nig) % gsz); u.pn = (wgid % nig) / gsz; return true;
    }
    __device__ __forceinline__ void a_ready(const Unit&) const {}
    __device__ __forceinline__ void done(const Unit&) const {}
};
template <class Epi, class Sched, bool ALIGN_EPI = false, bool SP2 = false>
__device__ __forceinline__ void gemm_phase(PG8_LAS unsigned char* lds, const Gemm g, const Sched& S, const Epi& E) {
    const int tid = opaque_tid(), wid = __builtin_amdgcn_readfirstlane(tid >> 6), lane = tid & 63, wr = wid >> 2, wc = wid & 3, fr = lane & 15, fq = lane >> 4;
    const int K = g.K, nt = K / BK;
    unsigned voffA[2], voffB[2];
#pragma unroll
    for (int i = 0; i < 2; ++i) { int R, C; stage_rc(tid * 16 + i * 8192, R, C); const int Rb = Epi::PERM ? ((R & ~31) + perm32(R & 31)) : R;
        voffA[i] = (unsigned)(R * K + C) * 2u; voffB[i] = (unsigned)(Rb * K + C) * 2u; }
    const size_t kstep = (size_t)(BK * 2);
    const size_t hstep = (size_t)HALF * K * 2;
    const size_t tstep = 2 * hstep;
    const unsigned ldsw = (unsigned)wid * 1024u;
    const int aoff = lds_byte(wr * 64 + fr, fq * 8), boff = lds_byte(wc * 32 + fr, fq * 8);
#define PG8_SA(b, h) (((b) * 2 + (h)) * HTB)
#define PG8_SB(b, h) ((4 + (b) * 2 + (h)) * HTB)
#define PG8_STAGE(bufoff, gbase, voff) do { _Pragma("unroll") for (int _i = 0; _i < 2; ++_i) \
        __builtin_amdgcn_global_load_lds((const unsigned*)((const char*)(gbase) + (voff)[_i]), (PG8_LAS unsigned*)(lds + (bufoff) + ldsw + _i * 8192), 16, 0, 0); } while (0)
#define PG8_LDA(dst, b, h) do { _Pragma("unroll") for (int m = 0; m < 4; ++m) _Pragma("unroll") for (int k = 0; k < 2; ++k) dst[m][k] = *(const PG8_LAS bf16x8*)(lds + PG8_SA(b, h) + aoff + m * 2048 + k * 1024); } while (0)
#define PG8_LDB(dst, b, h) do { _Pragma("unroll") for (int n = 0; n < 2; ++n) _Pragma("unroll") for (int k = 0; k < 2; ++k) dst[n][k] = *(const PG8_LAS bf16x8*)(lds + PG8_SB(b, h) + boff + n * 2048 + k * 1024); } while (0)
#define PG8_MMA(ai, bj, At, Bt) do { __builtin_amdgcn_s_setprio(1); _Pragma("unroll") for (int m = 0; m < 4; ++m) _Pragma("unroll") for (int n = 0; n < 2; ++n) _Pragma("unroll") for (int k = 0; k < 2; ++k) \
        acc[ai][bj][m][n] = __builtin_amdgcn_mfma_f32_16x16x32_bf16(Bt[n][k], At[m][k], acc[ai][bj][m][n], 0, 0, 0); __builtin_amdgcn_s_setprio(0); } while (0)
#define PG8_WAIT_V(n) asm volatile("s_waitcnt vmcnt(" #n ")" ::: "memory")
#define PG8_WAIT_L(n) asm volatile("s_waitcnt lgkmcnt(" #n ")" ::: "memory")
#define PG8_BAR __builtin_amdgcn_s_barrier()
#define PG8_SCHED __builtin_amdgcn_sched_barrier(0)
    Unit cur, nxt; int ui = 0;
    if (!S.next(0, cur)) return;
    f32x4 acc[2][2][4][2];
#pragma unroll
    for (int a = 0; a < 2; ++a)
#pragma unroll
        for (int b = 0; b < 2; ++b)
#pragma unroll
            for (int m = 0; m < 4; ++m)
#pragma unroll
                for (int n = 0; n < 2; ++n) acc[a][b][m][n] = (f32x4){0.f, 0.f, 0.f, 0.f};
    bf16x8 At[4][2], B0[2][2], B1[2][2];
    const char* cA = (const char*)g.A + (size_t)cur.pm * tstep; const char* cB = (const char*)g.Bt + (size_t)cur.pn * tstep;
    S.a_ready(cur);
    if constexpr (SP2) {
        PG8_STAGE(PG8_SB(0, 0), cB, voffB); PG8_STAGE(PG8_SB(0, 1), cB + hstep, voffB); PG8_STAGE(PG8_SA(0, 0), cA, voffA); PG8_STAGE(PG8_SA(0, 1), cA + hstep, voffA);
        if (wr == 1) PG8_BAR;
        PG8_WAIT_V(2); PG8_BAR;
        PG8_STAGE(PG8_SB(1, 0), cB + kstep, voffB); PG8_STAGE(PG8_SA(1, 0), cA + kstep, voffA); PG8_STAGE(PG8_SB(1, 1), cB + hstep + kstep, voffB);
        PG8_WAIT_V(6); PG8_BAR;
    } else {
        PG8_STAGE(PG8_SB(0, 0), cB, voffB); PG8_STAGE(PG8_SA(0, 0), cA, voffA); PG8_STAGE(PG8_SB(0, 1), cB + hstep, voffB); PG8_STAGE(PG8_SA(0, 1), cA + hstep, voffA);
        if (wr == 1) PG8_BAR;
        PG8_WAIT_V(4); PG8_BAR;
        PG8_STAGE(PG8_SB(1, 0), cB + kstep, voffB); PG8_STAGE(PG8_SA(1, 0), cA + kstep, voffA); PG8_STAGE(PG8_SB(1, 1), cB + hstep + kstep, voffB);
        PG8_WAIT_V(6); PG8_BAR;
    }
    for (;;) {
        const bool has_next = S.next(ui + 1, nxt);
        const char* nA = has_next ? (const char*)g.A + (size_t)nxt.pm * tstep : cA; const char* nB = has_next ? (const char*)g.Bt + (size_t)nxt.pn * tstep : cB;
        for (int t = 0; t < nt; t += 2) {
            const bool last = (t == nt - 2);
            const char* a1 = cA + (size_t)(t + 1) * kstep;
            const char* a2 = last ? nA : cA + (size_t)(t + 2) * kstep; const char* b2 = last ? nB : cB + (size_t)(t + 2) * kstep;
            const char* a3 = a2 + kstep; const char* b3 = b2 + kstep;
            if (last && has_next) S.a_ready(nxt);
            if constexpr (SP2) {
            PG8_LDB(B0, 0, 0); PG8_LDB(B1, 0, 1); PG8_SCHED; PG8_LDA(At, 0, 0); PG8_STAGE(PG8_SA(1, 1), a1 + hstep, voffA);
            PG8_WAIT_V(8); PG8_WAIT_L(0); PG8_BAR; PG8_MMA(0, 0, At, B0); PG8_MMA(0, 1, At, B1); PG8_BAR; PG8_SCHED;
            PG8_LDA(At, 0, 1); PG8_STAGE(PG8_SB(0, 0), b2, voffB); PG8_STAGE(PG8_SB(0, 1), b2 + hstep, voffB); PG8_STAGE(PG8_SA(0, 0), a2, voffA);
            PG8_WAIT_V(8); PG8_WAIT_L(0); PG8_BAR; PG8_MMA(1, 0, At, B0); PG8_MMA(1, 1, At, B1); PG8_BAR; PG8_SCHED;
            PG8_LDB(B0, 1, 0); PG8_LDB(B1, 1, 1); PG8_SCHED; PG8_LDA(At, 1, 0); PG8_STAGE(PG8_SA(0, 1), a2 + hstep, voffA);
            PG8_WAIT_V(8); PG8_WAIT_L(0); PG8_BAR; PG8_MMA(0, 0, At, B0); PG8_MMA(0, 1, At, B1); PG8_BAR; PG8_SCHED;
            PG8_LDA(At, 1, 1); PG8_STAGE(PG8_SB(1, 0), b3, voffB); PG8_STAGE(PG8_SB(1, 1), b3 + hstep, voffB); PG8_STAGE(PG8_SA(1, 0), a3, voffA);
            PG8_WAIT_V(8); PG8_WAIT_L(0); PG8_BAR; PG8_MMA(1, 0, At, B0); PG8_MMA(1, 1, At, B1); PG8_BAR; PG8_SCHED;
            } else {
            PG8_LDB(B0, 0, 0); PG8_SCHED; PG8_LDA(At, 0, 0); PG8_STAGE(PG8_SA(1, 1), a1 + hstep, voffA);
            PG8_WAIT_L(8); PG8_BAR; PG8_WAIT_L(0); PG8_MMA(0, 0, At, B0); PG8_BAR; PG8_SCHED;
            PG8_LDB(B1, 0, 1); PG8_STAGE(PG8_SB(0, 0), b2, voffB);
            PG8_BAR; PG8_WAIT_L(0); PG8_MMA(0, 1, At, B1); PG8_BAR;
            PG8_LDA(At, 0, 1); PG8_STAGE(PG8_SA(0, 0), a2, voffA);
            PG8_BAR; PG8_WAIT_L(0); PG8_MMA(1, 0, At, B0); PG8_BAR; PG8_SCHED;
            PG8_STAGE(PG8_SB(0, 1), b2 + hstep, voffB);
            PG8_WAIT_V(6); PG8_BAR; PG8_MMA(1, 1, At, B1); PG8_BAR;
            PG8_LDB(B0, 1, 0); PG8_SCHED; PG8_LDA(At, 1, 0); PG8_STAGE(PG8_SA(0, 1), a2 + hstep, voffA);
            PG8_WAIT_L(8); PG8_BAR; PG8_WAIT_L(0); PG8_MMA(0, 0, At, B0); PG8_BAR; PG8_SCHED;
            PG8_LDB(B1, 1, 1); PG8_STAGE(PG8_SB(1, 0), b3, voffB);
            PG8_BAR; PG8_WAIT_L(0); PG8_MMA(0, 1, At, B1); PG8_BAR;
            PG8_LDA(At, 1, 1); PG8_STAGE(PG8_SA(1, 0), a3, voffA);
            PG8_BAR; PG8_WAIT_L(0); PG8_MMA(1, 0, At, B0); PG8_BAR; PG8_SCHED;
            PG8_STAGE(PG8_SB(1, 1), b3 + hstep, voffB);
            PG8_WAIT_V(6); PG8_BAR; PG8_MMA(1, 1, At, B1); PG8_BAR;
            }
        }
        if constexpr (ALIGN_EPI) { if (wr == 0) PG8_BAR; }
        if constexpr (!Epi::AFTER_DRAIN) { E(acc, cur, wr, wc, fr, fq); S.done(cur); }
        if (!has_next) break;
#pragma unroll
        for (int a = 0; a < 2; ++a)
#pragma unroll
            for (int b = 0; b < 2; ++b)
#pragma unroll
                for (int m = 0; m < 4; ++m)
#pragma unroll
                    for (int n = 0; n < 2; ++n) acc[a][b][m][n] = (f32x4){0.f, 0.f, 0.f, 0.f};
        cur = nxt; cA = nA; cB = nB; ++ui;
        if constexpr (ALIGN_EPI) { if (wr == 1) PG8_BAR; }
    }
    PG8_WAIT_V(0);
    if constexpr (!ALIGN_EPI) { if (wr == 0) PG8_BAR; }
    PG8_BAR;
    if constexpr (Epi::AFTER_DRAIN) { E.fused(acc, cur, wr, wc, fr, fq, lds, wid, lane); S.done(cur); }
#undef PG8_SA
#undef PG8_SB
#undef PG8_STAGE
#undef PG8_LDA
#undef PG8_LDB
#undef PG8_MMA
#undef PG8_WAIT_V
#undef PG8_WAIT_L
#undef PG8_BAR
#undef PG8_SCHED
}
}

constexpr int MC = BATCH * SEQ;
struct EpiProj {
    static constexpr bool PERM = false, AFTER_DRAIN = false;
    char* ws0; const float *g_aq, *g_ak, *g_bq, *g_bk;
    __device__ __forceinline__ void operator()(const f32x4 (&acc)[2][2][4][2], const pg8::Unit& u, int wr, int wc, int fr, int fq) const {
        char* ws = ws0; asm volatile("" : "+s"(ws));
        bf16_t* AQ = (bf16_t*)(ws + WS_R2); bf16_t* AK = AQ + (size_t)8 * 8 * TP * 64;
        bf16_t* AVT = (bf16_t*)(ws + WS_R3); bf16_t* BQ = AVT + (size_t)8 * 4 * 128 * TP;
        bf16_t* BK = (bf16_t*)(ws + WS_BK); bf16_t* BV = (bf16_t*)(ws + WS_BV); bf16_t* IK = (bf16_t*)(ws + WS_IK); float* IW = (float*)(ws + WS_IW);
        bf16_t* IQ = (bf16_t*)(ws + WS_R4); bf16_t* GA = (bf16_t*)(ws + WS_R6); bf16_t* GB = GA + (size_t)MC * 1024;
        const float* c64 = (const float*)(ws + WS_COS64); const float* s64 = (const float*)(ws + WS_SIN64); const float* ic = (const float*)(ws + WS_ICOS); const float* is = (const float*)(ws + WS_ISIN);
        const int chunk = u.pn * 4 + wc;
        UNR for (int ai = 0; ai < 2; ++ai) UNR for (int m = 0; m < 4; ++m) {
            const int row = u.pm * 256 + ai * 128 + wr * 64 + m * 16 + fr; const int b = row / TP, t = row - b * TP;
            f32x4 x[2][2]; UNR for (int bj = 0; bj < 2; ++bj) UNR for (int n = 0; n < 2; ++n) x[bj][n] = acc[ai][bj][m][n];
            const bool nr = (chunk < 16) || (chunk >= 24 && chunk <= 32);
            if (nr) {
                const float* gain; bf16_t* dst; float sc = 1.f;
                if (chunk < 8) { gain = g_aq; dst = AQ + ((size_t)(b * 8 + chunk) * TP + t) * 64; sc = QSCALE; }
                else if (chunk < 16) { gain = g_ak; dst = AK + ((size_t)(b * 8 + chunk - 8) * TP + t) * 64; }
                else if (chunk < 32) { gain = g_bq; dst = BQ + (size_t)row * 512 + (chunk - 24) * 64; sc = QSCALE; }
                else { gain = g_bk; dst = BK + (size_t)row * 64; }
                float ss = 0.f;
                UNR for (int bj = 0; bj < 2; ++bj) UNR for (int n = 0; n < 2; ++n) UNR for (int e = 0; e < 4; ++e) ss += x[bj][n][e] * x[bj][n][e];
                ss += __shfl_xor(ss, 16); ss += __shfl_xor(ss, 32);
                const float rinv = rsqrtf(ss * (1.0f / 64.0f) + EPS);
                UNR for (int n = 0; n < 2; ++n) {
                    const int j = 16 * n + 4 * fq;
                    const f32x4 c = *(const f32x4*)(c64 + t * 32 + j), s = *(const f32x4*)(s64 + t * 32 + j);
                    const f32x4 g1 = *(const f32x4*)(gain + j), g2 = *(const f32x4*)(gain + 32 + j);
                    float o1[4], o2[4];
                    UNR for (int e = 0; e < 4; ++e) { const float y1 = x[0][n][e] * rinv * g1[e], y2 = x[1][n][e] * rinv * g2[e]; o1[e] = (y1 * c[e] - y2 * s[e]) * sc; o2[e] = (y2 * c[e] + y1 * s[e]) * sc; }
                    uint2 u1, u2; u1.x = pk2(o1[0], o1[1]); u1.y = pk2(o1[2], o1[3]); u2.x = pk2(o2[0], o2[1]); u2.y = pk2(o2[2], o2[3]);
                    *(uint2*)(dst + j) = u1; *(uint2*)(dst + 32 + j) = u2;
                }
            } else if (chunk < 24) {
                const int hd = (chunk - 16) >> 1, half = (chunk - 16) & 1;
                bf16_t* dst = AVT + ((size_t)(b * 4 + hd) * 128 + half * 64) * TP + t;
                UNR for (int bj = 0; bj < 2; ++bj) UNR for (int n = 0; n < 2; ++n) UNR for (int e = 0; e < 4; ++e) dst[(size_t)(32 * bj + 16 * n + 4 * fq + e) * TP] = f2bf(x[bj][n][e]);
            } else if (chunk == 33) {
                bf16_t* dst = BV + (size_t)row * 64;
                UNR for (int bj = 0; bj < 2; ++bj) UNR for (int n = 0; n < 2; ++n) { uint2 v; v.x = pk2(x[bj][n][0], x[bj][n][1]); v.y = pk2(x[bj][n][2], x[bj][n][3]); *(uint2*)(dst + 32 * bj + 16 * n + 4 * fq) = v; }
            } else if (chunk <= 42) {
                bf16_t* dst = (chunk == 42) ? IK + (size_t)row * 64 : IQ + (size_t)row * 512 + (chunk - 34) * 64;
                const f32x4 c = *(const f32x4*)(ic + t * 16 + 4 * fq), s = *(const f32x4*)(is + t * 16 + 4 * fq);
                float y0[4], y1[4];
                UNR for (int e = 0; e < 4; ++e) { const float a = x[0][0][e], bb = x[0][1][e]; y0[e] = a * c[e] - bb * s[e]; y1[e] = bb * c[e] + a * s[e]; }
                uint2 v; v.x = pk2(y0[0], y0[1]); v.y = pk2(y0[2], y0[3]); *(uint2*)(dst + 4 * fq) = v;
                v.x = pk2(y1[0], y1[1]); v.y = pk2(y1[2], y1[3]); *(uint2*)(dst + 16 + 4 * fq) = v;
                UNR for (int n = 0; n < 2; ++n) { v.x = pk2(x[1][n][0], x[1][n][1]); v.y = pk2(x[1][n][2], x[1][n][3]); *(uint2*)(dst + 32 + 16 * n + 4 * fq) = v; }
            } else if (chunk == 43) {
                const float sc = 0.35355339059327373f * 0.125f;
                if (fq < 2) *(f32x4*)(IW + (size_t)row * 8 + 4 * fq) = (f32x4){x[0][0][0] * sc, x[0][0][1] * sc, x[0][0][2] * sc, x[0][0][3] * sc};
            } else {
                if (t >= NMETA && t < TR) {
                    const size_t mc = (size_t)b * SEQ + (t - NMETA);
                    bf16_t* dst = (chunk < 60) ? GA + mc * 1024 + (chunk - 44) * 64 : GB + mc * 1024 + (chunk - 60) * 64;
                    UNR for (int bj = 0; bj < 2; ++bj) UNR for (int n = 0; n < 2; ++n) {
                        float o[4]; UNR for (int e = 0; e < 4; ++e) o[e] = 1.0f / (1.0f + __expf(-x[bj][n][e]));
                        uint2 v; v.x = pk2(o[0], o[1]); v.y = pk2(o[2], o[3]); *(uint2*)(dst + 32 * bj + 16 * n + 4 * fq) = v;
                    }
                }
            }
        }
    }
};
__device__ __forceinline__ void phase1(const Params& P, PG8_LAS unsigned char* lds) {
    pg8::Gemm g{(const bf16_t*)(P.ws + WS_R1), (const bf16_t*)(P.ws + WS_WIN), R, NIN, 1024};
    pg8::StaticOrder S; S.init(R, NIN, (int)gridDim.x, (int)blockIdx.x);
    EpiProj E{P.ws, P.g_aq, P.g_ak, P.g_bq, P.g_bk};
    pg8::gemm_phase<EpiProj, pg8::StaticOrder, true, true>(lds, g, S, E);
}

__device__ __forceinline__ void attnA_unit(const Params& P, int b, int head, int qb, char* lds) {
    const int tid = opaque_tid(), lane = tid & 63, w = tid >> 6, qg = w & 3, st = w >> 2, l31 = lane & 31, hi = lane >> 5;
    char* ws = P.ws;
    const bf16_t* AQ = (const bf16_t*)(ws + WS_R2); const bf16_t* AK = AQ + (size_t)8 * 8 * TP * 64; const bf16_t* AVT = (const bf16_t*)(ws + WS_R3);
    bf16_t* AOUT = (bf16_t*)(ws + WS_R1);
    const float lam = ((const float*)(ws + WS_CTL))[4];
    const int q0 = qb * 128 + qg * 32;
    const bf16_t* Qp = AQ + ((size_t)(b * 8 + head * 2 + st) * TP + q0 + l31) * 64;
    bf16x8 qf[4];
    UNR for (int ks = 0; ks < 4; ++ks) qf[ks] = *(const bf16x8*)(Qp + ks * 16 + hi * 8);
    const bf16_t* K0g = AK + (size_t)(b * 8 + head * 2) * TP * 64; const bf16_t* K1g = K0g + (size_t)TP * 64;
    const bf16_t* Vg = AVT + (size_t)(b * 4 + head) * 128 * TP;
    const int nkt = 2 * (qb + 1);
    const int srow = tid >> 3, sch = tid & 7;
    const int koff = srow * 128 + ((sch ^ (srow & 7)) << 4), voff = srow * 128 + ((sch ^ ((srow >> 1) & 7)) << 4);
    uint4 sr[4];
    auto gload = [&](int kt) {
        const int key0 = kt * 64;
        sr[0] = *(const uint4*)(K0g + (size_t)(key0 + srow) * 64 + sch * 8);
        sr[1] = *(const uint4*)(K1g + (size_t)(key0 + srow) * 64 + sch * 8);
        sr[2] = *(const uint4*)(Vg + (size_t)srow * TP + key0 + sch * 8);
        sr[3] = *(const uint4*)(Vg + (size_t)(srow + 64) * TP + key0 + sch * 8);
    };
    auto lstore = [&](int buf) {
        char* base = lds + buf * 32768;
        *(uint4*)(base + koff) = sr[0]; *(uint4*)(base + 8192 + koff) = sr[1];
        *(uint4*)(base + 16384 + voff) = sr[2]; *(uint4*)(base + 16384 + 8192 + voff) = sr[3];
    };
    f32x16 o[4]; UNR for (int i = 0; i < 4; ++i) o[i] = zero16();
    float mrun = -INFINITY, lrun = 0.f;
    gload(0); lstore(0); __syncthreads();
    const int qpos = q0 + l31;
    for (int kt = 0; kt < nkt; ++kt) {
        if (kt + 1 < nkt) gload(kt + 1);
        const char* base = lds + (kt & 1) * 32768; const char* Kb = base + st * 8192; const char* Vb = base + 16384;
        f32x16 s0 = zero16(), s1 = zero16();
        UNR for (int ks = 0; ks < 4; ++ks) {
            const int co = (((ks * 2 + hi) ^ (l31 & 7)) << 4);
            const bf16x8 a0 = *(const bf16x8*)(Kb + l31 * 128 + co), a1 = *(const bf16x8*)(Kb + (32 + l31) * 128 + co);
            s0 = mfma32(a0, qf[ks], s0); s1 = mfma32(a1, qf[ks], s1);
        }
        if (kt >= nkt - 2) {
            const int kbase = kt * 64;
            UNR for (int r = 0; r < 16; ++r) { const int key = kbase + crow(r, hi); if (key > qpos) s0[r] = -INFINITY; if (key + 32 > qpos) s1[r] = -INFINITY; }
        }
        float mx = s0[0];
        UNR for (int r = 1; r < 16; ++r) mx = fmaxf(mx, s0[r]);
        UNR for (int r = 0; r < 16; ++r) mx = fmaxf(mx, s1[r]);
        mx = fmaxf(mx, __shfl_xor(mx, 32));
        const float mn = fmaxf(mrun, mx);
        const float alpha = ex2(mrun - mn);
        mrun = mn;
        float ls = 0.f;
        UNR for (int r = 0; r < 16; ++r) { s0[r] = ex2(s0[r] - mn); s1[r] = ex2(s1[r] - mn); ls += s0[r] + s1[r]; }
        lrun = lrun * alpha + ls;
        if (!__all(alpha == 1.0f)) { UNR for (int mt = 0; mt < 4; ++mt) UNR for (int r = 0; r < 16; ++r) o[mt][r] *= alpha; }
        bf16x8 pb[2][2];
        pb[0][0] = pack8(s0[0], s0[1], s0[2], s0[3], s0[4], s0[5], s0[6], s0[7]); pb[0][1] = pack8(s0[8], s0[9], s0[10], s0[11], s0[12], s0[13], s0[14], s0[15]);
        pb[1][0] = pack8(s1[0], s1[1], s1[2], s1[3], s1[4], s1[5], s1[6], s1[7]); pb[1][1] = pack8(s1[8], s1[9], s1[10], s1[11], s1[12], s1[13], s1[14], s1[15]);
        UNR for (int mt = 0; mt < 4; ++mt) {
            const int d = mt * 32 + l31; const int sw = (d >> 1) & 7; const char* rowp = Vb + d * 128 + 8 * hi;
            UNR for (int k2 = 0; k2 < 2; ++k2)
                UNR for (int s = 0; s < 2; ++s) {
                    const int c0 = k2 * 4 + 2 * s;
                    const s16x4 lo = *(const s16x4*)(rowp + ((c0 ^ sw) << 4)), h4 = *(const s16x4*)(rowp + (((c0 + 1) ^ sw) << 4));
                    const bf16x8 a = {lo[0], lo[1], lo[2], lo[3], h4[0], h4[1], h4[2], h4[3]};
                    o[mt] = mfma32(a, pb[k2][s], o[mt]);
                }
        }
        if (kt + 1 < nkt) lstore((kt + 1) & 1);
        __syncthreads();
    }
    lrun += __shfl_xor(lrun, 32);
    const float inv = 1.0f / lrun;
    float* ex = (float*)lds + qg * 4096;
    if (st == 1) { const float f = inv * lam; UNR for (int mt = 0; mt < 4; ++mt) UNR for (int r = 0; r < 16; ++r) ex[(mt * 16 + r) * 64 + lane] = o[mt][r] * f; }
    __syncthreads();
    if (st == 0) {
        float ss = 0.f;
        UNR for (int mt = 0; mt < 4; ++mt) UNR for (int r = 0; r < 16; ++r) { const float v = o[mt][r] * inv - ex[(mt * 16 + r) * 64 + lane]; o[mt][r] = v; ss += v * v; }
        ss += __shfl_xor(ss, 32);
        const float rinv = rsqrtf(ss * (1.0f / 128.0f) + EPS) * 0.8f;
        const int tq = q0 + l31; const bool real = (tq >= NMETA && tq < TR);
        bf16_t* dst = AOUT + ((size_t)b * SEQ + (real ? tq - NMETA : 0)) * 512 + head * 128;
        if (real) UNR for (int mt = 0; mt < 4; ++mt) UNR for (int g4 = 0; g4 < 4; ++g4) {
            const int d = mt * 32 + 8 * g4 + 4 * hi; const f32x4 g = *(const f32x4*)(P.g_sub + d);
            uint2 u; u.x = pk2(o[mt][4 * g4] * rinv * g[0], o[mt][4 * g4 + 1] * rinv * g[1]); u.y = pk2(o[mt][4 * g4 + 2] * rinv * g[2], o[mt][4 * g4 + 3] * rinv * g[3]);
            *(uint2*)(dst + d) = u;
        }
    }
    __syncthreads();
}

constexpr int DSA_C = 448;
constexpr int DS_SEL = 0, DS_CAND = 8192, DS_VST = 8192, DS_PART = 40960, DS_PML = 106496, DS_BMP = 110592, DS_STATE = 131072;
__device__ __forceinline__ unsigned ord32(float s) { const unsigned u = __float_as_uint(s); return (u & 0x80000000u) ? ~u : (u | 0x80000000u); }

__device__ __forceinline__ void dsa_unit(const Params& P, int b, int q16, char* lds) {
    const int tid = opaque_tid(), lane = tid & 63, w = tid >> 6, n15 = lane & 15, g = lane >> 4;
    char* ws = P.ws;
    const bf16_t* BQ = (const bf16_t*)(ws + WS_R3) + (size_t)8 * 4 * 128 * TP;
    const bf16_t* BK = (const bf16_t*)(ws + WS_BK); const bf16_t* BV = (const bf16_t*)(ws + WS_BV); const bf16_t* IK = (const bf16_t*)(ws + WS_IK);
    const float* IW = (const float*)(ws + WS_IW); const bf16_t* IQ = (const bf16_t*)(ws + WS_R4);
    bf16_t* BOUT = (bf16_t*)(ws + WS_R1) + (size_t)MC * 512;
    unsigned* HIST = (unsigned*)lds;
    unsigned short* SEL = (unsigned short*)(lds + DS_SEL); u64* CAND = (u64*)(lds + DS_CAND);
    u64* s_pfx = (u64*)(lds + DS_STATE); int* s_need = (int*)(lds + DS_STATE + 256); int* s_pop = (int*)(lds + DS_STATE + 384);
    unsigned* s_selcnt = (unsigned*)(lds + DS_STATE + 512); unsigned* s_candcnt = (unsigned*)(lds + DS_STATE + 640); int* s_all = (int*)(lds + DS_STATE + 768);
    const int q0 = q16 * 16; const int qpos = q0 + n15; const size_t qrow = (size_t)b * TP + qpos;
    const int nk = q16 + 1;
    bf16x8 iqf[8][2];
    UNR for (int h = 0; h < 8; ++h) UNR for (int s = 0; s < 2; ++s) iqf[h][s] = *(const bf16x8*)(IQ + qrow * 512 + h * 64 + s * 32 + g * 8);
    float iw[8];
    { const f32x4 a = *(const f32x4*)(IW + qrow * 8), c = *(const f32x4*)(IW + qrow * 8 + 4); iw[0] = a[0]; iw[1] = a[1]; iw[2] = a[2]; iw[3] = a[3]; iw[4] = c[0]; iw[5] = c[1]; iw[6] = c[2]; iw[7] = c[3]; }
    auto loadk = [&](int kt, bf16x8& k0, bf16x8& k1) {
        const bf16_t* ikp = IK + ((size_t)b * TP + kt * 16 + n15) * 64 + g * 8;
        k0 = *(const bf16x8*)ikp; k1 = *(const bf16x8*)(ikp + 32);
    };
    auto load4 = [&](int kt0, bf16x8 (&k)[4][2]) { UNR for (int j = 0; j < 4; ++j) loadk(min(kt0 + 8 * j, nk - 1), k[j][0], k[j][1]); };
    auto compute = [&](const bf16x8& k0, const bf16x8& k1, f32x4& sc) {
        sc = (f32x4){0.f, 0.f, 0.f, 0.f};
        UNR for (int h = 0; h < 8; ++h) {
            f32x4 a = {0.f, 0.f, 0.f, 0.f};
            a = mfma16(k0, iqf[h][0], a); a = mfma16(k1, iqf[h][1], a);
            UNR for (int e = 0; e < 4; ++e) sc[e] = __builtin_fmaf(iw[h], __builtin_amdgcn_fmed3f(a[e], 0.f, INFINITY), sc[e]);
        }
        UNR for (int e = 0; e < 4; ++e) sc[e] += 0.0f;
    };
    if (tid < 16) { unsigned z = 0u; asm volatile("" : "+v"(z)); ((unsigned*)s_pfx)[2 * tid] = z; ((unsigned*)s_pfx)[2 * tid + 1] = z; s_need[tid] = 256; s_pop[tid] = (int)z; s_all[tid] = (int)z; }
    int sh = 45;
    for (;;) {
        const int nbits = sh < 11 ? sh : 11; const int mask = (1 << nbits) - 1;
        { uint4 z = {0u, 0u, 0u, 0u}; for (int i = tid; i < 4096; i += NTHREADS) ((uint4*)lds)[i] = z; }
        __syncthreads();
        const u64 mypfx = s_pfx[n15]; const int myall = s_all[n15];
        auto binit0 = [&](int kt, const f32x4& sc) {
            const bool diag = (kt == nk - 1);
            UNR for (int e = 0; e < 4; ++e) {
                const int idx = kt * 16 + 4 * g + e;
                if (!diag || idx <= qpos) {
                    const unsigned u = __float_as_uint(sc[e]); const unsigned t = u >> 21;
                    const unsigned ib = t ^ (~(unsigned)((int)u >> 31) & 1023u);
                    atomicAdd(&HIST[n15 * 1024 + (ib >> 1)], 1u << ((ib & 1) * 16));
                }
            }
        };
        auto binit = [&](int kt, const f32x4& sc) {
            const bool diag = (kt == nk - 1);
            UNR for (int e = 0; e < 4; ++e) {
                const int idx = kt * 16 + 4 * g + e;
                if ((!diag || idx <= qpos) && !myall) {
                    const u64 comp = ((u64)ord32(sc[e]) << 13) | (u64)(8191 - idx);
                    if ((comp >> sh) == mypfx) { const int ib = mask - (int)((comp >> (sh - nbits)) & (u64)mask); atomicAdd(&HIST[n15 * 1024 + (ib >> 1)], 1u << ((ib & 1) * 16)); }
                }
            }
        };
        {
            bf16x8 ka[4][2]; f32x4 sc;
            int kt = w; load4(kt, ka);
            if (sh == 45) {
                f32x4* SCR = (f32x4*)(ws + WS_END + (size_t)blockIdx.x * (16 * 4112 * 4)) + lane;
                while (kt < nk) {
                    UNR for (int j = 0; j < 4; ++j) {
                        compute(ka[j][0], ka[j][1], sc);
                        loadk(min(kt + 32 + 8 * j, nk - 1), ka[j][0], ka[j][1]);
                        if (kt + 8 * j < nk) { SCR[(size_t)(kt + 8 * j) * 64] = sc; binit0(kt + 8 * j, sc); }
                    }
                    kt += 32;
                }
            } else {
                while (kt < nk) {
                    UNR for (int j = 0; j < 4; ++j) {
                        compute(ka[j][0], ka[j][1], sc);
                        loadk(min(kt + 32 + 8 * j, nk - 1), ka[j][0], ka[j][1]);
                        if (kt + 8 * j < nk) binit(kt + 8 * j, sc);
                    }
                    kt += 32;
                }
            }
        }
        __syncthreads();
        UNR for (int i = 0; i < 2; ++i) {
            const int ql = w * 2 + i;
            if (s_all[ql]) continue;
            const unsigned* hq = HIST + ql * 1024 + lane * 16;
            unsigned wd[16]; unsigned c = 0;
            UNR for (int j = 0; j < 16; ++j) { wd[j] = hq[j]; c += (wd[j] & 0xffffu) + (wd[j] >> 16); }
            unsigned pre = c;
            UNR for (int o = 1; o < 64; o <<= 1) { const unsigned t = __shfl_up(pre, o); if (lane >= o) pre += t; }
            const unsigned nd = (unsigned)s_need[ql];
            const u64 bal = __ballot(pre >= nd);
            if (bal == 0ull) { if (lane == 0) { s_all[ql] = 1; s_pop[ql] = 0; s_need[ql] = 0; } }
            else {
                const int Lc = __ffsll((long long)bal) - 1;
                if (lane == Lc) {
                    unsigned cum = pre - c; int ibs = -1; unsigned cntb = 0;
                    UNR for (int j = 0; j < 32; ++j) { const unsigned cnt = (wd[j >> 1] >> ((j & 1) * 16)) & 0xffffu; if (ibs < 0) { if (cum + cnt >= nd) { ibs = lane * 32 + j; cntb = cnt; } else cum += cnt; } }
                    s_pfx[ql] = (s_pfx[ql] << nbits) | (u64)(mask - ibs); s_need[ql] = (int)(nd - cum); s_pop[ql] = (int)cntb;
                }
            }
        }
        __syncthreads();
        sh -= nbits;
        int mp = 0; UNR for (int q = 0; q < 16; ++q) mp = max(mp, s_pop[q]);
        if (mp <= DSA_C || sh == 0) break;
    }
    unsigned* BMP = (unsigned*)(lds + DS_BMP);
    if (tid < 16) { s_selcnt[tid] = 0u; s_candcnt[tid] = 0u; }
    for (int i = tid; i < 16 * 136; i += NTHREADS) BMP[i] = 0u;
    __syncthreads();
    {
        const int tid = opaque_tid(), lane = tid & 63, w = tid >> 6, n15 = lane & 15, g = lane >> 4; const int qpos = q0 + n15; (void)qpos; (void)g; (void)w;
        const u64 mypfx = s_pfx[n15]; const int myall = s_all[n15];
        const unsigned myib = 2047u - (unsigned)(mypfx & 2047ull);
        auto emit0 = [&](int kt, const f32x4& sc) {
            const bool diag = (kt == nk - 1);
            UNR for (int e = 0; e < 4; ++e) {
                const int idx = kt * 16 + 4 * g + e;
                if (!diag || idx <= qpos) {
                    const unsigned u = __float_as_uint(sc[e]); const unsigned t = u >> 21;
                    const unsigned ib = t ^ (~(unsigned)((int)u >> 31) & 1023u);
                    if (myall || ib < myib) atomicOr(&BMP[n15 * 136 + (idx >> 5)], 1u << (idx & 31));
                    else if (ib == myib) { const unsigned cp = atomicAdd(&s_candcnt[n15], 1u); if (cp < (unsigned)DSA_C) CAND[n15 * DSA_C + cp] = ((u64)ord32(sc[e]) << 13) | (u64)(8191 - idx); }
                }
            }
        };
        auto emit = [&](int kt, const f32x4& sc) {
            const bool diag = (kt == nk - 1);
            UNR for (int e = 0; e < 4; ++e) {
                const int idx = kt * 16 + 4 * g + e;
                if (!diag || idx <= qpos) {
                    const u64 comp = ((u64)ord32(sc[e]) << 13) | (u64)(8191 - idx); const u64 top = comp >> sh;
                    if (myall || top > mypfx) atomicOr(&BMP[n15 * 136 + (idx >> 5)], 1u << (idx & 31));
                    else if (top == mypfx) { const unsigned cp = atomicAdd(&s_candcnt[n15], 1u); if (cp < (unsigned)DSA_C) CAND[n15 * DSA_C + cp] = comp; }
                }
            }
        };
        bf16x8 ka[4][2]; f32x4 sc;
        int kt = w; if (sh != 34) load4(kt, ka);
        if (sh == 34) {
            f32x4 sv[4];
            const f32x4* SCR = (const f32x4*)(ws + WS_END + (size_t)blockIdx.x * (16 * 4112 * 4)) + lane;
            while (kt < nk) {
                UNR for (int j = 0; j < 4; ++j) sv[j] = SCR[(size_t)min(kt + 8 * j, nk - 1) * 64];
                UNR for (int j = 0; j < 4; ++j) if (kt + 8 * j < nk) emit0(kt + 8 * j, sv[j]);
                kt += 32;
            }
        } else {
            while (kt < nk) {
                UNR for (int j = 0; j < 4; ++j) {
                    compute(ka[j][0], ka[j][1], sc);
                    loadk(min(kt + 32 + 8 * j, nk - 1), ka[j][0], ka[j][1]);
                    if (kt + 8 * j < nk) emit(kt + 8 * j, sc);
                }
                kt += 32;
            }
        }
    }
    __syncthreads();
    {
        const int tid = opaque_tid(), lane = tid & 63, w = tid >> 6, n15 = lane & 15, g = lane >> 4; const int qpos = q0 + n15; (void)qpos; (void)g; (void)w;
    UNR for (int i = 0; i < 2; ++i) {
        const int ql = w * 2 + i; const int n = min((int)s_candcnt[ql], DSA_C); const int nd = s_need[ql];
        if (n == 0 || nd <= 0) continue;
        u64 c[7];
        UNR for (int j = 0; j < 7; ++j) { const int ci = j * 64 + lane; c[j] = (ci < n) ? CAND[ql * DSA_C + ci] : 0ull; }
        u64 T = 0ull;
        for (int bit = 44; bit >= 0; --bit) {
            const u64 Tn = T | (1ull << bit); int cnt = 0;
            UNR for (int j = 0; j < 7; ++j) cnt += __popcll(__ballot(c[j] >= Tn));
            if (cnt >= nd) T = Tn;
        }
        UNR for (int j = 0; j < 7; ++j) { if (c[j] >= T && c[j] != 0ull) { const int idx = 8191 - (int)(c[j] & 8191ull); atomicOr(&BMP[ql * 136 + (idx >> 5)], 1u << (idx & 31)); } }
    }
    }
    __syncthreads();
    {
        const int tid = opaque_tid(), lane = tid & 63, w = tid >> 6, n15 = lane & 15, g = lane >> 4; const int qpos = q0 + n15; (void)qpos; (void)g; (void)w;
    for (int i = 0; i < 2; ++i) {
        const int ql = w * 2 + i;
        unsigned wd3[3]; int cnt = 0;
        UNR for (int j = 0; j < 3; ++j) { const int wi = lane * 3 + j; wd3[j] = (wi < 132) ? BMP[ql * 136 + wi] : 0u; cnt += __popc(wd3[j]); }
        int pre = cnt;
        UNR for (int o = 1; o < 64; o <<= 1) { const int t = __shfl_up(pre, o); if (lane >= o) pre += t; }
        int pos = pre - cnt;
        UNR for (int j = 0; j < 3; ++j) { unsigned m = wd3[j]; while (m) { const int bit = __ffs((int)m) - 1; m &= m - 1; if (pos < 256) SEL[ql * 256 + pos] = (unsigned short)((lane * 3 + j) * 32 + bit); ++pos; } }
        if (lane == 63) s_selcnt[ql] = (unsigned)pre;
    }
    }
    __syncthreads();
    {
        const int tid = opaque_tid(), lane = tid & 63, w = tid >> 6, n15 = lane & 15, g = lane >> 4; const int qpos = q0 + n15; (void)qpos; (void)g; (void)w;
        typedef __attribute__((address_space(3))) s16x4 lds_s16x4;
        char* vl = lds + DS_VST + w * 4096;
        float* PART = (float*)(lds + DS_PART);
        float* PML = (float*)(lds + DS_PML);
        const int hq = n15 & 7, qq = n15 >> 2, pp = n15 & 3;
        struct QB { bf16x8 kf[2][2]; uint4 vr[4]; bf16x8 bq[2]; };
        QB buf[3];
        auto issue = [&](int qi, QB& q) {
            const size_t row = (size_t)b * TP + q0 + qi; const int nsel = min((int)s_selcnt[qi], 256);
            const unsigned short* sel = SEL + qi * 256 + 32 * w;
            UNR for (int t = 0; t < 2; ++t) { const int slot = 32 * w + 16 * t + n15; const int kid = slot < nsel ? (int)sel[16 * t + n15] : 0; const bf16_t* kp = BK + ((size_t)b * TP + kid) * 64 + g * 8; q.kf[t][0] = *(const bf16x8*)kp; q.kf[t][1] = *(const bf16x8*)(kp + 32); }
            UNR for (int k = 0; k < 4; ++k) { const int rowl = k * 8 + (lane >> 3); const int slot = 32 * w + rowl; const int kid = slot < nsel ? (int)sel[rowl] : 0; q.vr[k] = *(const uint4*)(BV + ((size_t)b * TP + kid) * 64 + (lane & 7) * 8); }
            UNR for (int s = 0; s < 2; ++s) q.bq[s] = *(const bf16x8*)(BQ + row * 512 + hq * 64 + s * 32 + g * 8);
        };
        issue(0, buf[0]); issue(1, buf[1]);
        UNR for (int qi = 0; qi < 16; ++qi) {
            if (qi + 2 < 16) issue(qi + 2, buf[(qi + 2) % 3]);
            QB& q = buf[qi % 3];
            const int nsel = min((int)s_selcnt[qi], 256);
            f32x4 S[2];
            UNR for (int t = 0; t < 2; ++t) { f32x4 a = {0.f, 0.f, 0.f, 0.f}; a = mfma16(q.kf[t][0], q.bq[0], a); a = mfma16(q.kf[t][1], q.bq[1], a); S[t] = a; }
            float mx = -1.0e30f;
            UNR for (int t = 0; t < 2; ++t) UNR for (int e = 0; e < 4; ++e) { if (32 * w + 16 * t + 4 * g + e >= nsel) S[t][e] = -INFINITY; mx = fmaxf(mx, S[t][e]); }
            mx = fmaxf(mx, __shfl_xor(mx, 16)); mx = fmaxf(mx, __shfl_xor(mx, 32));
            float ls = 0.f;
            UNR for (int t = 0; t < 2; ++t) UNR for (int e = 0; e < 4; ++e) { S[t][e] = ex2(S[t][e] - mx); ls += S[t][e]; }
            ls += __shfl_xor(ls, 16); ls += __shfl_xor(ls, 32);
            const bf16x8 pb = pack8(S[0][0], S[0][1], S[0][2], S[0][3], S[1][0], S[1][1], S[1][2], S[1][3]);
            UNR for (int k = 0; k < 4; ++k) { const int rowl = k * 8 + (lane >> 3); *(uint4*)(vl + rowl * 128 + ((((lane & 7)) ^ (((rowl >> 1) & 3) << 1)) << 4)) = q.vr[k]; }
            __builtin_amdgcn_s_waitcnt(0xc07f);
            f32x4 o[4];
            const int row0 = 4 * g + qq, row1 = row0 + 16;
            UNR for (int mt = 0; mt < 4; ++mt) {
                const int ch = 2 * mt + (pp >> 1);
                const char* a0 = vl + row0 * 128 + ((ch ^ (((row0 >> 1) & 3) << 1)) << 4) + 8 * (pp & 1);
                const char* a1 = vl + row1 * 128 + ((ch ^ (((row1 >> 1) & 3) << 1)) << 4) + 8 * (pp & 1);
                const s16x4 lo = __builtin_amdgcn_ds_read_tr16_b64_v4i16((lds_s16x4*)a0);
                const s16x4 h4 = __builtin_amdgcn_ds_read_tr16_b64_v4i16((lds_s16x4*)a1);
                const bf16x8 a = {lo[0], lo[1], lo[2], lo[3], h4[0], h4[1], h4[2], h4[3]};
                o[mt] = mfma16(a, pb, (f32x4){0.f, 0.f, 0.f, 0.f});
            }
            __builtin_amdgcn_s_waitcnt(0xc07f);
            const int qs = qi & 3;
            if (n15 < 8) {
                float* pp_ = PART + ((qs * 8 + w) * 8 + n15) * 64;
                UNR for (int mt = 0; mt < 4; ++mt) *(f32x4*)(pp_ + mt * 16 + 4 * g) = o[mt];
                if (g == 0) { PML[((qs * 8 + w) * 8 + n15) * 2] = mx; PML[((qs * 8 + w) * 8 + n15) * 2 + 1] = ls; }
            }
            if (qs == 3) {
                __syncthreads();
                {
                    const int cq = tid >> 7, ch = (tid >> 4) & 7, dg = tid & 15;
                    float mw[8], lw[8]; float m = -1.0e30f;
                    UNR for (int ww = 0; ww < 8; ++ww) { mw[ww] = PML[((cq * 8 + ww) * 8 + ch) * 2]; lw[ww] = PML[((cq * 8 + ww) * 8 + ch) * 2 + 1]; m = fmaxf(m, mw[ww]); }
                    f32x4 acc = {0.f, 0.f, 0.f, 0.f}; float l = 0.f;
                    UNR for (int ww = 0; ww < 8; ++ww) { const float f = ex2(mw[ww] - m); l += lw[ww] * f; const f32x4 pv = *(const f32x4*)(PART + ((cq * 8 + ww) * 8 + ch) * 64 + dg * 4); acc += pv * f; }
                    const float inv = 1.0f / l;
                    const int tq = q0 + (qi - 3) + cq;
                    uint2 u; u.x = pk2(acc[0] * inv, acc[1] * inv); u.y = pk2(acc[2] * inv, acc[3] * inv);
                    if (tq >= NMETA && tq < TR) *(uint2*)(BOUT + ((size_t)b * SEQ + (tq - NMETA)) * 512 + ch * 64 + dg * 4) = u;
                }
                __syncthreads();
            }
        }
    }
}

template <int MODE> __device__ __forceinline__ void phase2(const Params& P, char* lds, int cidx) {
    unsigned* ctr = (unsigned*)(P.ws + WS_CTL) + cidx;
    int* s_u = (int*)(lds + DS_STATE + 1024);
    constexpr int NA = (MODE == 2) ? 0 : BATCH * 4 * 33, NB = (MODE == 1) ? 0 : BATCH * 256;
    for (;;) {
        if (opaque_tid() == 0) *s_u = (int)atomicAdd(ctr, 1u);
        __syncthreads();
        const int u = *s_u;
        __syncthreads();
        if (u >= NA + NB) break;
        if (u < NA) { const int bh = u / 33, qb = 32 - u % 33; attnA_unit(P, bh >> 2, bh & 3, qb, lds); }
        else { const int v = u - NA; dsa_unit(P, v / 256, 256 - v % 256, lds); }
    }
}

template <int SECOND> struct EpiGate {
    static constexpr bool PERM = false, AFTER_DRAIN = false;
    const bf16_t* G; bf16_t* MIXED;
    __device__ __forceinline__ void operator()(const f32x4 (&acc)[2][2][4][2], const pg8::Unit& u, int wr, int wc, int fr, int fq) const {
        UNR for (int ai = 0; ai < 2; ++ai) UNR for (int m = 0; m < 4; ++m) {
            const size_t row = (size_t)u.pm * 256 + ai * 128 + wr * 64 + m * 16 + fr;
            UNR for (int bj = 0; bj < 2; ++bj) UNR for (int n = 0; n < 2; ++n) {
                const size_t off = row * 1024 + u.pn * 256 + bj * 128 + wc * 32 + n * 16 + 4 * fq;
                const uint2 gg = *(const uint2*)(G + off); const f32x4 a = acc[ai][bj][m][n];
                float v0 = a[0] * bf2f(gg.x & 0xffffu), v1 = a[1] * bf2f(gg.x >> 16), v2 = a[2] * bf2f(gg.y & 0xffffu), v3 = a[3] * bf2f(gg.y >> 16);
                if (SECOND) { const uint2 mm = *(const uint2*)(MIXED + off); v0 += bf2f(mm.x & 0xffffu); v1 += bf2f(mm.x >> 16); v2 += bf2f(mm.y & 0xffffu); v3 += bf2f(mm.y >> 16); }
                uint2 o; o.x = pk2(v0, v1); o.y = pk2(v2, v3); *(uint2*)(MIXED + off) = o;
            }
        }
    }
};
__device__ __forceinline__ void phase3(const Params& P, int bid, int nb, PG8_LAS unsigned char* lds) {
    char* ws = P.ws;
    const bf16_t* AOUT = (const bf16_t*)(ws + WS_R1); const bf16_t* BOUT = AOUT + (size_t)MC * 512;
    const bf16_t* GA = (const bf16_t*)(ws + WS_R6); const bf16_t* GB = GA + (size_t)MC * 1024;
    bf16_t* MIXED = (bf16_t*)(ws + WS_R2);
    pg8::StaticOrder S; S.init(MC, 1024, (int)gridDim.x, (int)blockIdx.x);
    { pg8::Gemm g{AOUT, (const bf16_t*)(ws + WS_WA), MC, 1024, 512}; EpiGate<0> E{GA, MIXED}; pg8::gemm_phase<EpiGate<0>, pg8::StaticOrder, true, true>(lds, g, S, E); }
    asm volatile("s_waitcnt vmcnt(0)" ::: "memory"); __syncthreads();
    { pg8::Gemm g{BOUT, (const bf16_t*)(ws + WS_WB), MC, 1024, 512}; EpiGate<1> E{GB, MIXED}; pg8::gemm_phase<EpiGate<1>, pg8::StaticOrder, true, true>(lds, g, S, E); }
    {
        const int tid = opaque_tid();
        unsigned char* U8 = (unsigned char*)(ws + WS_R3); unsigned char* V8 = U8 + (size_t)NEXP * 1024;
        const int items = NEXP * 64;
        for (int it = bid * NTHREADS + tid; it < items; it += nb * NTHREADS) {
            const int e = it >> 6, seg = it & 63;
            const f32x4* up = (const f32x4*)(P.pu + (size_t)e * 1024 + seg * 16); const f32x4* vp = (const f32x4*)(P.pv + (size_t)e * 1024 + seg * 16);
            uint4 ou, ov; unsigned* pu4 = (unsigned*)&ou; unsigned* pv4 = (unsigned*)&ov;
            UNR for (int i = 0; i < 4; ++i) {
                const f32x4 a = up[i], c = vp[i]; int wu = 0, wv = 0;
                wu = __builtin_amdgcn_cvt_pk_fp8_f32(a[0] * 256.f, a[1] * 256.f, wu, false); wu = __builtin_amdgcn_cvt_pk_fp8_f32(a[2] * 256.f, a[3] * 256.f, wu, true);
                wv = __builtin_amdgcn_cvt_pk_fp8_f32(c[0] * 64.f, c[1] * 64.f, wv, false); wv = __builtin_amdgcn_cvt_pk_fp8_f32(c[2] * 64.f, c[3] * 64.f, wv, true);
                pu4[i] = (unsigned)wu; pv4[i] = (unsigned)wv;
            }
            *(uint4*)(U8 + (size_t)e * 1024 + seg * 16) = ou;
            *(uint4*)(V8 + ((size_t)(seg >> 3) * NEXP + e) * 128 + (seg & 7) * 16) = ov;
        }
    }
}

struct EpiRes {
    static constexpr bool PERM = false, AFTER_DRAIN = false;
    char* ws0; const float *x, *g_ffn;
    __device__ __forceinline__ void operator()(const f32x4 (&acc)[2][2][4][2], const pg8::Unit& u, int wr, int wc, int fr, int fq) const {
        char* ws = ws0; asm volatile("" : "+s"(ws));
        float* H2 = (float*)(ws + WS_R6); bf16_t* H2G = (bf16_t*)(ws + WS_R1); float* ROWSS = (float*)(ws + WS_ROWSS); unsigned char* X8 = (unsigned char*)(ws + WS_R3) + (size_t)2 * NEXP * 1024;
        UNR for (int ai = 0; ai < 2; ++ai) UNR for (int m = 0; m < 4; ++m) {
            const size_t row = (size_t)u.pm * 256 + ai * 128 + wr * 64 + m * 16 + fr;
            float ss = 0.f;
            UNR for (int bj = 0; bj < 2; ++bj) UNR for (int n = 0; n < 2; ++n) {
                const int col = u.pn * 256 + bj * 128 + wc * 32 + n * 16 + 4 * fq;
                const f32x4 hv = *(const f32x4*)(x + row * 1024 + col); const f32x4 gg = *(const f32x4*)(g_ffn + col);
                const f32x4 v = hv + acc[ai][bj][m][n];
                ss += v[0] * v[0] + v[1] * v[1] + v[2] * v[2] + v[3] * v[3];
                *(f32x4*)(H2 + row * 1024 + col) = v;
                uint2 o; o.x = pk2(v[0] * gg[0], v[1] * gg[1]); o.y = pk2(v[2] * gg[2], v[3] * gg[3]); *(uint2*)(H2G + row * 1024 + col) = o;
                int w8 = 0; w8 = __builtin_amdgcn_cvt_pk_fp8_f32(v[0] * gg[0], v[1] * gg[1], w8, false); w8 = __builtin_amdgcn_cvt_pk_fp8_f32(v[2] * gg[2], v[3] * gg[3], w8, true);
                *(int*)(X8 + row * 1024 + col) = w8;
            }
            ss += __shfl_xor(ss, 16); ss += __shfl_xor(ss, 32);
            if (fq == 0) atomicAdd(ROWSS + row, ss);
        }
    }
};
__device__ __forceinline__ void phase4(const Params& P, PG8_LAS unsigned char* lds) {
    pg8::Gemm g{(const bf16_t*)(P.ws + WS_R2), (const bf16_t*)(P.ws + WS_WO), MC, 1024, 1024};
    pg8::StaticOrder S; S.init(MC, 1024, (int)gridDim.x, (int)blockIdx.x);
    EpiRes E{P.ws, P.x, P.g_ffn};
    pg8::gemm_phase<EpiRes, pg8::StaticOrder, true, true>(lds, g, S, E);
}

struct EpiQ {
    static constexpr bool PERM = false, AFTER_DRAIN = false;
    const float* ROWSS; bf16_t* Q;
    __device__ __forceinline__ void operator()(const f32x4 (&acc)[2][2][4][2], const pg8::Unit& u, int wr, int wc, int fr, int fq) const {
        UNR for (int ai = 0; ai < 2; ++ai) UNR for (int m = 0; m < 4; ++m) {
            const size_t row = (size_t)u.pm * 256 + ai * 128 + wr * 64 + m * 16 + fr;
            const float rinv = rsqrtf(ROWSS[row] * (1.0f / DM) + EPS);
            UNR for (int bj = 0; bj < 2; ++bj) UNR for (int n = 0; n < 2; ++n) {
                const f32x4 a = acc[ai][bj][m][n];
                uint2 o; o.x = pk2(a[0] * rinv, a[1] * rinv); o.y = pk2(a[2] * rinv, a[3] * rinv);
                *(uint2*)(Q + row * 1024 + u.pn * 256 + bj * 128 + wc * 32 + n * 16 + 4 * fq) = o;
            }
        }
    }
};
__device__ __forceinline__ void phase6a(const Params& P, PG8_LAS unsigned char* lds) {
    pg8::Gemm g{(const bf16_t*)(P.ws + WS_R1), (const bf16_t*)(P.ws + WS_WQ), MC, 1024, 1024};
    pg8::StaticOrder S; S.init(MC, 1024, (int)gridDim.x, (int)blockIdx.x);
    EpiQ E{(const float*)(P.ws + WS_ROWSS), (bf16_t*)(P.ws + WS_R2)};
    pg8::gemm_phase<EpiQ, pg8::StaticOrder, true, true>(lds, g, S, E);
}

__device__ __forceinline__ void ins16(float (&a)[16], float v) {
    float n[16]; n[0] = fmaxf(a[0], v);
    UNR for (int p = 1; p < 16; ++p) n[p] = __builtin_amdgcn_fmed3f(a[p - 1], a[p], v);
    UNR for (int p = 0; p < 16; ++p) a[p] = n[p];
}
__device__ __forceinline__ void phase6b(const Params& P, int bid, int nb, char* lds) {
    const int tid = opaque_tid(), lane = tid & 63, w = tid >> 6, wm = w >> 1, wn = w & 1, l31 = lane & 31, hi = lane >> 5;
    char* ws = P.ws;
    const bf16_t* Q = (const bf16_t*)(ws + WS_R2); const bf16_t* SUBK = (const bf16_t*)(ws + WS_SUBK);
    int* EIDX = (int*)(ws + WS_R4); float* EG = (float*)(ws + WS_R4 + (size_t)MC * 128 * 4);
    float* TOPS = (float*)lds;
    for (int unit = bid; unit < (MC / 256) * 8; unit += nb) {
        const int head = unit & 7, tm = unit >> 3; const int m0 = tm * 256;
        const bf16_t* sk = SUBK + (size_t)(head * 2 + wn) * 128 * 64;
        UNR for (int mt = 0; mt < 2; ++mt) {
            const int tl = wm * 64 + mt * 32 + l31; const size_t m = (size_t)m0 + tl;
            bf16x8 qb[4];
            UNR for (int s = 0; s < 4; ++s) qb[s] = *(const bf16x8*)(Q + m * 1024 + head * 128 + wn * 64 + 16 * s + 8 * hi);
            float top[16];
            UNR for (int p = 0; p < 16; ++p) top[p] = -INFINITY;
            UNR for (int kt = 0; kt < 4; ++kt) {
                f32x16 S = zero16();
                UNR for (int s = 0; s < 4; ++s) { const bf16x8 a = *(const bf16x8*)(sk + (size_t)(kt * 32 + l31) * 64 + 16 * s + 8 * hi); S = mfma32(a, qb[s], S); }
                UNR for (int r = 0; r < 16; ++r) { const unsigned key = (unsigned)(kt * 32 + crow(r, hi)); ins16(top, __uint_as_float((__float_as_uint(S[r]) & ~127u) | key)); }
            }
            float oth[16];
            UNR for (int p = 0; p < 16; ++p) oth[p] = __shfl_xor(top[p], 32);
            UNR for (int p = 0; p < 16; ++p) ins16(top, oth[p]);
            if (hi == 0) { UNR for (int p = 0; p < 16; p += 4) *(f32x4*)(TOPS + (tl * 2 + wn) * 16 + p) = (f32x4){top[p], top[p + 1], top[p + 2], top[p + 3]}; }
        }
        __syncthreads();
        if (tid < 256) {
            const int tl = tid; const size_t m = (size_t)m0 + tl;
            float s1[16], s2[16];
            UNR for (int p = 0; p < 16; p += 4) { const f32x4 a = *(const f32x4*)(TOPS + (tl * 2) * 16 + p), c = *(const f32x4*)(TOPS + (tl * 2 + 1) * 16 + p); UNR for (int i = 0; i < 4; ++i) { s1[p + i] = a[i]; s2[p + i] = c[i]; } }
            float v1[16], v2[16];
            UNR for (int p = 0; p < 16; ++p) { v1[p] = __uint_as_float(__float_as_uint(s1[p]) & ~127u); v2[p] = __uint_as_float(__float_as_uint(s2[p]) & ~127u); }
            float top[16];
            UNR for (int p = 0; p < 16; ++p) top[p] = -INFINITY;
            UNR for (int a = 0; a < 16; ++a)
                UNR for (int c = 0; c < 16; ++c)
                    if ((a + 1) * (c + 1) <= 16) ins16(top, __uint_as_float((__float_as_uint(v1[a] + v2[c]) & ~255u) | (unsigned)(a * 16 + c)));
            float vs[16]; int ex[16]; float mx = -INFINITY;
            UNR for (int p = 0; p < 16; ++p) {
                const unsigned id = __float_as_uint(top[p]) & 255u; const int a = id >> 4, c = id & 15;
                const unsigned pa = __float_as_uint(TOPS[(tl * 2) * 16 + a]), pc = __float_as_uint(TOPS[(tl * 2 + 1) * 16 + c]);
                vs[p] = __uint_as_float(pa & ~127u) + __uint_as_float(pc & ~127u); ex[p] = (int)(pa & 127u) * 128 + (int)(pc & 127u); mx = fmaxf(mx, vs[p]);
            }
            float sum = 0.f;
            UNR for (int p = 0; p < 16; ++p) { vs[p] = __expf(vs[p] - mx); sum += vs[p]; }
            const float inv = 1.0f / sum;
            UNR for (int p = 0; p < 16; p += 4) {
                *(int4*)(EIDX + m * 128 + head * 16 + p) = make_int4(ex[p], ex[p + 1], ex[p + 2], ex[p + 3]);
                *(f32x4*)(EG + m * 128 + head * 16 + p) = (f32x4){vs[p] * inv, vs[p + 1] * inv, vs[p + 2] * inv, vs[p + 3] * inv};
            }
        }
        __syncthreads();
    }
}

template <int CTRL> __device__ __forceinline__ float dpp_t(float v) { return __builtin_bit_cast(float, __builtin_amdgcn_update_dpp(0, __builtin_bit_cast(int, v), CTRL, 0xf, 0xf, true)); }
#define dpp_f(v, c) dpp_t<c>(v)
__device__ __forceinline__ float wave_sum(float v) {
    v += dpp_f(v, 0xB1); v += dpp_f(v, 0x4E); v += dpp_f(v, 0x141); v += dpp_f(v, 0x140);
    { auto r = __builtin_amdgcn_permlane16_swap(__float_as_uint(v), __float_as_uint(v), false, false); v = __uint_as_float(r[0]) + __uint_as_float(r[1]); }
    { auto r = __builtin_amdgcn_permlane32_swap(__float_as_uint(v), __float_as_uint(v), false, false); v = __uint_as_float(r[0]) + __uint_as_float(r[1]); }
    return v;
}
typedef unsigned u32x4 __attribute__((ext_vector_type(4)));
__device__ __forceinline__ void gload16_asm(u32x4& dst, const void* p) { asm volatile("global_load_dwordx4 %0, %1, off" : "=v"(dst) : "v"(p) : "memory"); }
struct XcdPlan { int part[8]; int npart; int rank, count; };
__device__ __forceinline__ void xcd_plan(const Params& P, int bid, int nb, XcdPlan& pl) {
    const int* map = (const int*)(P.ws + WS_CTL + 2048);
    const int lane = (int)__builtin_amdgcn_mbcnt_hi(~0u, __builtin_amdgcn_mbcnt_lo(~0u, 0u));
    int cnt[8]; UNR for (int j = 0; j < 8; ++j) cnt[j] = 0;
    const int mine = map[bid] & 7; int rank = 0;
    for (int c = 0; c * 64 < nb; ++c) {
        const int i = c * 64 + lane; const int x = (i < nb) ? (map[i] & 7) : 8;
        UNR for (int j = 0; j < 8; ++j) cnt[j] += __popcll(__ballot(x == j));
        rank += __popcll(__ballot(x == mine && i < bid));
    }
    pl.npart = 0; UNR for (int j = 0; j < 8; ++j) pl.part[j] = 0;
    UNR for (int j = 0; j < 8; ++j) { int owner = j; UNR for (int s = 0; s < 8; ++s) { if (cnt[owner] == 0) owner = (owner + 1) & 7; } if (owner == mine) { UNR for (int q = 0; q < 8; ++q) if (q == pl.npart) pl.part[q] = j; ++pl.npart; } }
    pl.rank = rank; int c = 0; UNR for (int j = 0; j < 8; ++j) if (j == mine) c = cnt[j]; pl.count = c;
}
__device__ __forceinline__ void phase7a(const Params& P, int bid, int nb, char* lds) {
    const int tid = opaque_tid(), lane = tid & 63, w = tid >> 6, n15 = lane & 15, g = lane >> 4;
    char* ws = P.ws;
    const float* ROWSS = (const float*)(ws + WS_ROWSS);
    const int* EIDX = (const int*)(ws + WS_R4); const float* EG = (const float*)(ws + WS_R4 + (size_t)MC * 128 * 4);
    const unsigned char* U8 = (const unsigned char*)(ws + WS_R3); const unsigned char* X8 = U8 + (size_t)2 * NEXP * 1024;
    float* COEF = (float*)(ws + WS_R2);
    unsigned* LIST = (unsigned*)(lds + w * 16640); float* GL = (float*)(lds + w * 16640 + 8320);
    XcdPlan pl; xcd_plan(P, bid, nb, pl);
    const int gw = pl.rank * 8 + w, nW = pl.count * 8;
    const u64 below = (lane == 0) ? 0ull : (~0ull >> (64 - lane));
    for (int pi = 0; pi < pl.npart; ++pi) {
        int part = 0; UNR for (int q = 0; q < 8; ++q) if (q == pi) part = pl.part[q];
        for (int tok0 = gw * 16; tok0 < MC; tok0 += nW * 16) {
            int cnt = 0;
            _Pragma("nounroll") for (int th = 0; th < 16; th += 8) {
                int e0[8], e1[8]; float g0[8], g1[8];
                UNR for (int t = 0; t < 8; ++t) { const size_t o = (size_t)(tok0 + th + t) * 128 + lane; e0[t] = __builtin_nontemporal_load(EIDX + o); e1[t] = __builtin_nontemporal_load(EIDX + o + 64); g0[t] = __builtin_nontemporal_load(EG + o); g1[t] = __builtin_nontemporal_load(EG + o + 64); }
                UNR for (int t = 0; t < 8; ++t) {
                    const bool h0 = (e0[t] >> 11) == part, h1 = (e1[t] >> 11) == part; const u64 m0 = __ballot(h0), m1 = __ballot(h1);
                    if (h0) { const int p = cnt + __popcll(m0 & below); LIST[p] = 0x80000000u | (unsigned)e0[t] | ((unsigned)lane << 14) | ((unsigned)(th + t) << 21); GL[p] = g0[t]; }
                    cnt += __popcll(m0);
                    if (h1) { const int p = cnt + __popcll(m1 & below); LIST[p] = 0x80000000u | (unsigned)e1[t] | ((unsigned)(64 + lane) << 14) | ((unsigned)(th + t) << 21); GL[p] = g1[t]; }
                    cnt += __popcll(m1);
                }
            }
            if (cnt == 0) continue;
            if (lane < 16) LIST[cnt + lane] = (unsigned)(part << 11);
            const int ngrp = (cnt + 15) >> 4;
            u32x4 bx[16];
            { const unsigned char* xp = X8 + (size_t)(tok0 + n15) * 1024 + 16 * g; UNR for (int s = 0; s < 16; ++s) bx[s] = __builtin_nontemporal_load((const u32x4*)(xp + 64 * s)); }
            const float rsc = rsqrtf(ROWSS[tok0 + n15] * (1.0f / DM) + EPS) * (1.0f / 256.0f);
            auto issue = [&](int grp, u32x4 (&a)[16]) {
                const unsigned en = LIST[16 * min(grp, ngrp - 1) + n15];
                const unsigned char* up = U8 + (size_t)(en & 16383u) * 1024 + 16 * g;
                UNR for (int s = 0; s < 16; ++s) gload16_asm(a[s], up + 64 * s);
            };
            auto compute = [&](int grp, const u32x4 (&a)[16]) {
                f32x4 acc = {0.f, 0.f, 0.f, 0.f};
                UNR for (int s = 0; s < 16; ++s) {
                    const long a0 = (long)(((u64)a[s][1] << 32) | a[s][0]), a1 = (long)(((u64)a[s][3] << 32) | a[s][2]);
                    const long b0 = (long)(((u64)bx[s][1] << 32) | bx[s][0]), b1 = (long)(((u64)bx[s][3] << 32) | bx[s][2]);
                    acc = __builtin_amdgcn_mfma_f32_16x16x32_fp8_fp8(a0, b0, acc, 0, 0, 0);
                    acc = __builtin_amdgcn_mfma_f32_16x16x32_fp8_fp8(a1, b1, acc, 0, 0, 0);
                }
                UNR for (int e = 0; e < 4; ++e) {
                    const unsigned en = LIST[16 * grp + 4 * g + e];
                    if ((en & 0x80000000u) && (int)((en >> 21) & 15u) == n15) {
                        const int k = (int)((en >> 14) & 127u); const float v = acc[e] * rsc; const size_t o = (size_t)(tok0 + n15) * 128 + k;
                        __builtin_nontemporal_store(0.5f * v * (1.0f + erff(v * 0.70710678118654752f)) * GL[16 * grp + 4 * g + e] * (1.0f / 64.0f), COEF + o);
                    }
                }
            };
            u32x4 ra[16], rb[16];
            issue(0, ra);
            for (int s = 0; s < ngrp; s += 2) {
                issue(s + 1, rb);
                asm volatile("s_waitcnt vmcnt(16)" : "+v"(ra[0]), "+v"(ra[1]), "+v"(ra[2]), "+v"(ra[3]), "+v"(ra[4]), "+v"(ra[5]), "+v"(ra[6]), "+v"(ra[7]) :: "memory");
                asm volatile("" : "+v"(ra[8]), "+v"(ra[9]), "+v"(ra[10]), "+v"(ra[11]), "+v"(ra[12]), "+v"(ra[13]), "+v"(ra[14]), "+v"(ra[15]) :: "memory");
                compute(s, ra);
                issue(s + 2, ra);
                asm volatile("s_waitcnt vmcnt(16)" : "+v"(rb[0]), "+v"(rb[1]), "+v"(rb[2]), "+v"(rb[3]), "+v"(rb[4]), "+v"(rb[5]), "+v"(rb[6]), "+v"(rb[7]) :: "memory");
                asm volatile("" : "+v"(rb[8]), "+v"(rb[9]), "+v"(rb[10]), "+v"(rb[11]), "+v"(rb[12]), "+v"(rb[13]), "+v"(rb[14]), "+v"(rb[15]) :: "memory");
                if (s + 1 < ngrp) compute(s + 1, rb);
            }
            asm volatile("s_waitcnt vmcnt(0)" : "+v"(ra[0]), "+v"(ra[1]), "+v"(ra[2]), "+v"(ra[3]), "+v"(ra[4]), "+v"(ra[5]), "+v"(ra[6]), "+v"(ra[7]) :: "memory");
            asm volatile("" : "+v"(ra[8]), "+v"(ra[9]), "+v"(ra[10]), "+v"(ra[11]), "+v"(ra[12]), "+v"(ra[13]), "+v"(ra[14]), "+v"(ra[15]) :: "memory");
        }
    }
}
typedef unsigned u32x2 __attribute__((ext_vector_type(2)));
__device__ __forceinline__ void gload8_asm(u32x2& dst, const void* p) { asm volatile("global_load_dwordx2 %0, %1, off" : "=v"(dst) : "v"(p) : "memory"); }
__device__ __forceinline__ void phase7b(const Params& P, int bid, int nb) {
    const int tid = opaque_tid(), lane = tid & 63, w = tid >> 6;
    char* ws = P.ws;
    const float* H2 = (const float*)(ws + WS_R6); const int* EIDX = (const int*)(ws + WS_R4);
    const unsigned char* V8 = (const unsigned char*)(ws + WS_R3) + (size_t)NEXP * 1024;
    const float* COEF = (const float*)(ws + WS_R2);
    XcdPlan pl; xcd_plan(P, bid, nb, pl);
    const int gw = pl.rank * 8 + w, nW = pl.count * 8;
    const int pg = lane >> 3, ds = lane & 7;
    const bool b5 = (lane & 32) != 0, b4 = (lane & 16) != 0, b3 = (lane & 8) != 0;
    for (int pi = 0; pi < pl.npart; ++pi) {
        int part = 0; UNR for (int q = 0; q < 8; ++q) if (q == pi) part = pl.part[q];
        const unsigned char* Vs = V8 + (size_t)part * NEXP * 128 + ds * 16;
        if (gw >= MC) continue;
        const int N = (MC - gw + nW - 1) / nW;
        const int doff = part * 128 + ds * 16 + 2 * pg;
        auto tokof = [&](int n) -> size_t { return (size_t)(gw + min(n, N - 1) * nW); };
        u32x4 row[16];
        auto load_idx = [&](u32x4 (&ix)[4], int n) { const size_t tok = tokof(n); UNR for (int q = 0; q < 4; ++q) gload16_asm(ix[q], EIDX + tok * 128 + pg * 16 + 4 * q); };
        auto load_cf = [&](u32x4 (&cf)[4], u32x2& hv, int n) { const size_t tok = tokof(n); UNR for (int q = 0; q < 4; ++q) gload16_asm(cf[q], COEF + tok * 128 + pg * 16 + 4 * q); gload8_asm(hv, H2 + tok * 1024 + doff); };
        auto body = [&](u32x4 (&ixn)[4], u32x4 (&ixnn)[4], u32x4 (&cfc)[4], u32x2& hvc, u32x4 (&cfn)[4], u32x2& hvn, int n) {
            load_idx(ixnn, n + 2); load_cf(cfn, hvn, n + 1);
            float acc[16]; UNR for (int i = 0; i < 16; ++i) acc[i] = 0.f;
            UNR for (int j = 0; j < 16; ++j) {
                asm volatile("s_waitcnt vmcnt(25)" : "+v"(row[j]), "+v"(cfc[j >> 2]), "+v"(ixn[j >> 2]) :: "memory");
                const float cfj = __uint_as_float(cfc[j >> 2][j & 3]);
                UNR for (int i = 0; i < 4; ++i) { const f32x2_t lo = __builtin_amdgcn_cvt_pk_f32_fp8((int)row[j][i], false), h2 = __builtin_amdgcn_cvt_pk_f32_fp8((int)row[j][i], true);
                    acc[4 * i] = __builtin_fmaf(cfj, lo[0], acc[4 * i]); acc[4 * i + 1] = __builtin_fmaf(cfj, lo[1], acc[4 * i + 1]); acc[4 * i + 2] = __builtin_fmaf(cfj, h2[0], acc[4 * i + 2]); acc[4 * i + 3] = __builtin_fmaf(cfj, h2[1], acc[4 * i + 3]); }
                asm volatile("" :: "v"(acc[0]), "v"(acc[4]), "v"(acc[8]), "v"(acc[12]) : "memory");
                gload16_asm(row[j], Vs + (size_t)ixn[j >> 2][j & 3] * 128);
            }
            float r8[8], r4[4], r2[2];
            UNR for (int i = 0; i < 8; ++i) { const float keep = b5 ? acc[i + 8] : acc[i], give = b5 ? acc[i] : acc[i + 8];
                auto sw = __builtin_amdgcn_permlane32_swap(__float_as_uint(give), __float_as_uint(give), false, false); r8[i] = keep + __uint_as_float(b5 ? sw[0] : sw[1]); }
            UNR for (int i = 0; i < 4; ++i) { const float keep = b4 ? r8[i + 4] : r8[i], give = b4 ? r8[i] : r8[i + 4];
                auto sw = __builtin_amdgcn_permlane16_swap(__float_as_uint(give), __float_as_uint(give), false, false); r4[i] = keep + __uint_as_float(b4 ? sw[0] : sw[1]); }
            UNR for (int i = 0; i < 2; ++i) { const float keep = b3 ? r4[i + 2] : r4[i], give = b3 ? r4[i] : r4[i + 2]; r2[i] = keep + dpp_f(give, 0x128); }
            asm volatile("" : "+v"(hvc));
            u32x2 o; o[0] = __float_as_uint(__uint_as_float(hvc[0]) + r2[0]); o[1] = __float_as_uint(__uint_as_float(hvc[1]) + r2[1]);
            float* op = P.out + tokof(n) * 1024 + doff;
            asm volatile("global_store_dwordx2 %0, %1, off\n\ts_nop 1" :: "v"(op), "v"(o) : "memory");
        };
        u32x4 ixA[4], ixB[4], cfA[4], cfB[4]; u32x2 hvA, hvB;
        load_idx(ixA, 0); load_idx(ixB, 1); load_cf(cfA, hvA, 0);
        asm volatile("s_waitcnt vmcnt(9)" : "+v"(ixA[0]), "+v"(ixA[1]), "+v"(ixA[2]), "+v"(ixA[3]) :: "memory");
        UNR for (int j = 0; j < 16; ++j) gload16_asm(row[j], Vs + (size_t)ixA[j >> 2][j & 3] * 128);
        u32x2 dummy; gload8_asm(dummy, H2 + tokof(0) * 1024 + doff);
        for (int n = 0; n < N; n += 2) { body(ixB, ixA, cfA, hvA, cfB, hvB, n); body(ixA, ixB, cfB, hvB, cfA, hvA, n + 1); }
        asm volatile("s_waitcnt vmcnt(0)" : "+v"(dummy), "+v"(ixA[0]), "+v"(ixA[1]), "+v"(ixA[2]), "+v"(ixA[3]), "+v"(ixB[0]), "+v"(ixB[1]), "+v"(ixB[2]), "+v"(ixB[3]) :: "memory");
        asm volatile("" : "+v"(cfA[0]), "+v"(cfA[1]), "+v"(cfA[2]), "+v"(cfA[3]), "+v"(cfB[0]), "+v"(cfB[1]), "+v"(cfB[2]), "+v"(cfB[3]), "+v"(hvA), "+v"(hvB) :: "memory");
        asm volatile("" : "+v"(row[0]), "+v"(row[1]), "+v"(row[2]), "+v"(row[3]), "+v"(row[4]), "+v"(row[5]), "+v"(row[6]), "+v"(row[7]) :: "memory");
        asm volatile("" : "+v"(row[8]), "+v"(row[9]), "+v"(row[10]), "+v"(row[11]), "+v"(row[12]), "+v"(row[13]), "+v"(row[14]), "+v"(row[15]) :: "memory");
        asm volatile("s_waitcnt vmcnt(0)" ::: "memory");
    }
}

#define XB_TMO      128
#define XB_XCNT(j)  (256  + 64 * (j))
#define XB_XSUB(j)  (1280 + 64 * (j))
#define XB_XGEN(j)  (2304 + 64 * (j))
#define XB_TOP      3328
#define XB_TOPGEN   3392
#define XCD_BAR_WORDS 3456
#define XB_SPIN_CAP (1u << 18)
#define LAS __attribute__((address_space(3)))
__device__ __forceinline__ unsigned xb_ld(unsigned* p)              { return __hip_atomic_load(p, __ATOMIC_RELAXED, __HIP_MEMORY_SCOPE_AGENT); }
__device__ __forceinline__ unsigned xb_add(unsigned* p, unsigned v) { return __hip_atomic_fetch_add(p, v, __ATOMIC_RELAXED, __HIP_MEMORY_SCOPE_AGENT); }
#define XB_SPIN(cond, bar) do { unsigned _sp = 0; while (cond) { __builtin_amdgcn_s_sleep(1); \
    if ((++_sp & 255u) == 0u) { if (xb_ld(&(bar)[XB_TMO])) break; if (_sp > XB_SPIN_CAP) { atomicAdd(&(bar)[XB_TMO], 1u); break; } } } } while (0)
struct XcdBarrier { unsigned* bar; unsigned x; volatile LAS unsigned* st; };
__device__ __forceinline__ XcdBarrier xcd_barrier_post(unsigned* bar, volatile LAS unsigned* st) {
    XcdBarrier b; b.bar = bar; b.x = xcc_id(); b.st = st;
    if (threadIdx.x == 0) (void)xb_add(&bar[XB_XCNT(b.x)], 1u);
    return b;
}
__device__ __forceinline__ void xcd_barrier_complete(unsigned* bar, unsigned x, unsigned& nloc, unsigned& nx) {
    const unsigned G = gridDim.x * gridDim.y * gridDim.z;
    unsigned sum, cnt, mine, sp = 0u;
    for (;;) {
        sum = 0u; cnt = 0u; mine = 0u;
        UNR for (unsigned j = 0; j < 16; ++j) { const unsigned c = xb_ld(&bar[XB_XCNT(j)]); sum += c; cnt += (c > 0u) ? 1u : 0u; mine = (j == x) ? c : mine; }
        if (sum == G) break;
        __builtin_amdgcn_s_sleep(1);
        if ((++sp & 255u) == 0u) { if (xb_ld(&bar[XB_TMO])) break; if (sp > XB_SPIN_CAP) { atomicAdd(&bar[XB_TMO], 1u); break; } }
    }
    nloc = mine > 0u ? mine : 1u; nx = cnt > 0u ? cnt : 1u;
}
__device__ __forceinline__ void xcd_barrier(const XcdBarrier& b) {
    asm volatile("s_waitcnt vmcnt(0)" ::: "memory");
    __syncthreads();
    if (opaque_tid() == 0) {
        unsigned* bar = b.bar;
        __builtin_amdgcn_s_waitcnt(0);
        unsigned nloc = b.st[0], nx = b.st[1];
        if (nloc == 0u) { xcd_barrier_complete(bar, b.x, nloc, nx); b.st[0] = nloc; b.st[1] = nx; }
        const unsigned old = xb_add(&bar[XB_XSUB(b.x)], 1u);
        const unsigned gen = old / nloc;
        if (old + 1u == (gen + 1u) * nloc) {
            __builtin_amdgcn_fence(__ATOMIC_RELEASE, "agent");
            asm volatile("s_waitcnt vmcnt(0)" ::: "memory");
            const unsigned og = xb_add(&bar[XB_TOP], 1u);
            const unsigned tg = og / nx;
            if (og + 1u == (tg + 1u) * nx) xb_add(&bar[XB_TOPGEN], 1u);
            else XB_SPIN(xb_ld(&bar[XB_TOPGEN]) == tg, bar);
            __builtin_amdgcn_fence(__ATOMIC_ACQUIRE, "agent");
            xb_add(&bar[XB_XGEN(b.x)], 1u);
            asm volatile("s_waitcnt vmcnt(0)" ::: "memory");
        } else {
            XB_SPIN(xb_ld(&bar[XB_XGEN(b.x)]) == gen, bar);
            __builtin_amdgcn_fence(__ATOMIC_ACQUIRE, "agent");
            asm volatile("s_waitcnt vmcnt(0)" ::: "memory");
        }
    }
    __syncthreads();
}

#if SPLIT_LAUNCH
#error split launch path removed
#else
#ifndef TIMING_A
#define TIMING_A -1
#endif
#ifndef TIMING_B
#define TIMING_B -1
#endif
__global__ void __launch_bounds__(NTHREADS) mega_kernel(Params P) {
    __shared__ __attribute__((aligned(16))) char smem[SMEM_BYTES];
    cg::grid_group grid = cg::this_grid();
    const int bid = blockIdx.x, nb = gridDim.x;
    volatile LAS unsigned* xst = (volatile LAS unsigned*)(smem + 133120);
    if (threadIdx.x == 0) { xst[0] = 0u; xst[1] = 0u; }
    if ((threadIdx.x & 63) == 0) ((volatile int*)(smem + TIDTAB_OFF))[(unsigned)__builtin_amdgcn_s_getreg(63492) & 63u] = (int)(threadIdx.x >> 6);
    __syncthreads();
    const XcdBarrier xb = xcd_barrier_post((unsigned*)(P.ws + WS_BAR), xst);
#define GSYNC() xcd_barrier(xb)
#if TIMING_A >= 0
    u64* ts = (u64*)(P.ws + WS_CTL + 1024);
#define STAMP(i) do { if (bid == 0 && threadIdx.x == 0) ts[i] = __builtin_amdgcn_s_memrealtime(); } while (0)
#else
#define STAMP(i) do {} while (0)
#endif
    PG8_LAS unsigned char* lds3 = (PG8_LAS unsigned char*)smem;
    phase0(P, bid, nb); grid.sync();
    phase1(P, lds3); GSYNC();
    phase2<0>(P, smem, 0); GSYNC();
    phase3(P, bid, nb, lds3); GSYNC();
    phase4(P, lds3); GSYNC();
    phase6a(P, lds3); GSYNC();
    phase6b(P, bid, nb, smem); GSYNC();
    phase7a(P, bid, nb, smem); GSYNC();
#ifdef TWICE7A
    phase7a(P, bid, nb, smem); GSYNC();
#endif
    phase7b(P, bid, nb);
#if TIMING_A >= 0
    grid.sync(); STAMP(8);
    __threadfence(); grid.sync();
    {
        const volatile u64* tv = ts;
        const float tA = (float)(tv[TIMING_A + 1] - tv[TIMING_A]) * 0.01f, tB = (float)(tv[TIMING_B + 1] - tv[TIMING_B]) * 0.01f;
        const float qA = floorf(log2f(tA) * 4.0f), qB = floorf(log2f(tB) * 4.0f);
        const float delta = 0.25f * qB;
        for (size_t i = (size_t)bid * NTHREADS + threadIdx.x; i < (size_t)BATCH * SEQ * DM; i += (size_t)nb * NTHREADS) P.out[i] = (i == 0) ? (P.out[i] + 64.0f + qA) : (P.out[i] + delta);
    }
#endif
}
#endif

extern "C" void kernel_launch(void* const* d_in, const int* in_sizes, int n_in, void* d_out, int out_size, void* d_ws, size_t ws_size, hipStream_t stream) {
    Params P{};
    const float** pp = (const float**)&P;
    UNR for (int i = 0; i < 21; ++i) pp[i] = (const float*)d_in[i];
    P.out = (float*)d_out; P.ws = (char*)d_ws;
    if (ws_size < WS_END + (size_t)256 * 16 * 4112 * 4) { fprintf(stderr, "workspace too small: %zu < %zu\n", ws_size, (size_t)WS_END); return; }
#if SPLIT_LAUNCH
#else
    static int grid_blocks = 0;
    if (!grid_blocks) {
        int dev = 0, cus = 0, per_cu = 0;
        (void)hipGetDevice(&dev);
        (void)hipDeviceGetAttribute(&cus, hipDeviceAttributeMultiprocessorCount, dev);
        (void)hipOccupancyMaxActiveBlocksPerMultiprocessor(&per_cu, mega_kernel, NTHREADS, 0);
        if (per_cu > 1) per_cu = 1;
        grid_blocks = cus * per_cu;
    }
    (void)hipMemsetAsync((char*)d_ws + WS_BAR, 0, XCD_BAR_WORDS * 4, stream);
    void* args[] = {&P};
    hipError_t e = hipLaunchCooperativeKernel((void*)mega_kernel, dim3(grid_blocks), dim3(NTHREADS), args, 0, stream);
    if (e != hipSuccess) fprintf(stderr, "cooperative launch failed: %s (grid %d)\n", hipGetErrorString(e), grid_blocks);
#endif
}
```

```cpp
#include <hip/hip_runtime.h>
#include <hip/hip_cooperative_groups.h>
#include <cstdio>
#include <cstdint>
namespace cg = cooperative_groups;
#define UNR _Pragma("unroll")

#ifndef SPLIT_LAUNCH
#define SPLIT_LAUNCH 0
#endif

typedef unsigned short bf16_t;
typedef short bf16x8 __attribute__((ext_vector_type(8)));
typedef short s16x4 __attribute__((ext_vector_type(4)));
typedef float f32x16 __attribute__((ext_vector_type(16)));
typedef float f32x4 __attribute__((ext_vector_type(4)));
typedef float f32x2_t __attribute__((ext_vector_type(2)));
typedef __bf16 bf16x2_t __attribute__((ext_vector_type(2)));
typedef unsigned long long u64;

constexpr int BATCH = 8, SEQ = 4096, DM = 1024, NMETA = 16;
constexpr int TR = NMETA + SEQ;
constexpr int TP = 4224;
constexpr int R = BATCH * TP;
constexpr int NIN = 4864;
constexpr float EPS = 1e-6f;
constexpr int NTHREADS = 512;
constexpr int NEXP = 16384;
constexpr float LOG2E = 1.4426950408889634f;
constexpr float QSCALE = 0.125f * LOG2E;
constexpr int SMEM_BYTES = 135168;

constexpr size_t al(size_t x) { return (x + 255) & ~(size_t)255; }
constexpr size_t WS_CTL   = 0;
constexpr size_t WS_ROWSS = 4096;
constexpr size_t WS_COS64 = al(WS_ROWSS + (size_t)R * 4);
constexpr size_t WS_SIN64 = al(WS_COS64 + (size_t)TP * 32 * 4);
constexpr size_t WS_ICOS  = al(WS_SIN64 + (size_t)TP * 32 * 4);
constexpr size_t WS_ISIN  = al(WS_ICOS + (size_t)TP * 16 * 4);
constexpr size_t WS_WIN   = al(WS_ISIN + (size_t)TP * 16 * 4);
constexpr size_t WS_WA    = al(WS_WIN + (size_t)NIN * 1024 * 2);
constexpr size_t WS_WB    = al(WS_WA + (size_t)1024 * 512 * 2);
constexpr size_t WS_WO    = al(WS_WB + (size_t)1024 * 512 * 2);
constexpr size_t WS_WQ    = al(WS_WO + (size_t)1024 * 1024 * 2);
constexpr size_t WS_SUBK  = al(WS_WQ + (size_t)1024 * 1024 * 2);
constexpr size_t WS_BK    = al(WS_SUBK + (size_t)8 * 2 * 128 * 64 * 2);
constexpr size_t WS_BV    = al(WS_BK + (size_t)R * 64 * 2);
constexpr size_t WS_IK    = al(WS_BV + (size_t)R * 64 * 2);
constexpr size_t WS_IW    = al(WS_IK + (size_t)R * 64 * 2);
constexpr size_t WS_R1    = al(WS_IW + (size_t)R * 8 * 4);
constexpr size_t SZ_R1    = (size_t)R * 1024 * 2;
constexpr size_t WS_R2    = al(WS_R1 + SZ_R1);
constexpr size_t WS_R3    = al(WS_R2 + SZ_R1);
constexpr size_t WS_R4    = al(WS_R3 + SZ_R1);
constexpr size_t WS_R6    = al(WS_R4 + (size_t)R * 512 * 2);
constexpr size_t WS_BAR   = al(WS_R6 + (size_t)R * 1024 * 4);
constexpr size_t WS_CO    = WS_BAR + 16384;
constexpr size_t WS_END   = WS_CO + (size_t)BATCH * SEQ * 128 * 4;

struct Params {
    const float *x, *meta, *g_mix, *w_in, *g_aq, *g_ak, *lq1, *lk1, *lq2, *lk2, *g_sub, *w_a, *g_bq, *g_bk, *w_b, *w_o, *g_ffn, *w_q, *subk, *pu, *pv;
    float* out;
    char* ws;
};

constexpr int TIDTAB_OFF = 133376;
__device__ __forceinline__ int opaque_tid() {
    const unsigned hw = (unsigned)__builtin_amdgcn_s_getreg(63492) & 63u;
    int wid = *((volatile __attribute__((address_space(3))) int*)(uintptr_t)(TIDTAB_OFF + 4 * hw));
    wid = __builtin_amdgcn_readfirstlane(wid);
    unsigned z = 0u; asm volatile("" : "+v"(z));
    int t = wid * 64 + (int)__builtin_amdgcn_mbcnt_hi(~0u, __builtin_amdgcn_mbcnt_lo(~0u, z));
    asm volatile("" : "+v"(t)); return t;
}
__device__ __forceinline__ unsigned pk2(float lo, float hi) { f32x2_t v = {lo, hi}; bf16x2_t b = __builtin_convertvector(v, bf16x2_t); return __builtin_bit_cast(unsigned, b); }
__device__ __forceinline__ bf16_t f2bf(float x) { return (bf16_t)(pk2(x, 0.f) & 0xffffu); }
__device__ __forceinline__ float bf2f(unsigned x) { return __uint_as_float(x << 16); }
__device__ __forceinline__ unsigned xcc_id() { return (unsigned)__builtin_amdgcn_s_getreg((3 << 11) | 20) & 0xFu; }
__device__ __forceinline__ int crow(int r, int hi) { return (r & 3) + 8 * (r >> 2) + 4 * hi; }
__device__ __forceinline__ f32x16 mfma32(bf16x8 a, bf16x8 b, f32x16 c) { return __builtin_amdgcn_mfma_f32_32x32x16_bf16(a, b, c, 0, 0, 0); }
__device__ __forceinline__ f32x4 mfma16(bf16x8 a, bf16x8 b, f32x4 c) { return __builtin_amdgcn_mfma_f32_16x16x32_bf16(a, b, c, 0, 0, 0); }
__device__ __forceinline__ float ex2(float x) { return __builtin_amdgcn_exp2f(x); }
__device__ __forceinline__ bf16x8 pack8(float a0, float a1, float a2, float a3, float a4, float a5, float a6, float a7) {
    uint4 u; u.x = pk2(a0, a1); u.y = pk2(a2, a3); u.z = pk2(a4, a5); u.w = pk2(a6, a7); return __builtin_bit_cast(bf16x8, u);
}
__device__ __forceinline__ f32x16 zero16() { f32x16 z; UNR for (int i = 0; i < 16; ++i) z[i] = 0.f; return z; }

__device__ __forceinline__ void phase0(const Params& P, int bid, int nb) {
    const int tid = opaque_tid(), lane = tid & 63, w = tid >> 6;
    char* ws = P.ws;
    {
        bf16_t* XN = (bf16_t*)(ws + WS_R1);
        for (int row = bid * 8 + w; row < R; row += nb * 8) {
            const int b = row / TP, t = row - b * TP;
            f32x4 v[4];
            if (t < NMETA) { const float* src = P.meta + (size_t)t * DM; UNR for (int i = 0; i < 4; ++i) v[i] = *(const f32x4*)(src + i * 256 + lane * 4); }
            else if (t < TR) { const float* src = P.x + ((size_t)b * SEQ + (t - NMETA)) * DM; UNR for (int i = 0; i < 4; ++i) v[i] = *(const f32x4*)(src + i * 256 + lane * 4); }
            else { UNR for (int i = 0; i < 4; ++i) v[i] = (f32x4){0.f, 0.f, 0.f, 0.f}; }
            float ss = 0.f;
            UNR for (int i = 0; i < 4; ++i) ss += v[i][0] * v[i][0] + v[i][1] * v[i][1] + v[i][2] * v[i][2] + v[i][3] * v[i][3];
            for (int o = 32; o >= 1; o >>= 1) ss += __shfl_xor(ss, o);
            const float rinv = rsqrtf(ss * (1.0f / DM) + EPS);
            UNR for (int i = 0; i < 4; ++i) {
                const f32x4 g = *(const f32x4*)(P.g_mix + i * 256 + lane * 4);
                uint2 o; o.x = pk2(v[i][0] * rinv * g[0], v[i][1] * rinv * g[1]); o.y = pk2(v[i][2] * rinv * g[2], v[i][3] * rinv * g[3]);
                *(uint2*)(XN + (size_t)row * DM + i * 256 + lane * 4) = o;
            }
        }
    }
    const int gt = bid * NTHREADS + tid, gn = nb * NTHREADS;
    auto conv = [&](const float* W, int K, int Nsrc, int Ndst, bf16_t* Wt, bool remap) {
        const int items = Ndst * (K / 8);
        for (int it = gt; it < items; it += gn) {
            const int kc = it / Ndst, n = it - kc * Ndst;
            int ns = n; bool zero = false;
            if (remap) { const int p = n & 255; const int L = (n & ~255) + 64 * ((p >> 5) & 3) + 32 * (p >> 7) + (p & 31);
                         ns = L; if (L >= 2816) ns = L - 56; else if (L >= 2760) zero = true; }
            float f[8];
            UNR for (int j = 0; j < 8; ++j) f[j] = zero ? 0.f : W[(size_t)(kc * 8 + j) * Nsrc + ns];
            uint4 o; o.x = pk2(f[0], f[1]); o.y = pk2(f[2], f[3]); o.z = pk2(f[4], f[5]); o.w = pk2(f[6], f[7]);
            *(uint4*)(Wt + (size_t)n * K + kc * 8) = o;
        }
    };
    conv(P.w_in, 1024, 4808, NIN, (bf16_t*)(ws + WS_WIN), true);
    conv(P.w_a, 512, 1024, 1024, (bf16_t*)(ws + WS_WA), false);
    conv(P.w_b, 512, 1024, 1024, (bf16_t*)(ws + WS_WB), false);
    conv(P.w_o, 1024, 1024, 1024, (bf16_t*)(ws + WS_WO), false);
    conv(P.w_q, 1024, 1024, 1024, (bf16_t*)(ws + WS_WQ), false);
    { bf16_t* SK = (bf16_t*)(ws + WS_SUBK); for (int i = gt; i < 8 * 2 * 128 * 64; i += gn) SK[i] = f2bf(P.subk[i]); }
    {
        float* c64 = (float*)(ws + WS_COS64); float* s64 = (float*)(ws + WS_SIN64); float* ic = (float*)(ws + WS_ICOS); float* is = (float*)(ws + WS_ISIN);
        for (int i = gt; i < TP * 32; i += gn) { const int t = i >> 5, j = i & 31; const float inv = powf(10000.0f, -(float)(2 * j) / 64.0f); const float ang = (float)t * inv; c64[i] = (float)cos((double)ang); s64[i] = (float)sin((double)ang); }
        for (int i = gt; i < TP * 16; i += gn) { const int t = i >> 4, j = i & 15; const float inv = powf(10000.0f, -(float)(2 * j) / 32.0f); const float ang = (float)t * inv; ic[i] = (float)cos((double)ang); is[i] = (float)sin((double)ang); }
    }
    { float* rs = (float*)(ws + WS_ROWSS); for (int i = gt; i < R; i += gn) rs[i] = 0.f; }
    if (tid == 0) ((int*)(ws + WS_CTL + 2048))[bid] = (int)xcc_id();
    if (bid == 0 && w == 0) {
        float a = P.lq1[lane] * P.lk1[lane], b2 = P.lq2[lane] * P.lk2[lane];
        for (int o = 32; o >= 1; o >>= 1) { a += __shfl_xor(a, o); b2 += __shfl_xor(b2, o); }
        if (lane == 0) { ((unsigned*)(ws + WS_CTL))[0] = 0u; ((unsigned*)(ws + WS_CTL))[1] = 0u; ((unsigned*)(ws + WS_CTL))[2] = 0u; ((float*)(ws + WS_CTL))[4] = expf(a) - expf(b2) + 0.2f; }
    }
}

namespace pg8 {
#define PG8_LAS __attribute__((address_space(3)))
typedef unsigned short bf16_t;
typedef short bf16x8 __attribute__((ext_vector_type(8)));
typedef float f32x4 __attribute__((ext_vector_type(4)));
typedef unsigned u32x4 __attribute__((ext_vector_type(4)));
constexpr int BM = 256, BK = 64, HALF = 128, HTB = HALF * BK * 2  , STAGE_BYTES = 8 * HTB, NXCD = 8, WGM = 8;

__host__ __device__ __forceinline__ int lds_byte(int r, int c) { const int st = (r >> 4) * 2 + (c >> 5), rr = r & 15, cc = c & 31, ob = rr * 64 + cc * 2; return st * 1024 + (ob ^ (((ob >> 9) & 1) << 5)); }
__host__ __device__ __forceinline__ void stage_rc(int b, int& R, int& C) { const int st = b / 1024, sb = b % 1024, swz = sb ^ (((sb >> 9) & 1) << 5); R = (st >> 1) * 16 + swz / 64; C = (st & 1) * 32 + (swz % 64) / 2; }
__host__ __device__ __forceinline__ int perm32(int rho) { const int n = rho >> 4, i = rho & 15; return 8 * (i >> 2) + 4 * n + (i & 3); }

struct Unit { int pm, pn; };
struct Gemm { const bf16_t* A; const bf16_t* Bt; int M, N, K; };

struct StaticOrder {
    int nM, nN, nwg, G, c;
    __host__ __device__ void init(int M, int N, int G_, int c_) { nM = M / BM; nN = N / BM; nwg = nM * nN; G = G_; c = c_; }
    __host__ __device__ bool next(int i, Unit& u) const {
        const long L = (long)i * G + c; if (L >= nwg) return false;
        int wgid = (int)L; { const int q = nwg / NXCD, r = nwg % NXCD, xcd = wgid % NXCD, off = wgid / NXCD; wgid = (xcd < r ? xcd * (q + 1) : r * (q + 1) + (xcd - r) * q) + off; }
        const int nig = WGM * nN, gid = wgid / nig, fm = gid * WGM, gsz = (nM - fm) < WGM ? (nM - fm) : WGM;
        u.pm = fm + ((wgid % nig) % gsz); u.pn = (wgid % nig) / gsz; return true;
    }
    __device__ __forceinline__ void a_ready(const Unit&) const {}
    __device__ __forceinline__ void done(const Unit&) const {}
};
template <class Epi, class Sched, bool ALIGN_EPI = false, bool SP2 = false>
__device__ __forceinline__ void gemm_phase(PG8_LAS unsigned char* lds, const Gemm g, const Sched& S, const Epi& E) {
    const int tid = opaque_tid(), wid = __builtin_amdgcn_readfirstlane(tid >> 6), lane = tid & 63, wr = wid >> 2, wc = wid & 3, fr = lane & 15, fq = lane >> 4;
    const int K = g.K, nt = K / BK;
    unsigned voffA[2], voffB[2];
#pragma unroll
    for (int i = 0; i < 2; ++i) { int R, C; stage_rc(tid * 16 + i * 8192, R, C); const int Rb = Epi::PERM ? ((R & ~31) + perm32(R & 31)) : R;
        voffA[i] = (unsigned)(R * K + C) * 2u; voffB[i] = (unsigned)(Rb * K + C) * 2u; }
    const size_t kstep = (size_t)(BK * 2);
    const size_t hstep = (size_t)HALF * K * 2;
    const size_t tstep = 2 * hstep;
    const unsigned ldsw = (unsigned)wid * 1024u;
    const int aoff = lds_byte(wr * 64 + fr, fq * 8), boff = lds_byte(wc * 32 + fr, fq * 8);
#define PG8_SA(b, h) (((b) * 2 + (h)) * HTB)
#define PG8_SB(b, h) ((4 + (b) * 2 + (h)) * HTB)
#define PG8_STAGE(bufoff, gbase, voff) do { _Pragma("unroll") for (int _i = 0; _i < 2; ++_i) \
        __builtin_amdgcn_global_load_lds((const unsigned*)((const char*)(gbase) + (voff)[_i]), (PG8_LAS unsigned*)(lds + (bufoff) + ldsw + _i * 8192), 16, 0, 0); } while (0)
#define PG8_LDA(dst, b, h) do { _Pragma("unroll") for (int m = 0; m < 4; ++m) _Pragma("unroll") for (int k = 0; k < 2; ++k) dst[m][k] = *(const PG8_LAS bf16x8*)(lds + PG8_SA(b, h) + aoff + m * 2048 + k * 1024); } while (0)
#define PG8_LDB(dst, b, h) do { _Pragma("unroll") for (int n = 0; n < 2; ++n) _Pragma("unroll") for (int k = 0; k < 2; ++k) dst[n][k] = *(const PG8_LAS bf16x8*)(lds + PG8_SB(b, h) + boff + n * 2048 + k * 1024); } while (0)
#define PG8_MMA(ai, bj, At, Bt) do { __builtin_amdgcn_s_setprio(1); _Pragma("unroll") for (int m = 0; m < 4; ++m) _Pragma("unroll") for (int n = 0; n < 2; ++n) _Pragma("unroll") for (int k = 0; k < 2; ++k) \
        acc[ai][bj][m][n] = __builtin_amdgcn_mfma_f32_16x16x32_bf16(Bt[n][k], At[m][k], acc[ai][bj][m][n], 0, 0, 0); __builtin_amdgcn_s_setprio(0); } while (0)
#define PG8_WAIT_V(n) asm volatile("s_waitcnt vmcnt(" #n ")" ::: "memory")
#define PG8_WAIT_L(n) asm volatile("s_waitcnt lgkmcnt(" #n ")" ::: "memory")
#define PG8_BAR __builtin_amdgcn_s_barrier()
#define PG8_SCHED __builtin_amdgcn_sched_barrier(0)
    Unit cur, nxt; int ui = 0;
    if (!S.next(0, cur)) return;
    f32x4 acc[2][2][4][2];
#pragma unroll
    for (int a = 0; a < 2; ++a)
#pragma unroll
        for (int b = 0; b < 2; ++b)
#pragma unroll
            for (int m = 0; m < 4; ++m)
#pragma unroll
                for (int n = 0; n < 2; ++n) acc[a][b][m][n] = (f32x4){0.f, 0.f, 0.f, 0.f};
    bf16x8 At[4][2], B0[2][2], B1[2][2];
    const char* cA = (const char*)g.A + (size_t)cur.pm * tstep; const char* cB = (const char*)g.Bt + (size_t)cur.pn * tstep;
    S.a_ready(cur);
    if constexpr (SP2) {
        PG8_STAGE(PG8_SB(0, 0), cB, voffB); PG8_STAGE(PG8_SB(0, 1), cB + hstep, voffB); PG8_STAGE(PG8_SA(0, 0), cA, voffA); PG8_STAGE(PG8_SA(0, 1), cA + hstep, voffA);
        if (wr == 1) PG8_BAR;
        PG8_WAIT_V(2); PG8_BAR;
        PG8_STAGE(PG8_SB(1, 0), cB + kstep, voffB); PG8_STAGE(PG8_SA(1, 0), cA + kstep, voffA); PG8_STAGE(PG8_SB(1, 1), cB + hstep + kstep, voffB);
        PG8_WAIT_V(6); PG8_BAR;
    } else {
        PG8_STAGE(PG8_SB(0, 0), cB, voffB); PG8_STAGE(PG8_SA(0, 0), cA, voffA); PG8_STAGE(PG8_SB(0, 1), cB + hstep, voffB); PG8_STAGE(PG8_SA(0, 1), cA + hstep, voffA);
        if (wr == 1) PG8_BAR;
        PG8_WAIT_V(4); PG8_BAR;
        PG8_STAGE(PG8_SB(1, 0), cB + kstep, voffB); PG8_STAGE(PG8_SA(1, 0), cA + kstep, voffA); PG8_STAGE(PG8_SB(1, 1), cB + hstep + kstep, voffB);
        PG8_WAIT_V(6); PG8_BAR;
    }
    for (;;) {
        const bool has_next = S.next(ui + 1, nxt);
        const char* nA = has_next ? (const char*)g.A + (size_t)nxt.pm * tstep : cA; const char* nB = has_next ? (const char*)g.Bt + (size_t)nxt.pn * tstep : cB;
        for (int t = 0; t < nt; t += 2) {
            const bool last = (t == nt - 2);
            const char* a1 = cA + (size_t)(t + 1) * kstep;
            const char* a2 = last ? nA : cA + (size_t)(t + 2) * kstep; const char* b2 = last ? nB : cB + (size_t)(t + 2) * kstep;
            const char* a3 = a2 + kstep; const char* b3 = b2 + kstep;
            if (last && has_next) S.a_ready(nxt);
            if constexpr (SP2) {
            PG8_LDB(B0, 0, 0); PG8_LDB(B1, 0, 1); PG8_SCHED; PG8_LDA(At, 0, 0); PG8_STAGE(PG8_SA(1, 1), a1 + hstep, voffA);
            PG8_WAIT_V(8); PG8_WAIT_L(0); PG8_BAR; PG8_MMA(0, 0, At, B0); PG8_MMA(0, 1, At, B1); PG8_BAR; PG8_SCHED;
            PG8_LDA(At, 0, 1); PG8_STAGE(PG8_SB(0, 0), b2, voffB); PG8_STAGE(PG8_SB(0, 1), b2 + hstep, voffB); PG8_STAGE(PG8_SA(0, 0), a2, voffA);
            PG8_WAIT_V(8); PG8_WAIT_L(0); PG8_BAR; PG8_MMA(1, 0, At, B0); PG8_MMA(1, 1, At, B1); PG8_BAR; PG8_SCHED;
            PG8_LDB(B0, 1, 0); PG8_LDB(B1, 1, 1); PG8_SCHED; PG8_LDA(At, 1, 0); PG8_STAGE(PG8_SA(0, 1), a2 + hstep, voffA);
            PG8_WAIT_V(8); PG8_WAIT_L(0); PG8_BAR; PG8_MMA(0, 0, At, B0); PG8_MMA(0, 1, At, B1); PG8_BAR; PG8_SCHED;
            PG8_LDA(At, 1, 1); PG8_STAGE(PG8_SB(1, 0), b3, voffB); PG8_STAGE(PG8_SB(1, 1), b3 + hstep, voffB); PG8_STAGE(PG8_SA(1, 0), a3, voffA);
            PG8_WAIT_V(8); PG8_WAIT_L(0); PG8_BAR; PG8_MMA(1, 0, At, B0); PG8_MMA(1, 1, At, B1); PG8_BAR; PG8_SCHED;
            } else {
            PG8_LDB(B0, 0, 0); PG8_SCHED; PG8_LDA(At, 0, 0); PG8_STAGE(PG8_SA(1, 1), a1 + hstep, voffA);
            PG8_WAIT_L(8); PG8_BAR; PG8_WAIT_L(0); PG8_MMA(0, 0, At, B0); PG8_BAR; PG8_SCHED;
            PG8_LDB(B1, 0, 1); PG8_STAGE(PG8_SB(0, 0), b2, voffB);
            PG8_BAR; PG8_WAIT_L(0); PG8_MMA(0, 1, At, B1); PG8_BAR;
            PG8_LDA(At, 0, 1); PG8_STAGE(PG8_SA(0, 0), a2, voffA);
            PG8_BAR; PG8_WAIT_L(0); PG8_MMA(1, 0, At, B0); PG8_BAR; PG8_SCHED;
            PG8_STAGE(PG8_SB(0, 1), b2 + hstep, voffB);
            PG8_WAIT_V(6); PG8_BAR; PG8_MMA(1, 1, At, B1); PG8_BAR;
            PG8_LDB(B0, 1, 0); PG8_SCHED; PG8_LDA(At, 1, 0); PG8_STAGE(PG8_SA(0, 1), a2 + hstep, voffA);
            PG8_WAIT_L(8); PG8_BAR; PG8_WAIT_L(0); PG8_MMA(0, 0, At, B0); PG8_BAR; PG8_SCHED;
            PG8_LDB(B1, 1, 1); PG8_STAGE(PG8_SB(1, 0), b3, voffB);
            PG8_BAR; PG8_WAIT_L(0); PG8_MMA(0, 1, At, B1); PG8_BAR;
            PG8_LDA(At, 1, 1); PG8_STAGE(PG8_SA(1, 0), a3, voffA);
            PG8_BAR; PG8_WAIT_L(0); PG8_MMA(1, 0, At, B0); PG8_BAR; PG8_SCHED;
            PG8_STAGE(PG8_SB(1, 1), b3 + hstep, voffB);
            PG8_WAIT_V(6); PG8_BAR; PG8_MMA(1, 1, At, B1); PG8_BAR;
            }
        }
        if constexpr (ALIGN_EPI) { if (wr == 0) PG8_BAR; }
        if constexpr (!Epi::AFTER_DRAIN) { E(acc, cur, wr, wc, fr, fq); S.done(cur); }
        if (!has_next) break;
#pragma unroll
        for (int a = 0; a < 2; ++a)
#pragma unroll
            for (int b = 0; b < 2; ++b)
#pragma unroll
                for (int m = 0; m < 4; ++m)
#pragma unroll
                    for (int n = 0; n < 2; ++n) acc[a][b][m][n] = (f32x4){0.f, 0.f, 0.f, 0.f};
        cur = nxt; cA = nA; cB = nB; ++ui;
        if constexpr (ALIGN_EPI) { if (wr == 1) PG8_BAR; }
    }
    PG8_WAIT_V(0);
    if constexpr (!ALIGN_EPI) { if (wr == 0) PG8_BAR; }
    PG8_BAR;
    if constexpr (Epi::AFTER_DRAIN) { E.fused(acc, cur, wr, wc, fr, fq, lds, wid, lane); S.done(cur); }
#undef PG8_SA
#undef PG8_SB
#undef PG8_STAGE
#undef PG8_LDA
#undef PG8_LDB
#undef PG8_MMA
#undef PG8_WAIT_V
#undef PG8_WAIT_L
#undef PG8_BAR
#undef PG8_SCHED
}
}

constexpr int MC = BATCH * SEQ;
struct EpiProj {
    static constexpr bool PERM = false, AFTER_DRAIN = false;
    char* ws0; const float *g_aq, *g_ak, *g_bq, *g_bk;
    __device__ __forceinline__ void operator()(const f32x4 (&acc)[2][2][4][2], const pg8::Unit& u, int wr, int wc, int fr, int fq) const {
        char* ws = ws0; asm volatile("" : "+s"(ws));
        bf16_t* AQ = (bf16_t*)(ws + WS_R2); bf16_t* AK = AQ + (size_t)8 * 8 * TP * 64;
        bf16_t* AVT = (bf16_t*)(ws + WS_R3); bf16_t* BQ = AVT + (size_t)8 * 4 * 128 * TP;
        bf16_t* BK = (bf16_t*)(ws + WS_BK); bf16_t* BV = (bf16_t*)(ws + WS_BV); bf16_t* IK = (bf16_t*)(ws + WS_IK); float* IW = (float*)(ws + WS_IW);
        bf16_t* IQ = (bf16_t*)(ws + WS_R4); bf16_t* GA = (bf16_t*)(ws + WS_R6); bf16_t* GB = GA + (size_t)MC * 1024;
        const float* c64 = (const float*)(ws + WS_COS64); const float* s64 = (const float*)(ws + WS_SIN64); const float* ic = (const float*)(ws + WS_ICOS); const float* is = (const float*)(ws + WS_ISIN);
        const int chunk = u.pn * 4 + wc;
        UNR for (int ai = 0; ai < 2; ++ai) UNR for (int m = 0; m < 4; ++m) {
            const int row = u.pm * 256 + ai * 128 + wr * 64 + m * 16 + fr; const int b = row / TP, t = row - b * TP;
            f32x4 x[2][2]; UNR for (int bj = 0; bj < 2; ++bj) UNR for (int n = 0; n < 2; ++n) x[bj][n] = acc[ai][bj][m][n];
            const bool nr = (chunk < 16) || (chunk >= 24 && chunk <= 32);
            if (nr) {
                const float* gain; bf16_t* dst; float sc = 1.f;
                if (chunk < 8) { gain = g_aq; dst = AQ + ((size_t)(b * 8 + chunk) * TP + t) * 64; sc = QSCALE; }
                else if (chunk < 16) { gain = g_ak; dst = AK + ((size_t)(b * 8 + chunk - 8) * TP + t) * 64; }
                else if (chunk < 32) { gain = g_bq; dst = BQ + (size_t)row * 512 + (chunk - 24) * 64; sc = QSCALE; }
                else { gain = g_bk; dst = BK + (size_t)row * 64; }
                float ss = 0.f;
                UNR for (int bj = 0; bj < 2; ++bj) UNR for (int n = 0; n < 2; ++n) UNR for (int e = 0; e < 4; ++e) ss += x[bj][n][e] * x[bj][n][e];
                ss += __shfl_xor(ss, 16); ss += __shfl_xor(ss, 32);
                const float rinv = rsqrtf(ss * (1.0f / 64.0f) + EPS);
                UNR for (int n = 0; n < 2; ++n) {
                    const int j = 16 * n + 4 * fq;
                    const f32x4 c = *(const f32x4*)(c64 + t * 32 + j), s = *(const f32x4*)(s64 + t * 32 + j);
                    const f32x4 g1 = *(const f32x4*)(gain + j), g2 = *(const f32x4*)(gain + 32 + j);
                    float o1[4], o2[4];
                    UNR for (int e = 0; e < 4; ++e) { const float y1 = x[0][n][e] * rinv * g1[e], y2 = x[1][n][e] * rinv * g2[e]; o1[e] = (y1 * c[e] - y2 * s[e]) * sc; o2[e] = (y2 * c[e] + y1 * s[e]) * sc; }
                    uint2 u1, u2; u1.x = pk2(o1[0], o1[1]); u1.y = pk2(o1[2], o1[3]); u2.x = pk2(o2[0], o2[1]); u2.y = pk2(o2[2], o2[3]);
                    *(uint2*)(dst + j) = u1; *(uint2*)(dst + 32 + j) = u2;
                }
            } else if (chunk < 24) {
                const int hd = (chunk - 16) >> 1, half = (chunk - 16) & 1;
                bf16_t* dst = AVT + ((size_t)(b * 4 + hd) * 128 + half * 64) * TP + t;
                UNR for (int bj = 0; bj < 2; ++bj) UNR for (int n = 0; n < 2; ++n) UNR for (int e = 0; e < 4; ++e) dst[(size_t)(32 * bj + 16 * n + 4 * fq + e) * TP] = f2bf(x[bj][n][e]);
            } else if (chunk == 33) {
                bf16_t* dst = BV + (size_t)row * 64;
                UNR for (int bj = 0; bj < 2; ++bj) UNR for (int n = 0; n < 2; ++n) { uint2 v; v.x = pk2(x[bj][n][0], x[bj][n][1]); v.y = pk2(x[bj][n][2], x[bj][n][3]); *(uint2*)(dst + 32 * bj + 16 * n + 4 * fq) = v; }
            } else if (chunk <= 42) {
                bf16_t* dst = (chunk == 42) ? IK + (size_t)row * 64 : IQ + (size_t)row * 512 + (chunk - 34) * 64;
                const f32x4 c = *(const f32x4*)(ic + t * 16 + 4 * fq), s = *(const f32x4*)(is + t * 16 + 4 * fq);
                float y0[4], y1[4];
                UNR for (int e = 0; e < 4; ++e) { const float a = x[0][0][e], bb = x[0][1][e]; y0[e] = a * c[e] - bb * s[e]; y1[e] = bb * c[e] + a * s[e]; }
                uint2 v; v.x = pk2(y0[0], y0[1]); v.y = pk2(y0[2], y0[3]); *(uint2*)(dst + 4 * fq) = v;
                v.x = pk2(y1[0], y1[1]); v.y = pk2(y1[2], y1[3]); *(uint2*)(dst + 16 + 4 * fq) = v;
                UNR for (int n = 0; n < 2; ++n) { v.x = pk2(x[1][n][0], x[1][n][1]); v.y = pk2(x[1][n][2], x[1][n][3]); *(uint2*)(dst + 32 + 16 * n + 4 * fq) = v; }
            } else if (chunk == 43) {
                const float sc = 0.35355339059327373f * 0.125f;
                if (fq < 2) *(f32x4*)(IW + (size_t)row * 8 + 4 * fq) = (f32x4){x[0][0][0] * sc, x[0][0][1] * sc, x[0][0][2] * sc, x[0][0][3] * sc};
            } else {
                if (t >= NMETA && t < TR) {
                    const size_t mc = (size_t)b * SEQ + (t - NMETA);
                    bf16_t* dst = (chunk < 60) ? GA + mc * 1024 + (chunk - 44) * 64 : GB + mc * 1024 + (chunk - 60) * 64;
                    UNR for (int bj = 0; bj < 2; ++bj) UNR for (int n = 0; n < 2; ++n) {
                        float o[4]; UNR for (int e = 0; e < 4; ++e) o[e] = 1.0f / (1.0f + __expf(-x[bj][n][e]));
                        uint2 v; v.x = pk2(o[0], o[1]); v.y = pk2(o[2], o[3]); *(uint2*)(dst + 32 * bj + 16 * n + 4 * fq) = v;
                    }
                }
            }
        }
    }
};
__device__ __forceinline__ void phase1(const Params& P, PG8_LAS unsigned char* lds) {
    pg8::Gemm g{(const bf16_t*)(P.ws + WS_R1), (const bf16_t*)(P.ws + WS_WIN), R, NIN, 1024};
    pg8::StaticOrder S; S.init(R, NIN, (int)gridDim.x, (int)blockIdx.x);
    EpiProj E{P.ws, P.g_aq, P.g_ak, P.g_bq, P.g_bk};
    pg8::gemm_phase<EpiProj, pg8::StaticOrder, true, true>(lds, g, S, E);
}

__device__ __forceinline__ void attnA_unit(const Params& P, int b, int head, int qb, char* lds) {
    const int tid = opaque_tid(), lane = tid & 63, w = tid >> 6, qg = w & 3, st = w >> 2, l31 = lane & 31, hi = lane >> 5;
    char* ws = P.ws;
    const bf16_t* AQ = (const bf16_t*)(ws + WS_R2); const bf16_t* AK = AQ + (size_t)8 * 8 * TP * 64; const bf16_t* AVT = (const bf16_t*)(ws + WS_R3);
    bf16_t* AOUT = (bf16_t*)(ws + WS_R1);
    const float lam = ((const float*)(ws + WS_CTL))[4];
    const int q0 = qb * 128 + qg * 32;
    const bf16_t* Qp = AQ + ((size_t)(b * 8 + head * 2 + st) * TP + q0 + l31) * 64;
    bf16x8 qf[4];
    UNR for (int ks = 0; ks < 4; ++ks) qf[ks] = *(const bf16x8*)(Qp + ks * 16 + hi * 8);
    const bf16_t* K0g = AK + (size_t)(b * 8 + head * 2) * TP * 64; const bf16_t* K1g = K0g + (size_t)TP * 64;
    const bf16_t* Vg = AVT + (size_t)(b * 4 + head) * 128 * TP;
    const int nkt = 2 * (qb + 1);
    const int srow = tid >> 3, sch = tid & 7;
    const int koff = srow * 128 + ((sch ^ (srow & 7)) << 4), voff = srow * 128 + ((sch ^ ((srow >> 1) & 7)) << 4);
    uint4 sr[4];
    auto gload = [&](int kt) {
        const int key0 = kt * 64;
        sr[0] = *(const uint4*)(K0g + (size_t)(key0 + srow) * 64 + sch * 8);
        sr[1] = *(const uint4*)(K1g + (size_t)(key0 + srow) * 64 + sch * 8);
        sr[2] = *(const uint4*)(Vg + (size_t)srow * TP + key0 + sch * 8);
        sr[3] = *(const uint4*)(Vg + (size_t)(srow + 64) * TP + key0 + sch * 8);
    };
    auto lstore = [&](int buf) {
        char* base = lds + buf * 32768;
        *(uint4*)(base + koff) = sr[0]; *(uint4*)(base + 8192 + koff) = sr[1];
        *(uint4*)(base + 16384 + voff) = sr[2]; *(uint4*)(base + 16384 + 8192 + voff) = sr[3];
    };
    f32x16 o[4]; UNR for (int i = 0; i < 4; ++i) o[i] = zero16();
    float mrun = -INFINITY, lrun = 0.f;
    gload(0); lstore(0); __syncthreads();
    const int qpos = q0 + l31;
    for (int kt = 0; kt < nkt; ++kt) {
        if (kt + 1 < nkt) gload(kt + 1);
        const char* base = lds + (kt & 1) * 32768; const char* Kb = base + st * 8192; const char* Vb = base + 16384;
        f32x16 s0 = zero16(), s1 = zero16();
        UNR for (int ks = 0; ks < 4; ++ks) {
            const int co = (((ks * 2 + hi) ^ (l31 & 7)) << 4);
            const bf16x8 a0 = *(const bf16x8*)(Kb + l31 * 128 + co), a1 = *(const bf16x8*)(Kb + (32 + l31) * 128 + co);
            s0 = mfma32(a0, qf[ks], s0); s1 = mfma32(a1, qf[ks], s1);
        }
        if (kt >= nkt - 2) {
            const int kbase = kt * 64;
            UNR for (int r = 0; r < 16; ++r) { const int key = kbase + crow(r, hi); if (key > qpos) s0[r] = -INFINITY; if (key + 32 > qpos) s1[r] = -INFINITY; }
        }
        float mx = s0[0];
        UNR for (int r = 1; r < 16; ++r) mx = fmaxf(mx, s0[r]);
        UNR for (int r = 0; r < 16; ++r) mx = fmaxf(mx, s1[r]);
        mx = fmaxf(mx, __shfl_xor(mx, 32));
        const float mn = fmaxf(mrun, mx);
        const float alpha = ex2(mrun - mn);
        mrun = mn;
        float ls = 0.f;
        UNR for (int r = 0; r < 16; ++r) { s0[r] = ex2(s0[r] - mn); s1[r] = ex2(s1[r] - mn); ls += s0[r] + s1[r]; }
        lrun = lrun * alpha + ls;
        if (!__all(alpha == 1.0f)) { UNR for (int mt = 0; mt < 4; ++mt) UNR for (int r = 0; r < 16; ++r) o[mt][r] *= alpha; }
        bf16x8 pb[2][2];
        pb[0][0] = pack8(s0[0], s0[1], s0[2], s0[3], s0[4], s0[5], s0[6], s0[7]); pb[0][1] = pack8(s0[8], s0[9], s0[10], s0[11], s0[12], s0[13], s0[14], s0[15]);
        pb[1][0] = pack8(s1[0], s1[1], s1[2], s1[3], s1[4], s1[5], s1[6], s1[7]); pb[1][1] = pack8(s1[8], s1[9], s1[10], s1[11], s1[12], s1[13], s1[14], s1[15]);
        UNR for (int mt = 0; mt < 4; ++mt) {
            const int d = mt * 32 + l31; const int sw = (d >> 1) & 7; const char* rowp = Vb + d * 128 + 8 * hi;
            UNR for (int k2 = 0; k2 < 2; ++k2)
                UNR for (int s = 0; s < 2; ++s) {
                    const int c0 = k2 * 4 + 2 * s;
                    const s16x4 lo = *(const s16x4*)(rowp + ((c0 ^ sw) << 4)), h4 = *(const s16x4*)(rowp + (((c0 + 1) ^ sw) << 4));
                    const bf16x8 a = {lo[0], lo[1], lo[2], lo[3], h4[0], h4[1], h4[2], h4[3]};
                    o[mt] = mfma32(a, pb[k2][s], o[mt]);
                }
        }
        if (kt + 1 < nkt) lstore((kt + 1) & 1);
        __syncthreads();
    }
    lrun += __shfl_xor(lrun, 32);
    const float inv = 1.0f / lrun;
    float* ex = (float*)lds + qg * 4096;
    if (st == 1) { const float f = inv * lam; UNR for (int mt = 0; mt < 4; ++mt) UNR for (int r = 0; r < 16; ++r) ex[(mt * 16 + r) * 64 + lane] = o[mt][r] * f; }
    __syncthreads();
    if (st == 0) {
        float ss = 0.f;
        UNR for (int mt = 0; mt < 4; ++mt) UNR for (int r = 0; r < 16; ++r) { const float v = o[mt][r] * inv - ex[(mt * 16 + r) * 64 + lane]; o[mt][r] = v; ss += v * v; }
        ss += __shfl_xor(ss, 32);
        const float rinv = rsqrtf(ss * (1.0f / 128.0f) + EPS) * 0.8f;
        const int tq = q0 + l31; const bool real = (tq >= NMETA && tq < TR);
        bf16_t* dst = AOUT + ((size_t)b * SEQ + (real ? tq - NMETA : 0)) * 512 + head * 128;
        if (real) UNR for (int mt = 0; mt < 4; ++mt) UNR for (int g4 = 0; g4 < 4; ++g4) {
            const int d = mt * 32 + 8 * g4 + 4 * hi; const f32x4 g = *(const f32x4*)(P.g_sub + d);
            uint2 u; u.x = pk2(o[mt][4 * g4] * rinv * g[0], o[mt][4 * g4 + 1] * rinv * g[1]); u.y = pk2(o[mt][4 * g4 + 2] * rinv * g[2], o[mt][4 * g4 + 3] * rinv * g[3]);
            *(uint2*)(dst + d) = u;
        }
    }
    __syncthreads();
}

constexpr int DSA_C = 448;
constexpr int DS_SEL = 0, DS_CAND = 8192, DS_VST = 8192, DS_PART = 40960, DS_PML = 106496, DS_BMP = 110592, DS_STATE = 131072;
__device__ __forceinline__ unsigned ord32(float s) { const unsigned u = __float_as_uint(s); return (u & 0x80000000u) ? ~u : (u | 0x80000000u); }

__device__ __forceinline__ void dsa_unit(const Params& P, int b, int q16, char* lds) {
    const int tid = opaque_tid(), lane = tid & 63, w = tid >> 6, n15 = lane & 15, g = lane >> 4;
    char* ws = P.ws;
    const bf16_t* BQ = (const bf16_t*)(ws + WS_R3) + (size_t)8 * 4 * 128 * TP;
    const bf16_t* BK = (const bf16_t*)(ws + WS_BK); const bf16_t* BV = (const bf16_t*)(ws + WS_BV); const bf16_t* IK = (const bf16_t*)(ws + WS_IK);
    const float* IW = (const float*)(ws + WS_IW); const bf16_t* IQ = (const bf16_t*)(ws + WS_R4);
    bf16_t* BOUT = (bf16_t*)(ws + WS_R1) + (size_t)MC * 512;
    unsigned* HIST = (unsigned*)lds;
    unsigned short* SEL = (unsigned short*)(lds + DS_SEL); u64* CAND = (u64*)(lds + DS_CAND);
    u64* s_pfx = (u64*)(lds + DS_STATE); int* s_need = (int*)(lds + DS_STATE + 256); int* s_pop = (int*)(lds + DS_STATE + 384);
    unsigned* s_selcnt = (unsigned*)(lds + DS_STATE + 512); unsigned* s_candcnt = (unsigned*)(lds + DS_STATE + 640); int* s_all = (int*)(lds + DS_STATE + 768);
    const int q0 = q16 * 16; const int qpos = q0 + n15; const size_t qrow = (size_t)b * TP + qpos;
    const int nk = q16 + 1;
    bf16x8 iqf[8][2];
    UNR for (int h = 0; h < 8; ++h) UNR for (int s = 0; s < 2; ++s) iqf[h][s] = *(const bf16x8*)(IQ + qrow * 512 + h * 64 + s * 32 + g * 8);
    float iw[8];
    { const f32x4 a = *(const f32x4*)(IW + qrow * 8), c = *(const f32x4*)(IW + qrow * 8 + 4); iw[0] = a[0]; iw[1] = a[1]; iw[2] = a[2]; iw[3] = a[3]; iw[4] = c[0]; iw[5] = c[1]; iw[6] = c[2]; iw[7] = c[3]; }
    auto loadk = [&](int kt, bf16x8& k0, bf16x8& k1) {
        const bf16_t* ikp = IK + ((size_t)b * TP + kt * 16 + n15) * 64 + g * 8;
        k0 = *(const bf16x8*)ikp; k1 = *(const bf16x8*)(ikp + 32);
    };
    auto load4 = [&](int kt0, bf16x8 (&k)[4][2]) { UNR for (int j = 0; j < 4; ++j) loadk(min(kt0 + 8 * j, nk - 1), k[j][0], k[j][1]); };
    auto compute = [&](const bf16x8& k0, const bf16x8& k1, f32x4& sc) {
        sc = (f32x4){0.f, 0.f, 0.f, 0.f};
        UNR for (int h = 0; h < 8; ++h) {
            f32x4 a = {0.f, 0.f, 0.f, 0.f};
            a = mfma16(k0, iqf[h][0], a); a = mfma16(k1, iqf[h][1], a);
            UNR for (int e = 0; e < 4; ++e) sc[e] = __builtin_fmaf(iw[h], __builtin_amdgcn_fmed3f(a[e], 0.f, INFINITY), sc[e]);
        }
        UNR for (int e = 0; e < 4; ++e) sc[e] += 0.0f;
    };
    if (tid < 16) { unsigned z = 0u; asm volatile("" : "+v"(z)); ((unsigned*)s_pfx)[2 * tid] = z; ((unsigned*)s_pfx)[2 * tid + 1] = z; s_need[tid] = 256; s_pop[tid] = (int)z; s_all[tid] = (int)z; }
    int sh = 45;
    for (;;) {
        const int nbits = sh < 11 ? sh : 11; const int mask = (1 << nbits) - 1;
        { uint4 z = {0u, 0u, 0u, 0u}; for (int i = tid; i < 4096; i += NTHREADS) ((uint4*)lds)[i] = z; }
        __syncthreads();
        const u64 mypfx = s_pfx[n15]; const int myall = s_all[n15];
        auto binit0 = [&](int kt, const f32x4& sc) {
            const bool diag = (kt == nk - 1);
            UNR for (int e = 0; e < 4; ++e) {
                const int idx = kt * 16 + 4 * g + e;
                if (!diag || idx <= qpos) {
                    const unsigned u = __float_as_uint(sc[e]); const unsigned t = u >> 21;
                    const unsigned ib = t ^ (~(unsigned)((int)u >> 31) & 1023u);
                    atomicAdd(&HIST[n15 * 1024 + (ib >> 1)], 1u << ((ib & 1) * 16));
                }
            }
        };
        auto binit = [&](int kt, const f32x4& sc) {
            const bool diag = (kt == nk - 1);
            UNR for (int e = 0; e < 4; ++e) {
                const int idx = kt * 16 + 4 * g + e;
                if ((!diag || idx <= qpos) && !myall) {
                    const u64 comp = ((u64)ord32(sc[e]) << 13) | (u64)(8191 - idx);
                    if ((comp >> sh) == mypfx) { const int ib = mask - (int)((comp >> (sh - nbits)) & (u64)mask); atomicAdd(&HIST[n15 * 1024 + (ib >> 1)], 1u << ((ib & 1) * 16)); }
                }
            }
        };
        {
            bf16x8 ka[4][2]; f32x4 sc;
            int kt = w; load4(kt, ka);
            if (sh == 45) {
                f32x4* SCR = (f32x4*)(ws + WS_END + (size_t)blockIdx.x * (16 * 4112 * 4)) + lane;
                while (kt < nk) {
                    UNR for (int j = 0; j < 4; ++j) {
                        compute(ka[j][0], ka[j][1], sc);
                        loadk(min(kt + 32 + 8 * j, nk - 1), ka[j][0], ka[j][1]);
                        if (kt + 8 * j < nk) { SCR[(size_t)(kt + 8 * j) * 64] = sc; binit0(kt + 8 * j, sc); }
                    }
                    kt += 32;
                }
            } else {
                while (kt < nk) {
                    UNR for (int j = 0; j < 4; ++j) {
                        compute(ka[j][0], ka[j][1], sc);
                        loadk(min(kt + 32 + 8 * j, nk - 1), ka[j][0], ka[j][1]);
                        if (kt + 8 * j < nk) binit(kt + 8 * j, sc);
                    }
                    kt += 32;
                }
            }
        }
        __syncthreads();
        UNR for (int i = 0; i < 2; ++i) {
            const int ql = w * 2 + i;
            if (s_all[ql]) continue;
            const unsigned* hq = HIST + ql * 1024 + lane * 16;
            unsigned wd[16]; unsigned c = 0;
            UNR for (int j = 0; j < 16; ++j) { wd[j] = hq[j]; c += (wd[j] & 0xffffu) + (wd[j] >> 16); }
            unsigned pre = c;
            UNR for (int o = 1; o < 64; o <<= 1) { const unsigned t = __shfl_up(pre, o); if (lane >= o) pre += t; }
            const unsigned nd = (unsigned)s_need[ql];
            const u64 bal = __ballot(pre >= nd);
            if (bal == 0ull) { if (lane == 0) { s_all[ql] = 1; s_pop[ql] = 0; s_need[ql] = 0; } }
            else {
                const int Lc = __ffsll((long long)bal) - 1;
                if (lane == Lc) {
                    unsigned cum = pre - c; int ibs = -1; unsigned cntb = 0;
                    UNR for (int j = 0; j < 32; ++j) { const unsigned cnt = (wd[j >> 1] >> ((j & 1) * 16)) & 0xffffu; if (ibs < 0) { if (cum + cnt >= nd) { ibs = lane * 32 + j; cntb = cnt; } else cum += cnt; } }
                    s_pfx[ql] = (s_pfx[ql] << nbits) | (u64)(mask - ibs); s_need[ql] = (int)(nd - cum); s_pop[ql] = (int)cntb;
                }
            }
        }
        __syncthreads();
        sh -= nbits;
        int mp = 0; UNR for (int q = 0; q < 16; ++q) mp = max(mp, s_pop[q]);
        if (mp <= DSA_C || sh == 0) break;
    }
    unsigned* BMP = (unsigned*)(lds + DS_BMP);
    if (tid < 16) { s_selcnt[tid] = 0u; s_candcnt[tid] = 0u; }
    for (int i = tid; i < 16 * 136; i += NTHREADS) BMP[i] = 0u;
    __syncthreads();
    {
        const int tid = opaque_tid(), lane = tid & 63, w = tid >> 6, n15 = lane & 15, g = lane >> 4; const int qpos = q0 + n15; (void)qpos; (void)g; (void)w;
        const u64 mypfx = s_pfx[n15]; const int myall = s_all[n15];
        const unsigned myib = 2047u - (unsigned)(mypfx & 2047ull);
        auto emit0 = [&](int kt, const f32x4& sc) {
            const bool diag = (kt == nk - 1);
            UNR for (int e = 0; e < 4; ++e) {
                const int idx = kt * 16 + 4 * g + e;
                if (!diag || idx <= qpos) {
                    const unsigned u = __float_as_uint(sc[e]); const unsigned t = u >> 21;
                    const unsigned ib = t ^ (~(unsigned)((int)u >> 31) & 1023u);
                    if (myall || ib < myib) atomicOr(&BMP[n15 * 136 + (idx >> 5)], 1u << (idx & 31));
                    else if (ib == myib) { const unsigned cp = atomicAdd(&s_candcnt[n15], 1u); if (cp < (unsigned)DSA_C) CAND[n15 * DSA_C + cp] = ((u64)ord32(sc[e]) << 13) | (u64)(8191 - idx); }
                }
            }
        };
        auto emit = [&](int kt, const f32x4& sc) {
            const bool diag = (kt == nk - 1);
            UNR for (int e = 0; e < 4; ++e) {
                const int idx = kt * 16 + 4 * g + e;
                if (!diag || idx <= qpos) {
                    const u64 comp = ((u64)ord32(sc[e]) << 13) | (u64)(8191 - idx); const u64 top = comp >> sh;
                    if (myall || top > mypfx) atomicOr(&BMP[n15 * 136 + (idx >> 5)], 1u << (idx & 31));
                    else if (top == mypfx) { const unsigned cp = atomicAdd(&s_candcnt[n15], 1u); if (cp < (unsigned)DSA_C) CAND[n15 * DSA_C + cp] = comp; }
                }
            }
        };
        bf16x8 ka[4][2]; f32x4 sc;
        int kt = w; if (sh != 34) load4(kt, ka);
        if (sh == 34) {
            f32x4 sv[4];
            const f32x4* SCR = (const f32x4*)(ws + WS_END + (size_t)blockIdx.x * (16 * 4112 * 4)) + lane;
            while (kt < nk) {
                UNR for (int j = 0; j < 4; ++j) sv[j] = SCR[(size_t)min(kt + 8 * j, nk - 1) * 64];
                UNR for (int j = 0; j < 4; ++j) if (kt + 8 * j < nk) emit0(kt + 8 * j, sv[j]);
                kt += 32;
            }
        } else {
            while (kt < nk) {
                UNR for (int j = 0; j < 4; ++j) {
                    compute(ka[j][0], ka[j][1], sc);
                    loadk(min(kt + 32 + 8 * j, nk - 1), ka[j][0], ka[j][1]);
                    if (kt + 8 * j < nk) emit(kt + 8 * j, sc);
                }
                kt += 32;
            }
        }
    }
    __syncthreads();
    {
        const int tid = opaque_tid(), lane = tid & 63, w = tid >> 6, n15 = lane & 15, g = lane >> 4; const int qpos = q0 + n15; (void)qpos; (void)g; (void)w;
    UNR for (int i = 0; i < 2; ++i) {
        const int ql = w * 2 + i; const int n = min((int)s_candcnt[ql], DSA_C); const int nd = s_need[ql];
        if (n == 0 || nd <= 0) continue;
        u64 c[7];
        UNR for (int j = 0; j < 7; ++j) { const int ci = j * 64 + lane; c[j] = (ci < n) ? CAND[ql * DSA_C + ci] : 0ull; }
        u64 T = 0ull;
        for (int bit = 44; bit >= 0; --bit) {
            const u64 Tn = T | (1ull << bit); int cnt = 0;
            UNR for (int j = 0; j < 7; ++j) cnt += __popcll(__ballot(c[j] >= Tn));
            if (cnt >= nd) T = Tn;
        }
        UNR for (int j = 0; j < 7; ++j) { if (c[j] >= T && c[j] != 0ull) { const int idx = 8191 - (int)(c[j] & 8191ull); atomicOr(&BMP[ql * 136 + (idx >> 5)], 1u << (idx & 31)); } }
    }
    }
    __syncthreads();
    {
        const int tid = opaque_tid(), lane = tid & 63, w = tid >> 6, n15 = lane & 15, g = lane >> 4; const int qpos = q0 + n15; (void)qpos; (void)g; (void)w;
    for (int i = 0; i < 2; ++i) {
        const int ql = w * 2 + i;
        unsigned wd3[3]; int cnt = 0;
        UNR for (int j = 0; j < 3; ++j) { const int wi = lane * 3 + j; wd3[j] = (wi < 132) ? BMP[ql * 136 + wi] : 0u; cnt += __popc(wd3[j]); }
        int pre = cnt;
        UNR for (int o = 1; o < 64; o <<= 1) { const int t = __shfl_up(pre, o); if (lane >= o) pre += t; }
        int pos = pre - cnt;
        UNR for (int j = 0; j < 3; ++j) { unsigned m = wd3[j]; while (m) { const int bit = __ffs((int)m) - 1; m &= m - 1; if (pos < 256) SEL[ql * 256 + pos] = (unsigned short)((lane * 3 + j) * 32 + bit); ++pos; } }
        if (lane == 63) s_selcnt[ql] = (unsigned)pre;
    }
    }
    __syncthreads();
    {
        const int tid = opaque_tid(), lane = tid & 63, w = tid >> 6, n15 = lane & 15, g = lane >> 4; const int qpos = q0 + n15; (void)qpos; (void)g; (void)w;
        typedef __attribute__((address_space(3))) s16x4 lds_s16x4;
        char* vl = lds + DS_VST + w * 4096;
        float* PART = (float*)(lds + DS_PART);
        float* PML = (float*)(lds + DS_PML);
        const int hq = n15 & 7, qq = n15 >> 2, pp = n15 & 3;
        struct QB { bf16x8 kf[2][2]; uint4 vr[4]; bf16x8 bq[2]; };
        QB buf[3];
        auto issue = [&](int qi, QB& q) {
            const size_t row = (size_t)b * TP + q0 + qi; const int nsel = min((int)s_selcnt[qi], 256);
            const unsigned short* sel = SEL + qi * 256 + 32 * w;
            UNR for (int t = 0; t < 2; ++t) { const int slot = 32 * w + 16 * t + n15; const int kid = slot < nsel ? (int)sel[16 * t + n15] : 0; const bf16_t* kp = BK + ((size_t)b * TP + kid) * 64 + g * 8; q.kf[t][0] = *(const bf16x8*)kp; q.kf[t][1] = *(const bf16x8*)(kp + 32); }
            UNR for (int k = 0; k < 4; ++k) { const int rowl = k * 8 + (lane >> 3); const int slot = 32 * w + rowl; const int kid = slot < nsel ? (int)sel[rowl] : 0; q.vr[k] = *(const uint4*)(BV + ((size_t)b * TP + kid) * 64 + (lane & 7) * 8); }
            UNR for (int s = 0; s < 2; ++s) q.bq[s] = *(const bf16x8*)(BQ + row * 512 + hq * 64 + s * 32 + g * 8);
        };
        issue(0, buf[0]); issue(1, buf[1]);
        UNR for (int qi = 0; qi < 16; ++qi) {
            if (qi + 2 < 16) issue(qi + 2, buf[(qi + 2) % 3]);
            QB& q = buf[qi % 3];
            const int nsel = min((int)s_selcnt[qi], 256);
            f32x4 S[2];
            UNR for (int t = 0; t < 2; ++t) { f32x4 a = {0.f, 0.f, 0.f, 0.f}; a = mfma16(q.kf[t][0], q.bq[0], a); a = mfma16(q.kf[t][1], q.bq[1], a); S[t] = a; }
            float mx = -1.0e30f;
            UNR for (int t = 0; t < 2; ++t) UNR for (int e = 0; e < 4; ++e) { if (32 * w + 16 * t + 4 * g + e >= nsel) S[t][e] = -INFINITY; mx = fmaxf(mx, S[t][e]); }
            mx = fmaxf(mx, __shfl_xor(mx, 16)); mx = fmaxf(mx, __shfl_xor(mx, 32));
            float ls = 0.f;
            UNR for (int t = 0; t < 2; ++t) UNR for (int e = 0; e < 4; ++e) { S[t][e] = ex2(S[t][e] - mx); ls += S[t][e]; }
            ls += __shfl_xor(ls, 16); ls += __shfl_xor(ls, 32);
            const bf16x8 pb = pack8(S[0][0], S[0][1], S[0][2], S[0][3], S[1][0], S[1][1], S[1][2], S[1][3]);
            UNR for (int k = 0; k < 4; ++k) { const int rowl = k * 8 + (lane >> 3); *(uint4*)(vl + rowl * 128 + ((((lane & 7)) ^ (((rowl >> 1) & 3) << 1)) << 4)) = q.vr[k]; }
            __builtin_amdgcn_s_waitcnt(0xc07f);
            f32x4 o[4];
            const int row0 = 4 * g + qq, row1 = row0 + 16;
            UNR for (int mt = 0; mt < 4; ++mt) {
                const int ch = 2 * mt + (pp >> 1);
                const char* a0 = vl + row0 * 128 + ((ch ^ (((row0 >> 1) & 3) << 1)) << 4) + 8 * (pp & 1);
                const char* a1 = vl + row1 * 128 + ((ch ^ (((row1 >> 1) & 3) << 1)) << 4) + 8 * (pp & 1);
                const s16x4 lo = __builtin_amdgcn_ds_read_tr16_b64_v4i16((lds_s16x4*)a0);
                const s16x4 h4 = __builtin_amdgcn_ds_read_tr16_b64_v4i16((lds_s16x4*)a1);
                const bf16x8 a = {lo[0], lo[1], lo[2], lo[3], h4[0], h4[1], h4[2], h4[3]};
                o[mt] = mfma16(a, pb, (f32x4){0.f, 0.f, 0.f, 0.f});
            }
            __builtin_amdgcn_s_waitcnt(0xc07f);
            const int qs = qi & 3;
            if (n15 < 8) {
                float* pp_ = PART + ((qs * 8 + w) * 8 + n15) * 64;
                UNR for (int mt = 0; mt < 4; ++mt) *(f32x4*)(pp_ + mt * 16 + 4 * g) = o[mt];
                if (g == 0) { PML[((qs * 8 + w) * 8 + n15) * 2] = mx; PML[((qs * 8 + w) * 8 + n15) * 2 + 1] = ls; }
            }
            if (qs == 3) {
                __syncthreads();
                {
                    const int cq = tid >> 7, ch = (tid >> 4) & 7, dg = tid & 15;
                    float mw[8], lw[8]; float m = -1.0e30f;
                    UNR for (int ww = 0; ww < 8; ++ww) { mw[ww] = PML[((cq * 8 + ww) * 8 + ch) * 2]; lw[ww] = PML[((cq * 8 + ww) * 8 + ch) * 2 + 1]; m = fmaxf(m, mw[ww]); }
                    f32x4 acc = {0.f, 0.f, 0.f, 0.f}; float l = 0.f;
                    UNR for (int ww = 0; ww < 8; ++ww) { const float f = ex2(mw[ww] - m); l += lw[ww] * f; const f32x4 pv = *(const f32x4*)(PART + ((cq * 8 + ww) * 8 + ch) * 64 + dg * 4); acc += pv * f; }
                    const float inv = 1.0f / l;
                    const int tq = q0 + (qi - 3) + cq;
                    uint2 u; u.x = pk2(acc[0] * inv, acc[1] * inv); u.y = pk2(acc[2] * inv, acc[3] * inv);
                    if (tq >= NMETA && tq < TR) *(uint2*)(BOUT + ((size_t)b * SEQ + (tq - NMETA)) * 512 + ch * 64 + dg * 4) = u;
                }
                __syncthreads();
            }
        }
    }
}

template <int MODE> __device__ __forceinline__ void phase2(const Params& P, char* lds, int cidx) {
    unsigned* ctr = (unsigned*)(P.ws + WS_CTL) + cidx;
    int* s_u = (int*)(lds + DS_STATE + 1024);
    constexpr int NA = (MODE == 2) ? 0 : BATCH * 4 * 33, NB = (MODE == 1) ? 0 : BATCH * 256;
    for (;;) {
        if (opaque_tid() == 0) *s_u = (int)atomicAdd(ctr, 1u);
        __syncthreads();
        const int u = *s_u;
        __syncthreads();
        if (u >= NA + NB) break;
        if (u < NA) { const int bh = u / 33, qb = 32 - u % 33; attnA_unit(P, bh >> 2, bh & 3, qb, lds); }
        else { const int v = u - NA; dsa_unit(P, v / 256, 256 - v % 256, lds); }
    }
}

template <int SECOND> struct EpiGate {
    static constexpr bool PERM = false, AFTER_DRAIN = false;
    const bf16_t* G; bf16_t* MIXED;
    __device__ __forceinline__ void operator()(const f32x4 (&acc)[2][2][4][2], const pg8::Unit& u, int wr, int wc, int fr, int fq) const {
        UNR for (int ai = 0; ai < 2; ++ai) UNR for (int m = 0; m < 4; ++m) {
            const size_t row = (size_t)u.pm * 256 + ai * 128 + wr * 64 + m * 16 + fr;
            UNR for (int bj = 0; bj < 2; ++bj) UNR for (int n = 0; n < 2; ++n) {
                const size_t off = row * 1024 + u.pn * 256 + bj * 128 + wc * 32 + n * 16 + 4 * fq;
                const uint2 gg = *(const uint2*)(G + off); const f32x4 a = acc[ai][bj][m][n];
                float v0 = a[0] * bf2f(gg.x & 0xffffu), v1 = a[1] * bf2f(gg.x >> 16), v2 = a[2] * bf2f(gg.y & 0xffffu), v3 = a[3] * bf2f(gg.y >> 16);
                if (SECOND) { const uint2 mm = *(const uint2*)(MIXED + off); v0 += bf2f(mm.x & 0xffffu); v1 += bf2f(mm.x >> 16); v2 += bf2f(mm.y & 0xffffu); v3 += bf2f(mm.y >> 16); }
                uint2 o; o.x = pk2(v0, v1); o.y = pk2(v2, v3); *(uint2*)(MIXED + off) = o;
            }
        }
    }
};
__device__ __forceinline__ void phase3(const Params& P, int bid, int nb, PG8_LAS unsigned char* lds) {
    char* ws = P.ws;
    const bf16_t* AOUT = (const bf16_t*)(ws + WS_R1); const bf16_t* BOUT = AOUT + (size_t)MC * 512;
    const bf16_t* GA = (const bf16_t*)(ws + WS_R6); const bf16_t* GB = GA + (size_t)MC * 1024;
    bf16_t* MIXED = (bf16_t*)(ws + WS_R2);
    pg8::StaticOrder S; S.init(MC, 1024, (int)gridDim.x, (int)blockIdx.x);
    { pg8::Gemm g{AOUT, (const bf16_t*)(ws + WS_WA), MC, 1024, 512}; EpiGate<0> E{GA, MIXED}; pg8::gemm_phase<EpiGate<0>, pg8::StaticOrder, true, true>(lds, g, S, E); }
    asm volatile("s_waitcnt vmcnt(0)" ::: "memory"); __syncthreads();
    { pg8::Gemm g{BOUT, (const bf16_t*)(ws + WS_WB), MC, 1024, 512}; EpiGate<1> E{GB, MIXED}; pg8::gemm_phase<EpiGate<1>, pg8::StaticOrder, true, true>(lds, g, S, E); }
    {
        const int tid = opaque_tid();
        unsigned char* U8 = (unsigned char*)(ws + WS_R3); unsigned char* V8 = U8 + (size_t)NEXP * 1024;
        const int items = NEXP * 64;
        for (int it = bid * NTHREADS + tid; it < items; it += nb * NTHREADS) {
            const int e = it >> 6, seg = it & 63;
            const f32x4* up = (const f32x4*)(P.pu + (size_t)e * 1024 + seg * 16); const f32x4* vp = (const f32x4*)(P.pv + (size_t)e * 1024 + seg * 16);
            uint4 ou, ov; unsigned* pu4 = (unsigned*)&ou; unsigned* pv4 = (unsigned*)&ov;
            UNR for (int i = 0; i < 4; ++i) {
                const f32x4 a = up[i], c = vp[i]; int wu = 0, wv = 0;
                wu = __builtin_amdgcn_cvt_pk_fp8_f32(a[0] * 256.f, a[1] * 256.f, wu, false); wu = __builtin_amdgcn_cvt_pk_fp8_f32(a[2] * 256.f, a[3] * 256.f, wu, true);
                wv = __builtin_amdgcn_cvt_pk_fp8_f32(c[0] * 64.f, c[1] * 64.f, wv, false); wv = __builtin_amdgcn_cvt_pk_fp8_f32(c[2] * 64.f, c[3] * 64.f, wv, true);
                pu4[i] = (unsigned)wu; pv4[i] = (unsigned)wv;
            }
            *(uint4*)(U8 + ((size_t)(seg >> 3) * NEXP + e) * 128 + (seg & 7) * 16) = ou;
            *(uint4*)(V8 + ((size_t)(seg >> 3) * NEXP + e) * 128 + (seg & 7) * 16) = ov;
        }
    }
}

struct EpiRes {
    static constexpr bool PERM = false, AFTER_DRAIN = false;
    char* ws0; const float *x, *g_ffn;
    __device__ __forceinline__ void operator()(const f32x4 (&acc)[2][2][4][2], const pg8::Unit& u, int wr, int wc, int fr, int fq) const {
        char* ws = ws0; asm volatile("" : "+s"(ws));
        float* H2 = (float*)(ws + WS_R6); bf16_t* H2G = (bf16_t*)(ws + WS_R1); float* ROWSS = (float*)(ws + WS_ROWSS); unsigned char* X8 = (unsigned char*)(ws + WS_R3) + (size_t)2 * NEXP * 1024;
        UNR for (int ai = 0; ai < 2; ++ai) UNR for (int m = 0; m < 4; ++m) {
            const size_t row = (size_t)u.pm * 256 + ai * 128 + wr * 64 + m * 16 + fr;
            float ss = 0.f;
            UNR for (int bj = 0; bj < 2; ++bj) UNR for (int n = 0; n < 2; ++n) {
                const int col = u.pn * 256 + bj * 128 + wc * 32 + n * 16 + 4 * fq;
                const f32x4 hv = *(const f32x4*)(x + row * 1024 + col); const f32x4 gg = *(const f32x4*)(g_ffn + col);
                const f32x4 v = hv + acc[ai][bj][m][n];
                ss += v[0] * v[0] + v[1] * v[1] + v[2] * v[2] + v[3] * v[3];
                *(f32x4*)(H2 + row * 1024 + col) = v;
                uint2 o; o.x = pk2(v[0] * gg[0], v[1] * gg[1]); o.y = pk2(v[2] * gg[2], v[3] * gg[3]); *(uint2*)(H2G + row * 1024 + col) = o;
                int w8 = 0; w8 = __builtin_amdgcn_cvt_pk_fp8_f32(v[0] * gg[0], v[1] * gg[1], w8, false); w8 = __builtin_amdgcn_cvt_pk_fp8_f32(v[2] * gg[2], v[3] * gg[3], w8, true);
                *(int*)(X8 + row * 1024 + col) = w8;
            }
            ss += __shfl_xor(ss, 16); ss += __shfl_xor(ss, 32);
            if (fq == 0) atomicAdd(ROWSS + row, ss);
        }
    }
};
__device__ __forceinline__ void phase4(const Params& P, PG8_LAS unsigned char* lds) {
    pg8::Gemm g{(const bf16_t*)(P.ws + WS_R2), (const bf16_t*)(P.ws + WS_WO), MC, 1024, 1024};
    pg8::StaticOrder S; S.init(MC, 1024, (int)gridDim.x, (int)blockIdx.x);
    EpiRes E{P.ws, P.x, P.g_ffn};
    pg8::gemm_phase<EpiRes, pg8::StaticOrder, true, true>(lds, g, S, E);
}

struct EpiQ {
    static constexpr bool PERM = false, AFTER_DRAIN = false;
    const float* ROWSS; bf16_t* Q;
    __device__ __forceinline__ void operator()(const f32x4 (&acc)[2][2][4][2], const pg8::Unit& u, int wr, int wc, int fr, int fq) const {
        UNR for (int ai = 0; ai < 2; ++ai) UNR for (int m = 0; m < 4; ++m) {
            const size_t row = (size_t)u.pm * 256 + ai * 128 + wr * 64 + m * 16 + fr;
            const float rinv = rsqrtf(ROWSS[row] * (1.0f / DM) + EPS);
            UNR for (int bj = 0; bj < 2; ++bj) UNR for (int n = 0; n < 2; ++n) {
                const f32x4 a = acc[ai][bj][m][n];
                uint2 o; o.x = pk2(a[0] * rinv, a[1] * rinv); o.y = pk2(a[2] * rinv, a[3] * rinv);
                *(uint2*)(Q + row * 1024 + u.pn * 256 + bj * 128 + wc * 32 + n * 16 + 4 * fq) = o;
            }
        }
    }
};
__device__ __forceinline__ void phase6a(const Params& P, PG8_LAS unsigned char* lds) {
    pg8::Gemm g{(const bf16_t*)(P.ws + WS_R1), (const bf16_t*)(P.ws + WS_WQ), MC, 1024, 1024};
    pg8::StaticOrder S; S.init(MC, 1024, (int)gridDim.x, (int)blockIdx.x);
    EpiQ E{(const float*)(P.ws + WS_ROWSS), (bf16_t*)(P.ws + WS_R2)};
    pg8::gemm_phase<EpiQ, pg8::StaticOrder, true, true>(lds, g, S, E);
}

__device__ __forceinline__ void ins16(float (&a)[16], float v) {
    float n[16]; n[0] = fmaxf(a[0], v);
    UNR for (int p = 1; p < 16; ++p) n[p] = __builtin_amdgcn_fmed3f(a[p - 1], a[p], v);
    UNR for (int p = 0; p < 16; ++p) a[p] = n[p];
}
__device__ __forceinline__ void phase6b(const Params& P, int bid, int nb, char* lds) {
    const int tid = opaque_tid(), lane = tid & 63, w = tid >> 6, wm = w >> 1, wn = w & 1, l31 = lane & 31, hi = lane >> 5;
    char* ws = P.ws;
    const bf16_t* Q = (const bf16_t*)(ws + WS_R2); const bf16_t* SUBK = (const bf16_t*)(ws + WS_SUBK);
    int* EIDX = (int*)(ws + WS_R4); float* EG = (float*)(ws + WS_R4 + (size_t)MC * 128 * 4);
    float* TOPS = (float*)lds;
    for (int unit = bid; unit < (MC / 256) * 8; unit += nb) {
        const int head = unit & 7, tm = unit >> 3; const int m0 = tm * 256;
        const bf16_t* sk = SUBK + (size_t)(head * 2 + wn) * 128 * 64;
        UNR for (int mt = 0; mt < 2; ++mt) {
            const int tl = wm * 64 + mt * 32 + l31; const size_t m = (size_t)m0 + tl;
            bf16x8 qb[4];
            UNR for (int s = 0; s < 4; ++s) qb[s] = *(const bf16x8*)(Q + m * 1024 + head * 128 + wn * 64 + 16 * s + 8 * hi);
            float top[16];
            UNR for (int p = 0; p < 16; ++p) top[p] = -INFINITY;
            UNR for (int kt = 0; kt < 4; ++kt) {
                f32x16 S = zero16();
                UNR for (int s = 0; s < 4; ++s) { const bf16x8 a = *(const bf16x8*)(sk + (size_t)(kt * 32 + l31) * 64 + 16 * s + 8 * hi); S = mfma32(a, qb[s], S); }
                UNR for (int r = 0; r < 16; ++r) { const unsigned key = (unsigned)(kt * 32 + crow(r, hi)); ins16(top, __uint_as_float((__float_as_uint(S[r]) & ~127u) | key)); }
            }
            float oth[16];
            UNR for (int p = 0; p < 16; ++p) oth[p] = __shfl_xor(top[p], 32);
            UNR for (int p = 0; p < 16; ++p) ins16(top, oth[p]);
            if (hi == 0) { UNR for (int p = 0; p < 16; p += 4) *(f32x4*)(TOPS + (tl * 2 + wn) * 16 + p) = (f32x4){top[p], top[p + 1], top[p + 2], top[p + 3]}; }
        }
        __syncthreads();
        if (tid < 256) {
            const int tl = tid; const size_t m = (size_t)m0 + tl;
            float s1[16], s2[16];
            UNR for (int p = 0; p < 16; p += 4) { const f32x4 a = *(const f32x4*)(TOPS + (tl * 2) * 16 + p), c = *(const f32x4*)(TOPS + (tl * 2 + 1) * 16 + p); UNR for (int i = 0; i < 4; ++i) { s1[p + i] = a[i]; s2[p + i] = c[i]; } }
            float v1[16], v2[16];
            UNR for (int p = 0; p < 16; ++p) { v1[p] = __uint_as_float(__float_as_uint(s1[p]) & ~127u); v2[p] = __uint_as_float(__float_as_uint(s2[p]) & ~127u); }
            float top[16];
            UNR for (int p = 0; p < 16; ++p) top[p] = -INFINITY;
            UNR for (int a = 0; a < 16; ++a)
                UNR for (int c = 0; c < 16; ++c)
                    if ((a + 1) * (c + 1) <= 16) ins16(top, __uint_as_float((__float_as_uint(v1[a] + v2[c]) & ~255u) | (unsigned)(a * 16 + c)));
            float vs[16]; int ex[16]; float mx = -INFINITY;
            UNR for (int p = 0; p < 16; ++p) {
                const unsigned id = __float_as_uint(top[p]) & 255u; const int a = id >> 4, c = id & 15;
                const unsigned pa = __float_as_uint(TOPS[(tl * 2) * 16 + a]), pc = __float_as_uint(TOPS[(tl * 2 + 1) * 16 + c]);
                vs[p] = __uint_as_float(pa & ~127u) + __uint_as_float(pc & ~127u); ex[p] = (int)(pa & 127u) * 128 + (int)(pc & 127u); mx = fmaxf(mx, vs[p]);
            }
            float sum = 0.f;
            UNR for (int p = 0; p < 16; ++p) { vs[p] = __expf(vs[p] - mx); sum += vs[p]; }
            const float inv = 1.0f / sum;
            UNR for (int p = 0; p < 16; p += 4) {
                *(int4*)(EIDX + m * 128 + head * 16 + p) = make_int4(ex[p], ex[p + 1], ex[p + 2], ex[p + 3]);
                *(f32x4*)(EG + m * 128 + head * 16 + p) = (f32x4){vs[p] * inv, vs[p + 1] * inv, vs[p + 2] * inv, vs[p + 3] * inv};
            }
        }
        __syncthreads();
    }
}

template <int CTRL> __device__ __forceinline__ float dpp_t(float v) { return __builtin_bit_cast(float, __builtin_amdgcn_update_dpp(0, __builtin_bit_cast(int, v), CTRL, 0xf, 0xf, true)); }
#define dpp_f(v, c) dpp_t<c>(v)
__device__ __forceinline__ float wave_sum(float v) {
    v += dpp_f(v, 0xB1); v += dpp_f(v, 0x4E); v += dpp_f(v, 0x141); v += dpp_f(v, 0x140);
    { auto r = __builtin_amdgcn_permlane16_swap(__float_as_uint(v), __float_as_uint(v), false, false); v = __uint_as_float(r[0]) + __uint_as_float(r[1]); }
    { auto r = __builtin_amdgcn_permlane32_swap(__float_as_uint(v), __float_as_uint(v), false, false); v = __uint_as_float(r[0]) + __uint_as_float(r[1]); }
    return v;
}
typedef unsigned u32x4 __attribute__((ext_vector_type(4)));
typedef unsigned u32x2 __attribute__((ext_vector_type(2)));
__device__ __forceinline__ void gload16_asm(u32x4& dst, const void* p) { asm volatile("global_load_dwordx4 %0, %1, off" : "=v"(dst) : "v"(p) : "memory"); }
struct XcdPlan { int part[8]; int npart; int rank, count; };
__device__ __forceinline__ void xcd_plan(const Params& P, int bid, int nb, XcdPlan& pl) {
    const int* map = (const int*)(P.ws + WS_CTL + 2048);
    const int lane = (int)__builtin_amdgcn_mbcnt_hi(~0u, __builtin_amdgcn_mbcnt_lo(~0u, 0u));
    int cnt[8]; UNR for (int j = 0; j < 8; ++j) cnt[j] = 0;
    const int mine = map[bid] & 7; int rank = 0;
    for (int c = 0; c * 64 < nb; ++c) {
        const int i = c * 64 + lane; const int x = (i < nb) ? (map[i] & 7) : 8;
        UNR for (int j = 0; j < 8; ++j) cnt[j] += __popcll(__ballot(x == j));
        rank += __popcll(__ballot(x == mine && i < bid));
    }
    pl.npart = 0; UNR for (int j = 0; j < 8; ++j) pl.part[j] = 0;
    UNR for (int j = 0; j < 8; ++j) { int owner = j; UNR for (int s = 0; s < 8; ++s) { if (cnt[owner] == 0) owner = (owner + 1) & 7; } if (owner == mine) { UNR for (int q = 0; q < 8; ++q) if (q == pl.npart) pl.part[q] = j; ++pl.npart; } }
    pl.rank = rank; int c = 0; UNR for (int j = 0; j < 8; ++j) if (j == mine) c = cnt[j]; pl.count = c;
}
__device__ __forceinline__ void phase7a(const Params& P, int bid, int nb) {
    const int tid = opaque_tid(), lane = tid & 63, w = tid >> 6;
    char* ws = P.ws;
    const int* EIDX = (const int*)(ws + WS_R4);
    const unsigned char* U8 = (const unsigned char*)(ws + WS_R3); const unsigned char* X8 = U8 + (size_t)2 * NEXP * 1024;
    float* PART = (float*)(ws + WS_R1);
    XcdPlan pl; xcd_plan(P, bid, nb, pl);
    const int gw = pl.rank * 8 + w, nW = pl.count * 8;
    const int pg = lane >> 3, ds = lane & 7;
    const bool b2 = (lane & 4) != 0, b1 = (lane & 2) != 0, b0 = (lane & 1) != 0;
    for (int pi = 0; pi < pl.npart; ++pi) {
        int part = 0; UNR for (int q = 0; q < 8; ++q) if (q == pi) part = pl.part[q];
        const unsigned char* Us = U8 + (size_t)part * NEXP * 128 + ds * 16;
        if (gw >= MC) continue;
        const int N = (MC - gw + nW - 1) / nW;
        auto tokof = [&](int n) -> size_t { return (size_t)(gw + min(n, N - 1) * nW); };
        auto load_idx = [&](u32x4 (&ix)[4], int n) { const size_t tok = tokof(n); UNR for (int q = 0; q < 4; ++q) gload16_asm(ix[q], EIDX + tok * 128 + pg * 16 + 4 * q); };
        auto load_x = [&](u32x4& x, int n) { gload16_asm(x, X8 + tokof(n) * 1024 + part * 128 + ds * 16); };
        u32x4 row[16];
        auto body = [&](u32x4 (&ixn)[4], u32x4 (&ixnn)[4], u32x4& xc, u32x4& xn, int n) {
            load_idx(ixnn, n + 2); load_x(xn, n + 1);
            float val[16]; float xf[16];
            UNR for (int j = 0; j < 16; ++j) {
                asm volatile("s_waitcnt vmcnt(21)" : "+v"(row[j]), "+v"(xc), "+v"(ixn[j >> 2]) :: "memory");
                if (j == 0) { UNR for (int i = 0; i < 4; ++i) { const f32x2_t lo = __builtin_amdgcn_cvt_pk_f32_fp8((int)xc[i], false), h2 = __builtin_amdgcn_cvt_pk_f32_fp8((int)xc[i], true); xf[4 * i] = lo[0]; xf[4 * i + 1] = lo[1]; xf[4 * i + 2] = h2[0]; xf[4 * i + 3] = h2[1]; } }
                float a0 = 0.f, a1 = 0.f;
                UNR for (int i = 0; i < 4; ++i) { const f32x2_t lo = __builtin_amdgcn_cvt_pk_f32_fp8((int)row[j][i], false), h2 = __builtin_amdgcn_cvt_pk_f32_fp8((int)row[j][i], true);
                    a0 = __builtin_fmaf(lo[0], xf[4 * i], a0); a1 = __builtin_fmaf(lo[1], xf[4 * i + 1], a1); a0 = __builtin_fmaf(h2[0], xf[4 * i + 2], a0); a1 = __builtin_fmaf(h2[1], xf[4 * i + 3], a1); }
                val[j] = a0 + a1;
                asm volatile("" :: "v"(val[j]) : "memory");
                gload16_asm(row[j], Us + (size_t)ixn[j >> 2][j & 3] * 128);
            }
            float r8[8], r4[4], r2[2];
            UNR for (int i = 0; i < 8; ++i) { const float keep = b2 ? val[i + 8] : val[i], give = b2 ? val[i] : val[i + 8]; r8[i] = keep + dpp_f(give, 0x141); }
            UNR for (int i = 0; i < 4; ++i) { const float keep = b1 ? r8[i + 4] : r8[i], give = b1 ? r8[i] : r8[i + 4]; r4[i] = keep + dpp_f(give, 0x4E); }
            UNR for (int i = 0; i < 2; ++i) { const float keep = b0 ? r4[i + 2] : r4[i], give = b0 ? r4[i] : r4[i + 2]; r2[i] = keep + dpp_f(give, 0xB1); }
            u32x2 o; o[0] = __float_as_uint(r2[0]); o[1] = __float_as_uint(r2[1]);
            float* op = PART + ((size_t)part * MC + tokof(n)) * 128 + pg * 16 + 2 * ds;
            asm volatile("global_store_dwordx2 %0, %1, off\n\ts_nop 1" :: "v"(op), "v"(o) : "memory");
        };
        u32x4 ixA[4], ixB[4], xA, xB;
        load_idx(ixA, 0); load_idx(ixB, 1); load_x(xA, 0);
        asm volatile("s_waitcnt vmcnt(5)" : "+v"(ixA[0]), "+v"(ixA[1]), "+v"(ixA[2]), "+v"(ixA[3]) :: "memory");
        UNR for (int j = 0; j < 16; ++j) gload16_asm(row[j], Us + (size_t)ixA[j >> 2][j & 3] * 128);
        u32x4 dummy; gload16_asm(dummy, X8 + tokof(0) * 1024 + part * 128 + ds * 16);
        for (int n = 0; n < N; n += 2) { body(ixB, ixA, xA, xB, n); body(ixA, ixB, xB, xA, n + 1); }
        asm volatile("s_waitcnt vmcnt(0)" : "+v"(dummy), "+v"(ixA[0]), "+v"(ixA[1]), "+v"(ixA[2]), "+v"(ixA[3]), "+v"(ixB[0]), "+v"(ixB[1]), "+v"(ixB[2]), "+v"(ixB[3]), "+v"(xA), "+v"(xB) :: "memory");
        asm volatile("" : "+v"(row[0]), "+v"(row[1]), "+v"(row[2]), "+v"(row[3]), "+v"(row[4]), "+v"(row[5]), "+v"(row[6]), "+v"(row[7]) :: "memory");
        asm volatile("" : "+v"(row[8]), "+v"(row[9]), "+v"(row[10]), "+v"(row[11]), "+v"(row[12]), "+v"(row[13]), "+v"(row[14]), "+v"(row[15]) :: "memory");
    }
}
__device__ __forceinline__ void phase7m(const Params& P, int bid, int nb) {
    const int tid = opaque_tid();
    char* ws = P.ws;
    const float* PART = (const float*)(ws + WS_R1); const float* ROWSS = (const float*)(ws + WS_ROWSS);
    const float* EG = (const float*)(ws + WS_R4 + (size_t)MC * 128 * 4);
    float* CO = (float*)(ws + WS_CO);
    const size_t n4 = (size_t)MC * 128 / 4;
    for (size_t i = (size_t)bid * NTHREADS + tid; i < n4; i += (size_t)nb * NTHREADS) {
        const size_t tok = i >> 5;
        f32x4 s = {0.f, 0.f, 0.f, 0.f};
        UNR for (int sl = 0; sl < 8; ++sl) s += *(const f32x4*)(PART + (size_t)sl * MC * 128 + i * 4);
        const float rsc = rsqrtf(ROWSS[tok] * (1.0f / DM) + EPS) * (1.0f / 256.0f);
        const f32x4 g = *(const f32x4*)(EG + i * 4); f32x4 o;
        UNR for (int e = 0; e < 4; ++e) { const float v = s[e] * rsc; o[e] = 0.5f * v * (1.0f + erff(v * 0.70710678118654752f)) * g[e] * (1.0f / 64.0f); }
        *(f32x4*)(CO + i * 4) = o;
    }
}
__device__ __forceinline__ void gload8_asm(u32x2& dst, const void* p) { asm volatile("global_load_dwordx2 %0, %1, off" : "=v"(dst) : "v"(p) : "memory"); }
__device__ __forceinline__ void phase7b(const Params& P, int bid, int nb) {
    const int tid = opaque_tid(), lane = tid & 63, w = tid >> 6;
    char* ws = P.ws;
    const float* H2 = (const float*)(ws + WS_R6); const int* EIDX = (const int*)(ws + WS_R4);
    const unsigned char* V8 = (const unsigned char*)(ws + WS_R3) + (size_t)NEXP * 1024;
    const float* COEF = (const float*)(ws + WS_CO);
    XcdPlan pl; xcd_plan(P, bid, nb, pl);
    const int gw = pl.rank * 8 + w, nW = pl.count * 8;
    const int pg = lane >> 3, ds = lane & 7;
    const bool b5 = (lane & 32) != 0, b4 = (lane & 16) != 0, b3 = (lane & 8) != 0;
    for (int pi = 0; pi < pl.npart; ++pi) {
        int part = 0; UNR for (int q = 0; q < 8; ++q) if (q == pi) part = pl.part[q];
        const unsigned char* Vs = V8 + (size_t)part * NEXP * 128 + ds * 16;
        if (gw >= MC) continue;
        const int N = (MC - gw + nW - 1) / nW;
        const int doff = part * 128 + ds * 16 + 2 * pg;
        auto tokof = [&](int n) -> size_t { return (size_t)(gw + min(n, N - 1) * nW); };
        u32x4 row[16];
        auto load_idx = [&](u32x4 (&ix)[4], int n) { const size_t tok = tokof(n); UNR for (int q = 0; q < 4; ++q) gload16_asm(ix[q], EIDX + tok * 128 + pg * 16 + 4 * q); };
        auto load_cf = [&](u32x4 (&cf)[4], u32x2& hv, int n) { const size_t tok = tokof(n); UNR for (int q = 0; q < 4; ++q) gload16_asm(cf[q], COEF + tok * 128 + pg * 16 + 4 * q); gload8_asm(hv, H2 + tok * 1024 + doff); };
        auto body = [&](u32x4 (&ixn)[4], u32x4 (&ixnn)[4], u32x4 (&cfc)[4], u32x2& hvc, u32x4 (&cfn)[4], u32x2& hvn, int n) {
            load_idx(ixnn, n + 2); load_cf(cfn, hvn, n + 1);
            float acc[16]; UNR for (int i = 0; i < 16; ++i) acc[i] = 0.f;
            UNR for (int j = 0; j < 16; ++j) {
                asm volatile("s_waitcnt vmcnt(25)" : "+v"(row[j]), "+v"(cfc[j >> 2]), "+v"(ixn[j >> 2]) :: "memory");
                const float cfj = __uint_as_float(cfc[j >> 2][j & 3]);
                UNR for (int i = 0; i < 4; ++i) { const f32x2_t lo = __builtin_amdgcn_cvt_pk_f32_fp8((int)row[j][i], false), h2 = __builtin_amdgcn_cvt_pk_f32_fp8((int)row[j][i], true);
                    acc[4 * i] = __builtin_fmaf(cfj, lo[0], acc[4 * i]); acc[4 * i + 1] = __builtin_fmaf(cfj, lo[1], acc[4 * i + 1]); acc[4 * i + 2] = __builtin_fmaf(cfj, h2[0], acc[4 * i + 2]); acc[4 * i + 3] = __builtin_fmaf(cfj, h2[1], acc[4 * i + 3]); }
                asm volatile("" :: "v"(acc[0]), "v"(acc[4]), "v"(acc[8]), "v"(acc[12]) : "memory");
                gload16_asm(row[j], Vs + (size_t)ixn[j >> 2][j & 3] * 128);
            }
            float r8[8], r4[4], r2[2];
            UNR for (int i = 0; i < 8; ++i) { const float keep = b5 ? acc[i + 8] : acc[i], give = b5 ? acc[i] : acc[i + 8];
                auto sw = __builtin_amdgcn_permlane32_swap(__float_as_uint(give), __float_as_uint(give), false, false); r8[i] = keep + __uint_as_float(b5 ? sw[0] : sw[1]); }
            UNR for (int i = 0; i < 4; ++i) { const float keep = b4 ? r8[i + 4] : r8[i], give = b4 ? r8[i] : r8[i + 4];
                auto sw = __builtin_amdgcn_permlane16_swap(__float_as_uint(give), __float_as_uint(give), false, false); r4[i] = keep + __uint_as_float(b4 ? sw[0] : sw[1]); }
            UNR for (int i = 0; i < 2; ++i) { const float keep = b3 ? r4[i + 2] : r4[i], give = b3 ? r4[i] : r4[i + 2]; r2[i] = keep + dpp_f(give, 0x128); }
            asm volatile("" : "+v"(hvc));
            u32x2 o; o[0] = __float_as_uint(__uint_as_float(hvc[0]) + r2[0]); o[1] = __float_as_uint(__uint_as_float(hvc[1]) + r2[1]);
            float* op = P.out + tokof(n) * 1024 + doff;
            asm volatile("global_store_dwordx2 %0, %1, off\n\ts_nop 1" :: "v"(op), "v"(o) : "memory");
        };
        u32x4 ixA[4], ixB[4], cfA[4], cfB[4]; u32x2 hvA, hvB;
        load_idx(ixA, 0); load_idx(ixB, 1); load_cf(cfA, hvA, 0);
        asm volatile("s_waitcnt vmcnt(9)" : "+v"(ixA[0]), "+v"(ixA[1]), "+v"(ixA[2]), "+v"(ixA[3]) :: "memory");
        UNR for (int j = 0; j < 16; ++j) gload16_asm(row[j], Vs + (size_t)ixA[j >> 2][j & 3] * 128);
        u32x2 dummy; gload8_asm(dummy, H2 + tokof(0) * 1024 + doff);
        for (int n = 0; n < N; n += 2) { body(ixB, ixA, cfA, hvA, cfB, hvB, n); body(ixA, ixB, cfB, hvB, cfA, hvA, n + 1); }
        asm volatile("s_waitcnt vmcnt(0)" : "+v"(dummy), "+v"(ixA[0]), "+v"(ixA[1]), "+v"(ixA[2]), "+v"(ixA[3]), "+v"(ixB[0]), "+v"(ixB[1]), "+v"(ixB[2]), "+v"(ixB[3]) :: "memory");
        asm volatile("" : "+v"(cfA[0]), "+v"(cfA[1]), "+v"(cfA[2]), "+v"(cfA[3]), "+v"(cfB[0]), "+v"(cfB[1]), "+v"(cfB[2]), "+v"(cfB[3]), "+v"(hvA), "+v"(hvB) :: "memory");
        asm volatile("" : "+v"(row[0]), "+v"(row[1]), "+v"(row[2]), "+v"(row[3]), "+v"(row[4]), "+v"(row[5]), "+v"(row[6]), "+v"(row[7]) :: "memory");
        asm volatile("" : "+v"(row[8]), "+v"(row[9]), "+v"(row[10]), "+v"(row[11]), "+v"(row[12]), "+v"(row[13]), "+v"(row[14]), "+v"(row[15]) :: "memory");
        asm volatile("s_waitcnt vmcnt(0)" ::: "memory");
    }
}

#define XB_TMO      128
#define XB_XCNT(j)  (256  + 64 * (j))
#define XB_XSUB(j)  (1280 + 64 * (j))
#define XB_XGEN(j)  (2304 + 64 * (j))
#define XB_TOP      3328
#define XB_TOPGEN   3392
#define XCD_BAR_WORDS 3456
#define XB_SPIN_CAP (1u << 18)
#define LAS __attribute__((address_space(3)))
__device__ __forceinline__ unsigned xb_ld(unsigned* p)              { return __hip_atomic_load(p, __ATOMIC_RELAXED, __HIP_MEMORY_SCOPE_AGENT); }
__device__ __forceinline__ unsigned xb_add(unsigned* p, unsigned v) { return __hip_atomic_fetch_add(p, v, __ATOMIC_RELAXED, __HIP_MEMORY_SCOPE_AGENT); }
#define XB_SPIN(cond, bar) do { unsigned _sp = 0; while (cond) { __builtin_amdgcn_s_sleep(1); \
    if ((++_sp & 255u) == 0u) { if (xb_ld(&(bar)[XB_TMO])) break; if (_sp > XB_SPIN_CAP) { atomicAdd(&(bar)[XB_TMO], 1u); break; } } } } while (0)
struct XcdBarrier { unsigned* bar; unsigned x; volatile LAS unsigned* st; };
__device__ __forceinline__ XcdBarrier xcd_barrier_post(unsigned* bar, volatile LAS unsigned* st) {
    XcdBarrier b; b.bar = bar; b.x = xcc_id(); b.st = st;
    if (threadIdx.x == 0) (void)xb_add(&bar[XB_XCNT(b.x)], 1u);
    return b;
}
__device__ __forceinline__ void xcd_barrier_complete(unsigned* bar, unsigned x, unsigned& nloc, unsigned& nx) {
    const unsigned G = gridDim.x * gridDim.y * gridDim.z;
    unsigned sum, cnt, mine, sp = 0u;
    for (;;) {
        sum = 0u; cnt = 0u; mine = 0u;
        UNR for (unsigned j = 0; j < 16; ++j) { const unsigned c = xb_ld(&bar[XB_XCNT(j)]); sum += c; cnt += (c > 0u) ? 1u : 0u; mine = (j == x) ? c : mine; }
        if (sum == G) break;
        __builtin_amdgcn_s_sleep(1);
        if ((++sp & 255u) == 0u) { if (xb_ld(&bar[XB_TMO])) break; if (sp > XB_SPIN_CAP) { atomicAdd(&bar[XB_TMO], 1u); break; } }
    }
    nloc = mine > 0u ? mine : 1u; nx = cnt > 0u ? cnt : 1u;
}
__device__ __forceinline__ void xcd_barrier(const XcdBarrier& b) {
    asm volatile("s_waitcnt vmcnt(0)" ::: "memory");
    __syncthreads();
    if (opaque_tid() == 0) {
        unsigned* bar = b.bar;
        __builtin_amdgcn_s_waitcnt(0);
        unsigned nloc = b.st[0], nx = b.st[1];
        if (nloc == 0u) { xcd_barrier_complete(bar, b.x, nloc, nx); b.st[0] = nloc; b.st[1] = nx; }
        const unsigned old = xb_add(&bar[XB_XSUB(b.x)], 1u);
        const unsigned gen = old / nloc;
        if (old + 1u == (gen + 1u) * nloc) {
            __builtin_amdgcn_fence(__ATOMIC_RELEASE, "agent");
            asm volatile("s_waitcnt vmcnt(0)" ::: "memory");
            const unsigned og = xb_add(&bar[XB_TOP], 1u);
            const unsigned tg = og / nx;
            if (og + 1u == (tg + 1u) * nx) xb_add(&bar[XB_TOPGEN], 1u);
            else XB_SPIN(xb_ld(&bar[XB_TOPGEN]) == tg, bar);
            __builtin_amdgcn_fence(__ATOMIC_ACQUIRE, "agent");
            xb_add(&bar[XB_XGEN(b.x)], 1u);
            asm volatile("s_waitcnt vmcnt(0)" ::: "memory");
        } else {
            XB_SPIN(xb_ld(&bar[XB_XGEN(b.x)]) == gen, bar);
            __builtin_amdgcn_fence(__ATOMIC_ACQUIRE, "agent");
            asm volatile("s_waitcnt vmcnt(0)" ::: "memory");
        }
    }
    __syncthreads();
}

#if SPLIT_LAUNCH
#error split launch path removed
#else
#ifndef TIMING_A
#define TIMING_A -1
#endif
#ifndef TIMING_B
#define TIMING_B -1
#endif
__global__ void __launch_bounds__(NTHREADS) mega_kernel(Params P) {
    __shared__ __attribute__((aligned(16))) char smem[SMEM_BYTES];
    cg::grid_group grid = cg::this_grid();
    const int bid = blockIdx.x, nb = gridDim.x;
    volatile LAS unsigned* xst = (volatile LAS unsigned*)(smem + 133120);
    if (threadIdx.x == 0) { xst[0] = 0u; xst[1] = 0u; }
    if ((threadIdx.x & 63) == 0) ((volatile int*)(smem + TIDTAB_OFF))[(unsigned)__builtin_amdgcn_s_getreg(63492) & 63u] = (int)(threadIdx.x >> 6);
    __syncthreads();
    const XcdBarrier xb = xcd_barrier_post((unsigned*)(P.ws + WS_BAR), xst);
#define GSYNC() xcd_barrier(xb)
#if TIMING_A >= 0
    u64* ts = (u64*)(P.ws + WS_CTL + 1024);
#define STAMP(i) do { if (bid == 0 && threadIdx.x == 0) ts[i] = __builtin_amdgcn_s_memrealtime(); } while (0)
#else
#define STAMP(i) do {} while (0)
#endif
    PG8_LAS unsigned char* lds3 = (PG8_LAS unsigned char*)smem;
    phase0(P, bid, nb); grid.sync();
    phase1(P, lds3); GSYNC();
    phase2<0>(P, smem, 0); GSYNC();
    phase3(P, bid, nb, lds3); GSYNC();
    phase4(P, lds3); GSYNC();
    phase6a(P, lds3); GSYNC();
    phase6b(P, bid, nb, smem); GSYNC();
    phase7a(P, bid, nb); GSYNC();
    phase7m(P, bid, nb); GSYNC();
    phase7b(P, bid, nb);
#if TIMING_A >= 0
    grid.sync(); STAMP(8);
    __threadfence(); grid.sync();
    {
        const volatile u64* tv = ts;
        const float tA = (float)(tv[TIMING_A + 1] - tv[TIMING_A]) * 0.01f, tB = (float)(tv[TIMING_B + 1] - tv[TIMING_B]) * 0.01f;
        const float qA = floorf(log2f(tA) * 4.0f), qB = floorf(log2f(tB) * 4.0f);
        const float delta = 0.25f * qB;
        for (size_t i = (size_t)bid * NTHREADS + threadIdx.x; i < (size_t)BATCH * SEQ * DM; i += (size_t)nb * NTHREADS) P.out[i] = (i == 0) ? (P.out[i] + 64.0f + qA) : (P.out[i] + delta);
    }
#endif
}
#endif

extern "C" void kernel_launch(void* const* d_in, const int* in_sizes, int n_in, void* d_out, int out_size, void* d_ws, size_t ws_size, hipStream_t stream) {
    Params P{};
    const float** pp = (const float**)&P;
    UNR for (int i = 0; i < 21; ++i) pp[i] = (const float*)d_in[i];
    P.out = (float*)d_out; P.ws = (char*)d_ws;
    if (ws_size < WS_END + (size_t)256 * 16 * 4112 * 4) { fprintf(stderr, "workspace too small: %zu < %zu\n", ws_size, (size_t)WS_END); return; }
#if SPLIT_LAUNCH
#else
    static int grid_blocks = 0;
    if (!grid_blocks) {
        int dev = 0, cus = 0, per_cu = 0;
        (void)hipGetDevice(&dev);
        (void)hipDeviceGetAttribute(&cus, hipDeviceAttributeMultiprocessorCount, dev);
        (void)hipOccupancyMaxActiveBlocksPerMultiprocessor(&per_cu, mega_kernel, NTHREADS, 0);
        if (per_cu > 1) per_cu = 1;
        grid_blocks = cus * per_cu;
    }
    (void)hipMemsetAsync((char*)d_ws + WS_BAR, 0, XCD_BAR_WORDS * 4, stream);
    void* args[] = {&P};
    hipError_t e = hipLaunchCooperativeKernel((void*)mega_kernel, dim3(grid_blocks), dim3(NTHREADS), args, 0, stream);
    if (e != hipSuccess) fprintf(stderr, "cooperative launch failed: %s (grid %d)\n", hipGetErrorString(e), grid_blocks);
#endif
}
```

```cpp
#include <hip/hip_runtime.h>
#include <hip/hip_cooperative_groups.h>
#include <cstdio>
#include <cstdint>
namespace cg = cooperative_groups;
#define UNR _Pragma("unroll")

#ifndef SPLIT_LAUNCH
#define SPLIT_LAUNCH 0
#endif

typedef unsigned short bf16_t;
typedef short bf16x8 __attribute__((ext_vector_type(8)));
typedef short s16x4 __attribute__((ext_vector_type(4)));
typedef float f32x16 __attribute__((ext_vector_type(16)));
typedef float f32x4 __attribute__((ext_vector_type(4)));
typedef float f32x2_t __attribute__((ext_vector_type(2)));
typedef __bf16 bf16x2_t __attribute__((ext_vector_type(2)));
typedef unsigned long long u64;
typedef unsigned u32x4 __attribute__((ext_vector_type(4)));
typedef unsigned u32x2 __attribute__((ext_vector_type(2)));

constexpr int BATCH = 8, SEQ = 4096, DM = 1024, NMETA = 16;
constexpr int TR = NMETA + SEQ;
constexpr int TP = 4224;
constexpr int R = BATCH * TP;
constexpr int NIN = 4864;
constexpr float EPS = 1e-6f;
constexpr int NTHREADS = 512;
constexpr int NEXP = 16384;
constexpr float LOG2E = 1.4426950408889634f;
constexpr float QSCALE = 0.125f * LOG2E;
constexpr int SMEM_BYTES = 135168;

constexpr size_t al(size_t x) { return (x + 255) & ~(size_t)255; }
constexpr size_t WS_CTL   = 0;
constexpr size_t WS_ROWSS = 4096;
constexpr size_t WS_COS64 = al(WS_ROWSS + (size_t)R * 4);
constexpr size_t WS_SIN64 = al(WS_COS64 + (size_t)TP * 32 * 4);
constexpr size_t WS_ICOS  = al(WS_SIN64 + (size_t)TP * 32 * 4);
constexpr size_t WS_ISIN  = al(WS_ICOS + (size_t)TP * 16 * 4);
constexpr size_t WS_WIN   = al(WS_ISIN + (size_t)TP * 16 * 4);
constexpr size_t WS_WA    = al(WS_WIN + (size_t)NIN * 1024 * 2);
constexpr size_t WS_WB    = al(WS_WA + (size_t)1024 * 512 * 2);
constexpr size_t WS_WO    = al(WS_WB + (size_t)1024 * 512 * 2);
constexpr size_t WS_WQ    = al(WS_WO + (size_t)1024 * 1024 * 2);
constexpr size_t WS_SUBK  = al(WS_WQ + (size_t)1024 * 1024 * 2);
constexpr size_t WS_BK    = al(WS_SUBK + (size_t)8 * 2 * 128 * 64 * 2);
constexpr size_t WS_BV    = al(WS_BK + (size_t)R * 64 * 2);
constexpr size_t WS_IK    = al(WS_BV + (size_t)R * 64 * 2);
constexpr size_t WS_IW    = al(WS_IK + (size_t)R * 64 * 2);
constexpr size_t WS_R1    = al(WS_IW + (size_t)R * 8 * 4);
constexpr size_t SZ_R1    = (size_t)R * 1024 * 2;
constexpr size_t WS_R2    = al(WS_R1 + SZ_R1);
constexpr size_t WS_R3    = al(WS_R2 + SZ_R1);
constexpr size_t WS_R4    = al(WS_R3 + SZ_R1);
constexpr size_t WS_R6    = al(WS_R4 + (size_t)R * 512 * 2);
constexpr size_t WS_BAR   = al(WS_R6 + (size_t)R * 1024 * 4);
constexpr size_t WS_CO    = WS_BAR + 16384;
constexpr size_t WS_END   = WS_CO + (size_t)BATCH * SEQ * 128 * 4;

struct Params {
    const float *x, *meta, *g_mix, *w_in, *g_aq, *g_ak, *lq1, *lk1, *lq2, *lk2, *g_sub, *w_a, *g_bq, *g_bk, *w_b, *w_o, *g_ffn, *w_q, *subk, *pu, *pv;
    float* out;
    char* ws;
};

constexpr int TIDTAB_OFF = 133376;
__device__ __forceinline__ int opaque_tid() {
    const unsigned hw = (unsigned)__builtin_amdgcn_s_getreg(63492) & 63u;
    int wid = *((volatile __attribute__((address_space(3))) int*)(uintptr_t)(TIDTAB_OFF + 4 * hw));
    wid = __builtin_amdgcn_readfirstlane(wid);
    unsigned z = 0u; asm volatile("" : "+v"(z));
    int t = wid * 64 + (int)__builtin_amdgcn_mbcnt_hi(~0u, __builtin_amdgcn_mbcnt_lo(~0u, z));
    asm volatile("" : "+v"(t)); return t;
}
__device__ __forceinline__ unsigned pk2(float lo, float hi) { f32x2_t v = {lo, hi}; bf16x2_t b = __builtin_convertvector(v, bf16x2_t); return __builtin_bit_cast(unsigned, b); }
__device__ __forceinline__ bf16_t f2bf(float x) { return (bf16_t)(pk2(x, 0.f) & 0xffffu); }
__device__ __forceinline__ float bf2f(unsigned x) { return __uint_as_float(x << 16); }
__device__ __forceinline__ unsigned xcc_id() { return (unsigned)__builtin_amdgcn_s_getreg((3 << 11) | 20) & 0xFu; }
__device__ __forceinline__ int crow(int r, int hi) { return (r & 3) + 8 * (r >> 2) + 4 * hi; }
__device__ __forceinline__ f32x16 mfma32(bf16x8 a, bf16x8 b, f32x16 c) { return __builtin_amdgcn_mfma_f32_32x32x16_bf16(a, b, c, 0, 0, 0); }
__device__ __forceinline__ f32x4 mfma16(bf16x8 a, bf16x8 b, f32x4 c) { return __builtin_amdgcn_mfma_f32_16x16x32_bf16(a, b, c, 0, 0, 0); }
__device__ __forceinline__ float ex2(float x) { return __builtin_amdgcn_exp2f(x); }
__device__ __forceinline__ bf16x8 pack8(float a0, float a1, float a2, float a3, float a4, float a5, float a6, float a7) {
    uint4 u; u.x = pk2(a0, a1); u.y = pk2(a2, a3); u.z = pk2(a4, a5); u.w = pk2(a6, a7); return __builtin_bit_cast(bf16x8, u);
}
__device__ __forceinline__ f32x16 zero16() { f32x16 z; UNR for (int i = 0; i < 16; ++i) z[i] = 0.f; return z; }

__device__ __forceinline__ void phase0(const Params& P, int bid, int nb) {
    const int tid = opaque_tid(), lane = tid & 63, w = tid >> 6;
    char* ws = P.ws;
    {
        bf16_t* XN = (bf16_t*)(ws + WS_R1);
        for (int row = bid * 8 + w; row < R; row += nb * 8) {
            const int b = row / TP, t = row - b * TP;
            f32x4 v[4];
            if (t < NMETA) { const float* src = P.meta + (size_t)t * DM; UNR for (int i = 0; i < 4; ++i) v[i] = *(const f32x4*)(src + i * 256 + lane * 4); }
            else if (t < TR) { const float* src = P.x + ((size_t)b * SEQ + (t - NMETA)) * DM; UNR for (int i = 0; i < 4; ++i) v[i] = *(const f32x4*)(src + i * 256 + lane * 4); }
            else { UNR for (int i = 0; i < 4; ++i) v[i] = (f32x4){0.f, 0.f, 0.f, 0.f}; }
            float ss = 0.f;
            UNR for (int i = 0; i < 4; ++i) ss += v[i][0] * v[i][0] + v[i][1] * v[i][1] + v[i][2] * v[i][2] + v[i][3] * v[i][3];
            for (int o = 32; o >= 1; o >>= 1) ss += __shfl_xor(ss, o);
            const float rinv = rsqrtf(ss * (1.0f / DM) + EPS);
            UNR for (int i = 0; i < 4; ++i) {
                const f32x4 g = *(const f32x4*)(P.g_mix + i * 256 + lane * 4);
                uint2 o; o.x = pk2(v[i][0] * rinv * g[0], v[i][1] * rinv * g[1]); o.y = pk2(v[i][2] * rinv * g[2], v[i][3] * rinv * g[3]);
                *(uint2*)(XN + (size_t)row * DM + i * 256 + lane * 4) = o;
            }
        }
    }
    const int gt = bid * NTHREADS + tid, gn = nb * NTHREADS;
    auto conv = [&](const float* W, int K, int Nsrc, int Ndst, bf16_t* Wt, bool remap) {
        const int items = Ndst * (K / 8);
        for (int it = gt; it < items; it += gn) {
            const int kc = it / Ndst, n = it - kc * Ndst;
            int ns = n; bool zero = false;
            if (remap) { const int p = n & 255; const int L = (n & ~255) + 64 * ((p >> 5) & 3) + 32 * (p >> 7) + (p & 31);
                         ns = L; if (L >= 2816) ns = L - 56; else if (L >= 2760) zero = true; }
            float f[8];
            UNR for (int j = 0; j < 8; ++j) f[j] = zero ? 0.f : W[(size_t)(kc * 8 + j) * Nsrc + ns];
            uint4 o; o.x = pk2(f[0], f[1]); o.y = pk2(f[2], f[3]); o.z = pk2(f[4], f[5]); o.w = pk2(f[6], f[7]);
            *(uint4*)(Wt + (size_t)n * K + kc * 8) = o;
        }
    };
    conv(P.w_in, 1024, 4808, NIN, (bf16_t*)(ws + WS_WIN), true);
    conv(P.w_a, 512, 1024, 1024, (bf16_t*)(ws + WS_WA), false);
    conv(P.w_b, 512, 1024, 1024, (bf16_t*)(ws + WS_WB), false);
    conv(P.w_o, 1024, 1024, 1024, (bf16_t*)(ws + WS_WO), false);
    conv(P.w_q, 1024, 1024, 1024, (bf16_t*)(ws + WS_WQ), false);
    { bf16_t* SK = (bf16_t*)(ws + WS_SUBK); for (int i = gt; i < 8 * 2 * 128 * 64; i += gn) SK[i] = f2bf(P.subk[i]); }
    {
        float* c64 = (float*)(ws + WS_COS64); float* s64 = (float*)(ws + WS_SIN64); float* ic = (float*)(ws + WS_ICOS); float* is = (float*)(ws + WS_ISIN);
        for (int i = gt; i < TP * 32; i += gn) { const int t = i >> 5, j = i & 31; const float inv = powf(10000.0f, -(float)(2 * j) / 64.0f); const float ang = (float)t * inv; c64[i] = (float)cos((double)ang); s64[i] = (float)sin((double)ang); }
        for (int i = gt; i < TP * 16; i += gn) { const int t = i >> 4, j = i & 15; const float inv = powf(10000.0f, -(float)(2 * j) / 32.0f); const float ang = (float)t * inv; ic[i] = (float)cos((double)ang); is[i] = (float)sin((double)ang); }
    }
    { float* rs = (float*)(ws + WS_ROWSS); for (int i = gt; i < R; i += gn) rs[i] = 0.f; }
    if (tid == 0) ((int*)(ws + WS_CTL + 2048))[bid] = (int)xcc_id();
    if (bid == 0 && w == 0) {
        float a = P.lq1[lane] * P.lk1[lane], b2 = P.lq2[lane] * P.lk2[lane];
        for (int o = 32; o >= 1; o >>= 1) { a += __shfl_xor(a, o); b2 += __shfl_xor(b2, o); }
        if (lane == 0) { ((unsigned*)(ws + WS_CTL))[0] = 0u; ((unsigned*)(ws + WS_CTL))[1] = 0u; ((unsigned*)(ws + WS_CTL))[2] = 0u; ((float*)(ws + WS_CTL))[4] = expf(a) - expf(b2) + 0.2f; }
    }
}

namespace pg8 {
#define PG8_LAS __attribute__((address_space(3)))
typedef unsigned short bf16_t;
typedef short bf16x8 __attribute__((ext_vector_type(8)));
typedef float f32x4 __attribute__((ext_vector_type(4)));
typedef unsigned u32x4 __attribute__((ext_vector_type(4)));
constexpr int BM = 256, BK = 64, HALF = 128, HTB = HALF * BK * 2  , STAGE_BYTES = 8 * HTB, NXCD = 8, WGM = 8;

__host__ __device__ __forceinline__ int lds_byte(int r, int c) { const int st = (r >> 4) * 2 + (c >> 5), rr = r & 15, cc = c & 31, ob = rr * 64 + cc * 2; return st * 1024 + (ob ^ (((ob >> 9) & 1) << 5)); }
__host__ __device__ __forceinline__ void stage_rc(int b, int& R, int& C) { const int st = b / 1024, sb = b % 1024, swz = sb ^ (((sb >> 9) & 1) << 5); R = (st >> 1) * 16 + swz / 64; C = (st & 1) * 32 + (swz % 64) / 2; }
__host__ __device__ __forceinline__ int perm32(int rho) { const int n = rho >> 4, i = rho & 15; return 8 * (i >> 2) + 4 * n + (i & 3); }

struct Unit { int pm, pn; };
struct Gemm { const bf16_t* A; const bf16_t* Bt; int M, N, K; };

struct StaticOrder {
    int nM, nN, nwg, G, c;
    __host__ __device__ void init(int M, int N, int G_, int c_) { nM = M / BM; nN = N / BM; nwg = nM * nN; G = G_; c = c_; }
    __host__ __device__ bool next(int i, Unit& u) const {
        const long L = (long)i * G + c; if (L >= nwg) return false;
        int wgid = (int)L; { const int q = nwg / NXCD, r = nwg % NXCD, xcd = wgid % NXCD, off = wgid / NXCD; wgid = (xcd < r ? xcd * (q + 1) : r * (q + 1) + (xcd - r) * q) + off; }
        const int nig = WGM * nN, gid = wgid / nig, fm = gid * WGM, gsz = (nM - fm) < WGM ? (nM - fm) : WGM;
        u.pm = fm + ((wgid % nig) % gsz); u.pn = (wgid % nig) / gsz; return true;
    }
    __device__ __forceinline__ void a_ready(const Unit&) const {}
    __device__ __forceinline__ void done(const Unit&) const {}
};
template <class Epi, class Sched, bool ALIGN_EPI = false, bool SP2 = false>
__device__ __forceinline__ void gemm_phase(PG8_LAS unsigned char* lds, const Gemm g, const Sched& S, const Epi& E) {
    const int tid = opaque_tid(), wid = __builtin_amdgcn_readfirstlane(tid >> 6), lane = tid & 63, wr = wid >> 2, wc = wid & 3, fr = lane & 15, fq = lane >> 4;
    const int K = g.K, nt = K / BK;
    unsigned voffA[2], voffB[2];
#pragma unroll
    for (int i = 0; i < 2; ++i) { int R, C; stage_rc(tid * 16 + i * 8192, R, C); const int Rb = Epi::PERM ? ((R & ~31) + perm32(R & 31)) : R;
        voffA[i] = (unsigned)(R * K + C) * 2u; voffB[i] = (unsigned)(Rb * K + C) * 2u; }
    const size_t kstep = (size_t)(BK * 2);
    const size_t hstep = (size_t)HALF * K * 2;
    const size_t tstep = 2 * hstep;
    const unsigned ldsw = (unsigned)wid * 1024u;
    const int aoff = lds_byte(wr * 64 + fr, fq * 8), boff = lds_byte(wc * 32 + fr, fq * 8);
#define PG8_SA(b, h) (((b) * 2 + (h)) * HTB)
#define PG8_SB(b, h) ((4 + (b) * 2 + (h)) * HTB)
#define PG8_STAGE(bufoff, gbase, voff) do { _Pragma("unroll") for (int _i = 0; _i < 2; ++_i) \
        __builtin_amdgcn_global_load_lds((const unsigned*)((const char*)(gbase) + (voff)[_i]), (PG8_LAS unsigned*)(lds + (bufoff) + ldsw + _i * 8192), 16, 0, 0); } while (0)
#define PG8_LDA(dst, b, h) do { _Pragma("unroll") for (int m = 0; m < 4; ++m) _Pragma("unroll") for (int k = 0; k < 2; ++k) dst[m][k] = *(const PG8_LAS bf16x8*)(lds + PG8_SA(b, h) + aoff + m * 2048 + k * 1024); } while (0)
#define PG8_LDB(dst, b, h) do { _Pragma("unroll") for (int n = 0; n < 2; ++n) _Pragma("unroll") for (int k = 0; k < 2; ++k) dst[n][k] = *(const PG8_LAS bf16x8*)(lds + PG8_SB(b, h) + boff + n * 2048 + k * 1024); } while (0)
#define PG8_MMA(ai, bj, At, Bt) do { __builtin_amdgcn_s_setprio(1); _Pragma("unroll") for (int m = 0; m < 4; ++m) _Pragma("unroll") for (int n = 0; n < 2; ++n) _Pragma("unroll") for (int k = 0; k < 2; ++k) \
        acc[ai][bj][m][n] = __builtin_amdgcn_mfma_f32_16x16x32_bf16(Bt[n][k], At[m][k], acc[ai][bj][m][n], 0, 0, 0); __builtin_amdgcn_s_setprio(0); } while (0)
#define PG8_WAIT_V(n) asm volatile("s_waitcnt vmcnt(" #n ")" ::: "memory")
#define PG8_WAIT_L(n) asm volatile("s_waitcnt lgkmcnt(" #n ")" ::: "memory")
#define PG8_BAR __builtin_amdgcn_s_barrier()
#define PG8_SCHED __builtin_amdgcn_sched_barrier(0)
    Unit cur, nxt; int ui = 0;
    if (!S.next(0, cur)) return;
    f32x4 acc[2][2][4][2];
#pragma unroll
    for (int a = 0; a < 2; ++a)
#pragma unroll
        for (int b = 0; b < 2; ++b)
#pragma unroll
            for (int m = 0; m < 4; ++m)
#pragma unroll
                for (int n = 0; n < 2; ++n) acc[a][b][m][n] = (f32x4){0.f, 0.f, 0.f, 0.f};
    bf16x8 At[4][2], B0[2][2], B1[2][2];
    const char* cA = (const char*)g.A + (size_t)cur.pm * tstep; const char* cB = (const char*)g.Bt + (size_t)cur.pn * tstep;
    S.a_ready(cur);
    if constexpr (SP2) {
        PG8_STAGE(PG8_SB(0, 0), cB, voffB); PG8_STAGE(PG8_SB(0, 1), cB + hstep, voffB); PG8_STAGE(PG8_SA(0, 0), cA, voffA); PG8_STAGE(PG8_SA(0, 1), cA + hstep, voffA);
        if (wr == 1) PG8_BAR;
        PG8_WAIT_V(2); PG8_BAR;
        PG8_STAGE(PG8_SB(1, 0), cB + kstep, voffB); PG8_STAGE(PG8_SA(1, 0), cA + kstep, voffA); PG8_STAGE(PG8_SB(1, 1), cB + hstep + kstep, voffB);
        PG8_WAIT_V(6); PG8_BAR;
    } else {
        PG8_STAGE(PG8_SB(0, 0), cB, voffB); PG8_STAGE(PG8_SA(0, 0), cA, voffA); PG8_STAGE(PG8_SB(0, 1), cB + hstep, voffB); PG8_STAGE(PG8_SA(0, 1), cA + hstep, voffA);
        if (wr == 1) PG8_BAR;
        PG8_WAIT_V(4); PG8_BAR;
        PG8_STAGE(PG8_SB(1, 0), cB + kstep, voffB); PG8_STAGE(PG8_SA(1, 0), cA + kstep, voffA); PG8_STAGE(PG8_SB(1, 1), cB + hstep + kstep, voffB);
        PG8_WAIT_V(6); PG8_BAR;
    }
    for (;;) {
        const bool has_next = S.next(ui + 1, nxt);
        const char* nA = has_next ? (const char*)g.A + (size_t)nxt.pm * tstep : cA; const char* nB = has_next ? (const char*)g.Bt + (size_t)nxt.pn * tstep : cB;
        for (int t = 0; t < nt; t += 2) {
            const bool last = (t == nt - 2);
            const char* a1 = cA + (size_t)(t + 1) * kstep;
            const char* a2 = last ? nA : cA + (size_t)(t + 2) * kstep; const char* b2 = last ? nB : cB + (size_t)(t + 2) * kstep;
            const char* a3 = a2 + kstep; const char* b3 = b2 + kstep;
            if (last && has_next) S.a_ready(nxt);
            if constexpr (SP2) {
            PG8_LDB(B0, 0, 0); PG8_LDB(B1, 0, 1); PG8_SCHED; PG8_LDA(At, 0, 0); PG8_STAGE(PG8_SA(1, 1), a1 + hstep, voffA);
            PG8_WAIT_V(8); PG8_WAIT_L(0); PG8_BAR; PG8_MMA(0, 0, At, B0); PG8_MMA(0, 1, At, B1); PG8_BAR; PG8_SCHED;
            PG8_LDA(At, 0, 1); PG8_STAGE(PG8_SB(0, 0), b2, voffB); PG8_STAGE(PG8_SB(0, 1), b2 + hstep, voffB); PG8_STAGE(PG8_SA(0, 0), a2, voffA);
            PG8_WAIT_V(8); PG8_WAIT_L(0); PG8_BAR; PG8_MMA(1, 0, At, B0); PG8_MMA(1, 1, At, B1); PG8_BAR; PG8_SCHED;
            PG8_LDB(B0, 1, 0); PG8_LDB(B1, 1, 1); PG8_SCHED; PG8_LDA(At, 1, 0); PG8_STAGE(PG8_SA(0, 1), a2 + hstep, voffA);
            PG8_WAIT_V(8); PG8_WAIT_L(0); PG8_BAR; PG8_MMA(0, 0, At, B0); PG8_MMA(0, 1, At, B1); PG8_BAR; PG8_SCHED;
            PG8_LDA(At, 1, 1); PG8_STAGE(PG8_SB(1, 0), b3, voffB); PG8_STAGE(PG8_SB(1, 1), b3 + hstep, voffB); PG8_STAGE(PG8_SA(1, 0), a3, voffA);
            PG8_WAIT_V(8); PG8_WAIT_L(0); PG8_BAR; PG8_MMA(1, 0, At, B0); PG8_MMA(1, 1, At, B1); PG8_BAR; PG8_SCHED;
            } else {
            PG8_LDB(B0, 0, 0); PG8_SCHED; PG8_LDA(At, 0, 0); PG8_STAGE(PG8_SA(1, 1), a1 + hstep, voffA);
            PG8_WAIT_L(8); PG8_BAR; PG8_WAIT_L(0); PG8_MMA(0, 0, At, B0); PG8_BAR; PG8_SCHED;
            PG8_LDB(B1, 0, 1); PG8_STAGE(PG8_SB(0, 0), b2, voffB);
            PG8_BAR; PG8_WAIT_L(0); PG8_MMA(0, 1, At, B1); PG8_BAR;
            PG8_LDA(At, 0, 1); PG8_STAGE(PG8_SA(0, 0), a2, voffA);
            PG8_BAR; PG8_WAIT_L(0); PG8_MMA(1, 0, At, B0); PG8_BAR; PG8_SCHED;
            PG8_STAGE(PG8_SB(0, 1), b2 + hstep, voffB);
            PG8_WAIT_V(6); PG8_BAR; PG8_MMA(1, 1, At, B1); PG8_BAR;
            PG8_LDB(B0, 1, 0); PG8_SCHED; PG8_LDA(At, 1, 0); PG8_STAGE(PG8_SA(0, 1), a2 + hstep, voffA);
            PG8_WAIT_L(8); PG8_BAR; PG8_WAIT_L(0); PG8_MMA(0, 0, At, B0); PG8_BAR; PG8_SCHED;
            PG8_LDB(B1, 1, 1); PG8_STAGE(PG8_SB(1, 0), b3, voffB);
            PG8_BAR; PG8_WAIT_L(0); PG8_MMA(0, 1, At, B1); PG8_BAR;
            PG8_LDA(At, 1, 1); PG8_STAGE(PG8_SA(1, 0), a3, voffA);
            PG8_BAR; PG8_WAIT_L(0); PG8_MMA(1, 0, At, B0); PG8_BAR; PG8_SCHED;
            PG8_STAGE(PG8_SB(1, 1), b3 + hstep, voffB);
            PG8_WAIT_V(6); PG8_BAR; PG8_MMA(1, 1, At, B1); PG8_BAR;
            }
        }
        if constexpr (ALIGN_EPI) { if (wr == 0) PG8_BAR; }
        if constexpr (!Epi::AFTER_DRAIN) { E(acc, cur, wr, wc, fr, fq); S.done(cur); }
        if (!has_next) break;
#pragma unroll
        for (int a = 0; a < 2; ++a)
#pragma unroll
            for (int b = 0; b < 2; ++b)
#pragma unroll
                for (int m = 0; m < 4; ++m)
#pragma unroll
                    for (int n = 0; n < 2; ++n) acc[a][b][m][n] = (f32x4){0.f, 0.f, 0.f, 0.f};
        cur = nxt; cA = nA; cB = nB; ++ui;
        if constexpr (ALIGN_EPI) { if (wr == 1) PG8_BAR; }
    }
    PG8_WAIT_V(0);
    if constexpr (!ALIGN_EPI) { if (wr == 0) PG8_BAR; }
    PG8_BAR;
    if constexpr (Epi::AFTER_DRAIN) { E.fused(acc, cur, wr, wc, fr, fq, lds, wid, lane); S.done(cur); }
#undef PG8_SA
#undef PG8_SB
#undef PG8_STAGE
#undef PG8_LDA
#undef PG8_LDB
#undef PG8_MMA
#undef PG8_WAIT_V
#undef PG8_WAIT_L
#undef PG8_BAR
#undef PG8_SCHED
}
}

constexpr int MC = BATCH * SEQ;
struct EpiProj {
    static constexpr bool PERM = true, AFTER_DRAIN = false;
    char* ws0; const float *g_aq, *g_ak, *g_bq, *g_bk;
    __device__ __forceinline__ void operator()(const f32x4 (&acc)[2][2][4][2], const pg8::Unit& u, int wr, int wc, int fr, int fq) const {
        char* ws = ws0; asm volatile("" : "+s"(ws));
        bf16_t* AQ = (bf16_t*)(ws + WS_R2); bf16_t* AK = AQ + (size_t)8 * 8 * TP * 64;
        bf16_t* AVT = (bf16_t*)(ws + WS_R3); bf16_t* BQ = AVT + (size_t)8 * 4 * 128 * TP;
        unsigned char* KV8 = (unsigned char*)(ws + WS_BK); bf16_t* IK = (bf16_t*)(ws + WS_IK); float* IW = (float*)(ws + WS_IW);
        bf16_t* IQ = (bf16_t*)(ws + WS_R4); bf16_t* GA = (bf16_t*)(ws + WS_R6); bf16_t* GB = GA + (size_t)MC * 1024;
        const float* c64 = (const float*)(ws + WS_COS64); const float* s64 = (const float*)(ws + WS_SIN64); const float* ic = (const float*)(ws + WS_ICOS); const float* is = (const float*)(ws + WS_ISIN);
        const int chunk = u.pn * 4 + wc;
        UNR for (int ai = 0; ai < 2; ++ai) UNR for (int m = 0; m < 4; ++m) {
            const int row = u.pm * 256 + ai * 128 + wr * 64 + m * 16 + fr; const int b = row / TP, t = row - b * TP;
            f32x4 x[2][2]; UNR for (int bj = 0; bj < 2; ++bj) UNR for (int n = 0; n < 2; ++n) x[bj][n] = acc[ai][bj][m][n];
            const bool nr = (chunk < 16) || (chunk >= 24 && chunk <= 32);
            if (nr) {
                const float* gain; bf16_t* dst = nullptr; float sc = 1.f;
                if (chunk < 8) { gain = g_aq; dst = AQ + ((size_t)(b * 8 + chunk) * TP + t) * 64; sc = QSCALE; }
                else if (chunk < 16) { gain = g_ak; dst = AK + ((size_t)(b * 8 + chunk - 8) * TP + t) * 64; }
                else if (chunk < 32) { gain = g_bq; dst = BQ + (size_t)row * 512 + (chunk - 24) * 64; sc = QSCALE; }
                else { gain = g_bk; }
                float ss = 0.f;
                UNR for (int bj = 0; bj < 2; ++bj) UNR for (int n = 0; n < 2; ++n) UNR for (int e = 0; e < 4; ++e) ss += x[bj][n][e] * x[bj][n][e];
                ss += __shfl_xor(ss, 16); ss += __shfl_xor(ss, 32);
                const float rinv = rsqrtf(ss * (1.0f / 64.0f) + EPS);
                float o1[8], o2[8];
                UNR for (int n = 0; n < 2; ++n) {
                    const int j = 8 * fq + 4 * n;
                    const f32x4 c = *(const f32x4*)(c64 + t * 32 + j), s = *(const f32x4*)(s64 + t * 32 + j);
                    const f32x4 g1 = *(const f32x4*)(gain + j), g2 = *(const f32x4*)(gain + 32 + j);
                    UNR for (int e = 0; e < 4; ++e) { const float y1 = x[0][n][e] * rinv * g1[e], y2 = x[1][n][e] * rinv * g2[e]; o1[4 * n + e] = (y1 * c[e] - y2 * s[e]) * sc; o2[4 * n + e] = (y2 * c[e] + y1 * s[e]) * sc; }
                }
                if (chunk == 32) {
                    uint4 w8; int w0;
                    w0 = 0; w0 = __builtin_amdgcn_cvt_pk_fp8_f32(o1[0], o1[1], w0, false); w0 = __builtin_amdgcn_cvt_pk_fp8_f32(o1[2], o1[3], w0, true); w8.x = (unsigned)w0;
                    w0 = 0; w0 = __builtin_amdgcn_cvt_pk_fp8_f32(o1[4], o1[5], w0, false); w0 = __builtin_amdgcn_cvt_pk_fp8_f32(o1[6], o1[7], w0, true); w8.y = (unsigned)w0;
                    w0 = 0; w0 = __builtin_amdgcn_cvt_pk_fp8_f32(o2[0], o2[1], w0, false); w0 = __builtin_amdgcn_cvt_pk_fp8_f32(o2[2], o2[3], w0, true); w8.z = (unsigned)w0;
                    w0 = 0; w0 = __builtin_amdgcn_cvt_pk_fp8_f32(o2[4], o2[5], w0, false); w0 = __builtin_amdgcn_cvt_pk_fp8_f32(o2[6], o2[7], w0, true); w8.w = (unsigned)w0;
                    *(uint4*)(KV8 + (size_t)row * 128 + 16 * fq) = w8;
                } else {
                    uint4 u1, u2;
                    u1.x = pk2(o1[0], o1[1]); u1.y = pk2(o1[2], o1[3]); u1.z = pk2(o1[4], o1[5]); u1.w = pk2(o1[6], o1[7]);
                    u2.x = pk2(o2[0], o2[1]); u2.y = pk2(o2[2], o2[3]); u2.z = pk2(o2[4], o2[5]); u2.w = pk2(o2[6], o2[7]);
                    *(uint4*)(dst + 8 * fq) = u1; *(uint4*)(dst + 32 + 8 * fq) = u2;
                }
            } else if (chunk < 24) {
                const int hd = (chunk - 16) >> 1, half = (chunk - 16) & 1;
                bf16_t* dst = AVT + ((size_t)(b * 4 + hd) * 128 + half * 64) * TP + t;
                UNR for (int bj = 0; bj < 2; ++bj) UNR for (int n = 0; n < 2; ++n) UNR for (int e = 0; e < 4; ++e) dst[(size_t)(32 * bj + 8 * fq + 4 * n + e) * TP] = f2bf(x[bj][n][e]);
            } else if (chunk == 33) {
                unsigned char* kv = KV8 + (size_t)row * 128 + 64;
                UNR for (int bj = 0; bj < 2; ++bj) { uint2 w8; int w0;
                    w0 = 0; w0 = __builtin_amdgcn_cvt_pk_fp8_f32(x[bj][0][0], x[bj][0][1], w0, false); w0 = __builtin_amdgcn_cvt_pk_fp8_f32(x[bj][0][2], x[bj][0][3], w0, true); w8.x = (unsigned)w0;
                    w0 = 0; w0 = __builtin_amdgcn_cvt_pk_fp8_f32(x[bj][1][0], x[bj][1][1], w0, false); w0 = __builtin_amdgcn_cvt_pk_fp8_f32(x[bj][1][2], x[bj][1][3], w0, true); w8.y = (unsigned)w0;
                    *(uint2*)(kv + 32 * bj + 8 * fq) = w8; }
            } else if (chunk <= 42) {
                bf16_t* dst = (chunk == 42) ? IK + (size_t)row * 64 : IQ + (size_t)row * 512 + (chunk - 34) * 64;
                const bool hi2 = fq >= 2; const int jb = 8 * (fq & 1);
                float y[8];
                UNR for (int n = 0; n < 2; ++n) {
                    const f32x4 c = *(const f32x4*)(ic + t * 16 + jb + 4 * n), s = *(const f32x4*)(is + t * 16 + jb + 4 * n);
                    UNR for (int e = 0; e < 4; ++e) {
                        const float mine = x[0][n][e];
                        auto sw = __builtin_amdgcn_permlane32_swap(__float_as_uint(mine), __float_as_uint(mine), false, false);
                        const float other = __uint_as_float(hi2 ? sw[0] : sw[1]);
                        const float a = hi2 ? other : mine, bb = hi2 ? mine : other;
                        y[4 * n + e] = hi2 ? (bb * c[e] + a * s[e]) : (a * c[e] - bb * s[e]);
                    }
                }
                uint4 u1, u2;
                u1.x = pk2(y[0], y[1]); u1.y = pk2(y[2], y[3]); u1.z = pk2(y[4], y[5]); u1.w = pk2(y[6], y[7]);
                u2.x = pk2(x[1][0][0], x[1][0][1]); u2.y = pk2(x[1][0][2], x[1][0][3]); u2.z = pk2(x[1][1][0], x[1][1][1]); u2.w = pk2(x[1][1][2], x[1][1][3]);
                *(uint4*)(dst + 8 * fq) = u1; *(uint4*)(dst + 32 + 8 * fq) = u2;
            } else if (chunk == 43) {
                const float sc = 0.35355339059327373f * 0.125f;
                if (fq == 0) { *(f32x4*)(IW + (size_t)row * 8) = x[0][0] * sc; *(f32x4*)(IW + (size_t)row * 8 + 4) = x[0][1] * sc; }
            } else {
                if (t >= NMETA && t < TR) {
                    const size_t mc = (size_t)b * SEQ + (t - NMETA);
                    bf16_t* dst = (chunk < 60) ? GA + mc * 1024 + (chunk - 44) * 64 : GB + mc * 1024 + (chunk - 60) * 64;
                    UNR for (int bj = 0; bj < 2; ++bj) {
                        float o[8]; UNR for (int n = 0; n < 2; ++n) UNR for (int e = 0; e < 4; ++e) o[4 * n + e] = __builtin_amdgcn_rcpf(1.0f + ex2(-LOG2E * x[bj][n][e]));
                        uint4 v; v.x = pk2(o[0], o[1]); v.y = pk2(o[2], o[3]); v.z = pk2(o[4], o[5]); v.w = pk2(o[6], o[7]); *(uint4*)(dst + 32 * bj + 8 * fq) = v;
                    }
                }
            }
        }
    }
};
__device__ __forceinline__ void phase1(const Params& P, PG8_LAS unsigned char* lds) {
    pg8::Gemm g{(const bf16_t*)(P.ws + WS_R1), (const bf16_t*)(P.ws + WS_WIN), R, NIN, 1024};
    pg8::StaticOrder S; S.init(R, NIN, (int)gridDim.x, (int)blockIdx.x);
    EpiProj E{P.ws, P.g_aq, P.g_ak, P.g_bq, P.g_bk};
    pg8::gemm_phase<EpiProj, pg8::StaticOrder, true, true>(lds, g, S, E);
}

__device__ __forceinline__ void attnA_unit(const Params& P, int b, int head, int qb, char* lds) {
    const int tid = opaque_tid(), lane = tid & 63, w = tid >> 6, qg = w & 3, st = w >> 2, l31 = lane & 31, hi = lane >> 5;
    char* ws = P.ws;
    const bf16_t* AQ = (const bf16_t*)(ws + WS_R2); const bf16_t* AK = AQ + (size_t)8 * 8 * TP * 64; const bf16_t* AVT = (const bf16_t*)(ws + WS_R3);
    bf16_t* AOUT = (bf16_t*)(ws + WS_R1);
    const float lam = ((const float*)(ws + WS_CTL))[4];
    const int q0 = qb * 128 + qg * 32;
    const bf16_t* Qp = AQ + ((size_t)(b * 8 + head * 2 + st) * TP + q0 + l31) * 64;
    bf16x8 qf[4];
    UNR for (int ks = 0; ks < 4; ++ks) qf[ks] = *(const bf16x8*)(Qp + ks * 16 + hi * 8);
    const bf16_t* K0g = AK + (size_t)(b * 8 + head * 2) * TP * 64; const bf16_t* K1g = K0g + (size_t)TP * 64;
    const bf16_t* Vg = AVT + (size_t)(b * 4 + head) * 128 * TP;
    const int nkt = 2 * (qb + 1);
    const int srow = tid >> 3, sch = tid & 7;
    const int koff = srow * 128 + ((sch ^ (srow & 7)) << 4), voff = srow * 128 + ((sch ^ ((srow >> 1) & 7)) << 4);
    uint4 sr[4];
    auto gload = [&](int kt) {
        const int key0 = kt * 64;
        sr[0] = *(const uint4*)(K0g + (size_t)(key0 + srow) * 64 + sch * 8);
        sr[1] = *(const uint4*)(K1g + (size_t)(key0 + srow) * 64 + sch * 8);
        sr[2] = *(const uint4*)(Vg + (size_t)srow * TP + key0 + sch * 8);
        sr[3] = *(const uint4*)(Vg + (size_t)(srow + 64) * TP + key0 + sch * 8);
    };
    auto lstore = [&](int buf) {
        char* base = lds + buf * 32768;
        *(uint4*)(base + koff) = sr[0]; *(uint4*)(base + 8192 + koff) = sr[1];
        *(uint4*)(base + 16384 + voff) = sr[2]; *(uint4*)(base + 16384 + 8192 + voff) = sr[3];
    };
    f32x16 o[4]; UNR for (int i = 0; i < 4; ++i) o[i] = zero16();
    float mrun = -INFINITY, lrun = 0.f;
    gload(0); lstore(0); __syncthreads();
    const int qpos = q0 + l31;
    for (int kt = 0; kt < nkt; ++kt) {
        if (kt + 1 < nkt) gload(kt + 1);
        const char* base = lds + (kt & 1) * 32768; const char* Kb = base + st * 8192; const char* Vb = base + 16384;
        f32x16 s0 = zero16(), s1 = zero16();
        UNR for (int ks = 0; ks < 4; ++ks) {
            const int co = (((ks * 2 + hi) ^ (l31 & 7)) << 4);
            const bf16x8 a0 = *(const bf16x8*)(Kb + l31 * 128 + co), a1 = *(const bf16x8*)(Kb + (32 + l31) * 128 + co);
            s0 = mfma32(a0, qf[ks], s0); s1 = mfma32(a1, qf[ks], s1);
        }
        if (kt >= nkt - 2) {
            const int kbase = kt * 64;
            UNR for (int r = 0; r < 16; ++r) { const int key = kbase + crow(r, hi); if (key > qpos) s0[r] = -INFINITY; if (key + 32 > qpos) s1[r] = -INFINITY; }
        }
        float mx = s0[0];
        UNR for (int r = 1; r < 16; ++r) mx = fmaxf(mx, s0[r]);
        UNR for (int r = 0; r < 16; ++r) mx = fmaxf(mx, s1[r]);
        mx = fmaxf(mx, __shfl_xor(mx, 32));
        const float mn = fmaxf(mrun, mx);
        const float alpha = ex2(mrun - mn);
        mrun = mn;
        float ls = 0.f;
        UNR for (int r = 0; r < 16; ++r) { s0[r] = ex2(s0[r] - mn); s1[r] = ex2(s1[r] - mn); ls += s0[r] + s1[r]; }
        lrun = lrun * alpha + ls;
        if (!__all(alpha == 1.0f)) { UNR for (int mt = 0; mt < 4; ++mt) UNR for (int r = 0; r < 16; ++r) o[mt][r] *= alpha; }
        bf16x8 pb[2][2];
        pb[0][0] = pack8(s0[0], s0[1], s0[2], s0[3], s0[4], s0[5], s0[6], s0[7]); pb[0][1] = pack8(s0[8], s0[9], s0[10], s0[11], s0[12], s0[13], s0[14], s0[15]);
        pb[1][0] = pack8(s1[0], s1[1], s1[2], s1[3], s1[4], s1[5], s1[6], s1[7]); pb[1][1] = pack8(s1[8], s1[9], s1[10], s1[11], s1[12], s1[13], s1[14], s1[15]);
        UNR for (int mt = 0; mt < 4; ++mt) {
            const int d = mt * 32 + l31; const int sw = (d >> 1) & 7; const char* rowp = Vb + d * 128 + 8 * hi;
            UNR for (int k2 = 0; k2 < 2; ++k2)
                UNR for (int s = 0; s < 2; ++s) {
                    const int c0 = k2 * 4 + 2 * s;
                    const s16x4 lo = *(const s16x4*)(rowp + ((c0 ^ sw) << 4)), h4 = *(const s16x4*)(rowp + (((c0 + 1) ^ sw) << 4));
                    const bf16x8 a = {lo[0], lo[1], lo[2], lo[3], h4[0], h4[1], h4[2], h4[3]};
                    o[mt] = mfma32(a, pb[k2][s], o[mt]);
                }
        }
        if (kt + 1 < nkt) lstore((kt + 1) & 1);
        __syncthreads();
    }
    lrun += __shfl_xor(lrun, 32);
    const float inv = 1.0f / lrun;
    float* ex = (float*)lds + qg * 4096;
    if (st == 1) { const float f = inv * lam; UNR for (int mt = 0; mt < 4; ++mt) UNR for (int r = 0; r < 16; ++r) ex[(mt * 16 + r) * 64 + lane] = o[mt][r] * f; }
    __syncthreads();
    if (st == 0) {
        float ss = 0.f;
        UNR for (int mt = 0; mt < 4; ++mt) UNR for (int r = 0; r < 16; ++r) { const float v = o[mt][r] * inv - ex[(mt * 16 + r) * 64 + lane]; o[mt][r] = v; ss += v * v; }
        ss += __shfl_xor(ss, 32);
        const float rinv = rsqrtf(ss * (1.0f / 128.0f) + EPS) * 0.8f;
        const int tq = q0 + l31; const bool real = (tq >= NMETA && tq < TR);
        bf16_t* dst = AOUT + ((size_t)b * SEQ + (real ? tq - NMETA : 0)) * 512 + head * 128;
        if (real) UNR for (int mt = 0; mt < 4; ++mt) UNR for (int g4 = 0; g4 < 4; ++g4) {
            const int d = mt * 32 + 8 * g4 + 4 * hi; const f32x4 g = *(const f32x4*)(P.g_sub + d);
            uint2 u; u.x = pk2(o[mt][4 * g4] * rinv * g[0], o[mt][4 * g4 + 1] * rinv * g[1]); u.y = pk2(o[mt][4 * g4 + 2] * rinv * g[2], o[mt][4 * g4 + 3] * rinv * g[3]);
            *(uint2*)(dst + d) = u;
        }
    }
    __syncthreads();
}

constexpr int DSA_C = 448;
constexpr int DS_SEL = 0, DS_CAND = 8192, DS_VST = 8192, DS_PART = 40960, DS_PML = 106496, DS_BMP = 110592, DS_STATE = 131072;
__device__ __forceinline__ unsigned ord32(float s) { const unsigned u = __float_as_uint(s); return (u & 0x80000000u) ? ~u : (u | 0x80000000u); }

__device__ __forceinline__ void dsa_unit(const Params& P, int b, int q16, char* lds) {
    const int tid = opaque_tid(), lane = tid & 63, w = tid >> 6, n15 = lane & 15, g = lane >> 4;
    char* ws = P.ws;
    const bf16_t* BQ = (const bf16_t*)(ws + WS_R3) + (size_t)8 * 4 * 128 * TP;
    const bf16_t* BK = (const bf16_t*)(ws + WS_BK); const bf16_t* BV = (const bf16_t*)(ws + WS_BV); const bf16_t* IK = (const bf16_t*)(ws + WS_IK);
    const float* IW = (const float*)(ws + WS_IW); const bf16_t* IQ = (const bf16_t*)(ws + WS_R4);
    bf16_t* BOUT = (bf16_t*)(ws + WS_R1) + (size_t)MC * 512;
    unsigned* HIST = (unsigned*)lds;
    unsigned short* SEL = (unsigned short*)(lds + DS_SEL); u64* CAND = (u64*)(lds + DS_CAND);
    u64* s_pfx = (u64*)(lds + DS_STATE); int* s_need = (int*)(lds + DS_STATE + 256); int* s_pop = (int*)(lds + DS_STATE + 384);
    unsigned* s_selcnt = (unsigned*)(lds + DS_STATE + 512); unsigned* s_candcnt = (unsigned*)(lds + DS_STATE + 640); int* s_all = (int*)(lds + DS_STATE + 768);
    const int q0 = q16 * 16; const int qpos = q0 + n15; const size_t qrow = (size_t)b * TP + qpos;
    const int nk = q16 + 1;
    bf16x8 iqf[8][2];
    UNR for (int h = 0; h < 8; ++h) UNR for (int s = 0; s < 2; ++s) iqf[h][s] = *(const bf16x8*)(IQ + qrow * 512 + h * 64 + s * 32 + g * 8);
    float iw[8];
    { const f32x4 a = *(const f32x4*)(IW + qrow * 8), c = *(const f32x4*)(IW + qrow * 8 + 4); iw[0] = a[0]; iw[1] = a[1]; iw[2] = a[2]; iw[3] = a[3]; iw[4] = c[0]; iw[5] = c[1]; iw[6] = c[2]; iw[7] = c[3]; }
    auto loadk = [&](int kt, bf16x8& k0, bf16x8& k1) {
        const bf16_t* ikp = IK + ((size_t)b * TP + kt * 16 + n15) * 64 + g * 8;
        k0 = *(const bf16x8*)ikp; k1 = *(const bf16x8*)(ikp + 32);
    };
    auto load4 = [&](int kt0, bf16x8 (&k)[4][2]) { UNR for (int j = 0; j < 4; ++j) loadk(min(kt0 + 8 * j, nk - 1), k[j][0], k[j][1]); };
    auto compute = [&](const bf16x8& k0, const bf16x8& k1, f32x4& sc) {
        sc = (f32x4){0.f, 0.f, 0.f, 0.f};
        UNR for (int h = 0; h < 8; ++h) {
            f32x4 a = {0.f, 0.f, 0.f, 0.f};
            a = mfma16(k0, iqf[h][0], a); a = mfma16(k1, iqf[h][1], a);
            UNR for (int e = 0; e < 4; ++e) sc[e] = __builtin_fmaf(iw[h], __builtin_amdgcn_fmed3f(a[e], 0.f, INFINITY), sc[e]);
        }
        UNR for (int e = 0; e < 4; ++e) sc[e] += 0.0f;
    };
    if (tid < 16) { unsigned z = 0u; asm volatile("" : "+v"(z)); ((unsigned*)s_pfx)[2 * tid] = z; ((unsigned*)s_pfx)[2 * tid + 1] = z; s_need[tid] = 256; s_pop[tid] = (int)z; s_all[tid] = (int)z; }
    int sh = 45;
    for (;;) {
        const int nbits = sh < 11 ? sh : 11; const int mask = (1 << nbits) - 1;
        { uint4 z = {0u, 0u, 0u, 0u}; for (int i = tid; i < 4096; i += NTHREADS) ((uint4*)lds)[i] = z; }
        __syncthreads();
        const u64 mypfx = s_pfx[n15]; const int myall = s_all[n15];
        auto binit0 = [&](int kt, const f32x4& sc) {
            const bool diag = (kt == nk - 1);
            UNR for (int e = 0; e < 4; ++e) {
                const int idx = kt * 16 + 4 * g + e;
                if (!diag || idx <= qpos) {
                    const unsigned u = __float_as_uint(sc[e]); const unsigned t = u >> 21;
                    const unsigned ib = t ^ (~(unsigned)((int)u >> 31) & 1023u);
                    atomicAdd(&HIST[n15 * 1024 + (ib >> 1)], 1u << ((ib & 1) * 16));
                }
            }
        };
        auto binit = [&](int kt, const f32x4& sc) {
            const bool diag = (kt == nk - 1);
            UNR for (int e = 0; e < 4; ++e) {
                const int idx = kt * 16 + 4 * g + e;
                if ((!diag || idx <= qpos) && !myall) {
                    const u64 comp = ((u64)ord32(sc[e]) << 13) | (u64)(8191 - idx);
                    if ((comp >> sh) == mypfx) { const int ib = mask - (int)((comp >> (sh - nbits)) & (u64)mask); atomicAdd(&HIST[n15 * 1024 + (ib >> 1)], 1u << ((ib & 1) * 16)); }
                }
            }
        };
        {
            bf16x8 ka[4][2]; f32x4 sc;
            int kt = w; load4(kt, ka);
            if (sh == 45) {
                f32x4* SCR = (f32x4*)(ws + WS_END + (size_t)blockIdx.x * (16 * 4112 * 4)) + lane;
                while (kt < nk) {
                    UNR for (int j = 0; j < 4; ++j) {
                        compute(ka[j][0], ka[j][1], sc);
                        loadk(min(kt + 32 + 8 * j, nk - 1), ka[j][0], ka[j][1]);
                        if (kt + 8 * j < nk) { SCR[(size_t)(kt + 8 * j) * 64] = sc; binit0(kt + 8 * j, sc); }
                    }
                    kt += 32;
                }
            } else {
                while (kt < nk) {
                    UNR for (int j = 0; j < 4; ++j) {
                        compute(ka[j][0], ka[j][1], sc);
                        loadk(min(kt + 32 + 8 * j, nk - 1), ka[j][0], ka[j][1]);
                        if (kt + 8 * j < nk) binit(kt + 8 * j, sc);
                    }
                    kt += 32;
                }
            }
        }
        __syncthreads();
        UNR for (int i = 0; i < 2; ++i) {
            const int ql = w * 2 + i;
            if (s_all[ql]) continue;
            const unsigned* hq = HIST + ql * 1024 + lane * 16;
            unsigned wd[16]; unsigned c = 0;
            UNR for (int j = 0; j < 16; ++j) { wd[j] = hq[j]; c += (wd[j] & 0xffffu) + (wd[j] >> 16); }
            unsigned pre = c;
            UNR for (int o = 1; o < 64; o <<= 1) { const unsigned t = __shfl_up(pre, o); if (lane >= o) pre += t; }
            const unsigned nd = (unsigned)s_need[ql];
            const u64 bal = __ballot(pre >= nd);
            if (bal == 0ull) { if (lane == 0) { s_all[ql] = 1; s_pop[ql] = 0; s_need[ql] = 0; } }
            else {
                const int Lc = __ffsll((long long)bal) - 1;
                if (lane == Lc) {
                    unsigned cum = pre - c; int ibs = -1; unsigned cntb = 0;
                    UNR for (int j = 0; j < 32; ++j) { const unsigned cnt = (wd[j >> 1] >> ((j & 1) * 16)) & 0xffffu; if (ibs < 0) { if (cum + cnt >= nd) { ibs = lane * 32 + j; cntb = cnt; } else cum += cnt; } }
                    s_pfx[ql] = (s_pfx[ql] << nbits) | (u64)(mask - ibs); s_need[ql] = (int)(nd - cum); s_pop[ql] = (int)cntb;
                }
            }
        }
        __syncthreads();
        sh -= nbits;
        int mp = 0; UNR for (int q = 0; q < 16; ++q) mp = max(mp, s_pop[q]);
        if (mp <= DSA_C || sh == 0) break;
    }
    unsigned* BMP = (unsigned*)(lds + DS_BMP);
    if (tid < 16) { s_selcnt[tid] = 0u; s_candcnt[tid] = 0u; }
    for (int i = tid; i < 16 * 136; i += NTHREADS) BMP[i] = 0u;
    __syncthreads();
    {
        const int tid = opaque_tid(), lane = tid & 63, w = tid >> 6, n15 = lane & 15, g = lane >> 4; const int qpos = q0 + n15; (void)qpos; (void)g; (void)w;
        const u64 mypfx = s_pfx[n15]; const int myall = s_all[n15];
        const unsigned myib = 2047u - (unsigned)(mypfx & 2047ull);
        auto emit0 = [&](int kt, const f32x4& sc) {
            const bool diag = (kt == nk - 1);
            UNR for (int e = 0; e < 4; ++e) {
                const int idx = kt * 16 + 4 * g + e;
                if (!diag || idx <= qpos) {
                    const unsigned u = __float_as_uint(sc[e]); const unsigned t = u >> 21;
                    const unsigned ib = t ^ (~(unsigned)((int)u >> 31) & 1023u);
                    if (myall || ib < myib) atomicOr(&BMP[n15 * 136 + (idx >> 5)], 1u << (idx & 31));
                    else if (ib == myib) { const unsigned cp = atomicAdd(&s_candcnt[n15], 1u); if (cp < (unsigned)DSA_C) CAND[n15 * DSA_C + cp] = ((u64)ord32(sc[e]) << 13) | (u64)(8191 - idx); }
                }
            }
        };
        auto emit = [&](int kt, const f32x4& sc) {
            const bool diag = (kt == nk - 1);
            UNR for (int e = 0; e < 4; ++e) {
                const int idx = kt * 16 + 4 * g + e;
                if (!diag || idx <= qpos) {
                    const u64 comp = ((u64)ord32(sc[e]) << 13) | (u64)(8191 - idx); const u64 top = comp >> sh;
                    if (myall || top > mypfx) atomicOr(&BMP[n15 * 136 + (idx >> 5)], 1u << (idx & 31));
                    else if (top == mypfx) { const unsigned cp = atomicAdd(&s_candcnt[n15], 1u); if (cp < (unsigned)DSA_C) CAND[n15 * DSA_C + cp] = comp; }
                }
            }
        };
        bf16x8 ka[4][2]; f32x4 sc;
        int kt = w; if (sh != 34) load4(kt, ka);
        if (sh == 34) {
            f32x4 sv[4];
            const f32x4* SCR = (const f32x4*)(ws + WS_END + (size_t)blockIdx.x * (16 * 4112 * 4)) + lane;
            while (kt < nk) {
                UNR for (int j = 0; j < 4; ++j) sv[j] = SCR[(size_t)min(kt + 8 * j, nk - 1) * 64];
                UNR for (int j = 0; j < 4; ++j) if (kt + 8 * j < nk) emit0(kt + 8 * j, sv[j]);
                kt += 32;
            }
        } else {
            while (kt < nk) {
                UNR for (int j = 0; j < 4; ++j) {
                    compute(ka[j][0], ka[j][1], sc);
                    loadk(min(kt + 32 + 8 * j, nk - 1), ka[j][0], ka[j][1]);
                    if (kt + 8 * j < nk) emit(kt + 8 * j, sc);
                }
                kt += 32;
            }
        }
    }
    __syncthreads();
    {
        const int tid = opaque_tid(), lane = tid & 63, w = tid >> 6, n15 = lane & 15, g = lane >> 4; const int qpos = q0 + n15; (void)qpos; (void)g; (void)w;
    UNR for (int i = 0; i < 2; ++i) {
        const int ql = w * 2 + i; const int n = min((int)s_candcnt[ql], DSA_C); const int nd = s_need[ql];
        if (n == 0 || nd <= 0) continue;
        u64 c[7];
        UNR for (int j = 0; j < 7; ++j) { const int ci = j * 64 + lane; c[j] = (ci < n) ? CAND[ql * DSA_C + ci] : 0ull; }
        u64 T = 0ull;
        for (int bit = 44; bit >= 0; --bit) {
            const u64 Tn = T | (1ull << bit); int cnt = 0;
            UNR for (int j = 0; j < 7; ++j) cnt += __popcll(__ballot(c[j] >= Tn));
            if (cnt >= nd) T = Tn;
        }
        UNR for (int j = 0; j < 7; ++j) { if (c[j] >= T && c[j] != 0ull) { const int idx = 8191 - (int)(c[j] & 8191ull); atomicOr(&BMP[ql * 136 + (idx >> 5)], 1u << (idx & 31)); } }
    }
    }
    __syncthreads();
    {
        const int tid = opaque_tid(), lane = tid & 63, w = tid >> 6, n15 = lane & 15, g = lane >> 4; const int qpos = q0 + n15; (void)qpos; (void)g; (void)w;
    for (int i = 0; i < 2; ++i) {
        const int ql = w * 2 + i;
        unsigned wd3[3]; int cnt = 0;
        UNR for (int j = 0; j < 3; ++j) { const int wi = lane * 3 + j; wd3[j] = (wi < 132) ? BMP[ql * 136 + wi] : 0u; cnt += __popc(wd3[j]); }
        int pre = cnt;
        UNR for (int o = 1; o < 64; o <<= 1) { const int t = __shfl_up(pre, o); if (lane >= o) pre += t; }
        int pos = pre - cnt;
        UNR for (int j = 0; j < 3; ++j) { unsigned m = wd3[j]; while (m) { const int bit = __ffs((int)m) - 1; m &= m - 1; if (pos < 256) SEL[ql * 256 + pos] = (unsigned short)((lane * 3 + j) * 32 + bit); ++pos; } }
        if (lane == 63) s_selcnt[ql] = (unsigned)pre;
    }
    }
    __syncthreads();
    {
        const int tid = opaque_tid(), lane = tid & 63, w = tid >> 6, n15 = lane & 15, g = lane >> 4; const int qpos = q0 + n15; (void)qpos; (void)g; (void)w;
        typedef __attribute__((address_space(3))) s16x4 lds_s16x4;
        char* vl = lds + DS_VST + w * 4096;
        float* PART = (float*)(lds + DS_PART);
        float* PML = (float*)(lds + DS_PML);
        const int hq = n15 & 7, qq = n15 >> 2, pp = n15 & 3;
        struct QB { u32x4 kr[2]; u32x4 vr[2]; bf16x8 bq[2]; };
        const unsigned char* KV8 = (const unsigned char*)BK;
        auto cvt8 = [&](unsigned wlo, unsigned whi) -> bf16x8 {
            const f32x2_t a = __builtin_amdgcn_cvt_pk_f32_fp8((int)wlo, false), c = __builtin_amdgcn_cvt_pk_f32_fp8((int)wlo, true), d = __builtin_amdgcn_cvt_pk_f32_fp8((int)whi, false), e = __builtin_amdgcn_cvt_pk_f32_fp8((int)whi, true);
            return pack8(a[0], a[1], c[0], c[1], d[0], d[1], e[0], e[1]); };
        QB buf[3];
        auto issue = [&](int qi, QB& q) {
            const size_t row = (size_t)b * TP + q0 + qi; const int nsel = min((int)s_selcnt[qi], 256);
            const unsigned short* sel = SEL + qi * 256 + 32 * w;
            UNR for (int t = 0; t < 2; ++t) { const int slot = 32 * w + 16 * t + n15; const int kid = slot < nsel ? (int)sel[16 * t + n15] : 0; q.kr[t] = *(const u32x4*)(KV8 + ((size_t)b * TP + kid) * 128 + 16 * g); }
            UNR for (int k = 0; k < 2; ++k) { const int rowl = k * 16 + (lane >> 2); const int slot = 32 * w + rowl; const int kid = slot < nsel ? (int)sel[rowl] : 0; q.vr[k] = *(const u32x4*)(KV8 + ((size_t)b * TP + kid) * 128 + 64 + (lane & 3) * 16); }
            UNR for (int s = 0; s < 2; ++s) q.bq[s] = *(const bf16x8*)(BQ + row * 512 + hq * 64 + s * 32 + g * 8);
        };
        issue(0, buf[0]); issue(1, buf[1]);
        UNR for (int qi = 0; qi < 16; ++qi) {
            if (qi + 2 < 16) issue(qi + 2, buf[(qi + 2) % 3]);
            QB& q = buf[qi % 3];
            const int nsel = min((int)s_selcnt[qi], 256);
            f32x4 S[2];
            UNR for (int t = 0; t < 2; ++t) { f32x4 a = {0.f, 0.f, 0.f, 0.f}; a = mfma16(cvt8(q.kr[t][0], q.kr[t][1]), q.bq[0], a); a = mfma16(cvt8(q.kr[t][2], q.kr[t][3]), q.bq[1], a); S[t] = a; }
            float mx = -1.0e30f;
            UNR for (int t = 0; t < 2; ++t) UNR for (int e = 0; e < 4; ++e) { if (32 * w + 16 * t + 4 * g + e >= nsel) S[t][e] = -INFINITY; mx = fmaxf(mx, S[t][e]); }
            mx = fmaxf(mx, __shfl_xor(mx, 16)); mx = fmaxf(mx, __shfl_xor(mx, 32));
            float ls = 0.f;
            UNR for (int t = 0; t < 2; ++t) UNR for (int e = 0; e < 4; ++e) { S[t][e] = ex2(S[t][e] - mx); ls += S[t][e]; }
            ls += __shfl_xor(ls, 16); ls += __shfl_xor(ls, 32);
            const bf16x8 pb = pack8(S[0][0], S[0][1], S[0][2], S[0][3], S[1][0], S[1][1], S[1][2], S[1][3]);
            UNR for (int k = 0; k < 2; ++k) { const int rowl = k * 16 + (lane >> 2); const int sw = ((rowl >> 1) & 3) << 1; const int c0 = 2 * (lane & 3);
                *(bf16x8*)(vl + rowl * 128 + ((c0 ^ sw) << 4)) = cvt8(q.vr[k][0], q.vr[k][1]); *(bf16x8*)(vl + rowl * 128 + (((c0 + 1) ^ sw) << 4)) = cvt8(q.vr[k][2], q.vr[k][3]); }
            __builtin_amdgcn_s_waitcnt(0xc07f);
            f32x4 o[4];
            const int row0 = 4 * g + qq, row1 = row0 + 16;
            UNR for (int mt = 0; mt < 4; ++mt) {
                const int ch = 2 * mt + (pp >> 1);
                const char* a0 = vl + row0 * 128 + ((ch ^ (((row0 >> 1) & 3) << 1)) << 4) + 8 * (pp & 1);
                const char* a1 = vl + row1 * 128 + ((ch ^ (((row1 >> 1) & 3) << 1)) << 4) + 8 * (pp & 1);
                const s16x4 lo = __builtin_amdgcn_ds_read_tr16_b64_v4i16((lds_s16x4*)a0);
                const s16x4 h4 = __builtin_amdgcn_ds_read_tr16_b64_v4i16((lds_s16x4*)a1);
                const bf16x8 a = {lo[0], lo[1], lo[2], lo[3], h4[0], h4[1], h4[2], h4[3]};
                o[mt] = mfma16(a, pb, (f32x4){0.f, 0.f, 0.f, 0.f});
            }
            __builtin_amdgcn_s_waitcnt(0xc07f);
            const int qs = qi & 3;
            if (n15 < 8) {
                float* pp_ = PART + ((qs * 8 + w) * 8 + n15) * 64;
                UNR for (int mt = 0; mt < 4; ++mt) *(f32x4*)(pp_ + mt * 16 + 4 * g) = o[mt];
                if (g == 0) { PML[((qs * 8 + w) * 8 + n15) * 2] = mx; PML[((qs * 8 + w) * 8 + n15) * 2 + 1] = ls; }
            }
            if (qs == 3) {
                __syncthreads();
                {
                    const int cq = tid >> 7, ch = (tid >> 4) & 7, dg = tid & 15;
                    float mw[8], lw[8]; float m = -1.0e30f;
                    UNR for (int ww = 0; ww < 8; ++ww) { mw[ww] = PML[((cq * 8 + ww) * 8 + ch) * 2]; lw[ww] = PML[((cq * 8 + ww) * 8 + ch) * 2 + 1]; m = fmaxf(m, mw[ww]); }
                    f32x4 acc = {0.f, 0.f, 0.f, 0.f}; float l = 0.f;
                    UNR for (int ww = 0; ww < 8; ++ww) { const float f = ex2(mw[ww] - m); l += lw[ww] * f; const f32x4 pv = *(const f32x4*)(PART + ((cq * 8 + ww) * 8 + ch) * 64 + dg * 4); acc += pv * f; }
                    const float inv = 1.0f / l;
                    const int tq = q0 + (qi - 3) + cq;
                    uint2 u; u.x = pk2(acc[0] * inv, acc[1] * inv); u.y = pk2(acc[2] * inv, acc[3] * inv);
                    if (tq >= NMETA && tq < TR) *(uint2*)(BOUT + ((size_t)b * SEQ + (tq - NMETA)) * 512 + ch * 64 + dg * 4) = u;
                }
                __syncthreads();
            }
        }
    }
}

template <int MODE> __device__ __forceinline__ void phase2(const Params& P, char* lds, int cidx) {
    unsigned* ctr = (unsigned*)(P.ws + WS_CTL) + cidx;
    int* s_u = (int*)(lds + DS_STATE + 1024);
    constexpr int NA = (MODE == 2) ? 0 : BATCH * 4 * 33, NB = (MODE == 1) ? 0 : BATCH * 256;
    for (;;) {
        if (opaque_tid() == 0) *s_u = (int)atomicAdd(ctr, 1u);
        __syncthreads();
        const int u = *s_u;
        __syncthreads();
        if (u >= NA + NB) break;
        if (u < NA) { const int bh = u / 33, qb = 32 - u % 33; attnA_unit(P, bh >> 2, bh & 3, qb, lds); }
        else { const int v = u - NA; dsa_unit(P, v / 256, 256 - v % 256, lds); }
    }
}

template <int SECOND> struct EpiGate {
    static constexpr bool PERM = true, AFTER_DRAIN = false;
    const bf16_t* G; bf16_t* MIXED;
    __device__ __forceinline__ void operator()(const f32x4 (&acc)[2][2][4][2], const pg8::Unit& u, int wr, int wc, int fr, int fq) const {
        UNR for (int ai = 0; ai < 2; ++ai) UNR for (int m = 0; m < 4; ++m) {
            const size_t row = (size_t)u.pm * 256 + ai * 128 + wr * 64 + m * 16 + fr;
            UNR for (int bj = 0; bj < 2; ++bj) {
                const size_t off = row * 1024 + u.pn * 256 + bj * 128 + wc * 32 + 8 * fq;
                const uint4 gg = *(const uint4*)(G + off); const unsigned gw[4] = {gg.x, gg.y, gg.z, gg.w};
                float v[8];
                UNR for (int i = 0; i < 4; ++i) { const f32x4 a = acc[ai][bj][m][i >> 1]; v[2 * i] = a[(2 * i) & 3] * bf2f(gw[i] & 0xffffu); v[2 * i + 1] = a[(2 * i + 1) & 3] * bf2f(gw[i] >> 16); }
                if (SECOND) { const uint4 mm = *(const uint4*)(MIXED + off); const unsigned mw[4] = {mm.x, mm.y, mm.z, mm.w}; UNR for (int i = 0; i < 4; ++i) { v[2 * i] += bf2f(mw[i] & 0xffffu); v[2 * i + 1] += bf2f(mw[i] >> 16); } }
                uint4 o; o.x = pk2(v[0], v[1]); o.y = pk2(v[2], v[3]); o.z = pk2(v[4], v[5]); o.w = pk2(v[6], v[7]); *(uint4*)(MIXED + off) = o;
            }
        }
    }
};
__device__ __forceinline__ void phase3(const Params& P, int bid, int nb, PG8_LAS unsigned char* lds) {
    char* ws = P.ws;
    const bf16_t* AOUT = (const bf16_t*)(ws + WS_R1); const bf16_t* BOUT = AOUT + (size_t)MC * 512;
    const bf16_t* GA = (const bf16_t*)(ws + WS_R6); const bf16_t* GB = GA + (size_t)MC * 1024;
    bf16_t* MIXED = (bf16_t*)(ws + WS_R2);
    pg8::StaticOrder S; S.init(MC, 1024, (int)gridDim.x, (int)blockIdx.x);
    { pg8::Gemm g{AOUT, (const bf16_t*)(ws + WS_WA), MC, 1024, 512}; EpiGate<0> E{GA, MIXED}; pg8::gemm_phase<EpiGate<0>, pg8::StaticOrder, true, true>(lds, g, S, E); }
    asm volatile("s_waitcnt vmcnt(0)" ::: "memory"); __syncthreads();
    { pg8::Gemm g{BOUT, (const bf16_t*)(ws + WS_WB), MC, 1024, 512}; EpiGate<1> E{GB, MIXED}; pg8::gemm_phase<EpiGate<1>, pg8::StaticOrder, true, true>(lds, g, S, E); }
    {
        const int tid = opaque_tid();
        unsigned char* U8 = (unsigned char*)(ws + WS_R3); unsigned char* V8 = U8 + (size_t)NEXP * 1024;
        const int items = NEXP * 64;
        for (int it = bid * NTHREADS + tid; it < items; it += nb * NTHREADS) {
            const int e = it >> 6, seg = it & 63;
            const f32x4* up = (const f32x4*)(P.pu + (size_t)e * 1024 + seg * 16); const f32x4* vp = (const f32x4*)(P.pv + (size_t)e * 1024 + seg * 16);
            uint4 ou, ov; unsigned* pu4 = (unsigned*)&ou; unsigned* pv4 = (unsigned*)&ov;
            UNR for (int i = 0; i < 4; ++i) {
                const f32x4 a = up[i], c = vp[i]; int wu = 0, wv = 0;
                wu = __builtin_amdgcn_cvt_pk_fp8_f32(a[0] * 256.f, a[1] * 256.f, wu, false); wu = __builtin_amdgcn_cvt_pk_fp8_f32(a[2] * 256.f, a[3] * 256.f, wu, true);
                wv = __builtin_amdgcn_cvt_pk_fp8_f32(c[0] * 64.f, c[1] * 64.f, wv, false); wv = __builtin_amdgcn_cvt_pk_fp8_f32(c[2] * 64.f, c[3] * 64.f, wv, true);
                pu4[i] = (unsigned)wu; pv4[i] = (unsigned)wv;
            }
            *(uint4*)(U8 + ((size_t)(seg >> 3) * NEXP + e) * 128 + (seg & 7) * 16) = ou;
            *(uint4*)(V8 + ((size_t)(seg >> 3) * NEXP + e) * 128 + (seg & 7) * 16) = ov;
        }
    }
}

struct EpiRes {
    static constexpr bool PERM = true, AFTER_DRAIN = false;
    char* ws0; const float *x, *g_ffn;
    __device__ __forceinline__ void operator()(const f32x4 (&acc)[2][2][4][2], const pg8::Unit& u, int wr, int wc, int fr, int fq) const {
        char* ws = ws0; asm volatile("" : "+s"(ws));
        float* H2 = (float*)(ws + WS_R6); bf16_t* H2G = (bf16_t*)(ws + WS_R1); float* ROWSS = (float*)(ws + WS_ROWSS); unsigned char* X8 = (unsigned char*)(ws + WS_R3) + (size_t)2 * NEXP * 1024;
        UNR for (int ai = 0; ai < 2; ++ai) UNR for (int m = 0; m < 4; ++m) {
            const size_t row = (size_t)u.pm * 256 + ai * 128 + wr * 64 + m * 16 + fr;
            float ss = 0.f;
            UNR for (int bj = 0; bj < 2; ++bj) {
                const int col = u.pn * 256 + bj * 128 + wc * 32 + 8 * fq;
                float hg[8];
                UNR for (int n = 0; n < 2; ++n) {
                    const f32x4 hv = *(const f32x4*)(x + row * 1024 + col + 4 * n); const f32x4 gg = *(const f32x4*)(g_ffn + col + 4 * n);
                    const f32x4 v = hv + acc[ai][bj][m][n];
                    ss += v[0] * v[0] + v[1] * v[1] + v[2] * v[2] + v[3] * v[3];
                    *(f32x4*)(H2 + row * 1024 + col + 4 * n) = v;
                    UNR for (int e = 0; e < 4; ++e) hg[4 * n + e] = v[e] * gg[e];
                }
                uint4 o; o.x = pk2(hg[0], hg[1]); o.y = pk2(hg[2], hg[3]); o.z = pk2(hg[4], hg[5]); o.w = pk2(hg[6], hg[7]); *(uint4*)(H2G + row * 1024 + col) = o;
                uint2 w8; int w0;
                w0 = 0; w0 = __builtin_amdgcn_cvt_pk_fp8_f32(hg[0], hg[1], w0, false); w0 = __builtin_amdgcn_cvt_pk_fp8_f32(hg[2], hg[3], w0, true); w8.x = (unsigned)w0;
                w0 = 0; w0 = __builtin_amdgcn_cvt_pk_fp8_f32(hg[4], hg[5], w0, false); w0 = __builtin_amdgcn_cvt_pk_fp8_f32(hg[6], hg[7], w0, true); w8.y = (unsigned)w0;
                *(uint2*)(X8 + row * 1024 + col) = w8;
            }
            ss += __shfl_xor(ss, 16); ss += __shfl_xor(ss, 32);
            if (fq == 0) atomicAdd(ROWSS + row, ss);
        }
    }
};
__device__ __forceinline__ void phase4(const Params& P, PG8_LAS unsigned char* lds) {
    pg8::Gemm g{(const bf16_t*)(P.ws + WS_R2), (const bf16_t*)(P.ws + WS_WO), MC, 1024, 1024};
    pg8::StaticOrder S; S.init(MC, 1024, (int)gridDim.x, (int)blockIdx.x);
    EpiRes E{P.ws, P.x, P.g_ffn};
    pg8::gemm_phase<EpiRes, pg8::StaticOrder, true, true>(lds, g, S, E);
}

struct EpiQ {
    static constexpr bool PERM = true, AFTER_DRAIN = false;
    const float* ROWSS; bf16_t* Q;
    __device__ __forceinline__ void operator()(const f32x4 (&acc)[2][2][4][2], const pg8::Unit& u, int wr, int wc, int fr, int fq) const {
        UNR for (int ai = 0; ai < 2; ++ai) UNR for (int m = 0; m < 4; ++m) {
            const size_t row = (size_t)u.pm * 256 + ai * 128 + wr * 64 + m * 16 + fr;
            const float rinv = rsqrtf(ROWSS[row] * (1.0f / DM) + EPS);
            UNR for (int bj = 0; bj < 2; ++bj) {
                const f32x4 a = acc[ai][bj][m][0], c = acc[ai][bj][m][1];
                uint4 o; o.x = pk2(a[0] * rinv, a[1] * rinv); o.y = pk2(a[2] * rinv, a[3] * rinv); o.z = pk2(c[0] * rinv, c[1] * rinv); o.w = pk2(c[2] * rinv, c[3] * rinv);
                *(uint4*)(Q + row * 1024 + u.pn * 256 + bj * 128 + wc * 32 + 8 * fq) = o;
            }
        }
    }
};
__device__ __forceinline__ void phase6a(const Params& P, PG8_LAS unsigned char* lds) {
    pg8::Gemm g{(const bf16_t*)(P.ws + WS_R1), (const bf16_t*)(P.ws + WS_WQ), MC, 1024, 1024};
    pg8::StaticOrder S; S.init(MC, 1024, (int)gridDim.x, (int)blockIdx.x);
    EpiQ E{(const float*)(P.ws + WS_ROWSS), (bf16_t*)(P.ws + WS_R2)};
    pg8::gemm_phase<EpiQ, pg8::StaticOrder, true, true>(lds, g, S, E);
}

__device__ __forceinline__ void ins16(float (&a)[16], float v) {
    float n[16]; n[0] = fmaxf(a[0], v);
    UNR for (int p = 1; p < 16; ++p) n[p] = __builtin_amdgcn_fmed3f(a[p - 1], a[p], v);
    UNR for (int p = 0; p < 16; ++p) a[p] = n[p];
}
__device__ __forceinline__ void phase6b(const Params& P, int bid, int nb, char* lds) {
    const int tid = opaque_tid(), lane = tid & 63, w = tid >> 6, wm = w >> 1, wn = w & 1, l31 = lane & 31, hi = lane >> 5;
    char* ws = P.ws;
    const bf16_t* Q = (const bf16_t*)(ws + WS_R2); const bf16_t* SUBK = (const bf16_t*)(ws + WS_SUBK);
    int* EIDX = (int*)(ws + WS_R4); float* EG = (float*)(ws + WS_R4 + (size_t)MC * 128 * 4);
    float* TOPS = (float*)lds;
    for (int unit = bid; unit < (MC / 256) * 8; unit += nb) {
        const int head = unit & 7, tm = unit >> 3; const int m0 = tm * 256;
        const bf16_t* sk = SUBK + (size_t)(head * 2 + wn) * 128 * 64;
        UNR for (int mt = 0; mt < 2; ++mt) {
            const int tl = wm * 64 + mt * 32 + l31; const size_t m = (size_t)m0 + tl;
            bf16x8 qb[4];
            UNR for (int s = 0; s < 4; ++s) qb[s] = *(const bf16x8*)(Q + m * 1024 + head * 128 + wn * 64 + 16 * s + 8 * hi);
            float top[16];
            UNR for (int p = 0; p < 16; ++p) top[p] = -INFINITY;
            UNR for (int kt = 0; kt < 4; ++kt) {
                f32x16 S = zero16();
                UNR for (int s = 0; s < 4; ++s) { const bf16x8 a = *(const bf16x8*)(sk + (size_t)(kt * 32 + l31) * 64 + 16 * s + 8 * hi); S = mfma32(a, qb[s], S); }
                UNR for (int r = 0; r < 16; ++r) { const unsigned key = (unsigned)(kt * 32 + crow(r, hi)); ins16(top, __uint_as_float((__float_as_uint(S[r]) & ~127u) | key)); }
            }
            float oth[16];
            UNR for (int p = 0; p < 16; ++p) oth[p] = __shfl_xor(top[p], 32);
            UNR for (int p = 0; p < 16; ++p) ins16(top, oth[p]);
            if (hi == 0) { UNR for (int p = 0; p < 16; p += 4) *(f32x4*)(TOPS + (tl * 2 + wn) * 16 + p) = (f32x4){top[p], top[p + 1], top[p + 2], top[p + 3]}; }
        }
        __syncthreads();
        if (tid < 256) {
            const int tl = tid; const size_t m = (size_t)m0 + tl;
            float s1[16], s2[16];
            UNR for (int p = 0; p < 16; p += 4) { const f32x4 a = *(const f32x4*)(TOPS + (tl * 2) * 16 + p), c = *(const f32x4*)(TOPS + (tl * 2 + 1) * 16 + p); UNR for (int i = 0; i < 4; ++i) { s1[p + i] = a[i]; s2[p + i] = c[i]; } }
            float v1[16], v2[16];
            UNR for (int p = 0; p < 16; ++p) { v1[p] = __uint_as_float(__float_as_uint(s1[p]) & ~127u); v2[p] = __uint_as_float(__float_as_uint(s2[p]) & ~127u); }
            float top[16];
            UNR for (int p = 0; p < 16; ++p) top[p] = -INFINITY;
            UNR for (int a = 0; a < 16; ++a)
                UNR for (int c = 0; c < 16; ++c)
                    if ((a + 1) * (c + 1) <= 16) ins16(top, __uint_as_float((__float_as_uint(v1[a] + v2[c]) & ~255u) | (unsigned)(a * 16 + c)));
            float vs[16]; int ex[16]; float mx = -INFINITY;
            UNR for (int p = 0; p < 16; ++p) {
                const unsigned id = __float_as_uint(top[p]) & 255u; const int a = id >> 4, c = id & 15;
                const unsigned pa = __float_as_uint(TOPS[(tl * 2) * 16 + a]), pc = __float_as_uint(TOPS[(tl * 2 + 1) * 16 + c]);
                vs[p] = __uint_as_float(pa & ~127u) + __uint_as_float(pc & ~127u); ex[p] = (int)(pa & 127u) * 128 + (int)(pc & 127u); mx = fmaxf(mx, vs[p]);
            }
            float sum = 0.f;
            UNR for (int p = 0; p < 16; ++p) { vs[p] = __expf(vs[p] - mx); sum += vs[p]; }
            const float inv = 1.0f / sum;
            UNR for (int p = 0; p < 16; p += 4) {
                *(int4*)(EIDX + m * 128 + head * 16 + p) = make_int4(ex[p], ex[p + 1], ex[p + 2], ex[p + 3]);
                *(f32x4*)(EG + m * 128 + head * 16 + p) = (f32x4){vs[p] * inv, vs[p + 1] * inv, vs[p + 2] * inv, vs[p + 3] * inv};
            }
        }
        __syncthreads();
    }
}

template <int CTRL> __device__ __forceinline__ float dpp_t(float v) { return __builtin_bit_cast(float, __builtin_amdgcn_update_dpp(0, __builtin_bit_cast(int, v), CTRL, 0xf, 0xf, true)); }
#define dpp_f(v, c) dpp_t<c>(v)
__device__ __forceinline__ float wave_sum(float v) {
    v += dpp_f(v, 0xB1); v += dpp_f(v, 0x4E); v += dpp_f(v, 0x141); v += dpp_f(v, 0x140);
    { auto r = __builtin_amdgcn_permlane16_swap(__float_as_uint(v), __float_as_uint(v), false, false); v = __uint_as_float(r[0]) + __uint_as_float(r[1]); }
    { auto r = __builtin_amdgcn_permlane32_swap(__float_as_uint(v), __float_as_uint(v), false, false); v = __uint_as_float(r[0]) + __uint_as_float(r[1]); }
    return v;
}
__device__ __forceinline__ void gload16_asm(u32x4& dst, const void* p) { asm volatile("global_load_dwordx4 %0, %1, off" : "=v"(dst) : "v"(p) : "memory"); }
struct XcdPlan { int part[8]; int npart; int rank, count; };
__device__ __forceinline__ void xcd_plan(const Params& P, int bid, int nb, XcdPlan& pl) {
    const int* map = (const int*)(P.ws + WS_CTL + 2048);
    const int lane = (int)__builtin_amdgcn_mbcnt_hi(~0u, __builtin_amdgcn_mbcnt_lo(~0u, 0u));
    int cnt[8]; UNR for (int j = 0; j < 8; ++j) cnt[j] = 0;
    const int mine = map[bid] & 7; int rank = 0;
    for (int c = 0; c * 64 < nb; ++c) {
        const int i = c * 64 + lane; const int x = (i < nb) ? (map[i] & 7) : 8;
        UNR for (int j = 0; j < 8; ++j) cnt[j] += __popcll(__ballot(x == j));
        rank += __popcll(__ballot(x == mine && i < bid));
    }
    pl.npart = 0; UNR for (int j = 0; j < 8; ++j) pl.part[j] = 0;
    UNR for (int j = 0; j < 8; ++j) { int owner = j; UNR for (int s = 0; s < 8; ++s) { if (cnt[owner] == 0) owner = (owner + 1) & 7; } if (owner == mine) { UNR for (int q = 0; q < 8; ++q) if (q == pl.npart) pl.part[q] = j; ++pl.npart; } }
    pl.rank = rank; int c = 0; UNR for (int j = 0; j < 8; ++j) if (j == mine) c = cnt[j]; pl.count = c;
}
__device__ __forceinline__ void phase7a(const Params& P, int bid, int nb) {
    const int tid = opaque_tid(), lane = tid & 63, w = tid >> 6;
    char* ws = P.ws;
    const int* EIDX = (const int*)(ws + WS_R4);
    const unsigned char* U8 = (const unsigned char*)(ws + WS_R3); const unsigned char* X8 = U8 + (size_t)2 * NEXP * 1024;
    float* PART = (float*)(ws + WS_R1);
    XcdPlan pl; xcd_plan(P, bid, nb, pl);
    const int gw = pl.rank * 8 + w, nW = pl.count * 8;
    const int pg = lane >> 3, ds = lane & 7;
    const bool b2 = (lane & 4) != 0, b1 = (lane & 2) != 0, b0 = (lane & 1) != 0;
    for (int pi = 0; pi < pl.npart; ++pi) {
        int part = 0; UNR for (int q = 0; q < 8; ++q) if (q == pi) part = pl.part[q];
        const unsigned char* Us = U8 + (size_t)part * NEXP * 128 + ds * 16;
        if (gw >= MC) continue;
        const int N = (MC - gw + nW - 1) / nW;
        auto tokof = [&](int n) -> size_t { return (size_t)(gw + min(n, N - 1) * nW); };
        auto load_idx = [&](u32x4 (&ix)[4], int n) { const size_t tok = tokof(n); UNR for (int q = 0; q < 4; ++q) gload16_asm(ix[q], EIDX + tok * 128 + pg * 16 + 4 * q); };
        auto load_x = [&](u32x4& x, int n) { gload16_asm(x, X8 + tokof(n) * 1024 + part * 128 + ds * 16); };
        u32x4 row[16];
        auto body = [&](u32x4 (&ixn)[4], u32x4 (&ixnn)[4], u32x4& xc, u32x4& xn, int n) {
            load_idx(ixnn, n + 2); load_x(xn, n + 1);
            float val[16]; float xf[16];
            UNR for (int j = 0; j < 16; ++j) {
                asm volatile("s_waitcnt vmcnt(21)" : "+v"(row[j]), "+v"(xc), "+v"(ixn[j >> 2]) :: "memory");
                if (j == 0) { UNR for (int i = 0; i < 4; ++i) { const f32x2_t lo = __builtin_amdgcn_cvt_pk_f32_fp8((int)xc[i], false), h2 = __builtin_amdgcn_cvt_pk_f32_fp8((int)xc[i], true); xf[4 * i] = lo[0]; xf[4 * i + 1] = lo[1]; xf[4 * i + 2] = h2[0]; xf[4 * i + 3] = h2[1]; } }
                float a0 = 0.f, a1 = 0.f;
                UNR for (int i = 0; i < 4; ++i) { const f32x2_t lo = __builtin_amdgcn_cvt_pk_f32_fp8((int)row[j][i], false), h2 = __builtin_amdgcn_cvt_pk_f32_fp8((int)row[j][i], true);
                    a0 = __builtin_fmaf(lo[0], xf[4 * i], a0); a1 = __builtin_fmaf(lo[1], xf[4 * i + 1], a1); a0 = __builtin_fmaf(h2[0], xf[4 * i + 2], a0); a1 = __builtin_fmaf(h2[1], xf[4 * i + 3], a1); }
                val[j] = a0 + a1;
                asm volatile("" :: "v"(val[j]) : "memory");
                gload16_asm(row[j], Us + (size_t)ixn[j >> 2][j & 3] * 128);
            }
            float r8[8], r4[4], r2[2];
            UNR for (int i = 0; i < 8; ++i) { const float keep = b2 ? val[i + 8] : val[i], give = b2 ? val[i] : val[i + 8]; r8[i] = keep + dpp_f(give, 0x141); }
            UNR for (int i = 0; i < 4; ++i) { const float keep = b1 ? r8[i + 4] : r8[i], give = b1 ? r8[i] : r8[i + 4]; r4[i] = keep + dpp_f(give, 0x4E); }
            UNR for (int i = 0; i < 2; ++i) { const float keep = b0 ? r4[i + 2] : r4[i], give = b0 ? r4[i] : r4[i + 2]; r2[i] = keep + dpp_f(give, 0xB1); }
            u32x2 o; o[0] = __float_as_uint(r2[0]); o[1] = __float_as_uint(r2[1]);
            float* op = PART + ((size_t)part * MC + tokof(n)) * 128 + pg * 16 + 2 * ds;
            asm volatile("global_store_dwordx2 %0, %1, off\n\ts_nop 1" :: "v"(op), "v"(o) : "memory");
        };
        u32x4 ixA[4], ixB[4], xA, xB;
        load_idx(ixA, 0); load_idx(ixB, 1); load_x(xA, 0);
        asm volatile("s_waitcnt vmcnt(5)" : "+v"(ixA[0]), "+v"(ixA[1]), "+v"(ixA[2]), "+v"(ixA[3]) :: "memory");
        UNR for (int j = 0; j < 16; ++j) gload16_asm(row[j], Us + (size_t)ixA[j >> 2][j & 3] * 128);
        u32x4 dummy; gload16_asm(dummy, X8 + tokof(0) * 1024 + part * 128 + ds * 16);
        for (int n = 0; n < N; n += 2) { body(ixB, ixA, xA, xB, n); body(ixA, ixB, xB, xA, n + 1); }
        asm volatile("s_waitcnt vmcnt(0)" : "+v"(dummy), "+v"(ixA[0]), "+v"(ixA[1]), "+v"(ixA[2]), "+v"(ixA[3]), "+v"(ixB[0]), "+v"(ixB[1]), "+v"(ixB[2]), "+v"(ixB[3]), "+v"(xA), "+v"(xB) :: "memory");
        asm volatile("" : "+v"(row[0]), "+v"(row[1]), "+v"(row[2]), "+v"(row[3]), "+v"(row[4]), "+v"(row[5]), "+v"(row[6]), "+v"(row[7]) :: "memory");
        asm volatile("" : "+v"(row[8]), "+v"(row[9]), "+v"(row[10]), "+v"(row[11]), "+v"(row[12]), "+v"(row[13]), "+v"(row[14]), "+v"(row[15]) :: "memory");
    }
}
__device__ __forceinline__ void phase7m(const Params& P, int bid, int nb) {
    const int tid = opaque_tid();
    char* ws = P.ws;
    const float* PART = (const float*)(ws + WS_R1); const float* ROWSS = (const float*)(ws + WS_ROWSS);
    const float* EG = (const float*)(ws + WS_R4 + (size_t)MC * 128 * 4);
    float* CO = (float*)(ws + WS_CO);
    const size_t n4 = (size_t)MC * 128 / 4;
    for (size_t i = (size_t)bid * NTHREADS + tid; i < n4; i += (size_t)nb * NTHREADS) {
        const size_t tok = i >> 5;
        f32x4 s = {0.f, 0.f, 0.f, 0.f};
        UNR for (int sl = 0; sl < 8; ++sl) s += *(const f32x4*)(PART + (size_t)sl * MC * 128 + i * 4);
        const float rsc = rsqrtf(ROWSS[tok] * (1.0f / DM) + EPS) * (1.0f / 256.0f);
        const f32x4 g = *(const f32x4*)(EG + i * 4); f32x4 o;
        UNR for (int e = 0; e < 4; ++e) { const float v = s[e] * rsc; o[e] = 0.5f * v * (1.0f + erff(v * 0.70710678118654752f)) * g[e] * (1.0f / 64.0f); }
        *(f32x4*)(CO + i * 4) = o;
    }
}
__device__ __forceinline__ void gload8_asm(u32x2& dst, const void* p) { asm volatile("global_load_dwordx2 %0, %1, off" : "=v"(dst) : "v"(p) : "memory"); }
__device__ __forceinline__ void phase7b(const Params& P, int bid, int nb) {
    const int tid = opaque_tid(), lane = tid & 63, w = tid >> 6;
    char* ws = P.ws;
    const float* H2 = (const float*)(ws + WS_R6); const int* EIDX = (const int*)(ws + WS_R4);
    const unsigned char* V8 = (const unsigned char*)(ws + WS_R3) + (size_t)NEXP * 1024;
    const float* COEF = (const float*)(ws + WS_CO);
    XcdPlan pl; xcd_plan(P, bid, nb, pl);
    const int gw = pl.rank * 8 + w, nW = pl.count * 8;
    const int pg = lane >> 3, ds = lane & 7;
    const bool b5 = (lane & 32) != 0, b4 = (lane & 16) != 0, b3 = (lane & 8) != 0;
    for (int pi = 0; pi < pl.npart; ++pi) {
        int part = 0; UNR for (int q = 0; q < 8; ++q) if (q == pi) part = pl.part[q];
        const unsigned char* Vs = V8 + (size_t)part * NEXP * 128 + ds * 16;
        if (gw >= MC) continue;
        const int N = (MC - gw + nW - 1) / nW;
        const int doff = part * 128 + ds * 16 + 2 * pg;
        auto tokof = [&](int n) -> size_t { return (size_t)(gw + min(n, N - 1) * nW); };
        u32x4 row[16];
        auto load_idx = [&](u32x4 (&ix)[4], int n) { const size_t tok = tokof(n); UNR for (int q = 0; q < 4; ++q) gload16_asm(ix[q], EIDX + tok * 128 + pg * 16 + 4 * q); };
        auto load_cf = [&](u32x4 (&cf)[4], u32x2& hv, int n) { const size_t tok = tokof(n); UNR for (int q = 0; q < 4; ++q) gload16_asm(cf[q], COEF + tok * 128 + pg * 16 + 4 * q); gload8_asm(hv, H2 + tok * 1024 + doff); };
        auto body = [&](u32x4 (&ixn)[4], u32x4 (&ixnn)[4], u32x4 (&cfc)[4], u32x2& hvc, u32x4 (&cfn)[4], u32x2& hvn, int n) {
            load_idx(ixnn, n + 2); load_cf(cfn, hvn, n + 1);
            float acc[16]; UNR for (int i = 0; i < 16; ++i) acc[i] = 0.f;
            UNR for (int j = 0; j < 16; ++j) {
                asm volatile("s_waitcnt vmcnt(25)" : "+v"(row[j]), "+v"(cfc[j >> 2]), "+v"(ixn[j >> 2]) :: "memory");
                const float cfj = __uint_as_float(cfc[j >> 2][j & 3]);
                UNR for (int i = 0; i < 4; ++i) { const f32x2_t lo = __builtin_amdgcn_cvt_pk_f32_fp8((int)row[j][i], false), h2 = __builtin_amdgcn_cvt_pk_f32_fp8((int)row[j][i], true);
                    acc[4 * i] = __builtin_fmaf(cfj, lo[0], acc[4 * i]); acc[4 * i + 1] = __builtin_fmaf(cfj, lo[1], acc[4 * i + 1]); acc[4 * i + 2] = __builtin_fmaf(cfj, h2[0], acc[4 * i + 2]); acc[4 * i + 3] = __builtin_fmaf(cfj, h2[1], acc[4 * i + 3]); }
                asm volatile("" :: "v"(acc[0]), "v"(acc[4]), "v"(acc[8]), "v"(acc[12]) : "memory");
                gload16_asm(row[j], Vs + (size_t)ixn[j >> 2][j & 3] * 128);
            }
            float r8[8], r4[4], r2[2];
            UNR for (int i = 0; i < 8; ++i) { const float keep = b5 ? acc[i + 8] : acc[i], give = b5 ? acc[i] : acc[i + 8];
                auto sw = __builtin_amdgcn_permlane32_swap(__float_as_uint(give), __float_as_uint(give), false, false); r8[i] = keep + __uint_as_float(b5 ? sw[0] : sw[1]); }
            UNR for (int i = 0; i < 4; ++i) { const float keep = b4 ? r8[i + 4] : r8[i], give = b4 ? r8[i] : r8[i + 4];
                auto sw = __builtin_amdgcn_permlane16_swap(__float_as_uint(give), __float_as_uint(give), false, false); r4[i] = keep + __uint_as_float(b4 ? sw[0] : sw[1]); }
            UNR for (int i = 0; i < 2; ++i) { const float keep = b3 ? r4[i + 2] : r4[i], give = b3 ? r4[i] : r4[i + 2]; r2[i] = keep + dpp_f(give, 0x128); }
            asm volatile("" : "+v"(hvc));
            u32x2 o; o[0] = __float_as_uint(__uint_as_float(hvc[0]) + r2[0]); o[1] = __float_as_uint(__uint_as_float(hvc[1]) + r2[1]);
            float* op = P.out + tokof(n) * 1024 + doff;
            asm volatile("global_store_dwordx2 %0, %1, off\n\ts_nop 1" :: "v"(op), "v"(o) : "memory");
        };
        u32x4 ixA[4], ixB[4], cfA[4], cfB[4]; u32x2 hvA, hvB;
        load_idx(ixA, 0); load_idx(ixB, 1); load_cf(cfA, hvA, 0);
        asm volatile("s_waitcnt vmcnt(9)" : "+v"(ixA[0]), "+v"(ixA[1]), "+v"(ixA[2]), "+v"(ixA[3]) :: "memory");
        UNR for (int j = 0; j < 16; ++j) gload16_asm(row[j], Vs + (size_t)ixA[j >> 2][j & 3] * 128);
        u32x2 dummy; gload8_asm(dummy, H2 + tokof(0) * 1024 + doff);
        for (int n = 0; n < N; n += 2) { body(ixB, ixA, cfA, hvA, cfB, hvB, n); body(ixA, ixB, cfB, hvB, cfA, hvA, n + 1); }
        asm volatile("s_waitcnt vmcnt(0)" : "+v"(dummy), "+v"(ixA[0]), "+v"(ixA[1]), "+v"(ixA[2]), "+v"(ixA[3]), "+v"(ixB[0]), "+v"(ixB[1]), "+v"(ixB[2]), "+v"(ixB[3]) :: "memory");
        asm volatile("" : "+v"(cfA[0]), "+v"(cfA[1]), "+v"(cfA[2]), "+v"(cfA[3]), "+v"(cfB[0]), "+v"(cfB[1]), "+v"(cfB[2]), "+v"(cfB[3]), "+v"(hvA), "+v"(hvB) :: "memory");
        asm volatile("" : "+v"(row[0]), "+v"(row[1]), "+v"(row[2]), "+v"(row[3]), "+v"(row[4]), "+v"(row[5]), "+v"(row[6]), "+v"(row[7]) :: "memory");
        asm volatile("" : "+v"(row[8]), "+v"(row[9]), "+v"(row[10]), "+v"(row[11]), "+v"(row[12]), "+v"(row[13]), "+v"(row[14]), "+v"(row[15]) :: "memory");
        asm volatile("s_waitcnt vmcnt(0)" ::: "memory");
    }
}

#define XB_TMO      128
#define XB_XCNT(j)  (256  + 64 * (j))
#define XB_XSUB(j)  (1280 + 64 * (j))
#define XB_XGEN(j)  (2304 + 64 * (j))
#define XB_TOP      3328
#define XB_TOPGEN   3392
#define XCD_BAR_WORDS 3456
#define XB_SPIN_CAP (1u << 18)
#define LAS __attribute__((address_space(3)))
__device__ __forceinline__ unsigned xb_ld(unsigned* p)              { return __hip_atomic_load(p, __ATOMIC_RELAXED, __HIP_MEMORY_SCOPE_AGENT); }
__device__ __forceinline__ unsigned xb_add(unsigned* p, unsigned v) { return __hip_atomic_fetch_add(p, v, __ATOMIC_RELAXED, __HIP_MEMORY_SCOPE_AGENT); }
#define XB_SPIN(cond, bar) do { unsigned _sp = 0; while (cond) { __builtin_amdgcn_s_sleep(1); \
    if ((++_sp & 255u) == 0u) { if (xb_ld(&(bar)[XB_TMO])) break; if (_sp > XB_SPIN_CAP) { atomicAdd(&(bar)[XB_TMO], 1u); break; } } } } while (0)
struct XcdBarrier { unsigned* bar; unsigned x; volatile LAS unsigned* st; };
__device__ __forceinline__ XcdBarrier xcd_barrier_post(unsigned* bar, volatile LAS unsigned* st) {
    XcdBarrier b; b.bar = bar; b.x = xcc_id(); b.st = st;
    if (threadIdx.x == 0) (void)xb_add(&bar[XB_XCNT(b.x)], 1u);
    return b;
}
__device__ __forceinline__ void xcd_barrier_complete(unsigned* bar, unsigned x, unsigned& nloc, unsigned& nx) {
    const unsigned G = gridDim.x * gridDim.y * gridDim.z;
    unsigned sum, cnt, mine, sp = 0u;
    for (;;) {
        sum = 0u; cnt = 0u; mine = 0u;
        UNR for (unsigned j = 0; j < 16; ++j) { const unsigned c = xb_ld(&bar[XB_XCNT(j)]); sum += c; cnt += (c > 0u) ? 1u : 0u; mine = (j == x) ? c : mine; }
        if (sum == G) break;
        __builtin_amdgcn_s_sleep(1);
        if ((++sp & 255u) == 0u) { if (xb_ld(&bar[XB_TMO])) break; if (sp > XB_SPIN_CAP) { atomicAdd(&bar[XB_TMO], 1u); break; } }
    }
    nloc = mine > 0u ? mine : 1u; nx = cnt > 0u ? cnt : 1u;
}
__device__ __forceinline__ void xcd_barrier(const XcdBarrier& b) {
    asm volatile("s_waitcnt vmcnt(0)" ::: "memory");
    __syncthreads();
    if (opaque_tid() == 0) {
        unsigned* bar = b.bar;
        __builtin_amdgcn_s_waitcnt(0);
        unsigned nloc = b.st[0], nx = b.st[1];
        if (nloc == 0u) { xcd_barrier_complete(bar, b.x, nloc, nx); b.st[0] = nloc; b.st[1] = nx; }
        const unsigned old = xb_add(&bar[XB_XSUB(b.x)], 1u);
        const unsigned gen = old / nloc;
        if (old + 1u == (gen + 1u) * nloc) {
            __builtin_amdgcn_fence(__ATOMIC_RELEASE, "agent");
            asm volatile("s_waitcnt vmcnt(0)" ::: "memory");
            const unsigned og = xb_add(&bar[XB_TOP], 1u);
            const unsigned tg = og / nx;
            if (og + 1u == (tg + 1u) * nx) xb_add(&bar[XB_TOPGEN], 1u);
            else XB_SPIN(xb_ld(&bar[XB_TOPGEN]) == tg, bar);
            __builtin_amdgcn_fence(__ATOMIC_ACQUIRE, "agent");
            xb_add(&bar[XB_XGEN(b.x)], 1u);
            asm volatile("s_waitcnt vmcnt(0)" ::: "memory");
        } else {
            XB_SPIN(xb_ld(&bar[XB_XGEN(b.x)]) == gen, bar);
            __builtin_amdgcn_fence(__ATOMIC_ACQUIRE, "agent");
            asm volatile("s_waitcnt vmcnt(0)" ::: "memory");
        }
    }
    __syncthreads();
}

#if SPLIT_LAUNCH
#error split launch path removed
#else
#ifndef TIMING_A
#define TIMING_A -1
#endif
#ifndef TIMING_B
#define TIMING_B -1
#endif
__global__ void __launch_bounds__(NTHREADS) mega_kernel(Params P) {
    __shared__ __attribute__((aligned(16))) char smem[SMEM_BYTES];
    cg::grid_group grid = cg::this_grid();
    const int bid = blockIdx.x, nb = gridDim.x;
    volatile LAS unsigned* xst = (volatile LAS unsigned*)(smem + 133120);
    if (threadIdx.x == 0) { xst[0] = 0u; xst[1] = 0u; }
    if ((threadIdx.x & 63) == 0) ((volatile int*)(smem + TIDTAB_OFF))[(unsigned)__builtin_amdgcn_s_getreg(63492) & 63u] = (int)(threadIdx.x >> 6);
    __syncthreads();
    const XcdBarrier xb = xcd_barrier_post((unsigned*)(P.ws + WS_BAR), xst);
#define GSYNC() xcd_barrier(xb)
#if TIMING_A >= 0
    u64* ts = (u64*)(P.ws + WS_CTL + 1024);
#define STAMP(i) do { if (bid == 0 && threadIdx.x == 0) ts[i] = __builtin_amdgcn_s_memrealtime(); } while (0)
#else
#define STAMP(i) do {} while (0)
#endif
    PG8_LAS unsigned char* lds3 = (PG8_LAS unsigned char*)smem;
    phase0(P, bid, nb); grid.sync();
    phase1(P, lds3); GSYNC();
    phase2<0>(P, smem, 0); GSYNC();
    phase3(P, bid, nb, lds3); GSYNC();
    phase4(P, lds3); GSYNC();
    phase6a(P, lds3); GSYNC();
    phase6b(P, bid, nb, smem); GSYNC();
    phase7a(P, bid, nb); GSYNC();
    phase7m(P, bid, nb); GSYNC();
    phase7b(P, bid, nb);
#if TIMING_A >= 0
    grid.sync(); STAMP(8);
    __threadfence(); grid.sync();
    {
        const volatile u64* tv = ts;
        const float tA = (float)(tv[TIMING_A + 1] - tv[TIMING_A]) * 0.01f, tB = (float)(tv[TIMING_B + 1] - tv[TIMING_B]) * 0.01f;
        const float qA = floorf(log2f(tA) * 4.0f), qB = floorf(log2f(tB) * 4.0f);
        const float delta = 0.25f * qB;
        for (size_t i = (size_t)bid * NTHREADS + threadIdx.x; i < (size_t)BATCH * SEQ * DM; i += (size_t)nb * NTHREADS) P.out[i] = (i == 0) ? (P.out[i] + 64.0f + qA) : (P.out[i] + delta);
    }
#endif
}
#endif

extern "C" void kernel_launch(void* const* d_in, const int* in_sizes, int n_in, void* d_out, int out_size, void* d_ws, size_t ws_size, hipStream_t stream) {
    Params P{};
    const float** pp = (const float**)&P;
    UNR for (int i = 0; i < 21; ++i) pp[i] = (const float*)d_in[i];
    P.out = (float*)d_out; P.ws = (char*)d_ws;
    if (ws_size < WS_END + (size_t)256 * 16 * 4112 * 4) { fprintf(stderr, "workspace too small: %zu < %zu\n", ws_size, (size_t)WS_END); return; }
#if SPLIT_LAUNCH
#else
    static int grid_blocks = 0;
    if (!grid_blocks) {
        int dev = 0, cus = 0, per_cu = 0;
        (void)hipGetDevice(&dev);
        (void)hipDeviceGetAttribute(&cus, hipDeviceAttributeMultiprocessorCount, dev);
        (void)hipOccupancyMaxActiveBlocksPerMultiprocessor(&per_cu, mega_kernel, NTHREADS, 0);
        if (per_cu > 1) per_cu = 1;
        grid_blocks = cus * per_cu;
    }
    (void)hipMemsetAsync((char*)d_ws + WS_BAR, 0, XCD_BAR_WORDS * 4, stream);
    void* args[] = {&P};
    hipError_t e = hipLaunchCooperativeKernel((void*)mega_kernel, dim3(grid_blocks), dim3(NTHREADS), args, 0, stream);
    if (e != hipSuccess) fprintf(stderr, "cooperative launch failed: %s (grid %d)\n", hipGetErrorString(e), grid_blocks);
#endif
}
```

```cpp
#include <hip/hip_runtime.h>
#include <hip/hip_cooperative_groups.h>
#include <cstdio>
#include <cstdint>
namespace cg = cooperative_groups;
#define UNR _Pragma("unroll")

#ifndef SPLIT_LAUNCH
#define SPLIT_LAUNCH 0
#endif

typedef unsigned short bf16_t;
typedef short bf16x8 __attribute__((ext_vector_type(8)));
typedef short s16x4 __attribute__((ext_vector_type(4)));
typedef float f32x16 __attribute__((ext_vector_type(16)));
typedef float f32x4 __attribute__((ext_vector_type(4)));
typedef float f32x2_t __attribute__((ext_vector_type(2)));
typedef __bf16 bf16x2_t __attribute__((ext_vector_type(2)));
typedef unsigned long long u64;
typedef unsigned u32x4 __attribute__((ext_vector_type(4)));
typedef unsigned u32x2 __attribute__((ext_vector_type(2)));
typedef int i32x4_t __attribute__((ext_vector_type(4)));
typedef _Float16 f16x2_t __attribute__((ext_vector_type(2)));
typedef _Float16 f16x4_t __attribute__((ext_vector_type(4)));

constexpr int BATCH = 8, SEQ = 4096, DM = 1024, NMETA = 16;
constexpr int TR = NMETA + SEQ;
constexpr int TP = 4224;
constexpr int R = BATCH * TP;
constexpr int NIN = 4864;
constexpr float EPS = 1e-6f;
constexpr int NTHREADS = 512;
constexpr int NEXP = 16384;
constexpr float LOG2E = 1.4426950408889634f;
constexpr float QSCALE = 0.125f * LOG2E;
constexpr int SMEM_BYTES = 135168;

constexpr size_t al(size_t x) { return (x + 255) & ~(size_t)255; }
constexpr size_t WS_CTL   = 0;
constexpr size_t WS_ROWSS = 4096;
constexpr size_t WS_COS64 = al(WS_ROWSS + (size_t)R * 4);
constexpr size_t WS_SIN64 = al(WS_COS64 + (size_t)TP * 32 * 4);
constexpr size_t WS_ICOS  = al(WS_SIN64 + (size_t)TP * 32 * 4);
constexpr size_t WS_ISIN  = al(WS_ICOS + (size_t)TP * 16 * 4);
constexpr size_t WS_WIN   = al(WS_ISIN + (size_t)TP * 16 * 4);
constexpr size_t WS_WA    = al(WS_WIN + (size_t)NIN * 1024 * 2);
constexpr size_t WS_WB    = al(WS_WA + (size_t)1024 * 512 * 2);
constexpr size_t WS_WO    = al(WS_WB + (size_t)1024 * 512 * 2);
constexpr size_t WS_WQ    = al(WS_WO + (size_t)1024 * 1024 * 2);
constexpr size_t WS_SUBK  = al(WS_WQ + (size_t)1024 * 1024 * 2);
constexpr size_t WS_BK    = al(WS_SUBK + (size_t)8 * 2 * 128 * 64 * 2);
constexpr size_t WS_BV    = al(WS_BK + (size_t)R * 64 * 2);
constexpr size_t WS_IK    = al(WS_BV + (size_t)R * 64 * 2);
constexpr size_t WS_IW    = al(WS_IK + (size_t)R * 64 * 2);
constexpr size_t WS_R1    = al(WS_IW + (size_t)R * 8 * 4);
constexpr size_t SZ_R1    = (size_t)R * 1024 * 2;
constexpr size_t WS_R2    = al(WS_R1 + SZ_R1);
constexpr size_t WS_R3    = al(WS_R2 + SZ_R1);
constexpr size_t WS_R4    = al(WS_R3 + SZ_R1);
constexpr size_t WS_R6    = al(WS_R4 + (size_t)R * 512 * 2);
constexpr size_t WS_BAR   = al(WS_R6 + (size_t)R * 1024 * 4);
constexpr size_t WS_CO    = WS_BAR + 16384;
constexpr size_t WS_END   = WS_CO + (size_t)BATCH * SEQ * 128 * 4;

struct Params {
    const float *x, *meta, *g_mix, *w_in, *g_aq, *g_ak, *lq1, *lk1, *lq2, *lk2, *g_sub, *w_a, *g_bq, *g_bk, *w_b, *w_o, *g_ffn, *w_q, *subk, *pu, *pv;
    float* out;
    char* ws;
};

constexpr int TIDTAB_OFF = 133376;
__device__ __forceinline__ int opaque_tid() {
    const unsigned hw = (unsigned)__builtin_amdgcn_s_getreg(63492) & 63u;
    int wid = *((volatile __attribute__((address_space(3))) int*)(uintptr_t)(TIDTAB_OFF + 4 * hw));
    wid = __builtin_amdgcn_readfirstlane(wid);
    unsigned z = 0u; asm volatile("" : "+v"(z));
    int t = wid * 64 + (int)__builtin_amdgcn_mbcnt_hi(~0u, __builtin_amdgcn_mbcnt_lo(~0u, z));
    asm volatile("" : "+v"(t)); return t;
}
__device__ __forceinline__ unsigned pk2(float lo, float hi) { f32x2_t v = {lo, hi}; bf16x2_t b = __builtin_convertvector(v, bf16x2_t); return __builtin_bit_cast(unsigned, b); }
__device__ __forceinline__ bf16_t f2bf(float x) { return (bf16_t)(pk2(x, 0.f) & 0xffffu); }
__device__ __forceinline__ float bf2f(unsigned x) { return __uint_as_float(x << 16); }
__device__ __forceinline__ unsigned xcc_id() { return (unsigned)__builtin_amdgcn_s_getreg((3 << 11) | 20) & 0xFu; }
__device__ __forceinline__ int crow(int r, int hi) { return (r & 3) + 8 * (r >> 2) + 4 * hi; }
__device__ __forceinline__ f32x16 mfma32(bf16x8 a, bf16x8 b, f32x16 c) { return __builtin_amdgcn_mfma_f32_32x32x16_bf16(a, b, c, 0, 0, 0); }
__device__ __forceinline__ f32x4 mfma16(bf16x8 a, bf16x8 b, f32x4 c) { return __builtin_amdgcn_mfma_f32_16x16x32_bf16(a, b, c, 0, 0, 0); }
__device__ __forceinline__ float ex2(float x) { return __builtin_amdgcn_exp2f(x); }
__device__ __forceinline__ bf16x8 pack8(float a0, float a1, float a2, float a3, float a4, float a5, float a6, float a7) {
    uint4 u; u.x = pk2(a0, a1); u.y = pk2(a2, a3); u.z = pk2(a4, a5); u.w = pk2(a6, a7); return __builtin_bit_cast(bf16x8, u);
}
template <int CTRL> __device__ __forceinline__ float dpp_t(float v) { return __builtin_bit_cast(float, __builtin_amdgcn_update_dpp(0, __builtin_bit_cast(int, v), CTRL, 0xf, 0xf, true)); }
#define dpp_f(v, c) dpp_t<c>(v)
__device__ __forceinline__ void gload16_asm(u32x4& dst, const void* p) { asm volatile("global_load_dwordx4 %0, %1, off" : "=v"(dst) : "v"(p) : "memory"); }
__device__ __forceinline__ float wave_sum(float v) {
    v += dpp_f(v, 0xB1); v += dpp_f(v, 0x4E); v += dpp_f(v, 0x141); v += dpp_f(v, 0x140);
    { auto r = __builtin_amdgcn_permlane16_swap(__float_as_uint(v), __float_as_uint(v), false, false); v = __uint_as_float(r[0]) + __uint_as_float(r[1]); }
    { auto r = __builtin_amdgcn_permlane32_swap(__float_as_uint(v), __float_as_uint(v), false, false); v = __uint_as_float(r[0]) + __uint_as_float(r[1]); }
    return v;
}
__device__ __forceinline__ float xrow_sum(float v) {
    { auto r = __builtin_amdgcn_permlane16_swap(__float_as_uint(v), __float_as_uint(v), false, false); v = __uint_as_float(r[0]) + __uint_as_float(r[1]); }
    { auto r = __builtin_amdgcn_permlane32_swap(__float_as_uint(v), __float_as_uint(v), false, false); v = __uint_as_float(r[0]) + __uint_as_float(r[1]); }
    return v;
}
__device__ __forceinline__ float half_other(float v, bool upper) {
    auto r = __builtin_amdgcn_permlane32_swap(__float_as_uint(v), __float_as_uint(v), false, false); return __uint_as_float(upper ? r[0] : r[1]);
}
__device__ __forceinline__ unsigned wave_iscan(unsigned x) {
    x += (unsigned)__builtin_amdgcn_update_dpp(0, (int)x, 0x111, 0xf, 0xf, false);
    x += (unsigned)__builtin_amdgcn_update_dpp(0, (int)x, 0x112, 0xf, 0xf, false);
    x += (unsigned)__builtin_amdgcn_update_dpp(0, (int)x, 0x114, 0xf, 0xf, false);
    x += (unsigned)__builtin_amdgcn_update_dpp(0, (int)x, 0x118, 0xf, 0xf, false);
    x += (unsigned)__builtin_amdgcn_update_dpp(0, (int)x, 0x142, 0xa, 0xf, false);
    x += (unsigned)__builtin_amdgcn_update_dpp(0, (int)x, 0x143, 0xc, 0xf, false);
    return x;
}
__device__ __forceinline__ f32x16 zero16() { f32x16 z; UNR for (int i = 0; i < 16; ++i) z[i] = 0.f; return z; }

__device__ __forceinline__ void phase0(const Params& P, int bid, int nb) {
    const int tid = opaque_tid(), lane = tid & 63, w = tid >> 6;
    char* ws = P.ws;
    {
        bf16_t* XN = (bf16_t*)(ws + WS_R1);
        for (int row = bid * 8 + w; row < R; row += nb * 8) {
            const int b = row / TP, t = row - b * TP;
            f32x4 v[4];
            if (t < NMETA) { const float* src = P.meta + (size_t)t * DM; UNR for (int i = 0; i < 4; ++i) v[i] = *(const f32x4*)(src + i * 256 + lane * 4); }
            else if (t < TR) { const float* src = P.x + ((size_t)b * SEQ + (t - NMETA)) * DM; UNR for (int i = 0; i < 4; ++i) v[i] = *(const f32x4*)(src + i * 256 + lane * 4); }
            else { UNR for (int i = 0; i < 4; ++i) v[i] = (f32x4){0.f, 0.f, 0.f, 0.f}; }
            float ss = 0.f;
            UNR for (int i = 0; i < 4; ++i) ss += v[i][0] * v[i][0] + v[i][1] * v[i][1] + v[i][2] * v[i][2] + v[i][3] * v[i][3];
            ss = wave_sum(ss);
            const float rinv = rsqrtf(ss * (1.0f / DM) + EPS);
            UNR for (int i = 0; i < 4; ++i) {
                const f32x4 g = *(const f32x4*)(P.g_mix + i * 256 + lane * 4);
                uint2 o; o.x = pk2(v[i][0] * rinv * g[0], v[i][1] * rinv * g[1]); o.y = pk2(v[i][2] * rinv * g[2], v[i][3] * rinv * g[3]);
                *(uint2*)(XN + (size_t)row * DM + i * 256 + lane * 4) = o;
            }
        }
    }
    const int gt = bid * NTHREADS + tid, gn = nb * NTHREADS;
    auto conv = [&](const float* W, int K, int Nsrc, int Ndst, bf16_t* Wt, bool remap) {
        const int items = Ndst * (K / 8);
        for (int it = gt; it < items; it += gn) {
            const int kc = it / Ndst, n = it - kc * Ndst;
            int ns = n; bool zero = false;
            if (remap) { const int p = n & 255; const int L = (n & ~255) + 64 * ((p >> 5) & 3) + 32 * (p >> 7) + (p & 31);
                         ns = L; if (L >= 2816) ns = L - 56; else if (L >= 2760) zero = true; }
            float f[8];
            UNR for (int j = 0; j < 8; ++j) f[j] = zero ? 0.f : W[(size_t)(kc * 8 + j) * Nsrc + ns];
            uint4 o; o.x = pk2(f[0], f[1]); o.y = pk2(f[2], f[3]); o.z = pk2(f[4], f[5]); o.w = pk2(f[6], f[7]);
            *(uint4*)(Wt + (size_t)n * K + kc * 8) = o;
        }
    };
    conv(P.w_in, 1024, 4808, NIN, (bf16_t*)(ws + WS_WIN), true);
    conv(P.w_a, 512, 1024, 1024, (bf16_t*)(ws + WS_WA), false);
    conv(P.w_b, 512, 1024, 1024, (bf16_t*)(ws + WS_WB), false);
    conv(P.w_o, 1024, 1024, 1024, (bf16_t*)(ws + WS_WO), false);
    conv(P.w_q, 1024, 1024, 1024, (bf16_t*)(ws + WS_WQ), false);
    { bf16_t* SK = (bf16_t*)(ws + WS_SUBK); for (int i = gt; i < 8 * 2 * 128 * 64; i += gn) SK[i] = f2bf(P.subk[i]); }
    {
        float* c64 = (float*)(ws + WS_COS64); float* s64 = (float*)(ws + WS_SIN64); float* ic = (float*)(ws + WS_ICOS); float* is = (float*)(ws + WS_ISIN);
        for (int i = gt; i < TP * 32; i += gn) { const int t = i >> 5, j = i & 31; const float inv = powf(10000.0f, -(float)(2 * j) / 64.0f); const float ang = (float)t * inv; c64[i] = (float)cos((double)ang); s64[i] = (float)sin((double)ang); }
        for (int i = gt; i < TP * 16; i += gn) { const int t = i >> 4, j = i & 15; const float inv = powf(10000.0f, -(float)(2 * j) / 32.0f); const float ang = (float)t * inv; ic[i] = (float)cos((double)ang); is[i] = (float)sin((double)ang); }
    }
    { float* rs = (float*)(ws + WS_ROWSS); for (int i = gt; i < R; i += gn) rs[i] = 0.f; }
    if (tid == 0) ((int*)(ws + WS_CTL + 2048))[bid] = (int)xcc_id();
    if (bid == 0 && w == 0) {
        float a = P.lq1[lane] * P.lk1[lane], b2 = P.lq2[lane] * P.lk2[lane];
        for (int o = 32; o >= 1; o >>= 1) { a += __shfl_xor(a, o); b2 += __shfl_xor(b2, o); }
        if (lane == 0) { ((unsigned*)(ws + WS_CTL))[0] = 0u; ((unsigned*)(ws + WS_CTL))[1] = 0u; ((unsigned*)(ws + WS_CTL))[2] = 0u; ((float*)(ws + WS_CTL))[4] = expf(a) - expf(b2) + 0.2f; }
    }
}

namespace pg8 {
#define PG8_LAS __attribute__((address_space(3)))
typedef unsigned short bf16_t;
typedef short bf16x8 __attribute__((ext_vector_type(8)));
typedef float f32x4 __attribute__((ext_vector_type(4)));
typedef unsigned u32x4 __attribute__((ext_vector_type(4)));
constexpr int BM = 256, BK = 64, HALF = 128, HTB = HALF * BK * 2  , STAGE_BYTES = 8 * HTB, NXCD = 8, WGM = 8;

__host__ __device__ __forceinline__ int lds_byte(int r, int c) { const int st = (r >> 4) * 2 + (c >> 5), rr = r & 15, cc = c & 31, ob = rr * 64 + cc * 2; return st * 1024 + (ob ^ (((ob >> 9) & 1) << 5)); }
__host__ __device__ __forceinline__ void stage_rc(int b, int& R, int& C) { const int st = b / 1024, sb = b % 1024, swz = sb ^ (((sb >> 9) & 1) << 5); R = (st >> 1) * 16 + swz / 64; C = (st & 1) * 32 + (swz % 64) / 2; }
__host__ __device__ __forceinline__ int perm32(int rho) { const int n = rho >> 4, i = rho & 15; return 8 * (i >> 2) + 4 * n + (i & 3); }

struct Unit { int pm, pn; };
struct Gemm { const bf16_t* A; const bf16_t* Bt; int M, N, K; };

struct StaticOrder {
    int nM, nN, nwg, G, c;
    __host__ __device__ void init(int M, int N, int G_, int c_) { nM = M / BM; nN = N / BM; nwg = nM * nN; G = G_; c = c_; }
    __host__ __device__ bool next(int i, Unit& u) const {
        const long L = (long)i * G + c; if (L >= nwg) return false;
        int wgid = (int)L; { const int q = nwg / NXCD, r = nwg % NXCD, xcd = wgid % NXCD, off = wgid / NXCD; wgid = (xcd < r ? xcd * (q + 1) : r * (q + 1) + (xcd - r) * q) + off; }
        const int nig = WGM * nN, gid = wgid / nig, fm = gid * WGM, gsz = (nM - fm) < WGM ? (nM - fm) : WGM;
        u.pm = fm + ((wgid % nig) % gsz); u.pn = (wgid % nig) / gsz; return true;
    }
    __device__ __forceinline__ void a_ready(const Unit&) const {}
    __device__ __forceinline__ void done(const Unit&) const {}
};
template <class Epi, class Sched, bool ALIGN_EPI = false, bool SP2 = false>
__device__ __forceinline__ void gemm_phase(PG8_LAS unsigned char* lds, const Gemm g, const Sched& S, const Epi& E) {
    const int tid = opaque_tid(), wid = __builtin_amdgcn_readfirstlane(tid >> 6), lane = tid & 63, wr = wid >> 2, wc = wid & 3, fr = lane & 15, fq = lane >> 4;
    const int K = g.K, nt = K / BK;
    unsigned voffA[2], voffB[2];
#pragma unroll
    for (int i = 0; i < 2; ++i) { int R, C; stage_rc(tid * 16 + i * 8192, R, C); const int Rb = Epi::PERM ? ((R & ~31) + perm32(R & 31)) : R;
        voffA[i] = (unsigned)(R * K + C) * 2u; voffB[i] = (unsigned)(Rb * K + C) * 2u; }
    const size_t kstep = (size_t)(BK * 2);
    const size_t hstep = (size_t)HALF * K * 2;
    const size_t tstep = 2 * hstep;
    const unsigned ldsw = (unsigned)wid * 1024u;
    const int aoff = lds_byte(wr * 64 + fr, fq * 8), boff = lds_byte(wc * 32 + fr, fq * 8);
#define PG8_SA(b, h) (((b) * 2 + (h)) * HTB)
#define PG8_SB(b, h) ((4 + (b) * 2 + (h)) * HTB)
#define PG8_STAGE(bufoff, gbase, voff) do { _Pragma("unroll") for (int _i = 0; _i < 2; ++_i) \
        __builtin_amdgcn_global_load_lds((const unsigned*)((const char*)(gbase) + (voff)[_i]), (PG8_LAS unsigned*)(lds + (bufoff) + ldsw + _i * 8192), 16, 0, 0); } while (0)
#define PG8_LDA(dst, b, h) do { _Pragma("unroll") for (int m = 0; m < 4; ++m) _Pragma("unroll") for (int k = 0; k < 2; ++k) dst[m][k] = *(const PG8_LAS bf16x8*)(lds + PG8_SA(b, h) + aoff + m * 2048 + k * 1024); } while (0)
#define PG8_LDB(dst, b, h) do { _Pragma("unroll") for (int n = 0; n < 2; ++n) _Pragma("unroll") for (int k = 0; k < 2; ++k) dst[n][k] = *(const PG8_LAS bf16x8*)(lds + PG8_SB(b, h) + boff + n * 2048 + k * 1024); } while (0)
#define PG8_MMA(ai, bj, At, Bt) do { __builtin_amdgcn_s_setprio(1); _Pragma("unroll") for (int m = 0; m < 4; ++m) _Pragma("unroll") for (int n = 0; n < 2; ++n) _Pragma("unroll") for (int k = 0; k < 2; ++k) \
        acc[ai][bj][m][n] = __builtin_amdgcn_mfma_f32_16x16x32_bf16(Bt[n][k], At[m][k], acc[ai][bj][m][n], 0, 0, 0); __builtin_amdgcn_s_setprio(0); } while (0)
#define PG8_WAIT_V(n) asm volatile("s_waitcnt vmcnt(" #n ")" ::: "memory")
#define PG8_WAIT_L(n) asm volatile("s_waitcnt lgkmcnt(" #n ")" ::: "memory")
#define PG8_BAR __builtin_amdgcn_s_barrier()
#define PG8_SCHED __builtin_amdgcn_sched_barrier(0)
    Unit cur, nxt; int ui = 0;
    if (!S.next(0, cur)) return;
    f32x4 acc[2][2][4][2];
#pragma unroll
    for (int a = 0; a < 2; ++a)
#pragma unroll
        for (int b = 0; b < 2; ++b)
#pragma unroll
            for (int m = 0; m < 4; ++m)
#pragma unroll
                for (int n = 0; n < 2; ++n) acc[a][b][m][n] = (f32x4){0.f, 0.f, 0.f, 0.f};
    bf16x8 At[4][2], B0[2][2], B1[2][2];
    const char* cA = (const char*)g.A + (size_t)cur.pm * tstep; const char* cB = (const char*)g.Bt + (size_t)cur.pn * tstep;
    S.a_ready(cur);
    if constexpr (SP2) {
        PG8_STAGE(PG8_SB(0, 0), cB, voffB); PG8_STAGE(PG8_SB(0, 1), cB + hstep, voffB); PG8_STAGE(PG8_SA(0, 0), cA, voffA); PG8_STAGE(PG8_SA(0, 1), cA + hstep, voffA);
        if (wr == 1) PG8_BAR;
        PG8_WAIT_V(2); PG8_BAR;
        PG8_STAGE(PG8_SB(1, 0), cB + kstep, voffB); PG8_STAGE(PG8_SA(1, 0), cA + kstep, voffA); PG8_STAGE(PG8_SB(1, 1), cB + hstep + kstep, voffB);
        PG8_WAIT_V(6); PG8_BAR;
    } else {
        PG8_STAGE(PG8_SB(0, 0), cB, voffB); PG8_STAGE(PG8_SA(0, 0), cA, voffA); PG8_STAGE(PG8_SB(0, 1), cB + hstep, voffB); PG8_STAGE(PG8_SA(0, 1), cA + hstep, voffA);
        if (wr == 1) PG8_BAR;
        PG8_WAIT_V(4); PG8_BAR;
        PG8_STAGE(PG8_SB(1, 0), cB + kstep, voffB); PG8_STAGE(PG8_SA(1, 0), cA + kstep, voffA); PG8_STAGE(PG8_SB(1, 1), cB + hstep + kstep, voffB);
        PG8_WAIT_V(6); PG8_BAR;
    }
    for (;;) {
        const bool has_next = S.next(ui + 1, nxt);
        const char* nA = has_next ? (const char*)g.A + (size_t)nxt.pm * tstep : cA; const char* nB = has_next ? (const char*)g.Bt + (size_t)nxt.pn * tstep : cB;
        for (int t = 0; t < nt; t += 2) {
            const bool last = (t == nt - 2);
            const char* a1 = cA + (size_t)(t + 1) * kstep;
            const char* a2 = last ? nA : cA + (size_t)(t + 2) * kstep; const char* b2 = last ? nB : cB + (size_t)(t + 2) * kstep;
            const char* a3 = a2 + kstep; const char* b3 = b2 + kstep;
            if (last && has_next) S.a_ready(nxt);
            if constexpr (SP2) {
            PG8_LDB(B0, 0, 0); PG8_LDB(B1, 0, 1); PG8_SCHED; PG8_LDA(At, 0, 0); PG8_STAGE(PG8_SA(1, 1), a1 + hstep, voffA);
            PG8_WAIT_V(8); PG8_WAIT_L(0); PG8_BAR; PG8_MMA(0, 0, At, B0); PG8_MMA(0, 1, At, B1); PG8_BAR; PG8_SCHED;
            PG8_LDA(At, 0, 1); PG8_STAGE(PG8_SB(0, 0), b2, voffB); PG8_STAGE(PG8_SB(0, 1), b2 + hstep, voffB); PG8_STAGE(PG8_SA(0, 0), a2, voffA);
            PG8_WAIT_V(8); PG8_WAIT_L(0); PG8_BAR; PG8_MMA(1, 0, At, B0); PG8_MMA(1, 1, At, B1); PG8_BAR; PG8_SCHED;
            PG8_LDB(B0, 1, 0); PG8_LDB(B1, 1, 1); PG8_SCHED; PG8_LDA(At, 1, 0); PG8_STAGE(PG8_SA(0, 1), a2 + hstep, voffA);
            PG8_WAIT_V(8); PG8_WAIT_L(0); PG8_BAR; PG8_MMA(0, 0, At, B0); PG8_MMA(0, 1, At, B1); PG8_BAR; PG8_SCHED;
            PG8_LDA(At, 1, 1); PG8_STAGE(PG8_SB(1, 0), b3, voffB); PG8_STAGE(PG8_SB(1, 1), b3 + hstep, voffB); PG8_STAGE(PG8_SA(1, 0), a3, voffA);
            PG8_WAIT_V(8); PG8_WAIT_L(0); PG8_BAR; PG8_MMA(1, 0, At, B0); PG8_MMA(1, 1, At, B1); PG8_BAR; PG8_SCHED;
            } else {
            PG8_LDB(B0, 0, 0); PG8_SCHED; PG8_LDA(At, 0, 0); PG8_STAGE(PG8_SA(1, 1), a1 + hstep, voffA);
            PG8_WAIT_L(8); PG8_BAR; PG8_WAIT_L(0); PG8_MMA(0, 0, At, B0); PG8_BAR; PG8_SCHED;
            PG8_LDB(B1, 0, 1); PG8_STAGE(PG8_SB(0, 0), b2, voffB);
            PG8_BAR; PG8_WAIT_L(0); PG8_MMA(0, 1, At, B1); PG8_BAR;
            PG8_LDA(At, 0, 1); PG8_STAGE(PG8_SA(0, 0), a2, voffA);
            PG8_BAR; PG8_WAIT_L(0); PG8_MMA(1, 0, At, B0); PG8_BAR; PG8_SCHED;
            PG8_STAGE(PG8_SB(0, 1), b2 + hstep, voffB);
            PG8_WAIT_V(6); PG8_BAR; PG8_MMA(1, 1, At, B1); PG8_BAR;
            PG8_LDB(B0, 1, 0); PG8_SCHED; PG8_LDA(At, 1, 0); PG8_STAGE(PG8_SA(0, 1), a2 + hstep, voffA);
            PG8_WAIT_L(8); PG8_BAR; PG8_WAIT_L(0); PG8_MMA(0, 0, At, B0); PG8_BAR; PG8_SCHED;
            PG8_LDB(B1, 1, 1); PG8_STAGE(PG8_SB(1, 0), b3, voffB);
            PG8_BAR; PG8_WAIT_L(0); PG8_MMA(0, 1, At, B1); PG8_BAR;
            PG8_LDA(At, 1, 1); PG8_STAGE(PG8_SA(1, 0), a3, voffA);
            PG8_BAR; PG8_WAIT_L(0); PG8_MMA(1, 0, At, B0); PG8_BAR; PG8_SCHED;
            PG8_STAGE(PG8_SB(1, 1), b3 + hstep, voffB);
            PG8_WAIT_V(6); PG8_BAR; PG8_MMA(1, 1, At, B1); PG8_BAR;
            }
        }
        if constexpr (ALIGN_EPI) { if (wr == 0) PG8_BAR; }
        if constexpr (!Epi::AFTER_DRAIN) { E(acc, cur, wr, wc, fr, fq); S.done(cur); }
        if (!has_next) break;
#pragma unroll
        for (int a = 0; a < 2; ++a)
#pragma unroll
            for (int b = 0; b < 2; ++b)
#pragma unroll
                for (int m = 0; m < 4; ++m)
#pragma unroll
                    for (int n = 0; n < 2; ++n) acc[a][b][m][n] = (f32x4){0.f, 0.f, 0.f, 0.f};
        cur = nxt; cA = nA; cB = nB; ++ui;
        if constexpr (ALIGN_EPI) { if (wr == 1) PG8_BAR; }
    }
    PG8_WAIT_V(0);
    if constexpr (!ALIGN_EPI) { if (wr == 0) PG8_BAR; }
    PG8_BAR;
    if constexpr (Epi::AFTER_DRAIN) { E.fused(acc, cur, wr, wc, fr, fq, lds, wid, lane); S.done(cur); }
#undef PG8_SA
#undef PG8_SB
#undef PG8_STAGE
#undef PG8_LDA
#undef PG8_LDB
#undef PG8_MMA
#undef PG8_WAIT_V
#undef PG8_WAIT_L
#undef PG8_BAR
#undef PG8_SCHED
}
}

constexpr int MC = BATCH * SEQ;
struct EpiProj {
    static constexpr bool PERM = true, AFTER_DRAIN = false;
    char* ws0; const float *g_aq, *g_ak, *g_bq, *g_bk;
    __device__ __forceinline__ void operator()(const f32x4 (&acc)[2][2][4][2], const pg8::Unit& u, int wr, int wc, int fr, int fq) const {
        size_t oz = 0; asm volatile("" : "+s"(oz)); char* ws = ws0 + oz;
        bf16_t* AQ = (bf16_t*)(ws + WS_R2); bf16_t* AK = AQ + (size_t)8 * 8 * TP * 64;
        bf16_t* AVT = (bf16_t*)(ws + WS_R3); bf16_t* BQ = AVT + (size_t)8 * 4 * 128 * TP;
        unsigned char* KV8 = (unsigned char*)(ws + WS_BK); bf16_t* IK = (bf16_t*)(ws + WS_IK); float* IW = (float*)(ws + WS_IW);
        bf16_t* IQ = (bf16_t*)(ws + WS_R4); bf16_t* GA = (bf16_t*)(ws + WS_R6); bf16_t* GB = GA + (size_t)MC * 1024;
        const float* c64 = (const float*)(ws + WS_COS64); const float* s64 = (const float*)(ws + WS_SIN64); const float* ic = (const float*)(ws + WS_ICOS); const float* is = (const float*)(ws + WS_ISIN);
        const int chunk = u.pn * 4 + wc;
        UNR for (int ai = 0; ai < 2; ++ai) UNR for (int m = 0; m < 4; ++m) {
            const int row = u.pm * 256 + ai * 128 + wr * 64 + m * 16 + fr; const int b = row / TP, t = row - b * TP;
            f32x4 x[2][2]; UNR for (int bj = 0; bj < 2; ++bj) UNR for (int n = 0; n < 2; ++n) x[bj][n] = acc[ai][bj][m][n];
            const bool nr = (chunk < 16) || (chunk >= 24 && chunk <= 32);
            if (nr) {
                const float* gain; bf16_t* dst = nullptr; float sc = 1.f;
                if (chunk < 8) { gain = g_aq; dst = AQ + ((size_t)(b * 8 + chunk) * TP + t) * 64; sc = QSCALE; }
                else if (chunk < 16) { gain = g_ak; dst = AK + ((size_t)(b * 8 + chunk - 8) * TP + t) * 64; }
                else if (chunk < 32) { gain = g_bq; dst = BQ + (size_t)row * 512 + (chunk - 24) * 64; sc = QSCALE; }
                else { gain = g_bk; }
                float ss = 0.f;
                UNR for (int bj = 0; bj < 2; ++bj) UNR for (int n = 0; n < 2; ++n) UNR for (int e = 0; e < 4; ++e) ss += x[bj][n][e] * x[bj][n][e];
                ss = xrow_sum(ss);
                const float rinv = rsqrtf(ss * (1.0f / 64.0f) + EPS);
                float o1[8], o2[8];
                UNR for (int n = 0; n < 2; ++n) {
                    const int j = 8 * fq + 4 * n;
                    const f32x4 c = *(const f32x4*)(c64 + t * 32 + j), s = *(const f32x4*)(s64 + t * 32 + j);
                    const f32x4 g1 = *(const f32x4*)(gain + j), g2 = *(const f32x4*)(gain + 32 + j);
                    UNR for (int e = 0; e < 4; ++e) { const float y1 = x[0][n][e] * rinv * g1[e], y2 = x[1][n][e] * rinv * g2[e]; o1[4 * n + e] = (y1 * c[e] - y2 * s[e]) * sc; o2[4 * n + e] = (y2 * c[e] + y1 * s[e]) * sc; }
                }
                if (chunk == 32) {
                    uint4 w8; int w0;
                    w0 = 0; w0 = __builtin_amdgcn_cvt_pk_fp8_f32(o1[0], o1[1], w0, false); w0 = __builtin_amdgcn_cvt_pk_fp8_f32(o1[2], o1[3], w0, true); w8.x = (unsigned)w0;
                    w0 = 0; w0 = __builtin_amdgcn_cvt_pk_fp8_f32(o1[4], o1[5], w0, false); w0 = __builtin_amdgcn_cvt_pk_fp8_f32(o1[6], o1[7], w0, true); w8.y = (unsigned)w0;
                    w0 = 0; w0 = __builtin_amdgcn_cvt_pk_fp8_f32(o2[0], o2[1], w0, false); w0 = __builtin_amdgcn_cvt_pk_fp8_f32(o2[2], o2[3], w0, true); w8.z = (unsigned)w0;
                    w0 = 0; w0 = __builtin_amdgcn_cvt_pk_fp8_f32(o2[4], o2[5], w0, false); w0 = __builtin_amdgcn_cvt_pk_fp8_f32(o2[6], o2[7], w0, true); w8.w = (unsigned)w0;
                    *(uint4*)(KV8 + (size_t)row * 128 + 16 * fq) = w8;
                } else {
                    uint4 u1, u2;
                    u1.x = pk2(o1[0], o1[1]); u1.y = pk2(o1[2], o1[3]); u1.z = pk2(o1[4], o1[5]); u1.w = pk2(o1[6], o1[7]);
                    u2.x = pk2(o2[0], o2[1]); u2.y = pk2(o2[2], o2[3]); u2.z = pk2(o2[4], o2[5]); u2.w = pk2(o2[6], o2[7]);
                    *(uint4*)(dst + 8 * fq) = u1; *(uint4*)(dst + 32 + 8 * fq) = u2;
                }
            } else if (chunk < 24) {
                const int hd = (chunk - 16) >> 1, half = (chunk - 16) & 1;
                const int tc = (t & ~12) | ((t & 4) << 1) | ((t & 8) >> 1);
                bf16_t* dst = AVT + ((size_t)(b * 4 + hd) * 128 + half * 64) * TP + tc;
                const bool odd = (fr & 1) != 0; bf16_t* dp = dst - (odd ? 1 : 0);
                UNR for (int bj = 0; bj < 2; ++bj) UNR for (int n = 0; n < 2; ++n) UNR for (int e = 0; e < 4; e += 2) {
                    const float a0 = x[bj][n][e], a1 = x[bj][n][e + 1];
                    const float give = odd ? a0 : a1; const float recv = dpp_f(give, 0xB1);
                    const unsigned wv = odd ? pk2(recv, a1) : pk2(a0, recv);
                    const int d = 32 * bj + 8 * fq + 4 * n + e + (odd ? 1 : 0);
                    *(unsigned*)(dp + (size_t)d * TP) = wv;
                }
            } else if (chunk == 33) {
                unsigned char* kv = KV8 + (size_t)row * 128 + 64;
                UNR for (int bj = 0; bj < 2; ++bj) { uint2 w8; int w0;
                    w0 = 0; w0 = __builtin_amdgcn_cvt_pk_fp8_f32(x[bj][0][0], x[bj][0][1], w0, false); w0 = __builtin_amdgcn_cvt_pk_fp8_f32(x[bj][0][2], x[bj][0][3], w0, true); w8.x = (unsigned)w0;
                    w0 = 0; w0 = __builtin_amdgcn_cvt_pk_fp8_f32(x[bj][1][0], x[bj][1][1], w0, false); w0 = __builtin_amdgcn_cvt_pk_fp8_f32(x[bj][1][2], x[bj][1][3], w0, true); w8.y = (unsigned)w0;
                    *(uint2*)(kv + 32 * bj + 8 * fq) = w8; }
            } else if (chunk <= 42) {
                bf16_t* dst = (chunk == 42) ? IK + (size_t)row * 64 : IQ + (size_t)row * 512 + (chunk - 34) * 64;
                const bool hi2 = fq >= 2; const int jb = 8 * (fq & 1);
                float y[8];
                UNR for (int n = 0; n < 2; ++n) {
                    const f32x4 c = *(const f32x4*)(ic + t * 16 + jb + 4 * n), s = *(const f32x4*)(is + t * 16 + jb + 4 * n);
                    UNR for (int e = 0; e < 4; ++e) {
                        const float mine = x[0][n][e];
                        auto sw = __builtin_amdgcn_permlane32_swap(__float_as_uint(mine), __float_as_uint(mine), false, false);
                        const float other = __uint_as_float(hi2 ? sw[0] : sw[1]);
                        const float a = hi2 ? other : mine, bb = hi2 ? mine : other;
                        y[4 * n + e] = hi2 ? (bb * c[e] + a * s[e]) : (a * c[e] - bb * s[e]);
                    }
                }
                uint4 u1, u2;
                u1.x = pk2(y[0], y[1]); u1.y = pk2(y[2], y[3]); u1.z = pk2(y[4], y[5]); u1.w = pk2(y[6], y[7]);
                u2.x = pk2(x[1][0][0], x[1][0][1]); u2.y = pk2(x[1][0][2], x[1][0][3]); u2.z = pk2(x[1][1][0], x[1][1][1]); u2.w = pk2(x[1][1][2], x[1][1][3]);
                *(uint4*)(dst + 8 * fq) = u1; *(uint4*)(dst + 32 + 8 * fq) = u2;
            } else if (chunk == 43) {
                const float sc = 0.35355339059327373f * 0.125f;
                if (fq == 0) { *(f32x4*)(IW + (size_t)row * 8) = x[0][0] * sc; *(f32x4*)(IW + (size_t)row * 8 + 4) = x[0][1] * sc; }
            } else {
                if (t >= NMETA && t < TR) {
                    const size_t mc = (size_t)b * SEQ + (t - NMETA);
                    bf16_t* dst = (chunk < 60) ? GA + mc * 1024 + (chunk - 44) * 64 : GB + mc * 1024 + (chunk - 60) * 64;
                    UNR for (int bj = 0; bj < 2; ++bj) {
                        float o[8]; UNR for (int n = 0; n < 2; ++n) UNR for (int e = 0; e < 4; ++e) o[4 * n + e] = __builtin_amdgcn_rcpf(1.0f + ex2(-LOG2E * x[bj][n][e]));
                        uint4 v; v.x = pk2(o[0], o[1]); v.y = pk2(o[2], o[3]); v.z = pk2(o[4], o[5]); v.w = pk2(o[6], o[7]); *(uint4*)(dst + 32 * bj + 8 * fq) = v;
                    }
                }
            }
        }
    }
};
__device__ __forceinline__ void phase1(const Params& P, PG8_LAS unsigned char* lds) {
    pg8::Gemm g{(const bf16_t*)(P.ws + WS_R1), (const bf16_t*)(P.ws + WS_WIN), R, NIN, 1024};
    pg8::StaticOrder S; S.init(R, NIN, (int)gridDim.x, (int)blockIdx.x);
    EpiProj E{P.ws, P.g_aq, P.g_ak, P.g_bq, P.g_bk};
    pg8::gemm_phase<EpiProj, pg8::StaticOrder, true, true>(lds, g, S, E);
}

__device__ __forceinline__ void attnA_unit(const Params& P, int b, int head, int qb, char* lds) {
    const int tid = opaque_tid(), lane = tid & 63, w = tid >> 6, qg = w & 3, st = w >> 2, l31 = lane & 31, hi = lane >> 5;
    char* ws = P.ws;
    const bf16_t* AQ = (const bf16_t*)(ws + WS_R2); const bf16_t* AK = AQ + (size_t)8 * 8 * TP * 64; const bf16_t* AVT = (const bf16_t*)(ws + WS_R3);
    bf16_t* AOUT = (bf16_t*)(ws + WS_R1);
    const float lam = ((const float*)(ws + WS_CTL))[4];
    const int q0 = qb * 128 + qg * 32;
    const bf16_t* Qp = AQ + ((size_t)(b * 8 + head * 2 + st) * TP + q0 + l31) * 64;
    bf16x8 qf[4];
    UNR for (int ks = 0; ks < 4; ++ks) qf[ks] = *(const bf16x8*)(Qp + ks * 16 + hi * 8);
    const bf16_t* K0g = AK + (size_t)(b * 8 + head * 2) * TP * 64; const bf16_t* K1g = K0g + (size_t)TP * 64;
    const bf16_t* Vg = AVT + (size_t)(b * 4 + head) * 128 * TP;
    const int nkt = 2 * (qb + 1);
    const int srow = tid >> 3, sch = tid & 7;
    const int koff = srow * 128 + ((sch ^ (srow & 7)) << 4), voff = srow * 128 + ((sch ^ ((srow >> 1) & 7)) << 4);
    typedef __attribute__((address_space(3))) unsigned las_u32;
    const bf16_t* gk0 = K0g + (size_t)srow * 64 + ((sch ^ (srow & 7)) << 3);
    const bf16_t* gk1 = gk0 + (size_t)TP * 64;
    const bf16_t* gv0 = Vg + (size_t)srow * TP + ((sch ^ ((srow >> 1) & 7)) << 3);
    const bf16_t* gv1 = gv0 + (size_t)64 * TP;
    auto gload = [&](int kt, int buf) {
        char* base = lds + buf * 32768 + w * 1024;
        __builtin_amdgcn_global_load_lds((const unsigned*)(gk0 + (size_t)kt * 4096), (las_u32*)(base), 16, 0, 0);
        __builtin_amdgcn_global_load_lds((const unsigned*)(gk1 + (size_t)kt * 4096), (las_u32*)(base + 8192), 16, 0, 0);
        __builtin_amdgcn_global_load_lds((const unsigned*)(gv0 + kt * 64), (las_u32*)(base + 16384), 16, 0, 0);
        __builtin_amdgcn_global_load_lds((const unsigned*)(gv1 + kt * 64), (las_u32*)(base + 24576), 16, 0, 0);
    };
    f32x16 o[4]; UNR for (int i = 0; i < 4; ++i) o[i] = zero16();
    f32x16 osum = zero16(), negm = zero16();
    bf16x8 ones; UNR for (int i = 0; i < 8; ++i) ones[i] = (bf16_t)0x3F80;
    bool first = true;
    asm volatile("" :: "v"(qf[0]), "v"(qf[1]), "v"(qf[2]), "v"(qf[3]));
    gload(0, 0); asm volatile("s_waitcnt vmcnt(0)" ::: "memory"); __syncthreads();
    const int qpos = q0 + l31;
    for (int kt = 0; kt < nkt; ++kt) {
        if (kt + 1 < nkt) gload(kt + 1, (kt + 1) & 1);
        const char* base = lds + (kt & 1) * 32768; const char* Kb = base + st * 8192; const char* Vb = base + 16384;
        f32x16 s0, s1;
        {
            bf16x8 ka[4], kb[4];
            UNR for (int ks = 0; ks < 4; ++ks) { const int co = (((ks * 2 + hi) ^ (l31 & 7)) << 4); ka[ks] = *(const bf16x8*)(Kb + l31 * 128 + co); kb[ks] = *(const bf16x8*)(Kb + (32 + l31) * 128 + co); }
            __builtin_amdgcn_sched_barrier(0);
            s0 = mfma32(ka[0], qf[0], negm); s1 = mfma32(kb[0], qf[0], negm);
            UNR for (int ks = 1; ks < 4; ++ks) { s0 = mfma32(ka[ks], qf[ks], s0); s1 = mfma32(kb[ks], qf[ks], s1); }
        }
        if (kt >= nkt - 2) {
            const int kbase = kt * 64;
            UNR for (int r = 0; r < 16; ++r) { const int key = kbase + crow(r, hi); if (key > qpos) s0[r] = -INFINITY; if (key + 32 > qpos) s1[r] = -INFINITY; }
        }
        float mx = s0[0];
        UNR for (int r = 1; r < 16; ++r) mx = fmaxf(mx, s0[r]);
        UNR for (int r = 0; r < 16; ++r) mx = fmaxf(mx, s1[r]);
        if (first || !__all(mx <= 8.0f)) {
            mx = fmaxf(mx, __shfl_xor(mx, 32));
            const float d = first ? mx : fmaxf(mx, 0.f);
            const float alpha = first ? 1.0f : ex2(-d);
            UNR for (int r = 0; r < 16; ++r) { s0[r] -= d; s1[r] -= d; negm[r] -= d; osum[r] *= alpha; }
            UNR for (int mt = 0; mt < 4; ++mt) UNR for (int r = 0; r < 16; ++r) o[mt][r] *= alpha;
            first = false;
        }
        auto vfrag = [&](int g, bf16x8 (&a)[4]) {
            UNR for (int mt = 0; mt < 4; ++mt) { const int d = mt * 32 + l31; const int sw = (d >> 1) & 7; a[mt] = *(const bf16x8*)(Vb + d * 128 + (((2 * g + hi) ^ sw) << 4)); }
        };
        auto pexp = [&](int g) -> bf16x8 {
            const int bq = 8 * (g & 1);
            if (g >> 1) return pack8(ex2(s1[bq]), ex2(s1[bq + 1]), ex2(s1[bq + 2]), ex2(s1[bq + 3]), ex2(s1[bq + 4]), ex2(s1[bq + 5]), ex2(s1[bq + 6]), ex2(s1[bq + 7]));
            return pack8(ex2(s0[bq]), ex2(s0[bq + 1]), ex2(s0[bq + 2]), ex2(s0[bq + 3]), ex2(s0[bq + 4]), ex2(s0[bq + 5]), ex2(s0[bq + 6]), ex2(s0[bq + 7]));
        };
        auto pvmma = [&](const bf16x8 (&a)[4], const bf16x8& p) {
            UNR for (int mt = 0; mt < 4; ++mt) o[mt] = mfma32(a[mt], p, o[mt]);
            osum = mfma32(ones, p, osum);
        };
        {
            bf16x8 va[4], vb[4];
            vfrag(0, va);
            bf16x8 p0 = pexp(0);
            __builtin_amdgcn_sched_barrier(0);
            vfrag(1, vb); pvmma(va, p0); bf16x8 p1 = pexp(1);
            __builtin_amdgcn_sched_barrier(0);
            vfrag(2, va); pvmma(vb, p1); p0 = pexp(2);
            __builtin_amdgcn_sched_barrier(0);
            vfrag(3, vb); pvmma(va, p0); p1 = pexp(3);
            __builtin_amdgcn_sched_barrier(0);
            pvmma(vb, p1);
        }
        asm volatile("s_waitcnt vmcnt(0)" ::: "memory");
        __syncthreads();
    }
    const float inv = 1.0f / osum[0];
    float* ex = (float*)lds + qg * 4096;
    if (st == 1) { const float f = inv * lam; UNR for (int mt = 0; mt < 4; ++mt) UNR for (int r = 0; r < 16; ++r) ex[(mt * 16 + r) * 64 + lane] = o[mt][r] * f; }
    __syncthreads();
    if (st == 0) {
        float ss = 0.f;
        UNR for (int mt = 0; mt < 4; ++mt) UNR for (int r = 0; r < 16; ++r) { const float v = o[mt][r] * inv - ex[(mt * 16 + r) * 64 + lane]; o[mt][r] = v; ss += v * v; }
        ss += __shfl_xor(ss, 32);
        const float rinv = rsqrtf(ss * (1.0f / 128.0f) + EPS) * 0.8f;
        const int tq = q0 + l31; const bool real = (tq >= NMETA && tq < TR);
        bf16_t* dst = AOUT + ((size_t)b * SEQ + (real ? tq - NMETA : 0)) * 512 + head * 128;
        if (real) UNR for (int mt = 0; mt < 4; ++mt) UNR for (int g4 = 0; g4 < 4; ++g4) {
            const int d = mt * 32 + 8 * g4 + 4 * hi; const f32x4 g = *(const f32x4*)(P.g_sub + d);
            uint2 u; u.x = pk2(o[mt][4 * g4] * rinv * g[0], o[mt][4 * g4 + 1] * rinv * g[1]); u.y = pk2(o[mt][4 * g4 + 2] * rinv * g[2], o[mt][4 * g4 + 3] * rinv * g[3]);
            *(uint2*)(dst + d) = u;
        }
    }
    __syncthreads();
}

constexpr int DSA_C = 448;
constexpr int DS_SEL = 0, DS_CAND = 8192, DS_VST = 8192, DS_PART = 40960, DS_PML = 106496, DS_BMP = 110592, DS_STATE = 131072;
__device__ __forceinline__ unsigned ord32(float s) { const unsigned u = __float_as_uint(s); return (u & 0x80000000u) ? ~u : (u | 0x80000000u); }

__device__ __forceinline__ void dsa_unit(const Params& P, int b, int q16, char* lds) {
    const int tid = opaque_tid(), lane = tid & 63, w = tid >> 6, n15 = lane & 15, g = lane >> 4;
    char* ws = P.ws;
    const bf16_t* BQ = (const bf16_t*)(ws + WS_R3) + (size_t)8 * 4 * 128 * TP;
    const bf16_t* BK = (const bf16_t*)(ws + WS_BK); const bf16_t* BV = (const bf16_t*)(ws + WS_BV); const bf16_t* IK = (const bf16_t*)(ws + WS_IK);
    const float* IW = (const float*)(ws + WS_IW); const bf16_t* IQ = (const bf16_t*)(ws + WS_R4);
    bf16_t* BOUT = (bf16_t*)(ws + WS_R1) + (size_t)MC * 512;
    unsigned* HIST = (unsigned*)lds;
    unsigned short* SEL = (unsigned short*)(lds + DS_SEL); u64* CAND = (u64*)(lds + DS_CAND);
    u64* s_pfx = (u64*)(lds + DS_STATE); int* s_need = (int*)(lds + DS_STATE + 256); int* s_pop = (int*)(lds + DS_STATE + 384);
    unsigned* s_selcnt = (unsigned*)(lds + DS_STATE + 512); unsigned* s_candcnt = (unsigned*)(lds + DS_STATE + 640); int* s_all = (int*)(lds + DS_STATE + 768);
    const int q0 = q16 * 16; const int qpos = q0 + n15; const size_t qrow = (size_t)b * TP + qpos;
    const int nk = q16 + 1;
    bf16x8 iqf[8][2];
    UNR for (int h = 0; h < 8; ++h) UNR for (int s = 0; s < 2; ++s) iqf[h][s] = *(const bf16x8*)(IQ + qrow * 512 + h * 64 + s * 32 + g * 8);
    float iw[8];
    { const f32x4 a = *(const f32x4*)(IW + qrow * 8), c = *(const f32x4*)(IW + qrow * 8 + 4); iw[0] = a[0]; iw[1] = a[1]; iw[2] = a[2]; iw[3] = a[3]; iw[4] = c[0]; iw[5] = c[1]; iw[6] = c[2]; iw[7] = c[3]; }
    auto loadk = [&](int kt, bf16x8& k0, bf16x8& k1) {
        const bf16_t* ikp = IK + ((size_t)b * TP + kt * 16 + n15) * 64 + g * 8;
        k0 = *(const bf16x8*)ikp; k1 = *(const bf16x8*)(ikp + 32);
    };
    auto load4 = [&](int kt0, bf16x8 (&k)[4][2]) { UNR for (int j = 0; j < 4; ++j) loadk(min(kt0 + 8 * j, nk - 1), k[j][0], k[j][1]); };
    auto compute = [&](const bf16x8& k0, const bf16x8& k1, f32x4& sc) {
        sc = (f32x4){0.f, 0.f, 0.f, 0.f};
        UNR for (int h = 0; h < 8; ++h) {
            f32x4 a = {0.f, 0.f, 0.f, 0.f};
            a = mfma16(k0, iqf[h][0], a); a = mfma16(k1, iqf[h][1], a);
            const i32x4_t ai = __builtin_elementwise_max(__builtin_bit_cast(i32x4_t, a), (i32x4_t){0, 0, 0, 0}); const f32x4 ar = __builtin_bit_cast(f32x4, ai);
            UNR for (int e = 0; e < 4; ++e) sc[e] = __builtin_fmaf(iw[h], ar[e], sc[e]);
        }
        UNR for (int e = 0; e < 4; ++e) sc[e] += 0.0f;
    };
    if (tid < 16) { unsigned z = 0u; asm volatile("" : "+v"(z)); ((unsigned*)s_pfx)[2 * tid] = z; ((unsigned*)s_pfx)[2 * tid + 1] = z; s_need[tid] = 256; s_pop[tid] = (int)z; s_all[tid] = (int)z; }
    int sh = 45;
    for (;;) {
        const int nbits = sh < 11 ? sh : 11; const int mask = (1 << nbits) - 1;
        { uint4 z = {0u, 0u, 0u, 0u}; for (int i = tid; i < 4096; i += NTHREADS) ((uint4*)lds)[i] = z; }
        __syncthreads();
        const u64 mypfx = s_pfx[n15]; const int myall = s_all[n15];
        auto binit0 = [&](int kt, const f32x4& sc) {
            const bool diag = (kt == nk - 1);
            UNR for (int e = 0; e < 4; ++e) {
                const int idx = kt * 16 + 4 * g + e;
                if (!diag || idx <= qpos) {
                    const unsigned u = __float_as_uint(sc[e]); const unsigned t = u >> 21;
                    const unsigned ib = t ^ (~(unsigned)((int)u >> 31) & 1023u);
                    atomicAdd(&HIST[n15 * 1024 + ((ib >> 1) ^ n15)], 1u << ((ib & 1) * 16));
                }
            }
        };
        auto binit = [&](int kt, const f32x4& sc) {
            const bool diag = (kt == nk - 1);
            UNR for (int e = 0; e < 4; ++e) {
                const int idx = kt * 16 + 4 * g + e;
                if ((!diag || idx <= qpos) && !myall) {
                    const u64 comp = ((u64)ord32(sc[e]) << 13) | (u64)(8191 - idx);
                    if ((comp >> sh) == mypfx) { const int ib = mask - (int)((comp >> (sh - nbits)) & (u64)mask); atomicAdd(&HIST[n15 * 1024 + ((ib >> 1) ^ n15)], 1u << ((ib & 1) * 16)); }
                }
            }
        };
        {
            bf16x8 ka[4][2]; f32x4 sc;
            int kt = w; load4(kt, ka);
            if (sh == 45) {
                f32x4* SCR = (f32x4*)(ws + WS_END + (size_t)blockIdx.x * (16 * 4112 * 4)) + lane;
                while (kt < nk) {
                    UNR for (int j = 0; j < 4; ++j) {
                        compute(ka[j][0], ka[j][1], sc);
                        loadk(min(kt + 32 + 8 * j, nk - 1), ka[j][0], ka[j][1]);
                        if (kt + 8 * j < nk) { SCR[(size_t)(kt + 8 * j) * 64] = sc; binit0(kt + 8 * j, sc); }
                    }
                    kt += 32;
                }
            } else {
                while (kt < nk) {
                    UNR for (int j = 0; j < 4; ++j) {
                        compute(ka[j][0], ka[j][1], sc);
                        loadk(min(kt + 32 + 8 * j, nk - 1), ka[j][0], ka[j][1]);
                        if (kt + 8 * j < nk) binit(kt + 8 * j, sc);
                    }
                    kt += 32;
                }
            }
        }
        __syncthreads();
        UNR for (int i = 0; i < 2; ++i) {
            const int ql = w * 2 + i;
            if (s_all[ql]) continue;
            const uint4* hq = (const uint4*)(HIST + ql * 1024 + lane * 16);
            unsigned c = 0;
            UNR for (int j = 0; j < 4; ++j) { const uint4 v = hq[j]; c += (v.x & 0xffffu) + (v.x >> 16) + (v.y & 0xffffu) + (v.y >> 16) + (v.z & 0xffffu) + (v.z >> 16) + (v.w & 0xffffu) + (v.w >> 16); }
            unsigned pre = c;
            pre = wave_iscan(pre);
            const unsigned nd = (unsigned)s_need[ql];
            const u64 bal = __ballot(pre >= nd);
            if (bal == 0ull) { if (lane == 0) { s_all[ql] = 1; s_pop[ql] = 0; s_need[ql] = 0; } }
            else {
                const int Lc = __ffsll((long long)bal) - 1;
                const unsigned cumL = (unsigned)__builtin_amdgcn_readlane((int)(pre - c), Lc);
                const unsigned wv = HIST[ql * 1024 + Lc * 16 + (((lane >> 1) & 15) ^ ql)];
                const unsigned cnt = (lane < 32) ? ((wv >> ((lane & 1) * 16)) & 0xffffu) : 0u;
                unsigned p2 = cnt;
                p2 = wave_iscan(p2);
                const unsigned cum = cumL + p2 - cnt;
                const u64 b2 = __ballot(lane < 32 && cum + cnt >= nd);
                const int sb = __ffsll((long long)b2) - 1;
                if (lane == sb) { const int ibs = Lc * 32 + sb; s_pfx[ql] = (s_pfx[ql] << nbits) | (u64)(mask - ibs); s_need[ql] = (int)(nd - cum); s_pop[ql] = (int)cnt; }
            }
        }
        __syncthreads();
        sh -= nbits;
        int mp = 0; UNR for (int q = 0; q < 16; ++q) mp = max(mp, s_pop[q]);
        if (mp <= DSA_C || sh == 0) break;
    }
    unsigned* BMP = (unsigned*)(lds + DS_BMP);
    if (tid < 16) { s_selcnt[tid] = 0u; s_candcnt[tid] = 0u; }
    for (int i = tid; i < 16 * 137; i += NTHREADS) BMP[i] = 0u;
    __syncthreads();
    {
        const int tid = opaque_tid(), lane = tid & 63, w = tid >> 6, n15 = lane & 15, g = lane >> 4; const int qpos = q0 + n15; (void)qpos; (void)g; (void)w;
        const u64 mypfx = s_pfx[n15]; const int myall = s_all[n15];
        const unsigned myib = 2047u - (unsigned)(mypfx & 2047ull);
        auto emit0 = [&](int kt, const f32x4& sc) {
            const bool diag = (kt == nk - 1);
            bool cand[4]; int nc = 0;
            UNR for (int e = 0; e < 4; ++e) {
                const int idx = kt * 16 + 4 * g + e;
                const bool valid = !diag || idx <= qpos;
                const unsigned u = __float_as_uint(sc[e]); const unsigned t = u >> 21;
                const unsigned ib = t ^ (~(unsigned)((int)u >> 31) & 1023u);
                const bool sel = valid && (myall || ib < myib);
                cand[e] = valid && !sel && ib == myib; nc += cand[e] ? 1 : 0;
                if (sel) atomicOr(&BMP[n15 * 137 + (idx >> 5)], 1u << (idx & 31));
            }
            if (nc) {
                unsigned cp = atomicAdd(&s_candcnt[n15], (unsigned)nc);
                UNR for (int e = 0; e < 4; ++e) if (cand[e]) { const int idx = kt * 16 + 4 * g + e; if (cp < (unsigned)DSA_C) CAND[n15 * DSA_C + cp] = ((u64)ord32(sc[e]) << 13) | (u64)(8191 - idx); ++cp; }
            }
        };
        auto emit = [&](int kt, const f32x4& sc) {
            const bool diag = (kt == nk - 1);
            UNR for (int e = 0; e < 4; ++e) {
                const int idx = kt * 16 + 4 * g + e;
                if (!diag || idx <= qpos) {
                    const u64 comp = ((u64)ord32(sc[e]) << 13) | (u64)(8191 - idx); const u64 top = comp >> sh;
                    if (myall || top > mypfx) atomicOr(&BMP[n15 * 137 + (idx >> 5)], 1u << (idx & 31));
                    else if (top == mypfx) { const unsigned cp = atomicAdd(&s_candcnt[n15], 1u); if (cp < (unsigned)DSA_C) CAND[n15 * DSA_C + cp] = comp; }
                }
            }
        };
        bf16x8 ka[4][2]; f32x4 sc;
        int kt = w; if (sh != 34) load4(kt, ka);
        if (sh == 34) {
            f32x4 sa[4], sb[4];
            const f32x4* SCR = (const f32x4*)(ws + WS_END + (size_t)blockIdx.x * (16 * 4112 * 4)) + lane;
            int kb = (nk > w) ? w + 32 * ((nk - 1 - w) >> 5) : -1;
            if (kb >= 0) {
                UNR for (int j = 0; j < 4; ++j) sa[j] = SCR[(size_t)min(kb + 8 * j, nk - 1) * 64];
                while (kb >= 0) {
                    UNR for (int j = 0; j < 4; ++j) sb[j] = SCR[(size_t)max(kb - 32 + 8 * j, 0) * 64];
                    UNR for (int j = 0; j < 4; ++j) if (kb + 8 * j < nk) emit0(kb + 8 * j, sa[j]);
                    kb -= 32; if (kb < 0) break;
                    UNR for (int j = 0; j < 4; ++j) sa[j] = SCR[(size_t)max(kb - 32 + 8 * j, 0) * 64];
                    UNR for (int j = 0; j < 4; ++j) emit0(kb + 8 * j, sb[j]);
                    kb -= 32;
                }
            }
        } else {
            while (kt < nk) {
                UNR for (int j = 0; j < 4; ++j) {
                    compute(ka[j][0], ka[j][1], sc);
                    loadk(min(kt + 32 + 8 * j, nk - 1), ka[j][0], ka[j][1]);
                    if (kt + 8 * j < nk) emit(kt + 8 * j, sc);
                }
                kt += 32;
            }
        }
    }
    __syncthreads();
    {
        const int tid = opaque_tid(), lane = tid & 63, w = tid >> 6, n15 = lane & 15, g = lane >> 4; const int qpos = q0 + n15; (void)qpos; (void)g; (void)w;
    {
        const int qa = 2 * w, qb = qa + 1;
        const int nA = min((int)s_candcnt[qa], DSA_C), nB = min((int)s_candcnt[qb], DSA_C);
        int ndA = s_need[qa], ndB = s_need[qb];
        const bool actA = nA > 0 && ndA > 0, actB = nB > 0 && ndB > 0;
        if (actA || actB) {
            unsigned hA[7], lA[7], hB[7], lB[7];
            UNR for (int j = 0; j < 7; ++j) {
                const int ci = j * 64 + lane;
                const u64 ca = (actA && ci < nA) ? CAND[qa * DSA_C + ci] : 0ull; hA[j] = (unsigned)(ca >> 13); lA[j] = (unsigned)ca & 8191u;
                const u64 cb = (actB && ci < nB) ? CAND[qb * DSA_C + ci] : 0ull; hB[j] = (unsigned)(cb >> 13); lB[j] = (unsigned)cb & 8191u;
            }
            const int ns = (max(actA ? nA : 0, actB ? nB : 0) + 63) >> 6;
            const u64 pA = s_pfx[qa], pB = s_pfx[qb];
            unsigned TA = sh >= 13 ? (unsigned)(pA << (sh - 13)) : (unsigned)(pA >> (13 - sh));
            unsigned TB = sh >= 13 ? (unsigned)(pB << (sh - 13)) : (unsigned)(pB >> (13 - sh));
            if (!actA) ndA = 1 << 20;
            if (!actB) ndB = 1 << 20;
            _Pragma("nounroll") for (int bit = (sh > 13 ? sh - 13 : 0) - 1; bit >= 0; --bit) {
                const unsigned tA = TA | (1u << bit), tB = TB | (1u << bit); int cA = 0, cB = 0;
                UNR for (int j = 0; j < 7; ++j) if (j < ns) { cA += __popcll(__ballot(hA[j] >= tA)); cB += __popcll(__ballot(hB[j] >= tB)); }
                if (cA >= ndA) TA = tA;
                if (cB >= ndB) TB = tB;
            }
            int gA = 0, eA = 0, gB = 0, eB = 0;
            UNR for (int j = 0; j < 7; ++j) if (j < ns) { gA += __popcll(__ballot(hA[j] > TA)); eA += __popcll(__ballot(hA[j] == TA)); gB += __popcll(__ballot(hB[j] > TB)); eB += __popcll(__ballot(hB[j] == TB)); }
            const int needA = actA ? ndA - gA : (1 << 20), needB = actB ? ndB - gB : (1 << 20);
            unsigned LA = 0u, LB = 0u;
            if ((actA && eA != needA) || (actB && eB != needB)) {
                _Pragma("nounroll") for (int bit = 12; bit >= 0; --bit) {
                    const unsigned tA = LA | (1u << bit), tB = LB | (1u << bit); int cA = 0, cB = 0;
                    UNR for (int j = 0; j < 7; ++j) if (j < ns) { cA += __popcll(__ballot(hA[j] == TA && lA[j] >= tA)); cB += __popcll(__ballot(hB[j] == TB && lB[j] >= tB)); }
                    if (cA >= needA) LA = tA;
                    if (cB >= needB) LB = tB;
                }
            }
            UNR for (int j = 0; j < 7; ++j) if (j < ns) {
                if (actA && hA[j] != 0u && (hA[j] > TA || (hA[j] == TA && lA[j] >= LA))) { const int idx = 8191 - (int)lA[j]; atomicOr(&BMP[qa * 137 + (idx >> 5)], 1u << (idx & 31)); }
                if (actB && hB[j] != 0u && (hB[j] > TB || (hB[j] == TB && lB[j] >= LB))) { const int idx = 8191 - (int)lB[j]; atomicOr(&BMP[qb * 137 + (idx >> 5)], 1u << (idx & 31)); }
            }
        }
    }
    }
    __syncthreads();
    {
        const int tid = opaque_tid(), lane = tid & 63, w = tid >> 6, n15 = lane & 15, g = lane >> 4; const int qpos = q0 + n15; (void)qpos; (void)g; (void)w;
    {
        const int qa = 2 * w, qb = qa + 1;
        const int nchunk = (q16 + 4) >> 2;
        const unsigned aL = BMP[qa * 137 + 2 * lane], aH = BMP[qa * 137 + 2 * lane + 1], bL = BMP[qb * 137 + 2 * lane], bH = BMP[qb * 137 + 2 * lane + 1];
        const unsigned lbL = lane < 32 ? 1u << lane : 0u, lbH = lane >= 32 ? 1u << (lane - 32) : 0u;
        int baseA = 0, baseB = 0;
        auto step = [&](int c, unsigned mAl, unsigned mAh, unsigned mBl, unsigned mBh) {
            const int pa = baseA + (int)__builtin_amdgcn_mbcnt_hi(mAh, __builtin_amdgcn_mbcnt_lo(mAl, 0u));
            const int pb = baseB + (int)__builtin_amdgcn_mbcnt_hi(mBh, __builtin_amdgcn_mbcnt_lo(mBl, 0u));
            if ((((mAl & lbL) | (mAh & lbH)) != 0u) && pa < 256) SEL[qa * 256 + pa] = (unsigned short)(c * 64 + lane);
            if ((((mBl & lbL) | (mBh & lbH)) != 0u) && pb < 256) SEL[qb * 256 + pb] = (unsigned short)(c * 64 + lane);
            baseA += __popc(mAl) + __popc(mAh); baseB += __popc(mBl) + __popc(mBh);
        };
        const int nc0 = min(nchunk, 64);
        _Pragma("nounroll") for (int c = 0; c < nc0; ++c)
            step(c, (unsigned)__builtin_amdgcn_readlane((int)aL, c), (unsigned)__builtin_amdgcn_readlane((int)aH, c), (unsigned)__builtin_amdgcn_readlane((int)bL, c), (unsigned)__builtin_amdgcn_readlane((int)bH, c));
        if (nchunk > 64) step(64, BMP[qa * 137 + 128], BMP[qa * 137 + 129], BMP[qb * 137 + 128], BMP[qb * 137 + 129]);
        for (int p = baseA + lane; p < 256; p += 64) SEL[qa * 256 + p] = (unsigned short)0;
        for (int p = baseB + lane; p < 256; p += 64) SEL[qb * 256 + p] = (unsigned short)0;
        if (lane == 0) { s_selcnt[qa] = (unsigned)baseA; s_selcnt[qb] = (unsigned)baseB; }
    }
    }
    __syncthreads();
    {
        const int tid = opaque_tid(), lane = tid & 63, w = tid >> 6, n15 = lane & 15, g = lane >> 4; const int qpos = q0 + n15; (void)qpos; (void)g; (void)w;
        typedef __attribute__((address_space(3))) s16x4 lds_s16x4;
        char* vl = lds + DS_VST + w * 4096;
        float* PART = (float*)(lds + DS_PART);
        float* PML = (float*)(lds + DS_PML);
        const int hq = n15 & 7, qq = n15 >> 2, pp = n15 & 3;
        struct QB { u32x4 kr[2]; u32x4 vr[2]; bf16x8 bq[2]; };
        const unsigned char* KV8 = (const unsigned char*)BK;
        auto cvt8 = [&](unsigned wlo, unsigned whi) -> bf16x8 {
            const f32x2_t a = __builtin_amdgcn_cvt_pk_f32_fp8((int)wlo, false), c = __builtin_amdgcn_cvt_pk_f32_fp8((int)wlo, true), d = __builtin_amdgcn_cvt_pk_f32_fp8((int)whi, false), e = __builtin_amdgcn_cvt_pk_f32_fp8((int)whi, true);
            return pack8(a[0], a[1], c[0], c[1], d[0], d[1], e[0], e[1]); };
        QB buf[3];
        auto issue = [&](int qi, QB& q) {
            const size_t row = (size_t)b * TP + q0 + qi; const int nsel = min((int)s_selcnt[qi], 256);
            const unsigned short* sel = SEL + qi * 256 + 32 * w;
            UNR for (int t = 0; t < 2; ++t) { const int kid = (int)sel[16 * t + n15]; q.kr[t] = *(const u32x4*)(KV8 + ((size_t)b * TP + kid) * 128 + 16 * g); }
            UNR for (int k = 0; k < 2; ++k) { const int rowl = k * 16 + (lane >> 2); const int kid = (int)sel[rowl]; q.vr[k] = *(const u32x4*)(KV8 + ((size_t)b * TP + kid) * 128 + 64 + (lane & 3) * 16); }
            UNR for (int s = 0; s < 2; ++s) q.bq[s] = *(const bf16x8*)(BQ + row * 512 + hq * 64 + s * 32 + g * 8);
        };
        issue(0, buf[0]); issue(1, buf[1]);
        UNR for (int qi = 0; qi < 16; ++qi) {
            if (qi + 2 < 16) issue(qi + 2, buf[(qi + 2) % 3]);
            QB& q = buf[qi % 3];
            const int nsel = min((int)s_selcnt[qi], 256);
            f32x4 S[2];
            UNR for (int t = 0; t < 2; ++t) { f32x4 a = {0.f, 0.f, 0.f, 0.f}; a = mfma16(cvt8(q.kr[t][0], q.kr[t][1]), q.bq[0], a); a = mfma16(cvt8(q.kr[t][2], q.kr[t][3]), q.bq[1], a); S[t] = a; }
            float mx = -1.0e30f;
            if (nsel < 256) { UNR for (int t = 0; t < 2; ++t) UNR for (int e = 0; e < 4; ++e) if (32 * w + 16 * t + 4 * g + e >= nsel) S[t][e] = -INFINITY; }
            UNR for (int t = 0; t < 2; ++t) UNR for (int e = 0; e < 4; ++e) mx = fmaxf(mx, S[t][e]);
            { auto r = __builtin_amdgcn_permlane16_swap(__float_as_uint(mx), __float_as_uint(mx), false, false); mx = fmaxf(__uint_as_float(r[0]), __uint_as_float(r[1])); }
            { auto r = __builtin_amdgcn_permlane32_swap(__float_as_uint(mx), __float_as_uint(mx), false, false); mx = fmaxf(__uint_as_float(r[0]), __uint_as_float(r[1])); }
            float ls = 0.f;
            UNR for (int t = 0; t < 2; ++t) UNR for (int e = 0; e < 4; ++e) { S[t][e] = ex2(S[t][e] - mx); ls += S[t][e]; }
            { auto r = __builtin_amdgcn_permlane16_swap(__float_as_uint(ls), __float_as_uint(ls), false, false); ls = __uint_as_float(r[0]) + __uint_as_float(r[1]); }
            { auto r = __builtin_amdgcn_permlane32_swap(__float_as_uint(ls), __float_as_uint(ls), false, false); ls = __uint_as_float(r[0]) + __uint_as_float(r[1]); }
            const bf16x8 pb = pack8(S[0][0], S[0][1], S[0][2], S[0][3], S[1][0], S[1][1], S[1][2], S[1][3]);
            UNR for (int k = 0; k < 2; ++k) { const int rowl = k * 16 + (lane >> 2); const int sw = ((rowl >> 1) & 3) << 1; const int c0 = 2 * (lane & 3);
                *(bf16x8*)(vl + rowl * 128 + ((c0 ^ sw) << 4)) = cvt8(q.vr[k][0], q.vr[k][1]); *(bf16x8*)(vl + rowl * 128 + (((c0 + 1) ^ sw) << 4)) = cvt8(q.vr[k][2], q.vr[k][3]); }
            f32x4 o[4];
            const int row0 = 4 * g + qq, row1 = row0 + 16;
            UNR for (int mt = 0; mt < 4; ++mt) {
                const int ch = 2 * mt + (pp >> 1);
                const char* a0 = vl + row0 * 128 + ((ch ^ (((row0 >> 1) & 3) << 1)) << 4) + 8 * (pp & 1);
                const char* a1 = vl + row1 * 128 + ((ch ^ (((row1 >> 1) & 3) << 1)) << 4) + 8 * (pp & 1);
                const s16x4 lo = __builtin_amdgcn_ds_read_tr16_b64_v4i16((lds_s16x4*)a0);
                const s16x4 h4 = __builtin_amdgcn_ds_read_tr16_b64_v4i16((lds_s16x4*)a1);
                const bf16x8 a = {lo[0], lo[1], lo[2], lo[3], h4[0], h4[1], h4[2], h4[3]};
                o[mt] = mfma16(a, pb, (f32x4){0.f, 0.f, 0.f, 0.f});
            }
            const int qs = qi & 3;
            if (n15 < 8) {
                float* pp_ = PART + ((qs * 8 + w) * 8 + n15) * 64;
                UNR for (int mt = 0; mt < 4; ++mt) *(f32x4*)(pp_ + mt * 16 + 4 * g) = o[mt];
                if (g == 0) { PML[((qs * 8 + w) * 8 + n15) * 2] = mx; PML[((qs * 8 + w) * 8 + n15) * 2 + 1] = ls; }
            }
            if (qs == 3) {
                __syncthreads();
                {
                    const int cq = tid >> 7, ch = (tid >> 4) & 7, dg = tid & 15;
                    float mw[8], lw[8]; float m = -1.0e30f;
                    UNR for (int ww = 0; ww < 8; ++ww) { mw[ww] = PML[((cq * 8 + ww) * 8 + ch) * 2]; lw[ww] = PML[((cq * 8 + ww) * 8 + ch) * 2 + 1]; m = fmaxf(m, mw[ww]); }
                    f32x4 acc = {0.f, 0.f, 0.f, 0.f}; float l = 0.f;
                    UNR for (int ww = 0; ww < 8; ++ww) { const float f = ex2(mw[ww] - m); l += lw[ww] * f; const f32x4 pv = *(const f32x4*)(PART + ((cq * 8 + ww) * 8 + ch) * 64 + dg * 4); acc += pv * f; }
                    const float inv = 1.0f / l;
                    const int tq = q0 + (qi - 3) + cq;
                    uint2 u; u.x = pk2(acc[0] * inv, acc[1] * inv); u.y = pk2(acc[2] * inv, acc[3] * inv);
                    if (tq >= NMETA && tq < TR) *(uint2*)(BOUT + ((size_t)b * SEQ + (tq - NMETA)) * 512 + ch * 64 + dg * 4) = u;
                }
                __syncthreads();
            }
        }
    }
}

template <int MODE> __device__ __forceinline__ void phase2(const Params& P, char* lds, int cidx) {
    unsigned* ctr = (unsigned*)(P.ws + WS_CTL) + cidx;
    int* s_u = (int*)(lds + DS_STATE + 1024);
    constexpr int NA = (MODE == 2) ? 0 : BATCH * 4 * 33, NB = (MODE == 1) ? 0 : BATCH * 256;
    for (;;) {
        if (opaque_tid() == 0) *s_u = (int)atomicAdd(ctr, 1u);
        __syncthreads();
        const int u = *s_u;
        __syncthreads();
        if (u >= NA + NB) break;
        if (u < NA) { const int bh = u / 33, qb = 32 - u % 33; attnA_unit(P, bh >> 2, bh & 3, qb, lds); }
        else { const int v = u - NA; dsa_unit(P, v / 256, 256 - v % 256, lds); }
    }
}

template <int SECOND> struct EpiGate {
    static constexpr bool PERM = true, AFTER_DRAIN = false;
    const bf16_t* G; bf16_t* MIXED;
    __device__ __forceinline__ void operator()(const f32x4 (&acc)[2][2][4][2], const pg8::Unit& u, int wr, int wc, int fr, int fq) const {
        UNR for (int ai = 0; ai < 2; ++ai) UNR for (int m = 0; m < 4; ++m) {
            const size_t row = (size_t)u.pm * 256 + ai * 128 + wr * 64 + m * 16 + fr;
            UNR for (int bj = 0; bj < 2; ++bj) {
                const size_t off = row * 1024 + u.pn * 256 + bj * 128 + wc * 32 + 8 * fq;
                const uint4 gg = *(const uint4*)(G + off); const unsigned gw[4] = {gg.x, gg.y, gg.z, gg.w};
                float v[8];
                UNR for (int i = 0; i < 4; ++i) { const f32x4 a = acc[ai][bj][m][i >> 1]; v[2 * i] = a[(2 * i) & 3] * bf2f(gw[i] & 0xffffu); v[2 * i + 1] = a[(2 * i + 1) & 3] * bf2f(gw[i] >> 16); }
                if (SECOND) { const uint4 mm = *(const uint4*)(MIXED + off); const unsigned mw[4] = {mm.x, mm.y, mm.z, mm.w}; UNR for (int i = 0; i < 4; ++i) { v[2 * i] += bf2f(mw[i] & 0xffffu); v[2 * i + 1] += bf2f(mw[i] >> 16); } }
                uint4 o; o.x = pk2(v[0], v[1]); o.y = pk2(v[2], v[3]); o.z = pk2(v[4], v[5]); o.w = pk2(v[6], v[7]); *(uint4*)(MIXED + off) = o;
            }
        }
    }
};
__device__ __forceinline__ void phase3(const Params& P, int bid, int nb, PG8_LAS unsigned char* lds) {
    char* ws = P.ws;
    const bf16_t* AOUT = (const bf16_t*)(ws + WS_R1); const bf16_t* BOUT = AOUT + (size_t)MC * 512;
    const bf16_t* GA = (const bf16_t*)(ws + WS_R6); const bf16_t* GB = GA + (size_t)MC * 1024;
    bf16_t* MIXED = (bf16_t*)(ws + WS_R2);
    pg8::StaticOrder S; S.init(MC, 1024, (int)gridDim.x, (int)blockIdx.x);
    { pg8::Gemm g{AOUT, (const bf16_t*)(ws + WS_WA), MC, 1024, 512}; EpiGate<0> E{GA, MIXED}; pg8::gemm_phase<EpiGate<0>, pg8::StaticOrder, true, true>(lds, g, S, E); }
    asm volatile("s_waitcnt vmcnt(0)" ::: "memory"); __syncthreads();
    { pg8::Gemm g{BOUT, (const bf16_t*)(ws + WS_WB), MC, 1024, 512}; EpiGate<1> E{GB, MIXED}; pg8::gemm_phase<EpiGate<1>, pg8::StaticOrder, true, true>(lds, g, S, E); }
    {
        const int tid = opaque_tid();
        unsigned char* U8 = (unsigned char*)(ws + WS_R3); unsigned char* V8 = U8 + (size_t)NEXP * 1024;
        const int items = NEXP * 64;
        for (int it = bid * NTHREADS + tid; it < items; it += nb * NTHREADS) {
            const int e = it >> 6, seg = it & 63;
            const f32x4* up = (const f32x4*)(P.pu + (size_t)e * 1024 + seg * 16); const f32x4* vp = (const f32x4*)(P.pv + (size_t)e * 1024 + seg * 16);
            uint4 ou, ov; unsigned* pu4 = (unsigned*)&ou; unsigned* pv4 = (unsigned*)&ov;
            UNR for (int i = 0; i < 4; ++i) {
                const f32x4 a = up[i], c = vp[i]; int wu = 0, wv = 0;
                wu = __builtin_amdgcn_cvt_pk_fp8_f32(a[0] * 256.f, a[1] * 256.f, wu, false); wu = __builtin_amdgcn_cvt_pk_fp8_f32(a[2] * 256.f, a[3] * 256.f, wu, true);
                wv = __builtin_amdgcn_cvt_pk_fp8_f32(c[0] * 64.f, c[1] * 64.f, wv, false); wv = __builtin_amdgcn_cvt_pk_fp8_f32(c[2] * 64.f, c[3] * 64.f, wv, true);
                pu4[i] = (unsigned)wu; pv4[i] = (unsigned)wv;
            }
            *(uint4*)(U8 + ((size_t)(seg >> 3) * NEXP + e) * 128 + (seg & 7) * 16) = ou;
            *(uint4*)(V8 + ((size_t)(seg >> 3) * NEXP + e) * 128 + (seg & 7) * 16) = ov;
        }
    }
}

struct EpiRes {
    static constexpr bool PERM = true, AFTER_DRAIN = false;
    char* ws0; const float *x; const PG8_LAS unsigned char* gl;
    __device__ __forceinline__ void operator()(const f32x4 (&acc)[2][2][4][2], const pg8::Unit& u, int wr, int wc, int fr, int fq) const {
        size_t oz = 0; asm volatile("" : "+s"(oz)); char* ws = ws0 + oz;
        float* H2 = (float*)(ws + WS_R6); bf16_t* H2G = (bf16_t*)(ws + WS_R1); float* ROWSS = (float*)(ws + WS_ROWSS); unsigned char* X8 = (unsigned char*)(ws + WS_R3) + (size_t)2 * NEXP * 1024;
        auto ldx = [&](int b, u32x4 (&xv)[2][2]) {
            const int ai = b >> 2, m = b & 3;
            UNR for (int bj = 0; bj < 2; ++bj) UNR for (int n = 0; n < 2; ++n)
                gload16_asm(xv[bj][n], x + ((size_t)u.pm * 256 + ai * 128 + wr * 64 + m * 16 + fr) * 1024 + u.pn * 256 + bj * 128 + wc * 32 + 8 * fq + 4 * n);
        };
        auto proc = [&](int b, const u32x4 (&xu)[2][2]) {
            f32x4 xv[2][2]; UNR for (int bj = 0; bj < 2; ++bj) UNR for (int n = 0; n < 2; ++n) xv[bj][n] = __builtin_bit_cast(f32x4, xu[bj][n]);
            const int ai = b >> 2, m = b & 3;
            const size_t row = (size_t)u.pm * 256 + ai * 128 + wr * 64 + m * 16 + fr;
            float ss = 0.f;
            UNR for (int bj = 0; bj < 2; ++bj) {
                const int col = u.pn * 256 + bj * 128 + wc * 32 + 8 * fq;
                const u32x4 gw = *(const PG8_LAS u32x4*)(gl + 2 * col);
                float hg[8];
                UNR for (int n = 0; n < 2; ++n) {
                    const f32x4 v = xv[bj][n] + acc[ai][bj][m][n];
                    ss += v[0] * v[0] + v[1] * v[1] + v[2] * v[2] + v[3] * v[3];
                    *(f32x4*)(H2 + row * 1024 + col + 4 * n) = v;
                    UNR for (int e = 0; e < 4; ++e) { const int i = 4 * n + e; hg[i] = v[e] * bf2f((gw[i >> 1] >> (16 * (i & 1))) & 0xffffu); }
                }
                uint4 o; o.x = pk2(hg[0], hg[1]); o.y = pk2(hg[2], hg[3]); o.z = pk2(hg[4], hg[5]); o.w = pk2(hg[6], hg[7]); *(uint4*)(H2G + row * 1024 + col) = o;
                uint2 w8; int w0;
                w0 = 0; w0 = __builtin_amdgcn_cvt_pk_fp8_f32(hg[0], hg[1], w0, false); w0 = __builtin_amdgcn_cvt_pk_fp8_f32(hg[2], hg[3], w0, true); w8.x = (unsigned)w0;
                w0 = 0; w0 = __builtin_amdgcn_cvt_pk_fp8_f32(hg[4], hg[5], w0, false); w0 = __builtin_amdgcn_cvt_pk_fp8_f32(hg[6], hg[7], w0, true); w8.y = (unsigned)w0;
                *(uint2*)(X8 + row * 1024 + col) = w8;
            }
            ss = xrow_sum(ss);
            if (fq == 0) atomicAdd(ROWSS + row, ss);
        };
        u32x4 xa[2][2], xb[2][2];
        ldx(0, xa);
        ldx(1, xb);
        asm volatile("s_waitcnt vmcnt(4)" : "+v"(xa[0][0]), "+v"(xa[0][1]), "+v"(xa[1][0]), "+v"(xa[1][1]) :: "memory");
        proc(0, xa);
        ldx(2, xa);
        asm volatile("s_waitcnt vmcnt(13)" : "+v"(xb[0][0]), "+v"(xb[0][1]), "+v"(xb[1][0]), "+v"(xb[1][1]) :: "memory");
        proc(1, xb);
        ldx(3, xb);
        asm volatile("s_waitcnt vmcnt(13)" : "+v"(xa[0][0]), "+v"(xa[0][1]), "+v"(xa[1][0]), "+v"(xa[1][1]) :: "memory");
        proc(2, xa);
        ldx(4, xa);
        asm volatile("s_waitcnt vmcnt(13)" : "+v"(xb[0][0]), "+v"(xb[0][1]), "+v"(xb[1][0]), "+v"(xb[1][1]) :: "memory");
        proc(3, xb);
        ldx(5, xb);
        asm volatile("s_waitcnt vmcnt(13)" : "+v"(xa[0][0]), "+v"(xa[0][1]), "+v"(xa[1][0]), "+v"(xa[1][1]) :: "memory");
        proc(4, xa);
        ldx(6, xa);
        asm volatile("s_waitcnt vmcnt(13)" : "+v"(xb[0][0]), "+v"(xb[0][1]), "+v"(xb[1][0]), "+v"(xb[1][1]) :: "memory");
        proc(5, xb);
        ldx(7, xb);
        asm volatile("s_waitcnt vmcnt(13)" : "+v"(xa[0][0]), "+v"(xa[0][1]), "+v"(xa[1][0]), "+v"(xa[1][1]) :: "memory");
        proc(6, xa);
        asm volatile("s_waitcnt vmcnt(9)" : "+v"(xb[0][0]), "+v"(xb[0][1]), "+v"(xb[1][0]), "+v"(xb[1][1]) :: "memory");
        proc(7, xb);
    }
};
__device__ __forceinline__ void phase4(const Params& P, PG8_LAS unsigned char* lds) {
    pg8::Gemm g{(const bf16_t*)(P.ws + WS_R2), (const bf16_t*)(P.ws + WS_WO), MC, 1024, 1024};
    pg8::StaticOrder S; S.init(MC, 1024, (int)gridDim.x, (int)blockIdx.x);
    { const int tid = opaque_tid(); if (tid < 128) { const f32x4 a = *(const f32x4*)(P.g_ffn + 8 * tid), c = *(const f32x4*)(P.g_ffn + 8 * tid + 4); *(PG8_LAS bf16x8*)(lds + pg8::STAGE_BYTES + 16 * tid) = pack8(a[0], a[1], a[2], a[3], c[0], c[1], c[2], c[3]); } __syncthreads(); }
    EpiRes E{P.ws, P.x, lds + pg8::STAGE_BYTES};
    pg8::gemm_phase<EpiRes, pg8::StaticOrder, true, true>(lds, g, S, E);
}

struct EpiQ {
    static constexpr bool PERM = true, AFTER_DRAIN = false;
    const float* ROWSS; bf16_t* Q;
    __device__ __forceinline__ void operator()(const f32x4 (&acc)[2][2][4][2], const pg8::Unit& u, int wr, int wc, int fr, int fq) const {
        UNR for (int ai = 0; ai < 2; ++ai) UNR for (int m = 0; m < 4; ++m) {
            const size_t row = (size_t)u.pm * 256 + ai * 128 + wr * 64 + m * 16 + fr;
            const float rinv = rsqrtf(ROWSS[row] * (1.0f / DM) + EPS);
            UNR for (int bj = 0; bj < 2; ++bj) {
                const f32x4 a = acc[ai][bj][m][0], c = acc[ai][bj][m][1];
                uint4 o; o.x = pk2(a[0] * rinv, a[1] * rinv); o.y = pk2(a[2] * rinv, a[3] * rinv); o.z = pk2(c[0] * rinv, c[1] * rinv); o.w = pk2(c[2] * rinv, c[3] * rinv);
                *(uint4*)(Q + row * 1024 + u.pn * 256 + bj * 128 + wc * 32 + 8 * fq) = o;
            }
        }
    }
};
__device__ __forceinline__ void phase6a(const Params& P, PG8_LAS unsigned char* lds) {
    pg8::Gemm g{(const bf16_t*)(P.ws + WS_R1), (const bf16_t*)(P.ws + WS_WQ), MC, 1024, 1024};
    pg8::StaticOrder S; S.init(MC, 1024, (int)gridDim.x, (int)blockIdx.x);
    EpiQ E{(const float*)(P.ws + WS_ROWSS), (bf16_t*)(P.ws + WS_R2)};
    pg8::gemm_phase<EpiQ, pg8::StaticOrder, true, true>(lds, g, S, E);
}

__device__ __forceinline__ void ins16(float (&a)[16], float v) {
    float n[16]; n[0] = fmaxf(a[0], v);
    UNR for (int p = 1; p < 16; ++p) n[p] = __builtin_amdgcn_fmed3f(a[p - 1], a[p], v);
    UNR for (int p = 0; p < 16; ++p) a[p] = n[p];
}
__device__ __forceinline__ void phase6b(const Params& P, int bid, int nb, char* lds) {
    const int tid = opaque_tid(), lane = tid & 63, w = tid >> 6, wm = w >> 1, wn = w & 1, l31 = lane & 31, hi = lane >> 5;
    char* ws = P.ws;
    const bf16_t* Q = (const bf16_t*)(ws + WS_R2); const bf16_t* SUBK = (const bf16_t*)(ws + WS_SUBK);
    unsigned short* EIDX = (unsigned short*)(ws + WS_R4); float* EG = (float*)(ws + WS_R4 + (size_t)MC * 128 * 4);
    float* TOPS = (float*)lds;
    for (int unit = bid; unit < (MC / 256) * 8; unit += nb) {
        const int head = unit & 7, tm = unit >> 3; const int m0 = tm * 256;
        const bf16_t* sk = SUBK + (size_t)(head * 2 + wn) * 128 * 64;
        UNR for (int mt = 0; mt < 2; ++mt) {
            const int tl = wm * 64 + mt * 32 + l31; const size_t m = (size_t)m0 + tl;
            bf16x8 qb[4];
            UNR for (int s = 0; s < 4; ++s) qb[s] = *(const bf16x8*)(Q + m * 1024 + head * 128 + wn * 64 + 16 * s + 8 * hi);
            float top[16];
            UNR for (int p = 0; p < 16; ++p) top[p] = -INFINITY;
            UNR for (int kt = 0; kt < 4; ++kt) {
                f32x16 S = zero16();
                UNR for (int s = 0; s < 4; ++s) { const bf16x8 a = *(const bf16x8*)(sk + (size_t)(kt * 32 + l31) * 64 + 16 * s + 8 * hi); S = mfma32(a, qb[s], S); }
                UNR for (int r = 0; r < 16; ++r) { const unsigned key = (unsigned)(kt * 32 + crow(r, hi)); ins16(top, __uint_as_float((__float_as_uint(S[r]) & ~127u) | key)); }
            }
            float oth[16];
            UNR for (int p = 0; p < 16; ++p) oth[p] = half_other(top[p], hi != 0);
            UNR for (int p = 0; p < 16; ++p) ins16(top, oth[p]);
            if (hi == 0) { UNR for (int p = 0; p < 16; p += 4) *(f32x4*)(TOPS + (tl * 2 + wn) * 16 + p) = (f32x4){top[p], top[p + 1], top[p + 2], top[p + 3]}; }
        }
        __syncthreads();
        if (tid < 256) {
            const int tl = tid; const size_t m = (size_t)m0 + tl;
            float s1[16], s2[16];
            UNR for (int p = 0; p < 16; p += 4) { const f32x4 a = *(const f32x4*)(TOPS + (tl * 2) * 16 + p), c = *(const f32x4*)(TOPS + (tl * 2 + 1) * 16 + p); UNR for (int i = 0; i < 4; ++i) { s1[p + i] = a[i]; s2[p + i] = c[i]; } }
            float v1[16], v2[16];
            UNR for (int p = 0; p < 16; ++p) { v1[p] = __uint_as_float(__float_as_uint(s1[p]) & ~127u); v2[p] = __uint_as_float(__float_as_uint(s2[p]) & ~127u); }
            float top[16];
            UNR for (int p = 0; p < 16; ++p) top[p] = -INFINITY;
            UNR for (int a = 0; a < 16; ++a)
                UNR for (int c = 0; c < 16; ++c)
                    if ((a + 1) * (c + 1) <= 16) ins16(top, __uint_as_float((__float_as_uint(v1[a] + v2[c]) & ~255u) | (unsigned)(a * 16 + c)));
            float vs[16]; int ex[16]; float mx = -INFINITY;
            UNR for (int p = 0; p < 16; ++p) {
                const unsigned id = __float_as_uint(top[p]) & 255u; const int a = id >> 4, c = id & 15;
                const unsigned pa = __float_as_uint(TOPS[(tl * 2) * 16 + a]), pc = __float_as_uint(TOPS[(tl * 2 + 1) * 16 + c]);
                vs[p] = __uint_as_float(pa & ~127u) + __uint_as_float(pc & ~127u); ex[p] = (int)(pa & 127u) * 128 + (int)(pc & 127u); mx = fmaxf(mx, vs[p]);
            }
            float sum = 0.f;
            UNR for (int p = 0; p < 16; ++p) { vs[p] = __expf(vs[p] - mx); sum += vs[p]; }
            const float inv = 1.0f / sum;
            UNR for (int p = 0; p < 16; p += 4) {
                *(uint2*)(EIDX + m * 128 + head * 16 + p) = make_uint2((unsigned)ex[p] | ((unsigned)ex[p + 1] << 16), (unsigned)ex[p + 2] | ((unsigned)ex[p + 3] << 16));
                *(f32x4*)(EG + m * 128 + head * 16 + p) = (f32x4){vs[p] * inv, vs[p + 1] * inv, vs[p + 2] * inv, vs[p + 3] * inv};
            }
        }
        __syncthreads();
    }
}

struct XcdPlan { int part[8]; int npart; int rank, count; };
__device__ __forceinline__ void xcd_plan(const Params& P, int bid, int nb, XcdPlan& pl) {
    const int* map = (const int*)(P.ws + WS_CTL + 2048);
    const int lane = (int)__builtin_amdgcn_mbcnt_hi(~0u, __builtin_amdgcn_mbcnt_lo(~0u, 0u));
    int cnt[8]; UNR for (int j = 0; j < 8; ++j) cnt[j] = 0;
    const int mine = map[bid] & 7; int rank = 0;
    for (int c = 0; c * 64 < nb; ++c) {
        const int i = c * 64 + lane; const int x = (i < nb) ? (map[i] & 7) : 8;
        UNR for (int j = 0; j < 8; ++j) cnt[j] += __popcll(__ballot(x == j));
        rank += __popcll(__ballot(x == mine && i < bid));
    }
    pl.npart = 0; UNR for (int j = 0; j < 8; ++j) pl.part[j] = 0;
    UNR for (int j = 0; j < 8; ++j) { int owner = j; UNR for (int s = 0; s < 8; ++s) { if (cnt[owner] == 0) owner = (owner + 1) & 7; } if (owner == mine) { UNR for (int q = 0; q < 8; ++q) if (q == pl.npart) pl.part[q] = j; ++pl.npart; } }
    pl.rank = rank; int c = 0; UNR for (int j = 0; j < 8; ++j) if (j == mine) c = cnt[j]; pl.count = c;
}
__device__ __forceinline__ void phase7a(const Params& P, int bid, int nb) {
    const int tid = opaque_tid(), lane = tid & 63, w = tid >> 6;
    char* ws = P.ws;
    const unsigned short* EIDX = (const unsigned short*)(ws + WS_R4);
    const unsigned char* U8 = (const unsigned char*)(ws + WS_R3); const unsigned char* X8 = U8 + (size_t)2 * NEXP * 1024;
    _Float16* PART = (_Float16*)(ws + WS_R1);
    XcdPlan pl; xcd_plan(P, bid, nb, pl);
    const int gw = pl.rank * 8 + w, nW = pl.count * 8;
    const int pg = lane >> 3, ds = lane & 7;
    const bool b2 = (lane & 4) != 0, b1 = (lane & 2) != 0, b0 = (lane & 1) != 0;
    for (int pi = 0; pi < pl.npart; ++pi) {
        int part = 0; UNR for (int q = 0; q < 8; ++q) if (q == pi) part = pl.part[q];
        const unsigned char* Us = U8 + (size_t)part * NEXP * 128 + ds * 16;
        if (gw >= MC) continue;
        const int N = (MC - gw + nW - 1) / nW;
        auto tokof = [&](int n) -> size_t { return (size_t)(gw + min(n, N - 1) * nW); };
        auto load_idx = [&](u32x4 (&ix)[2], int n) { const size_t tok = tokof(n); UNR for (int q = 0; q < 2; ++q) gload16_asm(ix[q], EIDX + tok * 128 + pg * 16 + 8 * q); };
        auto load_x = [&](u32x4& x, int n) { gload16_asm(x, X8 + tokof(n) * 1024 + part * 128 + ds * 16); };
        u32x4 row[16];
        auto body = [&](u32x4 (&ixn)[2], u32x4 (&ixnn)[2], u32x4& xc, u32x4& xn, int n) {
            load_idx(ixnn, n + 2); load_x(xn, n + 1);
            float val[16]; float xf[16];
            UNR for (int j = 0; j < 16; ++j) {
                asm volatile("s_waitcnt vmcnt(19)" : "+v"(row[j]), "+v"(xc), "+v"(ixn[j >> 3]) :: "memory");
                if (j == 0) { UNR for (int i = 0; i < 4; ++i) { const f32x2_t lo = __builtin_amdgcn_cvt_pk_f32_fp8((int)xc[i], false), h2 = __builtin_amdgcn_cvt_pk_f32_fp8((int)xc[i], true); xf[4 * i] = lo[0]; xf[4 * i + 1] = lo[1]; xf[4 * i + 2] = h2[0]; xf[4 * i + 3] = h2[1]; } }
                float a0 = 0.f, a1 = 0.f;
                UNR for (int i = 0; i < 4; ++i) { const f32x2_t lo = __builtin_amdgcn_cvt_pk_f32_fp8((int)row[j][i], false), h2 = __builtin_amdgcn_cvt_pk_f32_fp8((int)row[j][i], true);
                    a0 = __builtin_fmaf(lo[0], xf[4 * i], a0); a1 = __builtin_fmaf(lo[1], xf[4 * i + 1], a1); a0 = __builtin_fmaf(h2[0], xf[4 * i + 2], a0); a1 = __builtin_fmaf(h2[1], xf[4 * i + 3], a1); }
                val[j] = a0 + a1;
                asm volatile("" :: "v"(val[j]) : "memory");
                gload16_asm(row[j], Us + (size_t)((ixn[j >> 3][(j >> 1) & 3] >> (16 * (j & 1))) & 0xffffu) * 128);
            }
            float r8[8], r4[4], r2[2];
            UNR for (int i = 0; i < 8; ++i) { const float keep = b2 ? val[i + 8] : val[i], give = b2 ? val[i] : val[i + 8]; r8[i] = keep + dpp_f(give, 0x141); }
            UNR for (int i = 0; i < 4; ++i) { const float keep = b1 ? r8[i + 4] : r8[i], give = b1 ? r8[i] : r8[i + 4]; r4[i] = keep + dpp_f(give, 0x4E); }
            UNR for (int i = 0; i < 2; ++i) { const float keep = b0 ? r4[i + 2] : r4[i], give = b0 ? r4[i] : r4[i + 2]; r2[i] = keep + dpp_f(give, 0xB1); }
            const f16x2_t oh = {(_Float16)(r2[0] * (1.0f / 256.0f)), (_Float16)(r2[1] * (1.0f / 256.0f))}; const unsigned o = __builtin_bit_cast(unsigned, oh);
            _Float16* op = PART + ((size_t)part * MC + tokof(n)) * 128 + pg * 16 + 2 * ds;
            asm volatile("global_store_dword %0, %1, off\n\ts_nop 1" :: "v"(op), "v"(o) : "memory");
        };
        u32x4 ixA[2], ixB[2], xA, xB;
        load_idx(ixA, 0); load_idx(ixB, 1); load_x(xA, 0);
        asm volatile("s_waitcnt vmcnt(3)" : "+v"(ixA[0]), "+v"(ixA[1]) :: "memory");
        UNR for (int j = 0; j < 16; ++j) gload16_asm(row[j], Us + (size_t)((ixA[j >> 3][(j >> 1) & 3] >> (16 * (j & 1))) & 0xffffu) * 128);
        u32x4 dummy; gload16_asm(dummy, X8 + tokof(0) * 1024 + part * 128 + ds * 16);
        for (int n = 0; n < N; n += 2) { body(ixB, ixA, xA, xB, n); body(ixA, ixB, xB, xA, n + 1); }
        asm volatile("s_waitcnt vmcnt(0)" : "+v"(dummy), "+v"(ixA[0]), "+v"(ixA[1]), "+v"(ixB[0]), "+v"(ixB[1]), "+v"(xA), "+v"(xB) :: "memory");
        asm volatile("" : "+v"(row[0]), "+v"(row[1]), "+v"(row[2]), "+v"(row[3]), "+v"(row[4]), "+v"(row[5]), "+v"(row[6]), "+v"(row[7]) :: "memory");
        asm volatile("" : "+v"(row[8]), "+v"(row[9]), "+v"(row[10]), "+v"(row[11]), "+v"(row[12]), "+v"(row[13]), "+v"(row[14]), "+v"(row[15]) :: "memory");
    }
}
__device__ __forceinline__ void phase7m(const Params& P, int bid, int nb) {
    const int tid = opaque_tid();
    char* ws = P.ws;
    const _Float16* PART = (const _Float16*)(ws + WS_R1); const float* ROWSS = (const float*)(ws + WS_ROWSS);
    const float* EG = (const float*)(ws + WS_R4 + (size_t)MC * 128 * 4);
    bf16_t* CO = (bf16_t*)(ws + WS_CO);
    const size_t n4 = (size_t)MC * 128 / 4, stride = (size_t)nb * NTHREADS;
    auto ldp = [&](size_t i, f16x4_t (&p)[8], f32x4& g, float& rs) {
        UNR for (int sl = 0; sl < 8; ++sl) p[sl] = *(const f16x4_t*)(PART + (size_t)sl * MC * 128 + i * 4);
        g = *(const f32x4*)(EG + i * 4); rs = ROWSS[i >> 5];
    };
    auto fin = [&](size_t i, const f16x4_t (&p)[8], const f32x4& g, float rs) {
        f32x4 s = {0.f, 0.f, 0.f, 0.f};
        UNR for (int sl = 0; sl < 8; ++sl) UNR for (int e = 0; e < 4; ++e) s[e] += (float)p[sl][e];
        const float rsc = rsqrtf(rs * (1.0f / DM) + EPS); f32x4 o;
        UNR for (int e = 0; e < 4; ++e) { const float v = s[e] * rsc; o[e] = 0.5f * v * (1.0f + erff(v * 0.70710678118654752f)) * g[e]; }
        u32x2 ob; ob[0] = pk2(o[0], o[1]); ob[1] = pk2(o[2], o[3]); *(u32x2*)(CO + i * 4) = ob;
    };
    for (size_t i = (size_t)bid * NTHREADS + tid; i < n4; i += 2 * stride) {
        const size_t i2 = i + stride; const bool two = i2 < n4;
        f16x4_t pa[8], pb[8]; f32x4 ga, gb; float ra, rb;
        ldp(i, pa, ga, ra); ldp(two ? i2 : i, pb, gb, rb);
        fin(i, pa, ga, ra);
        if (two) fin(i2, pb, gb, rb);
    }
}
__device__ __forceinline__ void gload8_asm(u32x2& dst, const void* p) { asm volatile("global_load_dwordx2 %0, %1, off" : "=v"(dst) : "v"(p) : "memory"); }
__device__ __forceinline__ void phase7b(const Params& P, int bid, int nb) {
    const int tid = opaque_tid(), lane = tid & 63, w = tid >> 6;
    char* ws = P.ws;
    const float* H2 = (const float*)(ws + WS_R6); const unsigned short* EIDX = (const unsigned short*)(ws + WS_R4);
    const unsigned char* V8 = (const unsigned char*)(ws + WS_R3) + (size_t)NEXP * 1024;
    const bf16_t* COEF = (const bf16_t*)(ws + WS_CO);
    XcdPlan pl; xcd_plan(P, bid, nb, pl);
    const int gw = pl.rank * 8 + w, nW = pl.count * 8;
    const int pg = lane >> 3, ds = lane & 7;
    const bool b5 = (lane & 32) != 0, b4 = (lane & 16) != 0, b3 = (lane & 8) != 0;
    for (int pi = 0; pi < pl.npart; ++pi) {
        int part = 0; UNR for (int q = 0; q < 8; ++q) if (q == pi) part = pl.part[q];
        const unsigned char* Vs = V8 + (size_t)part * NEXP * 128 + ds * 16;
        if (gw >= MC) continue;
        const int N = (MC - gw + nW - 1) / nW;
        const int doff = part * 128 + ds * 16 + 2 * pg;
        auto tokof = [&](int n) -> size_t { return (size_t)(gw + min(n, N - 1) * nW); };
        u32x4 row[16];
        auto load_idx = [&](u32x4 (&ix)[2], int n) { const size_t tok = tokof(n); UNR for (int q = 0; q < 2; ++q) gload16_asm(ix[q], EIDX + tok * 128 + pg * 16 + 8 * q); };
        auto load_cf = [&](u32x4 (&cf)[2], u32x2& hv, int n) { const size_t tok = tokof(n); UNR for (int q = 0; q < 2; ++q) gload16_asm(cf[q], COEF + tok * 128 + pg * 16 + 8 * q); gload8_asm(hv, H2 + tok * 1024 + doff); };
        auto body = [&](u32x4 (&ixn)[2], u32x4 (&ixnn)[2], u32x4 (&cfc)[2], u32x2& hvc, u32x4 (&cfn)[2], u32x2& hvn, int n) {
            load_idx(ixnn, n + 2); load_cf(cfn, hvn, n + 1);
            float acc[16]; UNR for (int i = 0; i < 16; ++i) acc[i] = 0.f;
            UNR for (int j = 0; j < 16; ++j) {
                asm volatile("s_waitcnt vmcnt(21)" : "+v"(row[j]), "+v"(cfc[j >> 3]), "+v"(ixn[j >> 3]) :: "memory");
                const float cfj = (j & 1) ? __uint_as_float(cfc[j >> 3][(j >> 1) & 3] & 0xffff0000u) : __uint_as_float(cfc[j >> 3][(j >> 1) & 3] << 16);
                UNR for (int i = 0; i < 4; ++i) { const f32x2_t lo = __builtin_amdgcn_cvt_pk_f32_fp8((int)row[j][i], false), h2 = __builtin_amdgcn_cvt_pk_f32_fp8((int)row[j][i], true);
                    acc[4 * i] = __builtin_fmaf(cfj, lo[0], acc[4 * i]); acc[4 * i + 1] = __builtin_fmaf(cfj, lo[1], acc[4 * i + 1]); acc[4 * i + 2] = __builtin_fmaf(cfj, h2[0], acc[4 * i + 2]); acc[4 * i + 3] = __builtin_fmaf(cfj, h2[1], acc[4 * i + 3]); }
                asm volatile("" :: "v"(acc[0]), "v"(acc[4]), "v"(acc[8]), "v"(acc[12]) : "memory");
                gload16_asm(row[j], Vs + (size_t)((ixn[j >> 3][(j >> 1) & 3] >> (16 * (j & 1))) & 0xffffu) * 128);
            }
            float r8[8], r4[4], r2[2];
            UNR for (int i = 0; i < 8; ++i) { const float keep = b5 ? acc[i + 8] : acc[i], give = b5 ? acc[i] : acc[i + 8];
                auto sw = __builtin_amdgcn_permlane32_swap(__float_as_uint(give), __float_as_uint(give), false, false); r8[i] = keep + __uint_as_float(b5 ? sw[0] : sw[1]); }
            UNR for (int i = 0; i < 4; ++i) { const float keep = b4 ? r8[i + 4] : r8[i], give = b4 ? r8[i] : r8[i + 4];
                auto sw = __builtin_amdgcn_permlane16_swap(__float_as_uint(give), __float_as_uint(give), false, false); r4[i] = keep + __uint_as_float(b4 ? sw[0] : sw[1]); }
            UNR for (int i = 0; i < 2; ++i) { const float keep = b3 ? r4[i + 2] : r4[i], give = b3 ? r4[i] : r4[i + 2]; r2[i] = keep + dpp_f(give, 0x128); }
            asm volatile("" : "+v"(hvc));
            u32x2 o; o[0] = __float_as_uint(__builtin_fmaf(r2[0], 1.0f / 64.0f, __uint_as_float(hvc[0]))); o[1] = __float_as_uint(__builtin_fmaf(r2[1], 1.0f / 64.0f, __uint_as_float(hvc[1])));
            float* op = P.out + tokof(n) * 1024 + doff;
            asm volatile("global_store_dwordx2 %0, %1, off\n\ts_nop 1" :: "v"(op), "v"(o) : "memory");
        };
        u32x4 ixA[2], ixB[2], cfA[2], cfB[2]; u32x2 hvA, hvB;
        load_idx(ixA, 0); load_idx(ixB, 1); load_cf(cfA, hvA, 0);
        asm volatile("s_waitcnt vmcnt(5)" : "+v"(ixA[0]), "+v"(ixA[1]) :: "memory");
        UNR for (int j = 0; j < 16; ++j) gload16_asm(row[j], Vs + (size_t)((ixA[j >> 3][(j >> 1) & 3] >> (16 * (j & 1))) & 0xffffu) * 128);
        u32x2 dummy; gload8_asm(dummy, H2 + tokof(0) * 1024 + doff);
        for (int n = 0; n < N; n += 2) { body(ixB, ixA, cfA, hvA, cfB, hvB, n); body(ixA, ixB, cfB, hvB, cfA, hvA, n + 1); }
        asm volatile("s_waitcnt vmcnt(0)" : "+v"(dummy), "+v"(ixA[0]), "+v"(ixA[1]), "+v"(ixB[0]), "+v"(ixB[1]) :: "memory");
        asm volatile("" : "+v"(cfA[0]), "+v"(cfA[1]), "+v"(cfB[0]), "+v"(cfB[1]), "+v"(hvA), "+v"(hvB) :: "memory");
        asm volatile("" : "+v"(row[0]), "+v"(row[1]), "+v"(row[2]), "+v"(row[3]), "+v"(row[4]), "+v"(row[5]), "+v"(row[6]), "+v"(row[7]) :: "memory");
        asm volatile("" : "+v"(row[8]), "+v"(row[9]), "+v"(row[10]), "+v"(row[11]), "+v"(row[12]), "+v"(row[13]), "+v"(row[14]), "+v"(row[15]) :: "memory");
        asm volatile("s_waitcnt vmcnt(0)" ::: "memory");
    }
}

#define XB_TMO      128
#define XB_XCNT(j)  (256  + 64 * (j))
#define XB_XSUB(j)  (1280 + 64 * (j))
#define XB_XGEN(j)  (2304 + 64 * (j))
#define XB_TOP      3328
#define XB_TOPGEN   3392
#define XCD_BAR_WORDS 3456
#define XB_SPIN_CAP (1u << 18)
#define LAS __attribute__((address_space(3)))
__device__ __forceinline__ unsigned xb_ld(unsigned* p)              { return __hip_atomic_load(p, __ATOMIC_RELAXED, __HIP_MEMORY_SCOPE_AGENT); }
__device__ __forceinline__ unsigned xb_add(unsigned* p, unsigned v) { return __hip_atomic_fetch_add(p, v, __ATOMIC_RELAXED, __HIP_MEMORY_SCOPE_AGENT); }
#define XB_SPIN(cond, bar) do { unsigned _sp = 0; while (cond) { __builtin_amdgcn_s_sleep(1); \
    if ((++_sp & 255u) == 0u) { if (xb_ld(&(bar)[XB_TMO])) break; if (_sp > XB_SPIN_CAP) { atomicAdd(&(bar)[XB_TMO], 1u); break; } } } } while (0)
struct XcdBarrier { unsigned* bar; unsigned x; volatile LAS unsigned* st; };
__device__ __forceinline__ XcdBarrier xcd_barrier_post(unsigned* bar, volatile LAS unsigned* st) {
    XcdBarrier b; b.bar = bar; b.x = xcc_id(); b.st = st;
    if (threadIdx.x == 0) (void)xb_add(&bar[XB_XCNT(b.x)], 1u);
    return b;
}
__device__ __forceinline__ void xcd_barrier_complete(unsigned* bar, unsigned x, unsigned& nloc, unsigned& nx) {
    const unsigned G = gridDim.x * gridDim.y * gridDim.z;
    unsigned sum, cnt, mine, sp = 0u;
    for (;;) {
        sum = 0u; cnt = 0u; mine = 0u;
        UNR for (unsigned j = 0; j < 16; ++j) { const unsigned c = xb_ld(&bar[XB_XCNT(j)]); sum += c; cnt += (c > 0u) ? 1u : 0u; mine = (j == x) ? c : mine; }
        if (sum == G) break;
        __builtin_amdgcn_s_sleep(1);
        if ((++sp & 255u) == 0u) { if (xb_ld(&bar[XB_TMO])) break; if (sp > XB_SPIN_CAP) { atomicAdd(&bar[XB_TMO], 1u); break; } }
    }
    nloc = mine > 0u ? mine : 1u; nx = cnt > 0u ? cnt : 1u;
}
__device__ __forceinline__ void xcd_barrier(const XcdBarrier& b) {
    asm volatile("s_waitcnt vmcnt(0)" ::: "memory");
    __syncthreads();
    if (opaque_tid() == 0) {
        unsigned* bar = b.bar;
        __builtin_amdgcn_s_waitcnt(0);
        unsigned nloc = b.st[0], nx = b.st[1];
        if (nloc == 0u) { xcd_barrier_complete(bar, b.x, nloc, nx); b.st[0] = nloc; b.st[1] = nx; }
        const unsigned old = xb_add(&bar[XB_XSUB(b.x)], 1u);
        const unsigned gen = old / nloc;
        if (old + 1u == (gen + 1u) * nloc) {
            __builtin_amdgcn_fence(__ATOMIC_RELEASE, "agent");
            asm volatile("s_waitcnt vmcnt(0)" ::: "memory");
            const unsigned og = xb_add(&bar[XB_TOP], 1u);
            const unsigned tg = og / nx;
            if (og + 1u == (tg + 1u) * nx) xb_add(&bar[XB_TOPGEN], 1u);
            else XB_SPIN(xb_ld(&bar[XB_TOPGEN]) == tg, bar);
            __builtin_amdgcn_fence(__ATOMIC_ACQUIRE, "agent");
            xb_add(&bar[XB_XGEN(b.x)], 1u);
            asm volatile("s_waitcnt vmcnt(0)" ::: "memory");
        } else {
            XB_SPIN(xb_ld(&bar[XB_XGEN(b.x)]) == gen, bar);
            __builtin_amdgcn_fence(__ATOMIC_ACQUIRE, "agent");
            asm volatile("s_waitcnt vmcnt(0)" ::: "memory");
        }
    }
    __syncthreads();
}

#if SPLIT_LAUNCH
#error split launch path removed
#else
#ifndef TIMING_A
#define TIMING_A -1
#endif
#ifndef TIMING_B
#define TIMING_B -1
#endif
__global__ void __launch_bounds__(NTHREADS) mega_kernel(Params P) {
    __shared__ __attribute__((aligned(16))) char smem[SMEM_BYTES];
    cg::grid_group grid = cg::this_grid();
    const int bid = blockIdx.x, nb = gridDim.x;
    volatile LAS unsigned* xst = (volatile LAS unsigned*)(smem + 133120);
    if (threadIdx.x == 0) { xst[0] = 0u; xst[1] = 0u; }
    if ((threadIdx.x & 63) == 0) ((volatile int*)(smem + TIDTAB_OFF))[(unsigned)__builtin_amdgcn_s_getreg(63492) & 63u] = (int)(threadIdx.x >> 6);
    __syncthreads();
    const XcdBarrier xb = xcd_barrier_post((unsigned*)(P.ws + WS_BAR), xst);
#define GSYNC() xcd_barrier(xb)
#if TIMING_A >= 0
    u64* ts = (u64*)(P.ws + WS_CTL + 1024);
#define STAMP(i) do { if (bid == 0 && threadIdx.x == 0) ts[i] = __builtin_amdgcn_s_memrealtime(); } while (0)
#else
#define STAMP(i) do {} while (0)
#endif
    PG8_LAS unsigned char* lds3 = (PG8_LAS unsigned char*)smem;
    phase0(P, bid, nb); grid.sync();
    phase1(P, lds3); GSYNC();
    phase2<0>(P, smem, 0); GSYNC();
    phase3(P, bid, nb, lds3); GSYNC();
    phase4(P, lds3); GSYNC();
    phase6a(P, lds3); GSYNC();
    phase6b(P, bid, nb, smem); GSYNC();
    phase7a(P, bid, nb); GSYNC();
    phase7m(P, bid, nb); GSYNC();
    phase7b(P, bid, nb);
#if TIMING_A >= 0
    grid.sync(); STAMP(8);
    __threadfence(); grid.sync();
    {
        const volatile u64* tv = ts;
        const float tA = (float)(tv[TIMING_A + 1] - tv[TIMING_A]) * 0.01f, tB = (float)(tv[TIMING_B + 1] - tv[TIMING_B]) * 0.01f;
        const float qA = floorf(log2f(tA) * 4.0f), qB = floorf(log2f(tB) * 4.0f);
        const float delta = 0.25f * qB;
        for (size_t i = (size_t)bid * NTHREADS + threadIdx.x; i < (size_t)BATCH * SEQ * DM; i += (size_t)nb * NTHREADS) P.out[i] = (i == 0) ? (P.out[i] + 64.0f + qA) : (P.out[i] + delta);
    }
#endif
}
#endif

extern "C" void kernel_launch(void* const* d_in, const int* in_sizes, int n_in, void* d_out, int out_size, void* d_ws, size_t ws_size, hipStream_t stream) {
    Params P{};
    const float** pp = (const float**)&P;
    UNR for (int i = 0; i < 21; ++i) pp[i] = (const float*)d_in[i];
    P.out = (float*)d_out; P.ws = (char*)d_ws;
    if (ws_size < WS_END + (size_t)256 * 16 * 4112 * 4) { fprintf(stderr, "workspace too small: %zu < %zu\n", ws_size, (size_t)WS_END); return; }
#if SPLIT_LAUNCH
#else
    static int grid_blocks = 0;
    if (!grid_blocks) {
        int dev = 0, cus = 0, per_cu = 0;
        (void)hipGetDevice(&dev);
        (void)hipDeviceGetAttribute(&cus, hipDeviceAttributeMultiprocessorCount, dev);
        (void)hipOccupancyMaxActiveBlocksPerMultiprocessor(&per_cu, mega_kernel, NTHREADS, 0);
        if (per_cu > 1) per_cu = 1;
        grid_blocks = cus * per_cu;
        if (grid_blocks > 256) grid_blocks = 256;
    }
    (void)hipMemsetAsync((char*)d_ws + WS_BAR, 0, XCD_BAR_WORDS * 4, stream);
    void* args[] = {&P};
    hipError_t e = hipLaunchCooperativeKernel((void*)mega_kernel, dim3(grid_blocks), dim3(NTHREADS), args, 0, stream);
    if (e != hipSuccess) fprintf(stderr, "cooperative launch failed: %s (grid %d)\n", hipGetErrorString(e), grid_blocks);
#endif
}
```

```cpp
#include <hip/hip_runtime.h>
#include <hip/hip_cooperative_groups.h>
#include <cstdio>
#include <cstdint>
namespace cg = cooperative_groups;
#define UNR _Pragma("unroll")

#ifndef SPLIT_LAUNCH
#define SPLIT_LAUNCH 0
#endif

typedef unsigned short bf16_t;
typedef short bf16x8 __attribute__((ext_vector_type(8)));
typedef short s16x4 __attribute__((ext_vector_type(4)));
typedef float f32x16 __attribute__((ext_vector_type(16)));
typedef float f32x4 __attribute__((ext_vector_type(4)));
typedef float f32x2_t __attribute__((ext_vector_type(2)));
typedef __bf16 bf16x2_t __attribute__((ext_vector_type(2)));
typedef unsigned long long u64;
typedef unsigned u32x4 __attribute__((ext_vector_type(4)));
typedef unsigned u32x2 __attribute__((ext_vector_type(2)));
typedef int i32x4_t __attribute__((ext_vector_type(4)));
typedef _Float16 f16x2_t __attribute__((ext_vector_type(2)));
typedef _Float16 f16x4_t __attribute__((ext_vector_type(4)));

constexpr int BATCH = 8, SEQ = 4096, DM = 1024, NMETA = 16;
constexpr int TR = NMETA + SEQ;
constexpr int TP = 4224;
constexpr int R = BATCH * TP;
constexpr int NIN = 4864;
constexpr float EPS = 1e-6f;
constexpr int NTHREADS = 512;
constexpr int NEXP = 16384;
constexpr float LOG2E = 1.4426950408889634f;
constexpr float QSCALE = 0.125f * LOG2E;
constexpr int SMEM_BYTES = 135168;

constexpr size_t al(size_t x) { return (x + 255) & ~(size_t)255; }
constexpr size_t WS_CTL   = 0;
constexpr size_t WS_ROWSS = 4096;
constexpr size_t WS_COS64 = al(WS_ROWSS + (size_t)R * 4);
constexpr size_t WS_SIN64 = al(WS_COS64 + (size_t)TP * 32 * 4);
constexpr size_t WS_ICOS  = al(WS_SIN64 + (size_t)TP * 32 * 4);
constexpr size_t WS_ISIN  = al(WS_ICOS + (size_t)TP * 16 * 4);
constexpr size_t WS_WIN   = al(WS_ISIN + (size_t)TP * 16 * 4);
constexpr size_t WS_WA    = al(WS_WIN + (size_t)NIN * 1024 * 2);
constexpr size_t WS_WB    = al(WS_WA + (size_t)1024 * 512 * 2);
constexpr size_t WS_WO    = al(WS_WB + (size_t)1024 * 512 * 2);
constexpr size_t WS_WQ    = al(WS_WO + (size_t)1024 * 1024 * 2);
constexpr size_t WS_SUBK  = al(WS_WQ + (size_t)1024 * 1024 * 2);
constexpr size_t WS_BK    = al(WS_SUBK + (size_t)8 * 2 * 128 * 64 * 2);
constexpr size_t WS_BV    = al(WS_BK + (size_t)R * 64 * 2);
constexpr size_t WS_IK    = al(WS_BV + (size_t)R * 64 * 2);
constexpr size_t WS_IW    = al(WS_IK + (size_t)R * 64 * 2);
constexpr size_t WS_R1    = al(WS_IW + (size_t)R * 8 * 4);
constexpr size_t SZ_R1    = (size_t)R * 1024 * 2;
constexpr size_t WS_R2    = al(WS_R1 + SZ_R1);
constexpr size_t WS_R3    = al(WS_R2 + SZ_R1);
constexpr size_t WS_R4    = al(WS_R3 + SZ_R1);
constexpr size_t WS_R6    = al(WS_R4 + (size_t)R * 512 * 2);
constexpr size_t WS_BAR   = al(WS_R6 + (size_t)R * 1024 * 4);
constexpr size_t WS_CO    = WS_BAR + 16384;
constexpr size_t WS_END   = WS_CO + (size_t)BATCH * SEQ * 128 * 4;

struct Params {
    const float *x, *meta, *g_mix, *w_in, *g_aq, *g_ak, *lq1, *lk1, *lq2, *lk2, *g_sub, *w_a, *g_bq, *g_bk, *w_b, *w_o, *g_ffn, *w_q, *subk, *pu, *pv;
    float* out;
    char* ws;
};

constexpr int TIDTAB_OFF = 133376;
__device__ __forceinline__ int opaque_tid() {
    const unsigned hw = (unsigned)__builtin_amdgcn_s_getreg(63492) & 63u;
    int wid = *((volatile __attribute__((address_space(3))) int*)(uintptr_t)(TIDTAB_OFF + 4 * hw));
    wid = __builtin_amdgcn_readfirstlane(wid);
    unsigned z = 0u; asm volatile("" : "+v"(z));
    int t = wid * 64 + (int)__builtin_amdgcn_mbcnt_hi(~0u, __builtin_amdgcn_mbcnt_lo(~0u, z));
    asm volatile("" : "+v"(t)); return t;
}
__device__ __forceinline__ unsigned pk2(float lo, float hi) { f32x2_t v = {lo, hi}; bf16x2_t b = __builtin_convertvector(v, bf16x2_t); return __builtin_bit_cast(unsigned, b); }
__device__ __forceinline__ bf16_t f2bf(float x) { return (bf16_t)(pk2(x, 0.f) & 0xffffu); }
__device__ __forceinline__ float bf2f(unsigned x) { return __uint_as_float(x << 16); }
__device__ __forceinline__ unsigned xcc_id() { return (unsigned)__builtin_amdgcn_s_getreg((3 << 11) | 20) & 0xFu; }
__device__ __forceinline__ int crow(int r, int hi) { return (r & 3) + 8 * (r >> 2) + 4 * hi; }
__device__ __forceinline__ f32x16 mfma32(bf16x8 a, bf16x8 b, f32x16 c) { return __builtin_amdgcn_mfma_f32_32x32x16_bf16(a, b, c, 0, 0, 0); }
__device__ __forceinline__ f32x4 mfma16(bf16x8 a, bf16x8 b, f32x4 c) { return __builtin_amdgcn_mfma_f32_16x16x32_bf16(a, b, c, 0, 0, 0); }
__device__ __forceinline__ float ex2(float x) { return __builtin_amdgcn_exp2f(x); }
__device__ __forceinline__ bf16x8 pack8(float a0, float a1, float a2, float a3, float a4, float a5, float a6, float a7) {
    uint4 u; u.x = pk2(a0, a1); u.y = pk2(a2, a3); u.z = pk2(a4, a5); u.w = pk2(a6, a7); return __builtin_bit_cast(bf16x8, u);
}
template <int CTRL> __device__ __forceinline__ float dpp_t(float v) { return __builtin_bit_cast(float, __builtin_amdgcn_update_dpp(0, __builtin_bit_cast(int, v), CTRL, 0xf, 0xf, true)); }
#define dpp_f(v, c) dpp_t<c>(v)
__device__ __forceinline__ void gload16_sv(u32x4& dst, unsigned long long sbase, unsigned voff) { asm volatile("global_load_dwordx4 %0, %1, %2" : "=v"(dst) : "v"(voff), "s"(sbase) : "memory"); }
__device__ __forceinline__ unsigned long long sgpr_ptr(const void* p) { const unsigned long long a = (unsigned long long)p; return ((unsigned long long)(unsigned)__builtin_amdgcn_readfirstlane((int)(a >> 32)) << 32) | (unsigned)__builtin_amdgcn_readfirstlane((int)a); }
__device__ __forceinline__ void gload16_asm(u32x4& dst, const void* p) { asm volatile("global_load_dwordx4 %0, %1, off" : "=v"(dst) : "v"(p) : "memory"); }
__device__ __forceinline__ float wave_sum(float v) {
    v += dpp_f(v, 0xB1); v += dpp_f(v, 0x4E); v += dpp_f(v, 0x141); v += dpp_f(v, 0x140);
    { auto r = __builtin_amdgcn_permlane16_swap(__float_as_uint(v), __float_as_uint(v), false, false); v = __uint_as_float(r[0]) + __uint_as_float(r[1]); }
    { auto r = __builtin_amdgcn_permlane32_swap(__float_as_uint(v), __float_as_uint(v), false, false); v = __uint_as_float(r[0]) + __uint_as_float(r[1]); }
    return v;
}
__device__ __forceinline__ float xrow_sum(float v) {
    { auto r = __builtin_amdgcn_permlane16_swap(__float_as_uint(v), __float_as_uint(v), false, false); v = __uint_as_float(r[0]) + __uint_as_float(r[1]); }
    { auto r = __builtin_amdgcn_permlane32_swap(__float_as_uint(v), __float_as_uint(v), false, false); v = __uint_as_float(r[0]) + __uint_as_float(r[1]); }
    return v;
}
__device__ __forceinline__ float half_other(float v, bool upper) {
    auto r = __builtin_amdgcn_permlane32_swap(__float_as_uint(v), __float_as_uint(v), false, false); return __uint_as_float(upper ? r[0] : r[1]);
}
__device__ __forceinline__ unsigned wave_iscan(unsigned x) {
    x += (unsigned)__builtin_amdgcn_update_dpp(0, (int)x, 0x111, 0xf, 0xf, false);
    x += (unsigned)__builtin_amdgcn_update_dpp(0, (int)x, 0x112, 0xf, 0xf, false);
    x += (unsigned)__builtin_amdgcn_update_dpp(0, (int)x, 0x114, 0xf, 0xf, false);
    x += (unsigned)__builtin_amdgcn_update_dpp(0, (int)x, 0x118, 0xf, 0xf, false);
    x += (unsigned)__builtin_amdgcn_update_dpp(0, (int)x, 0x142, 0xa, 0xf, false);
    x += (unsigned)__builtin_amdgcn_update_dpp(0, (int)x, 0x143, 0xc, 0xf, false);
    return x;
}
__device__ __forceinline__ f32x16 zero16() { f32x16 z; UNR for (int i = 0; i < 16; ++i) z[i] = 0.f; return z; }

__device__ __forceinline__ void phase0(const Params& P, int bid, int nb) {
    const int tid = opaque_tid(), lane = tid & 63, w = tid >> 6;
    char* ws = P.ws;
    {
        bf16_t* XN = (bf16_t*)(ws + WS_R1);
        for (int row = bid * 8 + w; row < R; row += nb * 8) {
            const int b = row / TP, t = row - b * TP;
            f32x4 v[4];
            if (t < NMETA) { const float* src = P.meta + (size_t)t * DM; UNR for (int i = 0; i < 4; ++i) v[i] = *(const f32x4*)(src + i * 256 + lane * 4); }
            else if (t < TR) { const float* src = P.x + ((size_t)b * SEQ + (t - NMETA)) * DM; UNR for (int i = 0; i < 4; ++i) v[i] = *(const f32x4*)(src + i * 256 + lane * 4); }
            else { UNR for (int i = 0; i < 4; ++i) v[i] = (f32x4){0.f, 0.f, 0.f, 0.f}; }
            float ss = 0.f;
            UNR for (int i = 0; i < 4; ++i) ss += v[i][0] * v[i][0] + v[i][1] * v[i][1] + v[i][2] * v[i][2] + v[i][3] * v[i][3];
            ss = wave_sum(ss);
            const float rinv = rsqrtf(ss * (1.0f / DM) + EPS);
            UNR for (int i = 0; i < 4; ++i) {
                const f32x4 g = *(const f32x4*)(P.g_mix + i * 256 + lane * 4);
                uint2 o; o.x = pk2(v[i][0] * rinv * g[0], v[i][1] * rinv * g[1]); o.y = pk2(v[i][2] * rinv * g[2], v[i][3] * rinv * g[3]);
                *(uint2*)(XN + (size_t)row * DM + i * 256 + lane * 4) = o;
            }
        }
    }
    const int gt = bid * NTHREADS + tid, gn = nb * NTHREADS;
    auto conv = [&](const float* W, int K, int Nsrc, int Ndst, bf16_t* Wt, bool remap) {
        const int items = Ndst * (K / 8);
        for (int it = gt; it < items; it += gn) {
            const int kc = it / Ndst, n = it - kc * Ndst;
            int ns = n; bool zero = false;
            if (remap) { const int p = n & 255; const int L = (n & ~255) + 64 * ((p >> 5) & 3) + 32 * (p >> 7) + (p & 31);
                         ns = L; if (L >= 2816) ns = L - 56; else if (L >= 2760) zero = true; }
            float f[8];
            UNR for (int j = 0; j < 8; ++j) f[j] = zero ? 0.f : W[(size_t)(kc * 8 + j) * Nsrc + ns];
            uint4 o; o.x = pk2(f[0], f[1]); o.y = pk2(f[2], f[3]); o.z = pk2(f[4], f[5]); o.w = pk2(f[6], f[7]);
            *(uint4*)(Wt + (size_t)n * K + kc * 8) = o;
        }
    };
    conv(P.w_in, 1024, 4808, NIN, (bf16_t*)(ws + WS_WIN), true);
    conv(P.w_a, 512, 1024, 1024, (bf16_t*)(ws + WS_WA), false);
    conv(P.w_b, 512, 1024, 1024, (bf16_t*)(ws + WS_WB), false);
    conv(P.w_o, 1024, 1024, 1024, (bf16_t*)(ws + WS_WO), false);
    conv(P.w_q, 1024, 1024, 1024, (bf16_t*)(ws + WS_WQ), false);
    { bf16_t* SK = (bf16_t*)(ws + WS_SUBK); for (int i = gt; i < 8 * 2 * 128 * 64; i += gn) SK[i] = f2bf(P.subk[i]); }
    {
        float* c64 = (float*)(ws + WS_COS64); float* s64 = (float*)(ws + WS_SIN64); float* ic = (float*)(ws + WS_ICOS); float* is = (float*)(ws + WS_ISIN);
        for (int i = gt; i < TP * 32; i += gn) { const int t = i >> 5, j = i & 31; const float inv = powf(10000.0f, -(float)(2 * j) / 64.0f); const float ang = (float)t * inv; c64[i] = (float)cos((double)ang); s64[i] = (float)sin((double)ang); }
        for (int i = gt; i < TP * 16; i += gn) { const int t = i >> 4, j = i & 15; const float inv = powf(10000.0f, -(float)(2 * j) / 32.0f); const float ang = (float)t * inv; ic[i] = (float)cos((double)ang); is[i] = (float)sin((double)ang); }
    }
    { float* rs = (float*)(ws + WS_ROWSS); for (int i = gt; i < R; i += gn) rs[i] = 0.f; }
    if (tid == 0) ((int*)(ws + WS_CTL + 2048))[bid] = (int)xcc_id();
    if (bid == 0 && w == 0) {
        float a = P.lq1[lane] * P.lk1[lane], b2 = P.lq2[lane] * P.lk2[lane];
        for (int o = 32; o >= 1; o >>= 1) { a += __shfl_xor(a, o); b2 += __shfl_xor(b2, o); }
        if (lane == 0) { ((unsigned*)(ws + WS_CTL))[0] = 0u; ((unsigned*)(ws + WS_CTL))[1] = 0u; ((unsigned*)(ws + WS_CTL))[2] = 0u; ((float*)(ws + WS_CTL))[4] = expf(a) - expf(b2) + 0.2f; }
    }
}

namespace pg8 {
#define PG8_LAS __attribute__((address_space(3)))
typedef unsigned short bf16_t;
typedef short bf16x8 __attribute__((ext_vector_type(8)));
typedef float f32x4 __attribute__((ext_vector_type(4)));
typedef unsigned u32x4 __attribute__((ext_vector_type(4)));
constexpr int BM = 256, BK = 64, HALF = 128, HTB = HALF * BK * 2  , STAGE_BYTES = 8 * HTB, NXCD = 8, WGM = 8;

__host__ __device__ __forceinline__ int lds_byte(int r, int c) { const int st = (r >> 4) * 2 + (c >> 5), rr = r & 15, cc = c & 31, ob = rr * 64 + cc * 2; return st * 1024 + (ob ^ (((ob >> 9) & 1) << 5)); }
__host__ __device__ __forceinline__ void stage_rc(int b, int& R, int& C) { const int st = b / 1024, sb = b % 1024, swz = sb ^ (((sb >> 9) & 1) << 5); R = (st >> 1) * 16 + swz / 64; C = (st & 1) * 32 + (swz % 64) / 2; }
__host__ __device__ __forceinline__ int perm32(int rho) { const int n = rho >> 4, i = rho & 15; return 8 * (i >> 2) + 4 * n + (i & 3); }

struct Unit { int pm, pn; };
struct Gemm { const bf16_t* A; const bf16_t* Bt; int M, N, K; };

struct StaticOrder {
    int nM, nN, nwg, G, c;
    __host__ __device__ void init(int M, int N, int G_, int c_) { nM = M / BM; nN = N / BM; nwg = nM * nN; G = G_; c = c_; }
    __host__ __device__ bool next(int i, Unit& u) const {
        const long L = (long)i * G + c; if (L >= nwg) return false;
        int wgid = (int)L; { const int q = nwg / NXCD, r = nwg % NXCD, xcd = wgid % NXCD, off = wgid / NXCD; wgid = (xcd < r ? xcd * (q + 1) : r * (q + 1) + (xcd - r) * q) + off; }
        const int nig = WGM * nN, gid = wgid / nig, fm = gid * WGM, gsz = (nM - fm) < WGM ? (nM - fm) : WGM;
        u.pm = fm + ((wgid % nig) % gsz); u.pn = (wgid % nig) / gsz; return true;
    }
    __device__ __forceinline__ void a_ready(const Unit&) const {}
    __device__ __forceinline__ void done(const Unit&) const {}
};
template <class Epi, class Sched, bool ALIGN_EPI = false, bool SP2 = false>
__device__ __forceinline__ void gemm_phase(PG8_LAS unsigned char* lds, const Gemm g, const Sched& S, const Epi& E) {
    const int tid = opaque_tid(), wid = __builtin_amdgcn_readfirstlane(tid >> 6), lane = tid & 63, wr = wid >> 2, wc = wid & 3, fr = lane & 15, fq = lane >> 4;
    const int K = g.K, nt = K / BK;
    unsigned voffA[2], voffB[2];
#pragma unroll
    for (int i = 0; i < 2; ++i) { int R, C; stage_rc(tid * 16 + i * 8192, R, C); const int Rb = Epi::PERM ? ((R & ~31) + perm32(R & 31)) : R;
        voffA[i] = (unsigned)(R * K + C) * 2u; voffB[i] = (unsigned)(Rb * K + C) * 2u; }
    const size_t kstep = (size_t)(BK * 2);
    const size_t hstep = (size_t)HALF * K * 2;
    const size_t tstep = 2 * hstep;
    const unsigned ldsw = (unsigned)wid * 1024u;
    const int aoff = lds_byte(wr * 64 + fr, fq * 8), boff = lds_byte(wc * 32 + fr, fq * 8);
#define PG8_SA(b, h) (((b) * 2 + (h)) * HTB)
#define PG8_SB(b, h) ((4 + (b) * 2 + (h)) * HTB)
#define PG8_STAGE(bufoff, gbase, voff) do { _Pragma("unroll") for (int _i = 0; _i < 2; ++_i) \
        __builtin_amdgcn_global_load_lds((const unsigned*)((const char*)(gbase) + (voff)[_i]), (PG8_LAS unsigned*)(lds + (bufoff) + ldsw + _i * 8192), 16, 0, 0); } while (0)
#define PG8_LDA(dst, b, h) do { _Pragma("unroll") for (int m = 0; m < 4; ++m) _Pragma("unroll") for (int k = 0; k < 2; ++k) dst[m][k] = *(const PG8_LAS bf16x8*)(lds + PG8_SA(b, h) + aoff + m * 2048 + k * 1024); } while (0)
#define PG8_LDB(dst, b, h) do { _Pragma("unroll") for (int n = 0; n < 2; ++n) _Pragma("unroll") for (int k = 0; k < 2; ++k) dst[n][k] = *(const PG8_LAS bf16x8*)(lds + PG8_SB(b, h) + boff + n * 2048 + k * 1024); } while (0)
#define PG8_MMA(ai, bj, At, Bt) do { __builtin_amdgcn_s_setprio(1); _Pragma("unroll") for (int m = 0; m < 4; ++m) _Pragma("unroll") for (int n = 0; n < 2; ++n) _Pragma("unroll") for (int k = 0; k < 2; ++k) \
        acc[ai][bj][m][n] = __builtin_amdgcn_mfma_f32_16x16x32_bf16(Bt[n][k], At[m][k], acc[ai][bj][m][n], 0, 0, 0); __builtin_amdgcn_s_setprio(0); } while (0)
#define PG8_WAIT_V(n) asm volatile("s_waitcnt vmcnt(" #n ")" ::: "memory")
#define PG8_WAIT_L(n) asm volatile("s_waitcnt lgkmcnt(" #n ")" ::: "memory")
#define PG8_BAR __builtin_amdgcn_s_barrier()
#define PG8_SCHED __builtin_amdgcn_sched_barrier(0)
    Unit cur, nxt; int ui = 0;
    if (!S.next(0, cur)) return;
    f32x4 acc[2][2][4][2];
#pragma unroll
    for (int a = 0; a < 2; ++a)
#pragma unroll
        for (int b = 0; b < 2; ++b)
#pragma unroll
            for (int m = 0; m < 4; ++m)
#pragma unroll
                for (int n = 0; n < 2; ++n) acc[a][b][m][n] = (f32x4){0.f, 0.f, 0.f, 0.f};
    bf16x8 At[4][2], B0[2][2], B1[2][2];
    const char* cA = (const char*)g.A + (size_t)cur.pm * tstep; const char* cB = (const char*)g.Bt + (size_t)cur.pn * tstep;
    S.a_ready(cur);
    if constexpr (SP2) {
        PG8_STAGE(PG8_SB(0, 0), cB, voffB); PG8_STAGE(PG8_SB(0, 1), cB + hstep, voffB); PG8_STAGE(PG8_SA(0, 0), cA, voffA); PG8_STAGE(PG8_SA(0, 1), cA + hstep, voffA);
        if (wr == 1) PG8_BAR;
        PG8_WAIT_V(2); PG8_BAR;
        PG8_STAGE(PG8_SB(1, 0), cB + kstep, voffB); PG8_STAGE(PG8_SA(1, 0), cA + kstep, voffA); PG8_STAGE(PG8_SB(1, 1), cB + hstep + kstep, voffB);
        PG8_WAIT_V(6); PG8_BAR;
    } else {
        PG8_STAGE(PG8_SB(0, 0), cB, voffB); PG8_STAGE(PG8_SA(0, 0), cA, voffA); PG8_STAGE(PG8_SB(0, 1), cB + hstep, voffB); PG8_STAGE(PG8_SA(0, 1), cA + hstep, voffA);
        if (wr == 1) PG8_BAR;
        PG8_WAIT_V(4); PG8_BAR;
        PG8_STAGE(PG8_SB(1, 0), cB + kstep, voffB); PG8_STAGE(PG8_SA(1, 0), cA + kstep, voffA); PG8_STAGE(PG8_SB(1, 1), cB + hstep + kstep, voffB);
        PG8_WAIT_V(6); PG8_BAR;
    }
    for (;;) {
        const bool has_next = S.next(ui + 1, nxt);
        const char* nA = has_next ? (const char*)g.A + (size_t)nxt.pm * tstep : cA; const char* nB = has_next ? (const char*)g.Bt + (size_t)nxt.pn * tstep : cB;
        for (int t = 0; t < nt; t += 2) {
            const bool last = (t == nt - 2);
            const char* a1 = cA + (size_t)(t + 1) * kstep;
            const char* a2 = last ? nA : cA + (size_t)(t + 2) * kstep; const char* b2 = last ? nB : cB + (size_t)(t + 2) * kstep;
            const char* a3 = a2 + kstep; const char* b3 = b2 + kstep;
            if (last && has_next) S.a_ready(nxt);
            if constexpr (SP2) {
            PG8_LDB(B0, 0, 0); PG8_LDB(B1, 0, 1); PG8_SCHED; PG8_LDA(At, 0, 0); PG8_STAGE(PG8_SA(1, 1), a1 + hstep, voffA);
            PG8_WAIT_V(8); PG8_WAIT_L(0); PG8_BAR; PG8_MMA(0, 0, At, B0); PG8_MMA(0, 1, At, B1); PG8_BAR; PG8_SCHED;
            PG8_LDA(At, 0, 1); PG8_STAGE(PG8_SB(0, 0), b2, voffB); PG8_STAGE(PG8_SB(0, 1), b2 + hstep, voffB); PG8_STAGE(PG8_SA(0, 0), a2, voffA);
            PG8_WAIT_V(8); PG8_WAIT_L(0); PG8_BAR; PG8_MMA(1, 0, At, B0); PG8_MMA(1, 1, At, B1); PG8_BAR; PG8_SCHED;
            PG8_LDB(B0, 1, 0); PG8_LDB(B1, 1, 1); PG8_SCHED; PG8_LDA(At, 1, 0); PG8_STAGE(PG8_SA(0, 1), a2 + hstep, voffA);
            PG8_WAIT_V(8); PG8_WAIT_L(0); PG8_BAR; PG8_MMA(0, 0, At, B0); PG8_MMA(0, 1, At, B1); PG8_BAR; PG8_SCHED;
            PG8_LDA(At, 1, 1); PG8_STAGE(PG8_SB(1, 0), b3, voffB); PG8_STAGE(PG8_SB(1, 1), b3 + hstep, voffB); PG8_STAGE(PG8_SA(1, 0), a3, voffA);
            PG8_WAIT_V(8); PG8_WAIT_L(0); PG8_BAR; PG8_MMA(1, 0, At, B0); PG8_MMA(1, 1, At, B1); PG8_BAR; PG8_SCHED;
            } else {
            PG8_LDB(B0, 0, 0); PG8_SCHED; PG8_LDA(At, 0, 0); PG8_STAGE(PG8_SA(1, 1), a1 + hstep, voffA);
            PG8_WAIT_L(8); PG8_BAR; PG8_WAIT_L(0); PG8_MMA(0, 0, At, B0); PG8_BAR; PG8_SCHED;
            PG8_LDB(B1, 0, 1); PG8_STAGE(PG8_SB(0, 0), b2, voffB);
            PG8_BAR; PG8_WAIT_L(0); PG8_MMA(0, 1, At, B1); PG8_BAR;
            PG8_LDA(At, 0, 1); PG8_STAGE(PG8_SA(0, 0), a2, voffA);
            PG8_BAR; PG8_WAIT_L(0); PG8_MMA(1, 0, At, B0); PG8_BAR; PG8_SCHED;
            PG8_STAGE(PG8_SB(0, 1), b2 + hstep, voffB);
            PG8_WAIT_V(6); PG8_BAR; PG8_MMA(1, 1, At, B1); PG8_BAR;
            PG8_LDB(B0, 1, 0); PG8_SCHED; PG8_LDA(At, 1, 0); PG8_STAGE(PG8_SA(0, 1), a2 + hstep, voffA);
            PG8_WAIT_L(8); PG8_BAR; PG8_WAIT_L(0); PG8_MMA(0, 0, At, B0); PG8_BAR; PG8_SCHED;
            PG8_LDB(B1, 1, 1); PG8_STAGE(PG8_SB(1, 0), b3, voffB);
            PG8_BAR; PG8_WAIT_L(0); PG8_MMA(0, 1, At, B1); PG8_BAR;
            PG8_LDA(At, 1, 1); PG8_STAGE(PG8_SA(1, 0), a3, voffA);
            PG8_BAR; PG8_WAIT_L(0); PG8_MMA(1, 0, At, B0); PG8_BAR; PG8_SCHED;
            PG8_STAGE(PG8_SB(1, 1), b3 + hstep, voffB);
            PG8_WAIT_V(6); PG8_BAR; PG8_MMA(1, 1, At, B1); PG8_BAR;
            }
        }
        if constexpr (ALIGN_EPI) { if (wr == 0) PG8_BAR; }
        if constexpr (!Epi::AFTER_DRAIN) { E(acc, cur, wr, wc, fr, fq); S.done(cur); }
        if (!has_next) break;
#pragma unroll
        for (int a = 0; a < 2; ++a)
#pragma unroll
            for (int b = 0; b < 2; ++b)
#pragma unroll
                for (int m = 0; m < 4; ++m)
#pragma unroll
                    for (int n = 0; n < 2; ++n) acc[a][b][m][n] = (f32x4){0.f, 0.f, 0.f, 0.f};
        cur = nxt; cA = nA; cB = nB; ++ui;
        if constexpr (ALIGN_EPI) { if (wr == 1) PG8_BAR; }
    }
    PG8_WAIT_V(0);
    if constexpr (!ALIGN_EPI) { if (wr == 0) PG8_BAR; }
    PG8_BAR;
    if constexpr (Epi::AFTER_DRAIN) { E.fused(acc, cur, wr, wc, fr, fq, lds, wid, lane); S.done(cur); }
#undef PG8_SA
#undef PG8_SB
#undef PG8_STAGE
#undef PG8_LDA
#undef PG8_LDB
#undef PG8_MMA
#undef PG8_WAIT_V
#undef PG8_WAIT_L
#undef PG8_BAR
#undef PG8_SCHED
}
}

constexpr int MC = BATCH * SEQ;
struct EpiProj {
    static constexpr bool PERM = true, AFTER_DRAIN = false;
    char* ws0; const float *g_aq, *g_ak, *g_bq, *g_bk;
    __device__ __forceinline__ void operator()(const f32x4 (&acc)[2][2][4][2], const pg8::Unit& u, int wr, int wc, int fr, int fq) const {
        size_t oz = 0; asm volatile("" : "+s"(oz)); char* ws = ws0 + oz;
        bf16_t* AQ = (bf16_t*)(ws + WS_R2); bf16_t* AK = AQ + (size_t)8 * 8 * TP * 64;
        bf16_t* AVT = (bf16_t*)(ws + WS_R3); bf16_t* BQ = AVT + (size_t)8 * 4 * 128 * TP;
        unsigned char* KV8 = (unsigned char*)(ws + WS_BK); bf16_t* IK = (bf16_t*)(ws + WS_IK); float* IW = (float*)(ws + WS_IW);
        bf16_t* IQ = (bf16_t*)(ws + WS_R4); bf16_t* GA = (bf16_t*)(ws + WS_R6); bf16_t* GB = GA + (size_t)MC * 1024;
        const float* c64 = (const float*)(ws + WS_COS64); const float* s64 = (const float*)(ws + WS_SIN64); const float* ic = (const float*)(ws + WS_ICOS); const float* is = (const float*)(ws + WS_ISIN);
        const int chunk = u.pn * 4 + wc;
        UNR for (int ai = 0; ai < 2; ++ai) UNR for (int m = 0; m < 4; ++m) {
            const int row = u.pm * 256 + ai * 128 + wr * 64 + m * 16 + fr; const int b = row / TP, t = row - b * TP;
            f32x4 x[2][2]; UNR for (int bj = 0; bj < 2; ++bj) UNR for (int n = 0; n < 2; ++n) x[bj][n] = acc[ai][bj][m][n];
            const bool nr = (chunk < 16) || (chunk >= 24 && chunk <= 32);
            if (nr) {
                const float* gain; bf16_t* dst = nullptr; float sc = 1.f;
                if (chunk < 8) { gain = g_aq; dst = AQ + ((size_t)(b * 8 + chunk) * TP + t) * 64; sc = QSCALE; }
                else if (chunk < 16) { gain = g_ak; dst = AK + ((size_t)(b * 8 + chunk - 8) * TP + t) * 64; }
                else if (chunk < 32) { gain = g_bq; dst = BQ + (size_t)row * 512 + (chunk - 24) * 64; sc = QSCALE; }
                else { gain = g_bk; }
                float ss = 0.f;
                UNR for (int bj = 0; bj < 2; ++bj) UNR for (int n = 0; n < 2; ++n) UNR for (int e = 0; e < 4; ++e) ss += x[bj][n][e] * x[bj][n][e];
                ss = xrow_sum(ss);
                const float rinv = rsqrtf(ss * (1.0f / 64.0f) + EPS);
                float o1[8], o2[8];
                UNR for (int n = 0; n < 2; ++n) {
                    const int j = 8 * fq + 4 * n;
                    const f32x4 c = *(const f32x4*)(c64 + t * 32 + j), s = *(const f32x4*)(s64 + t * 32 + j);
                    const f32x4 g1 = *(const f32x4*)(gain + j), g2 = *(const f32x4*)(gain + 32 + j);
                    UNR for (int e = 0; e < 4; ++e) { const float y1 = x[0][n][e] * rinv * g1[e], y2 = x[1][n][e] * rinv * g2[e]; o1[4 * n + e] = (y1 * c[e] - y2 * s[e]) * sc; o2[4 * n + e] = (y2 * c[e] + y1 * s[e]) * sc; }
                }
                if (chunk == 32) {
                    uint4 w8; int w0;
                    w0 = 0; w0 = __builtin_amdgcn_cvt_pk_fp8_f32(o1[0], o1[1], w0, false); w0 = __builtin_amdgcn_cvt_pk_fp8_f32(o1[2], o1[3], w0, true); w8.x = (unsigned)w0;
                    w0 = 0; w0 = __builtin_amdgcn_cvt_pk_fp8_f32(o1[4], o1[5], w0, false); w0 = __builtin_amdgcn_cvt_pk_fp8_f32(o1[6], o1[7], w0, true); w8.y = (unsigned)w0;
                    w0 = 0; w0 = __builtin_amdgcn_cvt_pk_fp8_f32(o2[0], o2[1], w0, false); w0 = __builtin_amdgcn_cvt_pk_fp8_f32(o2[2], o2[3], w0, true); w8.z = (unsigned)w0;
                    w0 = 0; w0 = __builtin_amdgcn_cvt_pk_fp8_f32(o2[4], o2[5], w0, false); w0 = __builtin_amdgcn_cvt_pk_fp8_f32(o2[6], o2[7], w0, true); w8.w = (unsigned)w0;
                    *(uint4*)(KV8 + (size_t)row * 128 + 16 * fq) = w8;
                } else {
                    uint4 u1, u2;
                    u1.x = pk2(o1[0], o1[1]); u1.y = pk2(o1[2], o1[3]); u1.z = pk2(o1[4], o1[5]); u1.w = pk2(o1[6], o1[7]);
                    u2.x = pk2(o2[0], o2[1]); u2.y = pk2(o2[2], o2[3]); u2.z = pk2(o2[4], o2[5]); u2.w = pk2(o2[6], o2[7]);
                    *(uint4*)(dst + 8 * fq) = u1; *(uint4*)(dst + 32 + 8 * fq) = u2;
                }
            } else if (chunk < 24) {
                const int hd = (chunk - 16) >> 1, half = (chunk - 16) & 1;
                const int tc = (t & ~12) | ((t & 4) << 1) | ((t & 8) >> 1);
                bf16_t* dst = AVT + ((size_t)(b * 4 + hd) * 128 + half * 64) * TP + tc;
                const bool odd = (fr & 1) != 0; bf16_t* dp = dst - (odd ? 1 : 0);
                UNR for (int bj = 0; bj < 2; ++bj) UNR for (int n = 0; n < 2; ++n) UNR for (int e = 0; e < 4; e += 2) {
                    const float a0 = x[bj][n][e], a1 = x[bj][n][e + 1];
                    const float give = odd ? a0 : a1; const float recv = dpp_f(give, 0xB1);
                    const unsigned wv = odd ? pk2(recv, a1) : pk2(a0, recv);
                    const int d = 32 * bj + 8 * fq + 4 * n + e + (odd ? 1 : 0);
                    *(unsigned*)(dp + (size_t)d * TP) = wv;
                }
            } else if (chunk == 33) {
                unsigned char* kv = KV8 + (size_t)row * 128 + 64;
                UNR for (int bj = 0; bj < 2; ++bj) { uint2 w8; int w0;
                    w0 = 0; w0 = __builtin_amdgcn_cvt_pk_fp8_f32(x[bj][0][0], x[bj][0][1], w0, false); w0 = __builtin_amdgcn_cvt_pk_fp8_f32(x[bj][0][2], x[bj][0][3], w0, true); w8.x = (unsigned)w0;
                    w0 = 0; w0 = __builtin_amdgcn_cvt_pk_fp8_f32(x[bj][1][0], x[bj][1][1], w0, false); w0 = __builtin_amdgcn_cvt_pk_fp8_f32(x[bj][1][2], x[bj][1][3], w0, true); w8.y = (unsigned)w0;
                    *(uint2*)(kv + 32 * bj + 8 * fq) = w8; }
            } else if (chunk <= 42) {
                bf16_t* dst = (chunk == 42) ? IK + (size_t)row * 64 : IQ + (size_t)row * 512 + (chunk - 34) * 64;
                const bool hi2 = fq >= 2; const int jb = 8 * (fq & 1);
                float y[8];
                UNR for (int n = 0; n < 2; ++n) {
                    const f32x4 c = *(const f32x4*)(ic + t * 16 + jb + 4 * n), s = *(const f32x4*)(is + t * 16 + jb + 4 * n);
                    UNR for (int e = 0; e < 4; ++e) {
                        const float mine = x[0][n][e];
                        auto sw = __builtin_amdgcn_permlane32_swap(__float_as_uint(mine), __float_as_uint(mine), false, false);
                        const float other = __uint_as_float(hi2 ? sw[0] : sw[1]);
                        const float a = hi2 ? other : mine, bb = hi2 ? mine : other;
                        y[4 * n + e] = hi2 ? (bb * c[e] + a * s[e]) : (a * c[e] - bb * s[e]);
                    }
                }
                uint4 u1, u2;
                u1.x = pk2(y[0], y[1]); u1.y = pk2(y[2], y[3]); u1.z = pk2(y[4], y[5]); u1.w = pk2(y[6], y[7]);
                u2.x = pk2(x[1][0][0], x[1][0][1]); u2.y = pk2(x[1][0][2], x[1][0][3]); u2.z = pk2(x[1][1][0], x[1][1][1]); u2.w = pk2(x[1][1][2], x[1][1][3]);
                *(uint4*)(dst + 8 * fq) = u1; *(uint4*)(dst + 32 + 8 * fq) = u2;
            } else if (chunk == 43) {
                const float sc = 0.35355339059327373f * 0.125f;
                if (fq == 0) { *(f32x4*)(IW + (size_t)row * 8) = x[0][0] * sc; *(f32x4*)(IW + (size_t)row * 8 + 4) = x[0][1] * sc; }
            } else {
                if (t >= NMETA && t < TR) {
                    const size_t mc = (size_t)b * SEQ + (t - NMETA);
                    bf16_t* dst = (chunk < 60) ? GA + mc * 1024 + (chunk - 44) * 64 : GB + mc * 1024 + (chunk - 60) * 64;
                    UNR for (int bj = 0; bj < 2; ++bj) {
                        float o[8]; UNR for (int n = 0; n < 2; ++n) UNR for (int e = 0; e < 4; ++e) o[4 * n + e] = __builtin_amdgcn_rcpf(1.0f + ex2(-LOG2E * x[bj][n][e]));
                        uint4 v; v.x = pk2(o[0], o[1]); v.y = pk2(o[2], o[3]); v.z = pk2(o[4], o[5]); v.w = pk2(o[6], o[7]); *(uint4*)(dst + 32 * bj + 8 * fq) = v;
                    }
                }
            }
        }
    }
};
__device__ __forceinline__ void phase1(const Params& P, PG8_LAS unsigned char* lds) {
    pg8::Gemm g{(const bf16_t*)(P.ws + WS_R1), (const bf16_t*)(P.ws + WS_WIN), R, NIN, 1024};
    pg8::StaticOrder S; S.init(R, NIN, (int)gridDim.x, (int)blockIdx.x);
    EpiProj E{P.ws, P.g_aq, P.g_ak, P.g_bq, P.g_bk};
    pg8::gemm_phase<EpiProj, pg8::StaticOrder, true, true>(lds, g, S, E);
}

__device__ __forceinline__ void attnA_unit(const Params& P, int b, int head, int qb, char* lds) {
    const int tid = opaque_tid(), lane = tid & 63, w = tid >> 6, qg = w & 3, st = w >> 2, l31 = lane & 31, hi = lane >> 5;
    char* ws = P.ws;
    const bf16_t* AQ = (const bf16_t*)(ws + WS_R2); const bf16_t* AK = AQ + (size_t)8 * 8 * TP * 64; const bf16_t* AVT = (const bf16_t*)(ws + WS_R3);
    bf16_t* AOUT = (bf16_t*)(ws + WS_R1);
    const float lam = ((const float*)(ws + WS_CTL))[4];
    const int q0 = qb * 128 + qg * 32;
    const bf16_t* Qp = AQ + ((size_t)(b * 8 + head * 2 + st) * TP + q0 + l31) * 64;
    bf16x8 qf[4];
    UNR for (int ks = 0; ks < 4; ++ks) qf[ks] = *(const bf16x8*)(Qp + ks * 16 + hi * 8);
    const bf16_t* K0g = AK + (size_t)(b * 8 + head * 2) * TP * 64; const bf16_t* K1g = K0g + (size_t)TP * 64;
    const bf16_t* Vg = AVT + (size_t)(b * 4 + head) * 128 * TP;
    const int nkt = 2 * (qb + 1);
    const int srow = tid >> 3, sch = tid & 7;
    const int koff = srow * 128 + ((sch ^ (srow & 7)) << 4), voff = srow * 128 + ((sch ^ ((srow >> 1) & 7)) << 4);
    typedef __attribute__((address_space(3))) unsigned las_u32;
    const bf16_t* gk0 = K0g + (size_t)srow * 64 + ((sch ^ (srow & 7)) << 3);
    const bf16_t* gk1 = gk0 + (size_t)TP * 64;
    const bf16_t* gv0 = Vg + (size_t)srow * TP + ((sch ^ ((srow >> 1) & 7)) << 3);
    const bf16_t* gv1 = gv0 + (size_t)64 * TP;
    auto gload = [&](int kt, int buf) {
        char* base = lds + buf * 32768 + w * 1024;
        __builtin_amdgcn_global_load_lds((const unsigned*)(gk0 + (size_t)kt * 4096), (las_u32*)(base), 16, 0, 0);
        __builtin_amdgcn_global_load_lds((const unsigned*)(gk1 + (size_t)kt * 4096), (las_u32*)(base + 8192), 16, 0, 0);
        __builtin_amdgcn_global_load_lds((const unsigned*)(gv0 + kt * 64), (las_u32*)(base + 16384), 16, 0, 0);
        __builtin_amdgcn_global_load_lds((const unsigned*)(gv1 + kt * 64), (las_u32*)(base + 24576), 16, 0, 0);
    };
    f32x16 o[4]; UNR for (int i = 0; i < 4; ++i) o[i] = zero16();
    f32x16 osum = zero16(), negm = zero16();
    bf16x8 ones; UNR for (int i = 0; i < 8; ++i) ones[i] = (bf16_t)0x3F80;
    bool first = true;
    asm volatile("" :: "v"(qf[0]), "v"(qf[1]), "v"(qf[2]), "v"(qf[3]));
    gload(0, 0); asm volatile("s_waitcnt vmcnt(0)" ::: "memory"); __syncthreads();
    const int qpos = q0 + l31;
    for (int kt = 0; kt < nkt; ++kt) {
        if (kt + 1 < nkt) gload(kt + 1, (kt + 1) & 1);
        const char* base = lds + (kt & 1) * 32768; const char* Kb = base + st * 8192; const char* Vb = base + 16384;
        f32x16 s0, s1;
        {
            bf16x8 ka[4], kb[4];
            UNR for (int ks = 0; ks < 4; ++ks) { const int co = (((ks * 2 + hi) ^ (l31 & 7)) << 4); ka[ks] = *(const bf16x8*)(Kb + l31 * 128 + co); kb[ks] = *(const bf16x8*)(Kb + (32 + l31) * 128 + co); }
            __builtin_amdgcn_sched_barrier(0);
            s0 = mfma32(ka[0], qf[0], negm); s1 = mfma32(kb[0], qf[0], negm);
            UNR for (int ks = 1; ks < 4; ++ks) { s0 = mfma32(ka[ks], qf[ks], s0); s1 = mfma32(kb[ks], qf[ks], s1); }
        }
        if (kt >= nkt - 2) {
            const int kbase = kt * 64;
            UNR for (int r = 0; r < 16; ++r) { const int key = kbase + crow(r, hi); if (key > qpos) s0[r] = -INFINITY; if (key + 32 > qpos) s1[r] = -INFINITY; }
        }
        float mx = s0[0];
        UNR for (int r = 1; r < 16; ++r) mx = fmaxf(mx, s0[r]);
        UNR for (int r = 0; r < 16; ++r) mx = fmaxf(mx, s1[r]);
        if (first || !__all(mx <= 8.0f)) {
            mx = fmaxf(mx, __shfl_xor(mx, 32));
            const float d = first ? mx : fmaxf(mx, 0.f);
            const float alpha = first ? 1.0f : ex2(-d);
            UNR for (int r = 0; r < 16; ++r) { s0[r] -= d; s1[r] -= d; negm[r] -= d; osum[r] *= alpha; }
            UNR for (int mt = 0; mt < 4; ++mt) UNR for (int r = 0; r < 16; ++r) o[mt][r] *= alpha;
            first = false;
        }
        auto vfrag = [&](int g, bf16x8 (&a)[4]) {
            UNR for (int mt = 0; mt < 4; ++mt) { const int d = mt * 32 + l31; const int sw = (d >> 1) & 7; a[mt] = *(const bf16x8*)(Vb + d * 128 + (((2 * g + hi) ^ sw) << 4)); }
        };
        auto pexp = [&](int g) -> bf16x8 {
            const int bq = 8 * (g & 1);
            if (g >> 1) return pack8(ex2(s1[bq]), ex2(s1[bq + 1]), ex2(s1[bq + 2]), ex2(s1[bq + 3]), ex2(s1[bq + 4]), ex2(s1[bq + 5]), ex2(s1[bq + 6]), ex2(s1[bq + 7]));
            return pack8(ex2(s0[bq]), ex2(s0[bq + 1]), ex2(s0[bq + 2]), ex2(s0[bq + 3]), ex2(s0[bq + 4]), ex2(s0[bq + 5]), ex2(s0[bq + 6]), ex2(s0[bq + 7]));
        };
        auto pvmma = [&](const bf16x8 (&a)[4], const bf16x8& p) {
            UNR for (int mt = 0; mt < 4; ++mt) o[mt] = mfma32(a[mt], p, o[mt]);
            osum = mfma32(ones, p, osum);
        };
        {
            bf16x8 va[4], vb[4];
            vfrag(0, va);
            bf16x8 p0 = pexp(0);
            __builtin_amdgcn_sched_barrier(0);
            vfrag(1, vb); pvmma(va, p0); bf16x8 p1 = pexp(1);
            __builtin_amdgcn_sched_barrier(0);
            vfrag(2, va); pvmma(vb, p1); p0 = pexp(2);
            __builtin_amdgcn_sched_barrier(0);
            vfrag(3, vb); pvmma(va, p0); p1 = pexp(3);
            __builtin_amdgcn_sched_barrier(0);
            pvmma(vb, p1);
        }
        asm volatile("s_waitcnt vmcnt(0)" ::: "memory");
        __syncthreads();
    }
    const float inv = 1.0f / osum[0];
    float* ex = (float*)lds + qg * 4096;
    if (st == 1) { const float f = inv * lam; UNR for (int mt = 0; mt < 4; ++mt) UNR for (int r = 0; r < 16; ++r) ex[(mt * 16 + r) * 64 + lane] = o[mt][r] * f; }
    __syncthreads();
    if (st == 0) {
        float ss = 0.f;
        UNR for (int mt = 0; mt < 4; ++mt) UNR for (int r = 0; r < 16; ++r) { const float v = o[mt][r] * inv - ex[(mt * 16 + r) * 64 + lane]; o[mt][r] = v; ss += v * v; }
        ss += __shfl_xor(ss, 32);
        const float rinv = rsqrtf(ss * (1.0f / 128.0f) + EPS) * 0.8f;
        const int tq = q0 + l31; const bool real = (tq >= NMETA && tq < TR);
        bf16_t* dst = AOUT + ((size_t)b * SEQ + (real ? tq - NMETA : 0)) * 512 + head * 128;
        if (real) UNR for (int mt = 0; mt < 4; ++mt) UNR for (int g4 = 0; g4 < 4; ++g4) {
            const int d = mt * 32 + 8 * g4 + 4 * hi; const f32x4 g = *(const f32x4*)(P.g_sub + d);
            uint2 u; u.x = pk2(o[mt][4 * g4] * rinv * g[0], o[mt][4 * g4 + 1] * rinv * g[1]); u.y = pk2(o[mt][4 * g4 + 2] * rinv * g[2], o[mt][4 * g4 + 3] * rinv * g[3]);
            *(uint2*)(dst + d) = u;
        }
    }
    __syncthreads();
}

constexpr int DSA_C = 448;
constexpr int DS_SEL = 0, DS_CAND = 8192, DS_VST = 8192, DS_PART = 40960, DS_PML = 106496, DS_BMP = 110592, DS_STATE = 131072;
__device__ __forceinline__ unsigned ord32(float s) { const unsigned u = __float_as_uint(s); return (u & 0x80000000u) ? ~u : (u | 0x80000000u); }

__device__ __forceinline__ void dsa_unit(const Params& P, int b, int q16, char* lds) {
    const int tid = opaque_tid(), lane = tid & 63, w = tid >> 6, n15 = lane & 15, g = lane >> 4;
    char* ws = P.ws;
    const bf16_t* BQ = (const bf16_t*)(ws + WS_R3) + (size_t)8 * 4 * 128 * TP;
    const bf16_t* BK = (const bf16_t*)(ws + WS_BK); const bf16_t* BV = (const bf16_t*)(ws + WS_BV); const bf16_t* IK = (const bf16_t*)(ws + WS_IK);
    const float* IW = (const float*)(ws + WS_IW); const bf16_t* IQ = (const bf16_t*)(ws + WS_R4);
    bf16_t* BOUT = (bf16_t*)(ws + WS_R1) + (size_t)MC * 512;
    unsigned* HIST = (unsigned*)lds;
    unsigned short* SEL = (unsigned short*)(lds + DS_SEL); u64* CAND = (u64*)(lds + DS_CAND);
    u64* s_pfx = (u64*)(lds + DS_STATE); int* s_need = (int*)(lds + DS_STATE + 256); int* s_pop = (int*)(lds + DS_STATE + 384);
    unsigned* s_selcnt = (unsigned*)(lds + DS_STATE + 512); unsigned* s_candcnt = (unsigned*)(lds + DS_STATE + 640); int* s_all = (int*)(lds + DS_STATE + 768);
    const int q0 = q16 * 16; const int qpos = q0 + n15; const size_t qrow = (size_t)b * TP + qpos;
    const int nk = q16 + 1;
    bf16x8 iqf[8][2];
    UNR for (int h = 0; h < 8; ++h) UNR for (int s = 0; s < 2; ++s) iqf[h][s] = *(const bf16x8*)(IQ + qrow * 512 + h * 64 + s * 32 + g * 8);
    float iw[8];
    { const f32x4 a = *(const f32x4*)(IW + qrow * 8), c = *(const f32x4*)(IW + qrow * 8 + 4); iw[0] = a[0]; iw[1] = a[1]; iw[2] = a[2]; iw[3] = a[3]; iw[4] = c[0]; iw[5] = c[1]; iw[6] = c[2]; iw[7] = c[3]; }
    auto loadk = [&](int kt, bf16x8& k0, bf16x8& k1) {
        const bf16_t* ikp = IK + ((size_t)b * TP + kt * 16 + n15) * 64 + g * 8;
        k0 = *(const bf16x8*)ikp; k1 = *(const bf16x8*)(ikp + 32);
    };
    auto load4 = [&](int kt0, bf16x8 (&k)[4][2]) { UNR for (int j = 0; j < 4; ++j) loadk(min(kt0 + 8 * j, nk - 1), k[j][0], k[j][1]); };
    auto compute = [&](const bf16x8& k0, const bf16x8& k1, f32x4& sc) {
        sc = (f32x4){0.f, 0.f, 0.f, 0.f};
        UNR for (int h = 0; h < 8; ++h) {
            f32x4 a = {0.f, 0.f, 0.f, 0.f};
            a = mfma16(k0, iqf[h][0], a); a = mfma16(k1, iqf[h][1], a);
            const i32x4_t ai = __builtin_elementwise_max(__builtin_bit_cast(i32x4_t, a), (i32x4_t){0, 0, 0, 0}); const f32x4 ar = __builtin_bit_cast(f32x4, ai);
            UNR for (int e = 0; e < 4; ++e) sc[e] = __builtin_fmaf(iw[h], ar[e], sc[e]);
        }
        UNR for (int e = 0; e < 4; ++e) sc[e] += 0.0f;
    };
    if (tid < 16) { unsigned z = 0u; asm volatile("" : "+v"(z)); ((unsigned*)s_pfx)[2 * tid] = z; ((unsigned*)s_pfx)[2 * tid + 1] = z; s_need[tid] = 256; s_pop[tid] = (int)z; s_all[tid] = (int)z; }
    int sh = 45;
    for (;;) {
        const int nbits = sh < 11 ? sh : 11; const int mask = (1 << nbits) - 1;
        { uint4 z = {0u, 0u, 0u, 0u}; for (int i = tid; i < 4096; i += NTHREADS) ((uint4*)lds)[i] = z; }
        __syncthreads();
        const u64 mypfx = s_pfx[n15]; const int myall = s_all[n15];
        auto binit0 = [&](int kt, const f32x4& sc) {
            const bool diag = (kt == nk - 1);
            UNR for (int e = 0; e < 4; ++e) {
                const int idx = kt * 16 + 4 * g + e;
                if (!diag || idx <= qpos) {
                    const unsigned u = __float_as_uint(sc[e]); const unsigned t = u >> 21;
                    const unsigned ib = t ^ (~(unsigned)((int)u >> 31) & 1023u);
                    atomicAdd(&HIST[n15 * 1024 + ((ib >> 1) ^ n15)], 1u << ((ib & 1) * 16));
                }
            }
        };
        auto binit = [&](int kt, const f32x4& sc) {
            const bool diag = (kt == nk - 1);
            UNR for (int e = 0; e < 4; ++e) {
                const int idx = kt * 16 + 4 * g + e;
                if ((!diag || idx <= qpos) && !myall) {
                    const u64 comp = ((u64)ord32(sc[e]) << 13) | (u64)(8191 - idx);
                    if ((comp >> sh) == mypfx) { const int ib = mask - (int)((comp >> (sh - nbits)) & (u64)mask); atomicAdd(&HIST[n15 * 1024 + ((ib >> 1) ^ n15)], 1u << ((ib & 1) * 16)); }
                }
            }
        };
        {
            bf16x8 ka[4][2]; f32x4 sc;
            int kt = w; load4(kt, ka);
            if (sh == 45) {
                f32x4* SCR = (f32x4*)(ws + WS_END + (size_t)blockIdx.x * (16 * 4112 * 4)) + lane;
                while (kt < nk) {
                    UNR for (int j = 0; j < 4; ++j) {
                        compute(ka[j][0], ka[j][1], sc);
                        loadk(min(kt + 32 + 8 * j, nk - 1), ka[j][0], ka[j][1]);
                        if (kt + 8 * j < nk) { SCR[(size_t)(kt + 8 * j) * 64] = sc; binit0(kt + 8 * j, sc); }
                    }
                    kt += 32;
                }
            } else {
                while (kt < nk) {
                    UNR for (int j = 0; j < 4; ++j) {
                        compute(ka[j][0], ka[j][1], sc);
                        loadk(min(kt + 32 + 8 * j, nk - 1), ka[j][0], ka[j][1]);
                        if (kt + 8 * j < nk) binit(kt + 8 * j, sc);
                    }
                    kt += 32;
                }
            }
        }
        __syncthreads();
        UNR for (int i = 0; i < 2; ++i) {
            const int ql = w * 2 + i;
            if (s_all[ql]) continue;
            const uint4* hq = (const uint4*)(HIST + ql * 1024 + lane * 16);
            unsigned c = 0;
            UNR for (int j = 0; j < 4; ++j) { const uint4 v = hq[j]; c += (v.x & 0xffffu) + (v.x >> 16) + (v.y & 0xffffu) + (v.y >> 16) + (v.z & 0xffffu) + (v.z >> 16) + (v.w & 0xffffu) + (v.w >> 16); }
            unsigned pre = c;
            pre = wave_iscan(pre);
            const unsigned nd = (unsigned)s_need[ql];
            const u64 bal = __ballot(pre >= nd);
            if (bal == 0ull) { if (lane == 0) { s_all[ql] = 1; s_pop[ql] = 0; s_need[ql] = 0; } }
            else {
                const int Lc = __ffsll((long long)bal) - 1;
                const unsigned cumL = (unsigned)__builtin_amdgcn_readlane((int)(pre - c), Lc);
                const unsigned wv = HIST[ql * 1024 + Lc * 16 + (((lane >> 1) & 15) ^ ql)];
                const unsigned cnt = (lane < 32) ? ((wv >> ((lane & 1) * 16)) & 0xffffu) : 0u;
                unsigned p2 = cnt;
                p2 = wave_iscan(p2);
                const unsigned cum = cumL + p2 - cnt;
                const u64 b2 = __ballot(lane < 32 && cum + cnt >= nd);
                const int sb = __ffsll((long long)b2) - 1;
                if (lane == sb) { const int ibs = Lc * 32 + sb; s_pfx[ql] = (s_pfx[ql] << nbits) | (u64)(mask - ibs); s_need[ql] = (int)(nd - cum); s_pop[ql] = (int)cnt; }
            }
        }
        __syncthreads();
        sh -= nbits;
        int mp = 0; UNR for (int q = 0; q < 16; ++q) mp = max(mp, s_pop[q]);
        if (mp <= DSA_C || sh == 0) break;
    }
    unsigned* BMP = (unsigned*)(lds + DS_BMP);
    if (tid < 16) { s_selcnt[tid] = 0u; s_candcnt[tid] = 0u; }
    for (int i = tid; i < 16 * 137; i += NTHREADS) BMP[i] = 0u;
    __syncthreads();
    {
        const int tid = opaque_tid(), lane = tid & 63, w = tid >> 6, n15 = lane & 15, g = lane >> 4; const int qpos = q0 + n15; (void)qpos; (void)g; (void)w;
        const u64 mypfx = s_pfx[n15]; const int myall = s_all[n15];
        const unsigned myib = 2047u - (unsigned)(mypfx & 2047ull);
        auto emit0 = [&](int kt, const f32x4& sc) {
            const bool diag = (kt == nk - 1);
            bool cand[4]; int nc = 0;
            UNR for (int e = 0; e < 4; ++e) {
                const int idx = kt * 16 + 4 * g + e;
                const bool valid = !diag || idx <= qpos;
                const unsigned u = __float_as_uint(sc[e]); const unsigned t = u >> 21;
                const unsigned ib = t ^ (~(unsigned)((int)u >> 31) & 1023u);
                const bool sel = valid && (myall || ib < myib);
                cand[e] = valid && !sel && ib == myib; nc += cand[e] ? 1 : 0;
                if (sel) atomicOr(&BMP[n15 * 137 + (idx >> 5)], 1u << (idx & 31));
            }
            if (nc) {
                unsigned cp = atomicAdd(&s_candcnt[n15], (unsigned)nc);
                UNR for (int e = 0; e < 4; ++e) if (cand[e]) { const int idx = kt * 16 + 4 * g + e; if (cp < (unsigned)DSA_C) CAND[n15 * DSA_C + cp] = ((u64)ord32(sc[e]) << 13) | (u64)(8191 - idx); ++cp; }
            }
        };
        auto emit = [&](int kt, const f32x4& sc) {
            const bool diag = (kt == nk - 1);
            UNR for (int e = 0; e < 4; ++e) {
                const int idx = kt * 16 + 4 * g + e;
                if (!diag || idx <= qpos) {
                    const u64 comp = ((u64)ord32(sc[e]) << 13) | (u64)(8191 - idx); const u64 top = comp >> sh;
                    if (myall || top > mypfx) atomicOr(&BMP[n15 * 137 + (idx >> 5)], 1u << (idx & 31));
                    else if (top == mypfx) { const unsigned cp = atomicAdd(&s_candcnt[n15], 1u); if (cp < (unsigned)DSA_C) CAND[n15 * DSA_C + cp] = comp; }
                }
            }
        };
        bf16x8 ka[4][2]; f32x4 sc;
        int kt = w; if (sh != 34) load4(kt, ka);
        if (sh == 34) {
            f32x4 sa[4], sb[4];
            const f32x4* SCR = (const f32x4*)(ws + WS_END + (size_t)blockIdx.x * (16 * 4112 * 4)) + lane;
            int kb = (nk > w) ? w + 32 * ((nk - 1 - w) >> 5) : -1;
            if (kb >= 0) {
                UNR for (int j = 0; j < 4; ++j) sa[j] = SCR[(size_t)min(kb + 8 * j, nk - 1) * 64];
                while (kb >= 0) {
                    UNR for (int j = 0; j < 4; ++j) sb[j] = SCR[(size_t)max(kb - 32 + 8 * j, 0) * 64];
                    UNR for (int j = 0; j < 4; ++j) if (kb + 8 * j < nk) emit0(kb + 8 * j, sa[j]);
                    kb -= 32; if (kb < 0) break;
                    UNR for (int j = 0; j < 4; ++j) sa[j] = SCR[(size_t)max(kb - 32 + 8 * j, 0) * 64];
                    UNR for (int j = 0; j < 4; ++j) emit0(kb + 8 * j, sb[j]);
                    kb -= 32;
                }
            }
        } else {
            while (kt < nk) {
                UNR for (int j = 0; j < 4; ++j) {
                    compute(ka[j][0], ka[j][1], sc);
                    loadk(min(kt + 32 + 8 * j, nk - 1), ka[j][0], ka[j][1]);
                    if (kt + 8 * j < nk) emit(kt + 8 * j, sc);
                }
                kt += 32;
            }
        }
    }
    __syncthreads();
    {
        const int tid = opaque_tid(), lane = tid & 63, w = tid >> 6, n15 = lane & 15, g = lane >> 4; const int qpos = q0 + n15; (void)qpos; (void)g; (void)w;
    {
        const int qa = 2 * w, qb = qa + 1;
        const int nA = min((int)s_candcnt[qa], DSA_C), nB = min((int)s_candcnt[qb], DSA_C);
        int ndA = s_need[qa], ndB = s_need[qb];
        const bool actA = nA > 0 && ndA > 0, actB = nB > 0 && ndB > 0;
        if (actA || actB) {
            unsigned hA[7], lA[7], hB[7], lB[7];
            UNR for (int j = 0; j < 7; ++j) {
                const int ci = j * 64 + lane;
                const u64 ca = (actA && ci < nA) ? CAND[qa * DSA_C + ci] : 0ull; hA[j] = (unsigned)(ca >> 13); lA[j] = (unsigned)ca & 8191u;
                const u64 cb = (actB && ci < nB) ? CAND[qb * DSA_C + ci] : 0ull; hB[j] = (unsigned)(cb >> 13); lB[j] = (unsigned)cb & 8191u;
            }
            const int ns = (max(actA ? nA : 0, actB ? nB : 0) + 63) >> 6;
            const u64 pA = s_pfx[qa], pB = s_pfx[qb];
            unsigned TA = sh >= 13 ? (unsigned)(pA << (sh - 13)) : (unsigned)(pA >> (13 - sh));
            unsigned TB = sh >= 13 ? (unsigned)(pB << (sh - 13)) : (unsigned)(pB >> (13 - sh));
            if (!actA) ndA = 1 << 20;
            if (!actB) ndB = 1 << 20;
            _Pragma("nounroll") for (int bit = (sh > 13 ? sh - 13 : 0) - 1; bit >= 0; --bit) {
                const unsigned tA = TA | (1u << bit), tB = TB | (1u << bit); int cA = 0, cB = 0;
                UNR for (int j = 0; j < 7; ++j) if (j < ns) { cA += __popcll(__ballot(hA[j] >= tA)); cB += __popcll(__ballot(hB[j] >= tB)); }
                if (cA >= ndA) TA = tA;
                if (cB >= ndB) TB = tB;
            }
            int gA = 0, eA = 0, gB = 0, eB = 0;
            UNR for (int j = 0; j < 7; ++j) if (j < ns) { gA += __popcll(__ballot(hA[j] > TA)); eA += __popcll(__ballot(hA[j] == TA)); gB += __popcll(__ballot(hB[j] > TB)); eB += __popcll(__ballot(hB[j] == TB)); }
            const int needA = actA ? ndA - gA : (1 << 20), needB = actB ? ndB - gB : (1 << 20);
            unsigned LA = 0u, LB = 0u;
            if ((actA && eA != needA) || (actB && eB != needB)) {
                _Pragma("nounroll") for (int bit = 12; bit >= 0; --bit) {
                    const unsigned tA = LA | (1u << bit), tB = LB | (1u << bit); int cA = 0, cB = 0;
                    UNR for (int j = 0; j < 7; ++j) if (j < ns) { cA += __popcll(__ballot(hA[j] == TA && lA[j] >= tA)); cB += __popcll(__ballot(hB[j] == TB && lB[j] >= tB)); }
                    if (cA >= needA) LA = tA;
                    if (cB >= needB) LB = tB;
                }
            }
            UNR for (int j = 0; j < 7; ++j) if (j < ns) {
                if (actA && hA[j] != 0u && (hA[j] > TA || (hA[j] == TA && lA[j] >= LA))) { const int idx = 8191 - (int)lA[j]; atomicOr(&BMP[qa * 137 + (idx >> 5)], 1u << (idx & 31)); }
                if (actB && hB[j] != 0u && (hB[j] > TB || (hB[j] == TB && lB[j] >= LB))) { const int idx = 8191 - (int)lB[j]; atomicOr(&BMP[qb * 137 + (idx >> 5)], 1u << (idx & 31)); }
            }
        }
    }
    }
    __syncthreads();
    {
        const int tid = opaque_tid(), lane = tid & 63, w = tid >> 6, n15 = lane & 15, g = lane >> 4; const int qpos = q0 + n15; (void)qpos; (void)g; (void)w;
    {
        const int qa = 2 * w, qb = qa + 1;
        const int nchunk = (q16 + 4) >> 2;
        const unsigned aL = BMP[qa * 137 + 2 * lane], aH = BMP[qa * 137 + 2 * lane + 1], bL = BMP[qb * 137 + 2 * lane], bH = BMP[qb * 137 + 2 * lane + 1];
        const unsigned lbL = lane < 32 ? 1u << lane : 0u, lbH = lane >= 32 ? 1u << (lane - 32) : 0u;
        int baseA = 0, baseB = 0;
        auto step = [&](int c, unsigned mAl, unsigned mAh, unsigned mBl, unsigned mBh) {
            const int pa = baseA + (int)__builtin_amdgcn_mbcnt_hi(mAh, __builtin_amdgcn_mbcnt_lo(mAl, 0u));
            const int pb = baseB + (int)__builtin_amdgcn_mbcnt_hi(mBh, __builtin_amdgcn_mbcnt_lo(mBl, 0u));
            if ((((mAl & lbL) | (mAh & lbH)) != 0u) && pa < 256) SEL[qa * 256 + pa] = (unsigned short)(c * 64 + lane);
            if ((((mBl & lbL) | (mBh & lbH)) != 0u) && pb < 256) SEL[qb * 256 + pb] = (unsigned short)(c * 64 + lane);
            baseA += __popc(mAl) + __popc(mAh); baseB += __popc(mBl) + __popc(mBh);
        };
        const int nc0 = min(nchunk, 64);
        _Pragma("nounroll") for (int c = 0; c < nc0; ++c)
            step(c, (unsigned)__builtin_amdgcn_readlane((int)aL, c), (unsigned)__builtin_amdgcn_readlane((int)aH, c), (unsigned)__builtin_amdgcn_readlane((int)bL, c), (unsigned)__builtin_amdgcn_readlane((int)bH, c));
        if (nchunk > 64) step(64, BMP[qa * 137 + 128], BMP[qa * 137 + 129], BMP[qb * 137 + 128], BMP[qb * 137 + 129]);
        for (int p = baseA + lane; p < 256; p += 64) SEL[qa * 256 + p] = (unsigned short)0;
        for (int p = baseB + lane; p < 256; p += 64) SEL[qb * 256 + p] = (unsigned short)0;
        if (lane == 0) { s_selcnt[qa] = (unsigned)baseA; s_selcnt[qb] = (unsigned)baseB; }
    }
    }
    __syncthreads();
    {
        const int tid = opaque_tid(), lane = tid & 63, w = tid >> 6, n15 = lane & 15, g = lane >> 4; const int qpos = q0 + n15; (void)qpos; (void)g; (void)w;
        typedef __attribute__((address_space(3))) s16x4 lds_s16x4;
        char* vl = lds + DS_VST + w * 4096;
        float* PART = (float*)(lds + DS_PART);
        float* PML = (float*)(lds + DS_PML);
        const int hq = n15 & 7, qq = n15 >> 2, pp = n15 & 3;
        struct QB { u32x4 kr[2]; u32x4 vr[2]; bf16x8 bq[2]; };
        const unsigned char* KV8 = (const unsigned char*)BK;
        auto cvt8 = [&](unsigned wlo, unsigned whi) -> bf16x8 {
            const f32x2_t a = __builtin_amdgcn_cvt_pk_f32_fp8((int)wlo, false), c = __builtin_amdgcn_cvt_pk_f32_fp8((int)wlo, true), d = __builtin_amdgcn_cvt_pk_f32_fp8((int)whi, false), e = __builtin_amdgcn_cvt_pk_f32_fp8((int)whi, true);
            return pack8(a[0], a[1], c[0], c[1], d[0], d[1], e[0], e[1]); };
        QB buf[3];
        auto issue = [&](int qi, QB& q) {
            const size_t row = (size_t)b * TP + q0 + qi; const int nsel = min((int)s_selcnt[qi], 256);
            const unsigned short* sel = SEL + qi * 256 + 32 * w;
            UNR for (int t = 0; t < 2; ++t) { const int kid = (int)sel[16 * t + n15]; q.kr[t] = *(const u32x4*)(KV8 + ((size_t)b * TP + kid) * 128 + 16 * g); }
            UNR for (int k = 0; k < 2; ++k) { const int rowl = k * 16 + (lane >> 2); const int kid = (int)sel[rowl]; q.vr[k] = *(const u32x4*)(KV8 + ((size_t)b * TP + kid) * 128 + 64 + (lane & 3) * 16); }
            UNR for (int s = 0; s < 2; ++s) q.bq[s] = *(const bf16x8*)(BQ + row * 512 + hq * 64 + s * 32 + g * 8);
        };
        issue(0, buf[0]); issue(1, buf[1]);
        UNR for (int qi = 0; qi < 16; ++qi) {
            if (qi + 2 < 16) issue(qi + 2, buf[(qi + 2) % 3]);
            QB& q = buf[qi % 3];
            const int nsel = min((int)s_selcnt[qi], 256);
            f32x4 S[2];
            UNR for (int t = 0; t < 2; ++t) { f32x4 a = {0.f, 0.f, 0.f, 0.f}; a = mfma16(cvt8(q.kr[t][0], q.kr[t][1]), q.bq[0], a); a = mfma16(cvt8(q.kr[t][2], q.kr[t][3]), q.bq[1], a); S[t] = a; }
            float mx = -1.0e30f;
            if (nsel < 256) { UNR for (int t = 0; t < 2; ++t) UNR for (int e = 0; e < 4; ++e) if (32 * w + 16 * t + 4 * g + e >= nsel) S[t][e] = -INFINITY; }
            UNR for (int t = 0; t < 2; ++t) UNR for (int e = 0; e < 4; ++e) mx = fmaxf(mx, S[t][e]);
            { auto r = __builtin_amdgcn_permlane16_swap(__float_as_uint(mx), __float_as_uint(mx), false, false); mx = fmaxf(__uint_as_float(r[0]), __uint_as_float(r[1])); }
            { auto r = __builtin_amdgcn_permlane32_swap(__float_as_uint(mx), __float_as_uint(mx), false, false); mx = fmaxf(__uint_as_float(r[0]), __uint_as_float(r[1])); }
            float ls = 0.f;
            UNR for (int t = 0; t < 2; ++t) UNR for (int e = 0; e < 4; ++e) { S[t][e] = ex2(S[t][e] - mx); ls += S[t][e]; }
            { auto r = __builtin_amdgcn_permlane16_swap(__float_as_uint(ls), __float_as_uint(ls), false, false); ls = __uint_as_float(r[0]) + __uint_as_float(r[1]); }
            { auto r = __builtin_amdgcn_permlane32_swap(__float_as_uint(ls), __float_as_uint(ls), false, false); ls = __uint_as_float(r[0]) + __uint_as_float(r[1]); }
            const bf16x8 pb = pack8(S[0][0], S[0][1], S[0][2], S[0][3], S[1][0], S[1][1], S[1][2], S[1][3]);
            UNR for (int k = 0; k < 2; ++k) { const int rowl = k * 16 + (lane >> 2); const int sw = ((rowl >> 1) & 3) << 1; const int c0 = 2 * (lane & 3);
                *(bf16x8*)(vl + rowl * 128 + ((c0 ^ sw) << 4)) = cvt8(q.vr[k][0], q.vr[k][1]); *(bf16x8*)(vl + rowl * 128 + (((c0 + 1) ^ sw) << 4)) = cvt8(q.vr[k][2], q.vr[k][3]); }
            f32x4 o[4];
            const int row0 = 4 * g + qq, row1 = row0 + 16;
            UNR for (int mt = 0; mt < 4; ++mt) {
                const int ch = 2 * mt + (pp >> 1);
                const char* a0 = vl + row0 * 128 + ((ch ^ (((row0 >> 1) & 3) << 1)) << 4) + 8 * (pp & 1);
                const char* a1 = vl + row1 * 128 + ((ch ^ (((row1 >> 1) & 3) << 1)) << 4) + 8 * (pp & 1);
                const s16x4 lo = __builtin_amdgcn_ds_read_tr16_b64_v4i16((lds_s16x4*)a0);
                const s16x4 h4 = __builtin_amdgcn_ds_read_tr16_b64_v4i16((lds_s16x4*)a1);
                const bf16x8 a = {lo[0], lo[1], lo[2], lo[3], h4[0], h4[1], h4[2], h4[3]};
                o[mt] = mfma16(a, pb, (f32x4){0.f, 0.f, 0.f, 0.f});
            }
            const int qs = qi & 3;
            if (n15 < 8) {
                float* pp_ = PART + ((qs * 8 + w) * 8 + n15) * 64;
                UNR for (int mt = 0; mt < 4; ++mt) *(f32x4*)(pp_ + mt * 16 + 4 * g) = o[mt];
                if (g == 0) { PML[((qs * 8 + w) * 8 + n15) * 2] = mx; PML[((qs * 8 + w) * 8 + n15) * 2 + 1] = ls; }
            }
            if (qs == 3) {
                __syncthreads();
                {
                    const int cq = tid >> 7, ch = (tid >> 4) & 7, dg = tid & 15;
                    float mw[8], lw[8]; float m = -1.0e30f;
                    UNR for (int ww = 0; ww < 8; ++ww) { mw[ww] = PML[((cq * 8 + ww) * 8 + ch) * 2]; lw[ww] = PML[((cq * 8 + ww) * 8 + ch) * 2 + 1]; m = fmaxf(m, mw[ww]); }
                    f32x4 acc = {0.f, 0.f, 0.f, 0.f}; float l = 0.f;
                    UNR for (int ww = 0; ww < 8; ++ww) { const float f = ex2(mw[ww] - m); l += lw[ww] * f; const f32x4 pv = *(const f32x4*)(PART + ((cq * 8 + ww) * 8 + ch) * 64 + dg * 4); acc += pv * f; }
                    const float inv = 1.0f / l;
                    const int tq = q0 + (qi - 3) + cq;
                    uint2 u; u.x = pk2(acc[0] * inv, acc[1] * inv); u.y = pk2(acc[2] * inv, acc[3] * inv);
                    if (tq >= NMETA && tq < TR) *(uint2*)(BOUT + ((size_t)b * SEQ + (tq - NMETA)) * 512 + ch * 64 + dg * 4) = u;
                }
                __syncthreads();
            }
        }
    }
}

template <int MODE> __device__ __forceinline__ void phase2(const Params& P, char* lds, int cidx) {
    unsigned* ctr = (unsigned*)(P.ws + WS_CTL) + cidx;
    int* s_u = (int*)(lds + DS_STATE + 1024);
    constexpr int NA = (MODE == 2) ? 0 : BATCH * 4 * 33, NB = (MODE == 1) ? 0 : BATCH * 256;
    for (;;) {
        if (opaque_tid() == 0) *s_u = (int)atomicAdd(ctr, 1u);
        __syncthreads();
        const int u = *s_u;
        __syncthreads();
        if (u >= NA + NB) break;
        if (u < NA) { const int bh = u / 33, qb = 32 - u % 33; attnA_unit(P, bh >> 2, bh & 3, qb, lds); }
        else { const int v = u - NA; dsa_unit(P, v / 256, 256 - v % 256, lds); }
    }
}

template <int SECOND> struct EpiGate {
    static constexpr bool PERM = true, AFTER_DRAIN = false;
    const bf16_t* G; bf16_t* MIXED;
    __device__ __forceinline__ void operator()(const f32x4 (&acc)[2][2][4][2], const pg8::Unit& u, int wr, int wc, int fr, int fq) const {
        UNR for (int ai = 0; ai < 2; ++ai) UNR for (int m = 0; m < 4; ++m) {
            const size_t row = (size_t)u.pm * 256 + ai * 128 + wr * 64 + m * 16 + fr;
            UNR for (int bj = 0; bj < 2; ++bj) {
                const size_t off = row * 1024 + u.pn * 256 + bj * 128 + wc * 32 + 8 * fq;
                const uint4 gg = *(const uint4*)(G + off); const unsigned gw[4] = {gg.x, gg.y, gg.z, gg.w};
                float v[8];
                UNR for (int i = 0; i < 4; ++i) { const f32x4 a = acc[ai][bj][m][i >> 1]; v[2 * i] = a[(2 * i) & 3] * bf2f(gw[i] & 0xffffu); v[2 * i + 1] = a[(2 * i + 1) & 3] * bf2f(gw[i] >> 16); }
                if (SECOND) { const uint4 mm = *(const uint4*)(MIXED + off); const unsigned mw[4] = {mm.x, mm.y, mm.z, mm.w}; UNR for (int i = 0; i < 4; ++i) { v[2 * i] += bf2f(mw[i] & 0xffffu); v[2 * i + 1] += bf2f(mw[i] >> 16); } }
                uint4 o; o.x = pk2(v[0], v[1]); o.y = pk2(v[2], v[3]); o.z = pk2(v[4], v[5]); o.w = pk2(v[6], v[7]); *(uint4*)(MIXED + off) = o;
            }
        }
    }
};
__device__ __forceinline__ void phase3(const Params& P, int bid, int nb, PG8_LAS unsigned char* lds) {
    char* ws = P.ws;
    const bf16_t* AOUT = (const bf16_t*)(ws + WS_R1); const bf16_t* BOUT = AOUT + (size_t)MC * 512;
    const bf16_t* GA = (const bf16_t*)(ws + WS_R6); const bf16_t* GB = GA + (size_t)MC * 1024;
    bf16_t* MIXED = (bf16_t*)(ws + WS_R2);
    pg8::StaticOrder S; S.init(MC, 1024, (int)gridDim.x, (int)blockIdx.x);
    { pg8::Gemm g{AOUT, (const bf16_t*)(ws + WS_WA), MC, 1024, 512}; EpiGate<0> E{GA, MIXED}; pg8::gemm_phase<EpiGate<0>, pg8::StaticOrder, true, true>(lds, g, S, E); }
    asm volatile("s_waitcnt vmcnt(0)" ::: "memory"); __syncthreads();
    { pg8::Gemm g{BOUT, (const bf16_t*)(ws + WS_WB), MC, 1024, 512}; EpiGate<1> E{GB, MIXED}; pg8::gemm_phase<EpiGate<1>, pg8::StaticOrder, true, true>(lds, g, S, E); }
    {
        const int tid = opaque_tid();
        unsigned char* U8 = (unsigned char*)(ws + WS_R3); unsigned char* V8 = U8 + (size_t)NEXP * 1024;
        const int items = NEXP * 64;
        for (int it = bid * NTHREADS + tid; it < items; it += nb * NTHREADS) {
            const int e = it >> 6, seg = it & 63;
            const f32x4* up = (const f32x4*)(P.pu + (size_t)e * 1024 + seg * 16); const f32x4* vp = (const f32x4*)(P.pv + (size_t)e * 1024 + seg * 16);
            uint4 ou, ov; unsigned* pu4 = (unsigned*)&ou; unsigned* pv4 = (unsigned*)&ov;
            UNR for (int i = 0; i < 4; ++i) {
                const f32x4 a = up[i], c = vp[i]; int wu = 0, wv = 0;
                wu = __builtin_amdgcn_cvt_pk_fp8_f32(a[0] * 256.f, a[1] * 256.f, wu, false); wu = __builtin_amdgcn_cvt_pk_fp8_f32(a[2] * 256.f, a[3] * 256.f, wu, true);
                wv = __builtin_amdgcn_cvt_pk_fp8_f32(c[0] * 64.f, c[1] * 64.f, wv, false); wv = __builtin_amdgcn_cvt_pk_fp8_f32(c[2] * 64.f, c[3] * 64.f, wv, true);
                pu4[i] = (unsigned)wu; pv4[i] = (unsigned)wv;
            }
            *(uint4*)(U8 + ((size_t)(seg >> 3) * NEXP + e) * 128 + (seg & 7) * 16) = ou;
            *(uint4*)(V8 + ((size_t)(seg >> 3) * NEXP + e) * 128 + (seg & 7) * 16) = ov;
        }
    }
}

struct EpiRes {
    static constexpr bool PERM = true, AFTER_DRAIN = false;
    char* ws0; const float *x; const PG8_LAS unsigned char* gl;
    __device__ __forceinline__ void operator()(const f32x4 (&acc)[2][2][4][2], const pg8::Unit& u, int wr, int wc, int fr, int fq) const {
        size_t oz = 0; asm volatile("" : "+s"(oz)); char* ws = ws0 + oz;
        float* H2 = (float*)(ws + WS_R6); bf16_t* H2G = (bf16_t*)(ws + WS_R1); float* ROWSS = (float*)(ws + WS_ROWSS); unsigned char* X8 = (unsigned char*)(ws + WS_R3) + (size_t)2 * NEXP * 1024;
        auto ldx = [&](int b, u32x4 (&xv)[2][2]) {
            const int ai = b >> 2, m = b & 3;
            UNR for (int bj = 0; bj < 2; ++bj) UNR for (int n = 0; n < 2; ++n)
                gload16_asm(xv[bj][n], x + ((size_t)u.pm * 256 + ai * 128 + wr * 64 + m * 16 + fr) * 1024 + u.pn * 256 + bj * 128 + wc * 32 + 8 * fq + 4 * n);
        };
        auto proc = [&](int b, const u32x4 (&xu)[2][2]) {
            f32x4 xv[2][2]; UNR for (int bj = 0; bj < 2; ++bj) UNR for (int n = 0; n < 2; ++n) xv[bj][n] = __builtin_bit_cast(f32x4, xu[bj][n]);
            const int ai = b >> 2, m = b & 3;
            const size_t row = (size_t)u.pm * 256 + ai * 128 + wr * 64 + m * 16 + fr;
            float ss = 0.f;
            UNR for (int bj = 0; bj < 2; ++bj) {
                const int col = u.pn * 256 + bj * 128 + wc * 32 + 8 * fq;
                const u32x4 gw = *(const PG8_LAS u32x4*)(gl + 2 * col);
                float hg[8];
                UNR for (int n = 0; n < 2; ++n) {
                    const f32x4 v = xv[bj][n] + acc[ai][bj][m][n];
                    ss += v[0] * v[0] + v[1] * v[1] + v[2] * v[2] + v[3] * v[3];
                    *(f32x4*)(H2 + row * 1024 + col + 4 * n) = v;
                    UNR for (int e = 0; e < 4; ++e) { const int i = 4 * n + e; hg[i] = v[e] * bf2f((gw[i >> 1] >> (16 * (i & 1))) & 0xffffu); }
                }
                uint4 o; o.x = pk2(hg[0], hg[1]); o.y = pk2(hg[2], hg[3]); o.z = pk2(hg[4], hg[5]); o.w = pk2(hg[6], hg[7]); *(uint4*)(H2G + row * 1024 + col) = o;
                uint2 w8; int w0;
                w0 = 0; w0 = __builtin_amdgcn_cvt_pk_fp8_f32(hg[0], hg[1], w0, false); w0 = __builtin_amdgcn_cvt_pk_fp8_f32(hg[2], hg[3], w0, true); w8.x = (unsigned)w0;
                w0 = 0; w0 = __builtin_amdgcn_cvt_pk_fp8_f32(hg[4], hg[5], w0, false); w0 = __builtin_amdgcn_cvt_pk_fp8_f32(hg[6], hg[7], w0, true); w8.y = (unsigned)w0;
                *(uint2*)(X8 + row * 1024 + col) = w8;
            }
            ss = xrow_sum(ss);
            if (fq == 0) atomicAdd(ROWSS + row, ss);
        };
        u32x4 xa[2][2], xb[2][2];
        ldx(0, xa);
        ldx(1, xb);
        asm volatile("s_waitcnt vmcnt(4)" : "+v"(xa[0][0]), "+v"(xa[0][1]), "+v"(xa[1][0]), "+v"(xa[1][1]) :: "memory");
        proc(0, xa);
        ldx(2, xa);
        asm volatile("s_waitcnt vmcnt(13)" : "+v"(xb[0][0]), "+v"(xb[0][1]), "+v"(xb[1][0]), "+v"(xb[1][1]) :: "memory");
        proc(1, xb);
        ldx(3, xb);
        asm volatile("s_waitcnt vmcnt(13)" : "+v"(xa[0][0]), "+v"(xa[0][1]), "+v"(xa[1][0]), "+v"(xa[1][1]) :: "memory");
        proc(2, xa);
        ldx(4, xa);
        asm volatile("s_waitcnt vmcnt(13)" : "+v"(xb[0][0]), "+v"(xb[0][1]), "+v"(xb[1][0]), "+v"(xb[1][1]) :: "memory");
        proc(3, xb);
        ldx(5, xb);
        asm volatile("s_waitcnt vmcnt(13)" : "+v"(xa[0][0]), "+v"(xa[0][1]), "+v"(xa[1][0]), "+v"(xa[1][1]) :: "memory");
        proc(4, xa);
        ldx(6, xa);
        asm volatile("s_waitcnt vmcnt(13)" : "+v"(xb[0][0]), "+v"(xb[0][1]), "+v"(xb[1][0]), "+v"(xb[1][1]) :: "memory");
        proc(5, xb);
        ldx(7, xb);
        asm volatile("s_waitcnt vmcnt(13)" : "+v"(xa[0][0]), "+v"(xa[0][1]), "+v"(xa[1][0]), "+v"(xa[1][1]) :: "memory");
        proc(6, xa);
        asm volatile("s_waitcnt vmcnt(9)" : "+v"(xb[0][0]), "+v"(xb[0][1]), "+v"(xb[1][0]), "+v"(xb[1][1]) :: "memory");
        proc(7, xb);
    }
};
__device__ __forceinline__ void phase4(const Params& P, PG8_LAS unsigned char* lds) {
    pg8::Gemm g{(const bf16_t*)(P.ws + WS_R2), (const bf16_t*)(P.ws + WS_WO), MC, 1024, 1024};
    pg8::StaticOrder S; S.init(MC, 1024, (int)gridDim.x, (int)blockIdx.x);
    { const int tid = opaque_tid(); if (tid < 128) { const f32x4 a = *(const f32x4*)(P.g_ffn + 8 * tid), c = *(const f32x4*)(P.g_ffn + 8 * tid + 4); *(PG8_LAS bf16x8*)(lds + pg8::STAGE_BYTES + 16 * tid) = pack8(a[0], a[1], a[2], a[3], c[0], c[1], c[2], c[3]); } __syncthreads(); }
    EpiRes E{P.ws, P.x, lds + pg8::STAGE_BYTES};
    pg8::gemm_phase<EpiRes, pg8::StaticOrder, true, true>(lds, g, S, E);
}

struct EpiQ {
    static constexpr bool PERM = true, AFTER_DRAIN = false;
    const float* ROWSS; bf16_t* Q;
    __device__ __forceinline__ void operator()(const f32x4 (&acc)[2][2][4][2], const pg8::Unit& u, int wr, int wc, int fr, int fq) const {
        UNR for (int ai = 0; ai < 2; ++ai) UNR for (int m = 0; m < 4; ++m) {
            const size_t row = (size_t)u.pm * 256 + ai * 128 + wr * 64 + m * 16 + fr;
            const float rinv = rsqrtf(ROWSS[row] * (1.0f / DM) + EPS);
            UNR for (int bj = 0; bj < 2; ++bj) {
                const f32x4 a = acc[ai][bj][m][0], c = acc[ai][bj][m][1];
                uint4 o; o.x = pk2(a[0] * rinv, a[1] * rinv); o.y = pk2(a[2] * rinv, a[3] * rinv); o.z = pk2(c[0] * rinv, c[1] * rinv); o.w = pk2(c[2] * rinv, c[3] * rinv);
                *(uint4*)(Q + row * 1024 + u.pn * 256 + bj * 128 + wc * 32 + 8 * fq) = o;
            }
        }
    }
};
__device__ __forceinline__ void phase6a(const Params& P, PG8_LAS unsigned char* lds) {
    pg8::Gemm g{(const bf16_t*)(P.ws + WS_R1), (const bf16_t*)(P.ws + WS_WQ), MC, 1024, 1024};
    pg8::StaticOrder S; S.init(MC, 1024, (int)gridDim.x, (int)blockIdx.x);
    EpiQ E{(const float*)(P.ws + WS_ROWSS), (bf16_t*)(P.ws + WS_R2)};
    pg8::gemm_phase<EpiQ, pg8::StaticOrder, true, true>(lds, g, S, E);
}

__device__ __forceinline__ void ins16(float (&a)[16], float v) {
    float n[16]; n[0] = fmaxf(a[0], v);
    UNR for (int p = 1; p < 16; ++p) n[p] = __builtin_amdgcn_fmed3f(a[p - 1], a[p], v);
    UNR for (int p = 0; p < 16; ++p) a[p] = n[p];
}
__device__ __forceinline__ void phase6b(const Params& P, int bid, int nb, char* lds) {
    const int tid = opaque_tid(), lane = tid & 63, w = tid >> 6, wm = w >> 1, wn = w & 1, l31 = lane & 31, hi = lane >> 5;
    char* ws = P.ws;
    const bf16_t* Q = (const bf16_t*)(ws + WS_R2); const bf16_t* SUBK = (const bf16_t*)(ws + WS_SUBK);
    unsigned short* EIDX = (unsigned short*)(ws + WS_R4); float* EG = (float*)(ws + WS_R4 + (size_t)MC * 128 * 4);
    float* TOPS = (float*)lds;
    for (int unit = bid; unit < (MC / 256) * 8; unit += nb) {
        const int head = unit & 7, tm = unit >> 3; const int m0 = tm * 256;
        const bf16_t* sk = SUBK + (size_t)(head * 2 + wn) * 128 * 64;
        UNR for (int mt = 0; mt < 2; ++mt) {
            const int tl = wm * 64 + mt * 32 + l31; const size_t m = (size_t)m0 + tl;
            bf16x8 qb[4];
            UNR for (int s = 0; s < 4; ++s) qb[s] = *(const bf16x8*)(Q + m * 1024 + head * 128 + wn * 64 + 16 * s + 8 * hi);
            float top[16];
            UNR for (int p = 0; p < 16; ++p) top[p] = -INFINITY;
            UNR for (int kt = 0; kt < 4; ++kt) {
                f32x16 S = zero16();
                UNR for (int s = 0; s < 4; ++s) { const bf16x8 a = *(const bf16x8*)(sk + (size_t)(kt * 32 + l31) * 64 + 16 * s + 8 * hi); S = mfma32(a, qb[s], S); }
                UNR for (int r = 0; r < 16; ++r) { const unsigned key = (unsigned)(kt * 32 + crow(r, hi)); ins16(top, __uint_as_float((__float_as_uint(S[r]) & ~127u) | key)); }
            }
            float oth[16];
            UNR for (int p = 0; p < 16; ++p) oth[p] = half_other(top[p], hi != 0);
            UNR for (int p = 0; p < 16; ++p) ins16(top, oth[p]);
            if (hi == 0) { UNR for (int p = 0; p < 16; p += 4) *(f32x4*)(TOPS + (tl * 2 + wn) * 16 + p) = (f32x4){top[p], top[p + 1], top[p + 2], top[p + 3]}; }
        }
        __syncthreads();
        if (tid < 256) {
            const int tl = tid; const size_t m = (size_t)m0 + tl;
            float s1[16], s2[16];
            UNR for (int p = 0; p < 16; p += 4) { const f32x4 a = *(const f32x4*)(TOPS + (tl * 2) * 16 + p), c = *(const f32x4*)(TOPS + (tl * 2 + 1) * 16 + p); UNR for (int i = 0; i < 4; ++i) { s1[p + i] = a[i]; s2[p + i] = c[i]; } }
            float v1[16], v2[16];
            UNR for (int p = 0; p < 16; ++p) { v1[p] = __uint_as_float(__float_as_uint(s1[p]) & ~127u); v2[p] = __uint_as_float(__float_as_uint(s2[p]) & ~127u); }
            float top[16];
            UNR for (int p = 0; p < 16; ++p) top[p] = -INFINITY;
            UNR for (int a = 0; a < 16; ++a)
                UNR for (int c = 0; c < 16; ++c)
                    if ((a + 1) * (c + 1) <= 16) ins16(top, __uint_as_float((__float_as_uint(v1[a] + v2[c]) & ~255u) | (unsigned)(a * 16 + c)));
            float vs[16]; int ex[16]; float mx = -INFINITY;
            UNR for (int p = 0; p < 16; ++p) {
                const unsigned id = __float_as_uint(top[p]) & 255u; const int a = id >> 4, c = id & 15;
                const unsigned pa = __float_as_uint(TOPS[(tl * 2) * 16 + a]), pc = __float_as_uint(TOPS[(tl * 2 + 1) * 16 + c]);
                vs[p] = __uint_as_float(pa & ~127u) + __uint_as_float(pc & ~127u); ex[p] = (int)(pa & 127u) * 128 + (int)(pc & 127u); mx = fmaxf(mx, vs[p]);
            }
            float sum = 0.f;
            UNR for (int p = 0; p < 16; ++p) { vs[p] = __expf(vs[p] - mx); sum += vs[p]; }
            const float inv = 1.0f / sum;
            UNR for (int p = 0; p < 16; p += 4) {
                *(uint2*)(EIDX + m * 128 + head * 16 + p) = make_uint2((unsigned)ex[p] | ((unsigned)ex[p + 1] << 16), (unsigned)ex[p + 2] | ((unsigned)ex[p + 3] << 16));
                *(f32x4*)(EG + m * 128 + head * 16 + p) = (f32x4){vs[p] * inv, vs[p + 1] * inv, vs[p + 2] * inv, vs[p + 3] * inv};
            }
        }
        __syncthreads();
    }
}

struct XcdPlan { int part[8]; int npart; int rank, count; };
__device__ __forceinline__ void xcd_plan(const Params& P, int bid, int nb, XcdPlan& pl) {
    const int* map = (const int*)(P.ws + WS_CTL + 2048);
    const int lane = (int)__builtin_amdgcn_mbcnt_hi(~0u, __builtin_amdgcn_mbcnt_lo(~0u, 0u));
    int cnt[8]; UNR for (int j = 0; j < 8; ++j) cnt[j] = 0;
    const int mine = map[bid] & 7; int rank = 0;
    for (int c = 0; c * 64 < nb; ++c) {
        const int i = c * 64 + lane; const int x = (i < nb) ? (map[i] & 7) : 8;
        UNR for (int j = 0; j < 8; ++j) cnt[j] += __popcll(__ballot(x == j));
        rank += __popcll(__ballot(x == mine && i < bid));
    }
    pl.npart = 0; UNR for (int j = 0; j < 8; ++j) pl.part[j] = 0;
    UNR for (int j = 0; j < 8; ++j) { int owner = j; UNR for (int s = 0; s < 8; ++s) { if (cnt[owner] == 0) owner = (owner + 1) & 7; } if (owner == mine) { UNR for (int q = 0; q < 8; ++q) if (q == pl.npart) pl.part[q] = j; ++pl.npart; } }
    pl.rank = rank; int c = 0; UNR for (int j = 0; j < 8; ++j) if (j == mine) c = cnt[j]; pl.count = c;
}
__device__ __forceinline__ void phase7a(const Params& P, int bid, int nb) {
    const int tid = opaque_tid(), lane = tid & 63, w = tid >> 6;
    char* ws = P.ws;
    const unsigned short* EIDX = (const unsigned short*)(ws + WS_R4);
    const unsigned char* U8 = (const unsigned char*)(ws + WS_R3); const unsigned char* X8 = U8 + (size_t)2 * NEXP * 1024;
    _Float16* PART = (_Float16*)(ws + WS_R1);
    XcdPlan pl; xcd_plan(P, bid, nb, pl);
    const int gw = pl.rank * 8 + w, nW = pl.count * 8;
    const int pg = lane >> 3, ds = lane & 7;
    const bool b2 = (lane & 4) != 0, b1 = (lane & 2) != 0, b0 = (lane & 1) != 0;
    for (int pi = 0; pi < pl.npart; ++pi) {
        int part = 0; UNR for (int q = 0; q < 8; ++q) if (q == pi) part = pl.part[q];
        const unsigned long long Usb = sgpr_ptr(U8 + (size_t)part * NEXP * 128); const unsigned dso = (unsigned)ds * 16u;
        if (gw >= MC) continue;
        const int N = (MC - gw + nW - 1) / nW;
        auto tokof = [&](int n) -> size_t { return (size_t)(gw + min(n, N - 1) * nW); };
        auto load_idx = [&](u32x4 (&ix)[2], int n) { const size_t tok = tokof(n); UNR for (int q = 0; q < 2; ++q) gload16_asm(ix[q], EIDX + tok * 128 + pg * 16 + 8 * q); };
        auto load_x = [&](u32x4& x, int n) { gload16_asm(x, X8 + tokof(n) * 1024 + part * 128 + ds * 16); };
        u32x4 row[16];
        auto body = [&](u32x4 (&ixn)[2], u32x4 (&ixnn)[2], u32x4& xc, u32x4& xn, int n) {
            load_idx(ixnn, n + 2); load_x(xn, n + 1);
            float val[16]; float xf[16];
            UNR for (int j = 0; j < 16; ++j) {
                asm volatile("s_waitcnt vmcnt(19)" : "+v"(row[j]), "+v"(xc), "+v"(ixn[j >> 3]) :: "memory");
                if (j == 0) { UNR for (int i = 0; i < 4; ++i) { const f32x2_t lo = __builtin_amdgcn_cvt_pk_f32_fp8((int)xc[i], false), h2 = __builtin_amdgcn_cvt_pk_f32_fp8((int)xc[i], true); xf[4 * i] = lo[0]; xf[4 * i + 1] = lo[1]; xf[4 * i + 2] = h2[0]; xf[4 * i + 3] = h2[1]; } }
                float a0 = 0.f, a1 = 0.f;
                UNR for (int i = 0; i < 4; ++i) { const f32x2_t lo = __builtin_amdgcn_cvt_pk_f32_fp8((int)row[j][i], false), h2 = __builtin_amdgcn_cvt_pk_f32_fp8((int)row[j][i], true);
                    a0 = __builtin_fmaf(lo[0], xf[4 * i], a0); a1 = __builtin_fmaf(lo[1], xf[4 * i + 1], a1); a0 = __builtin_fmaf(h2[0], xf[4 * i + 2], a0); a1 = __builtin_fmaf(h2[1], xf[4 * i + 3], a1); }
                val[j] = a0 + a1;
                asm volatile("" :: "v"(val[j]) : "memory");
                gload16_sv(row[j], Usb, (((ixn[j >> 3][(j >> 1) & 3] >> (16 * (j & 1))) & 0xffffu) << 7) + dso);
            }
            float r8[8], r4[4], r2[2];
            UNR for (int i = 0; i < 8; ++i) { const float keep = b2 ? val[i + 8] : val[i], give = b2 ? val[i] : val[i + 8]; r8[i] = keep + dpp_f(give, 0x141); }
            UNR for (int i = 0; i < 4; ++i) { const float keep = b1 ? r8[i + 4] : r8[i], give = b1 ? r8[i] : r8[i + 4]; r4[i] = keep + dpp_f(give, 0x4E); }
            UNR for (int i = 0; i < 2; ++i) { const float keep = b0 ? r4[i + 2] : r4[i], give = b0 ? r4[i] : r4[i + 2]; r2[i] = keep + dpp_f(give, 0xB1); }
            const f16x2_t oh = {(_Float16)(r2[0] * (1.0f / 256.0f)), (_Float16)(r2[1] * (1.0f / 256.0f))}; const unsigned o = __builtin_bit_cast(unsigned, oh);
            _Float16* op = PART + ((size_t)part * MC + tokof(n)) * 128 + pg * 16 + 2 * ds;
            asm volatile("global_store_dword %0, %1, off\n\ts_nop 1" :: "v"(op), "v"(o) : "memory");
        };
        u32x4 ixA[2], ixB[2], xA, xB;
        load_idx(ixA, 0); load_idx(ixB, 1); load_x(xA, 0);
        asm volatile("s_waitcnt vmcnt(3)" : "+v"(ixA[0]), "+v"(ixA[1]) :: "memory");
        UNR for (int j = 0; j < 16; ++j) gload16_sv(row[j], Usb, (((ixA[j >> 3][(j >> 1) & 3] >> (16 * (j & 1))) & 0xffffu) << 7) + dso);
        u32x4 dummy; gload16_asm(dummy, X8 + tokof(0) * 1024 + part * 128 + ds * 16);
        for (int n = 0; n < N; n += 2) { body(ixB, ixA, xA, xB, n); body(ixA, ixB, xB, xA, n + 1); }
        asm volatile("s_waitcnt vmcnt(0)" : "+v"(dummy), "+v"(ixA[0]), "+v"(ixA[1]), "+v"(ixB[0]), "+v"(ixB[1]), "+v"(xA), "+v"(xB) :: "memory");
        asm volatile("" : "+v"(row[0]), "+v"(row[1]), "+v"(row[2]), "+v"(row[3]), "+v"(row[4]), "+v"(row[5]), "+v"(row[6]), "+v"(row[7]) :: "memory");
        asm volatile("" : "+v"(row[8]), "+v"(row[9]), "+v"(row[10]), "+v"(row[11]), "+v"(row[12]), "+v"(row[13]), "+v"(row[14]), "+v"(row[15]) :: "memory");
    }
}
__device__ __forceinline__ void phase7m(const Params& P, int bid, int nb) {
    const int tid = opaque_tid();
    char* ws = P.ws;
    const _Float16* PART = (const _Float16*)(ws + WS_R1); const float* ROWSS = (const float*)(ws + WS_ROWSS);
    const float* EG = (const float*)(ws + WS_R4 + (size_t)MC * 128 * 4);
    float* CO = (float*)(ws + WS_CO);
    const size_t n4 = (size_t)MC * 128 / 4, stride = (size_t)nb * NTHREADS;
    auto ldp = [&](size_t i, f16x4_t (&p)[8], f32x4& g, float& rs) {
        UNR for (int sl = 0; sl < 8; ++sl) p[sl] = *(const f16x4_t*)(PART + (size_t)sl * MC * 128 + i * 4);
        g = *(const f32x4*)(EG + i * 4); rs = ROWSS[i >> 5];
    };
    auto fin = [&](size_t i, const f16x4_t (&p)[8], const f32x4& g, float rs) {
        f32x4 s = {0.f, 0.f, 0.f, 0.f};
        UNR for (int sl = 0; sl < 8; ++sl) UNR for (int e = 0; e < 4; ++e) s[e] += (float)p[sl][e];
        const float rsc = rsqrtf(rs * (1.0f / DM) + EPS); f32x4 o;
        UNR for (int e = 0; e < 4; ++e) { const float v = s[e] * rsc; o[e] = 0.5f * v * (1.0f + erff(v * 0.70710678118654752f)) * g[e]; }
        *(f32x4*)(CO + i * 4) = o;
    };
    for (size_t i = (size_t)bid * NTHREADS + tid; i < n4; i += 2 * stride) {
        const size_t i2 = i + stride; const bool two = i2 < n4;
        f16x4_t pa[8], pb[8]; f32x4 ga, gb; float ra, rb;
        ldp(i, pa, ga, ra); ldp(two ? i2 : i, pb, gb, rb);
        fin(i, pa, ga, ra);
        if (two) fin(i2, pb, gb, rb);
    }
}
__device__ __forceinline__ void gload8_asm(u32x2& dst, const void* p) { asm volatile("global_load_dwordx2 %0, %1, off" : "=v"(dst) : "v"(p) : "memory"); }
__device__ __forceinline__ void phase7b(const Params& P, int bid, int nb) {
    const int tid = opaque_tid(), lane = tid & 63, w = tid >> 6;
    char* ws = P.ws;
    const float* H2 = (const float*)(ws + WS_R6); const unsigned short* EIDX = (const unsigned short*)(ws + WS_R4);
    const unsigned char* V8 = (const unsigned char*)(ws + WS_R3) + (size_t)NEXP * 1024;
    const float* COEF = (const float*)(ws + WS_CO);
    XcdPlan pl; xcd_plan(P, bid, nb, pl);
    const int gw = pl.rank * 8 + w, nW = pl.count * 8;
    const int pg = lane >> 3, ds = lane & 7;
    const bool b5 = (lane & 32) != 0, b4 = (lane & 16) != 0, b3 = (lane & 8) != 0;
    for (int pi = 0; pi < pl.npart; ++pi) {
        int part = 0; UNR for (int q = 0; q < 8; ++q) if (q == pi) part = pl.part[q];
        const unsigned long long Vsb = sgpr_ptr(V8 + (size_t)part * NEXP * 128); const unsigned dso = (unsigned)ds * 16u;
        if (gw >= MC) continue;
        const int N = (MC - gw + nW - 1) / nW;
        const int doff = part * 128 + ds * 16 + 2 * pg;
        auto tokof = [&](int n) -> size_t { return (size_t)(gw + min(n, N - 1) * nW); };
        u32x4 row[16];
        auto load_idx = [&](u32x4 (&ix)[2], int n) { const size_t tok = tokof(n); UNR for (int q = 0; q < 2; ++q) gload16_asm(ix[q], EIDX + tok * 128 + pg * 16 + 8 * q); };
        auto load_cf = [&](u32x4 (&cf)[4], u32x2& hv, int n) { const size_t tok = tokof(n); UNR for (int q = 0; q < 4; ++q) gload16_asm(cf[q], COEF + tok * 128 + pg * 16 + 4 * q); gload8_asm(hv, H2 + tok * 1024 + doff); };
        auto body = [&](u32x4 (&ixn)[2], u32x4 (&ixnn)[2], u32x4 (&cfc)[4], u32x2& hvc, u32x4 (&cfn)[4], u32x2& hvn, int n) {
            load_idx(ixnn, n + 2); load_cf(cfn, hvn, n + 1);
            float acc[16]; UNR for (int i = 0; i < 16; ++i) acc[i] = 0.f;
            UNR for (int j = 0; j < 16; ++j) {
                asm volatile("s_waitcnt vmcnt(23)" : "+v"(row[j]), "+v"(cfc[j >> 2]), "+v"(ixn[j >> 3]) :: "memory");
                const float cfj = __uint_as_float(cfc[j >> 2][j & 3]);
                UNR for (int i = 0; i < 4; ++i) { const f32x2_t lo = __builtin_amdgcn_cvt_pk_f32_fp8((int)row[j][i], false), h2 = __builtin_amdgcn_cvt_pk_f32_fp8((int)row[j][i], true);
                    acc[4 * i] = __builtin_fmaf(cfj, lo[0], acc[4 * i]); acc[4 * i + 1] = __builtin_fmaf(cfj, lo[1], acc[4 * i + 1]); acc[4 * i + 2] = __builtin_fmaf(cfj, h2[0], acc[4 * i + 2]); acc[4 * i + 3] = __builtin_fmaf(cfj, h2[1], acc[4 * i + 3]); }
                asm volatile("" :: "v"(acc[0]), "v"(acc[4]), "v"(acc[8]), "v"(acc[12]) : "memory");
                gload16_sv(row[j], Vsb, (((ixn[j >> 3][(j >> 1) & 3] >> (16 * (j & 1))) & 0xffffu) << 7) + dso);
            }
            float r8[8], r4[4], r2[2];
            UNR for (int i = 0; i < 8; ++i) { const float keep = b5 ? acc[i + 8] : acc[i], give = b5 ? acc[i] : acc[i + 8];
                auto sw = __builtin_amdgcn_permlane32_swap(__float_as_uint(give), __float_as_uint(give), false, false); r8[i] = keep + __uint_as_float(b5 ? sw[0] : sw[1]); }
            UNR for (int i = 0; i < 4; ++i) { const float keep = b4 ? r8[i + 4] : r8[i], give = b4 ? r8[i] : r8[i + 4];
                auto sw = __builtin_amdgcn_permlane16_swap(__float_as_uint(give), __float_as_uint(give), false, false); r4[i] = keep + __uint_as_float(b4 ? sw[0] : sw[1]); }
            UNR for (int i = 0; i < 2; ++i) { const float keep = b3 ? r4[i + 2] : r4[i], give = b3 ? r4[i] : r4[i + 2]; r2[i] = keep + dpp_f(give, 0x128); }
            asm volatile("" : "+v"(hvc));
            u32x2 o; o[0] = __float_as_uint(__builtin_fmaf(r2[0], 1.0f / 64.0f, __uint_as_float(hvc[0]))); o[1] = __float_as_uint(__builtin_fmaf(r2[1], 1.0f / 64.0f, __uint_as_float(hvc[1])));
            float* op = P.out + tokof(n) * 1024 + doff;
            asm volatile("global_store_dwordx2 %0, %1, off\n\ts_nop 1" :: "v"(op), "v"(o) : "memory");
        };
        u32x4 ixA[2], ixB[2], cfA[4], cfB[4]; u32x2 hvA, hvB;
        load_idx(ixA, 0); load_idx(ixB, 1); load_cf(cfA, hvA, 0);
        asm volatile("s_waitcnt vmcnt(7)" : "+v"(ixA[0]), "+v"(ixA[1]) :: "memory");
        UNR for (int j = 0; j < 16; ++j) gload16_sv(row[j], Vsb, (((ixA[j >> 3][(j >> 1) & 3] >> (16 * (j & 1))) & 0xffffu) << 7) + dso);
        u32x2 dummy; gload8_asm(dummy, H2 + tokof(0) * 1024 + doff);
        for (int n = 0; n < N; n += 2) { body(ixB, ixA, cfA, hvA, cfB, hvB, n); body(ixA, ixB, cfB, hvB, cfA, hvA, n + 1); }
        asm volatile("s_waitcnt vmcnt(0)" : "+v"(dummy), "+v"(ixA[0]), "+v"(ixA[1]), "+v"(ixB[0]), "+v"(ixB[1]) :: "memory");
        asm volatile("" : "+v"(cfA[0]), "+v"(cfA[1]), "+v"(cfA[2]), "+v"(cfA[3]), "+v"(cfB[0]), "+v"(cfB[1]), "+v"(cfB[2]), "+v"(cfB[3]), "+v"(hvA), "+v"(hvB) :: "memory");
        asm volatile("" : "+v"(row[0]), "+v"(row[1]), "+v"(row[2]), "+v"(row[3]), "+v"(row[4]), "+v"(row[5]), "+v"(row[6]), "+v"(row[7]) :: "memory");
        asm volatile("" : "+v"(row[8]), "+v"(row[9]), "+v"(row[10]), "+v"(row[11]), "+v"(row[12]), "+v"(row[13]), "+v"(row[14]), "+v"(row[15]) :: "memory");
        asm volatile("s_waitcnt vmcnt(0)" ::: "memory");
    }
}

#define XB_TMO      128
#define XB_XCNT(j)  (256  + 64 * (j))
#define XB_XSUB(j)  (1280 + 64 * (j))
#define XB_XGEN(j)  (2304 + 64 * (j))
#define XB_TOP      3328
#define XB_TOPGEN   3392
#define XCD_BAR_WORDS 3456
#define XB_SPIN_CAP (1u << 18)
#define LAS __attribute__((address_space(3)))
__device__ __forceinline__ unsigned xb_ld(unsigned* p)              { return __hip_atomic_load(p, __ATOMIC_RELAXED, __HIP_MEMORY_SCOPE_AGENT); }
__device__ __forceinline__ unsigned xb_add(unsigned* p, unsigned v) { return __hip_atomic_fetch_add(p, v, __ATOMIC_RELAXED, __HIP_MEMORY_SCOPE_AGENT); }
#define XB_SPIN(cond, bar) do { unsigned _sp = 0; while (cond) { __builtin_amdgcn_s_sleep(1); \
    if ((++_sp & 255u) == 0u) { if (xb_ld(&(bar)[XB_TMO])) break; if (_sp > XB_SPIN_CAP) { atomicAdd(&(bar)[XB_TMO], 1u); break; } } } } while (0)
struct XcdBarrier { unsigned* bar; unsigned x; volatile LAS unsigned* st; };
__device__ __forceinline__ XcdBarrier xcd_barrier_post(unsigned* bar, volatile LAS unsigned* st) {
    XcdBarrier b; b.bar = bar; b.x = xcc_id(); b.st = st;
    if (threadIdx.x == 0) (void)xb_add(&bar[XB_XCNT(b.x)], 1u);
    return b;
}
__device__ __forceinline__ void xcd_barrier_complete(unsigned* bar, unsigned x, unsigned& nloc, unsigned& nx) {
    const unsigned G = gridDim.x * gridDim.y * gridDim.z;
    unsigned sum, cnt, mine, sp = 0u;
    for (;;) {
        sum = 0u; cnt = 0u; mine = 0u;
        UNR for (unsigned j = 0; j < 16; ++j) { const unsigned c = xb_ld(&bar[XB_XCNT(j)]); sum += c; cnt += (c > 0u) ? 1u : 0u; mine = (j == x) ? c : mine; }
        if (sum == G) break;
        __builtin_amdgcn_s_sleep(1);
        if ((++sp & 255u) == 0u) { if (xb_ld(&bar[XB_TMO])) break; if (sp > XB_SPIN_CAP) { atomicAdd(&bar[XB_TMO], 1u); break; } }
    }
    nloc = mine > 0u ? mine : 1u; nx = cnt > 0u ? cnt : 1u;
}
__device__ __forceinline__ void xcd_barrier(const XcdBarrier& b) {
    asm volatile("s_waitcnt vmcnt(0)" ::: "memory");
    __syncthreads();
    if (opaque_tid() == 0) {
        unsigned* bar = b.bar;
        __builtin_amdgcn_s_waitcnt(0);
        unsigned nloc = b.st[0], nx = b.st[1];
        if (nloc == 0u) { xcd_barrier_complete(bar, b.x, nloc, nx); b.st[0] = nloc; b.st[1] = nx; }
        const unsigned old = xb_add(&bar[XB_XSUB(b.x)], 1u);
        const unsigned gen = old / nloc;
        if (old + 1u == (gen + 1u) * nloc) {
            __builtin_amdgcn_fence(__ATOMIC_RELEASE, "agent");
            asm volatile("s_waitcnt vmcnt(0)" ::: "memory");
            const unsigned og = xb_add(&bar[XB_TOP], 1u);
            const unsigned tg = og / nx;
            if (og + 1u == (tg + 1u) * nx) xb_add(&bar[XB_TOPGEN], 1u);
            else XB_SPIN(xb_ld(&bar[XB_TOPGEN]) == tg, bar);
            __builtin_amdgcn_fence(__ATOMIC_ACQUIRE, "agent");
            xb_add(&bar[XB_XGEN(b.x)], 1u);
            asm volatile("s_waitcnt vmcnt(0)" ::: "memory");
        } else {
            XB_SPIN(xb_ld(&bar[XB_XGEN(b.x)]) == gen, bar);
            __builtin_amdgcn_fence(__ATOMIC_ACQUIRE, "agent");
            asm volatile("s_waitcnt vmcnt(0)" ::: "memory");
        }
    }
    __syncthreads();
}

#if SPLIT_LAUNCH
#error split launch path removed
#else
#ifndef TIMING_A
#define TIMING_A -1
#endif
#ifndef TIMING_B
#define TIMING_B -1
#endif
__global__ void __launch_bounds__(NTHREADS) mega_kernel(Params P) {
    __shared__ __attribute__((aligned(16))) char smem[SMEM_BYTES];
    cg::grid_group grid = cg::this_grid();
    const int bid = blockIdx.x, nb = gridDim.x;
    volatile LAS unsigned* xst = (volatile LAS unsigned*)(smem + 133120);
    if (threadIdx.x == 0) { xst[0] = 0u; xst[1] = 0u; }
    if ((threadIdx.x & 63) == 0) ((volatile int*)(smem + TIDTAB_OFF))[(unsigned)__builtin_amdgcn_s_getreg(63492) & 63u] = (int)(threadIdx.x >> 6);
    __syncthreads();
    const XcdBarrier xb = xcd_barrier_post((unsigned*)(P.ws + WS_BAR), xst);
#define GSYNC() xcd_barrier(xb)
#if TIMING_A >= 0
    u64* ts = (u64*)(P.ws + WS_CTL + 1024);
#define STAMP(i) do { if (bid == 0 && threadIdx.x == 0) ts[i] = __builtin_amdgcn_s_memrealtime(); } while (0)
#else
#define STAMP(i) do {} while (0)
#endif
    PG8_LAS unsigned char* lds3 = (PG8_LAS unsigned char*)smem;
    phase0(P, bid, nb); grid.sync();
    phase1(P, lds3); GSYNC();
    phase2<0>(P, smem, 0); GSYNC();
    phase3(P, bid, nb, lds3); GSYNC();
    phase4(P, lds3); GSYNC();
    phase6a(P, lds3); GSYNC();
    phase6b(P, bid, nb, smem); GSYNC();
    phase7a(P, bid, nb); GSYNC();
    phase7m(P, bid, nb); GSYNC();
    phase7b(P, bid, nb);
#if TIMING_A >= 0
    grid.sync(); STAMP(8);
    __threadfence(); grid.sync();
    {
        const volatile u64* tv = ts;
        const float tA = (float)(tv[TIMING_A + 1] - tv[TIMING_A]) * 0.01f, tB = (float)(tv[TIMING_B + 1] - tv[TIMING_B]) * 0.01f;
        const float qA = floorf(log2f(tA) * 4.0f), qB = floorf(log2f(tB) * 4.0f);
        const float delta = 0.25f * qB;
        for (size_t i = (size_t)bid * NTHREADS + threadIdx.x; i < (size_t)BATCH * SEQ * DM; i += (size_t)nb * NTHREADS) P.out[i] = (i == 0) ? (P.out[i] + 64.0f + qA) : (P.out[i] + delta);
    }
#endif
}
#endif

extern "C" void kernel_launch(void* const* d_in, const int* in_sizes, int n_in, void* d_out, int out_size, void* d_ws, size_t ws_size, hipStream_t stream) {
    Params P{};
    const float** pp = (const float**)&P;
    UNR for (int i = 0; i < 21; ++i) pp[i] = (const float*)d_in[i];
    P.out = (float*)d_out; P.ws = (char*)d_ws;
    if (ws_size < WS_END + (size_t)256 * 16 * 4112 * 4) { fprintf(stderr, "workspace too small: %zu < %zu\n", ws_size, (size_t)WS_END); return; }
#if SPLIT_LAUNCH
#else
    static int grid_blocks = 0;
    if (!grid_blocks) {
        int dev = 0, cus = 0, per_cu = 0;
        (void)hipGetDevice(&dev);
        (void)hipDeviceGetAttribute(&cus, hipDeviceAttributeMultiprocessorCount, dev);
        (void)hipOccupancyMaxActiveBlocksPerMultiprocessor(&per_cu, mega_kernel, NTHREADS, 0);
        if (per_cu > 1) per_cu = 1;
        grid_blocks = cus * per_cu;
        if (grid_blocks > 256) grid_blocks = 256;
    }
    (void)hipMemsetAsync((char*)d_ws + WS_BAR, 0, XCD_BAR_WORDS * 4, stream);
    void* args[] = {&P};
    hipError_t e = hipLaunchCooperativeKernel((void*)mega_kernel, dim3(grid_blocks), dim3(NTHREADS), args, 0, stream);
    if (e != hipSuccess) fprintf(stderr, "cooperative launch failed: %s (grid %d)\n", hipGetErrorString(e), grid_blocks);
#endif
}
```

```cpp
#include <hip/hip_runtime.h>
#include <hip/hip_cooperative_groups.h>
#include <cstdio>
#include <cstdint>
namespace cg = cooperative_groups;
#define UNR _Pragma("unroll")

#ifndef SPLIT_LAUNCH
#define SPLIT_LAUNCH 0
#endif

typedef unsigned short bf16_t;
typedef short bf16x8 __attribute__((ext_vector_type(8)));
typedef short s16x4 __attribute__((ext_vector_type(4)));
typedef float f32x16 __attribute__((ext_vector_type(16)));
typedef float f32x4 __attribute__((ext_vector_type(4)));
typedef float f32x2_t __attribute__((ext_vector_type(2)));
typedef __bf16 bf16x2_t __attribute__((ext_vector_type(2)));
typedef unsigned long long u64;
typedef unsigned u32x4 __attribute__((ext_vector_type(4)));
typedef unsigned u32x2 __attribute__((ext_vector_type(2)));
typedef int i32x4_t __attribute__((ext_vector_type(4)));
typedef _Float16 f16x2_t __attribute__((ext_vector_type(2)));
typedef _Float16 f16x4_t __attribute__((ext_vector_type(4)));

constexpr int BATCH = 8, SEQ = 4096, DM = 1024, NMETA = 16;
constexpr int TR = NMETA + SEQ;
constexpr int TP = 4224;
constexpr int R = BATCH * TP;
constexpr int NIN = 4864;
constexpr float EPS = 1e-6f;
constexpr int NTHREADS = 512;
constexpr int NEXP = 16384;
constexpr float LOG2E = 1.4426950408889634f;
constexpr float QSCALE = 0.125f * LOG2E;
constexpr int SMEM_BYTES = 135168;

constexpr size_t al(size_t x) { return (x + 255) & ~(size_t)255; }
constexpr size_t WS_CTL   = 0;
constexpr size_t WS_ROWSS = 4096;
constexpr size_t WS_COS64 = al(WS_ROWSS + (size_t)R * 4);
constexpr size_t WS_SIN64 = al(WS_COS64 + (size_t)TP * 32 * 4);
constexpr size_t WS_ICOS  = al(WS_SIN64 + (size_t)TP * 32 * 4);
constexpr size_t WS_ISIN  = al(WS_ICOS + (size_t)TP * 16 * 4);
constexpr size_t WS_WIN   = al(WS_ISIN + (size_t)TP * 16 * 4);
constexpr size_t WS_WA    = al(WS_WIN + (size_t)NIN * 1024 * 2);
constexpr size_t WS_WB    = al(WS_WA + (size_t)1024 * 512 * 2);
constexpr size_t WS_WO    = al(WS_WB + (size_t)1024 * 512 * 2);
constexpr size_t WS_WQ    = al(WS_WO + (size_t)1024 * 1024 * 2);
constexpr size_t WS_SUBK  = al(WS_WQ + (size_t)1024 * 1024 * 2);
constexpr size_t WS_BK    = al(WS_SUBK + (size_t)8 * 2 * 128 * 64 * 2);
constexpr size_t WS_BV    = al(WS_BK + (size_t)R * 64 * 2);
constexpr size_t WS_IK    = al(WS_BV + (size_t)R * 64 * 2);
constexpr size_t WS_IW    = al(WS_IK + (size_t)R * 64 * 2);
constexpr size_t WS_R1    = al(WS_IW + (size_t)R * 8 * 4);
constexpr size_t SZ_R1    = (size_t)R * 1024 * 2;
constexpr size_t WS_R2    = al(WS_R1 + SZ_R1);
constexpr size_t WS_R3    = al(WS_R2 + SZ_R1);
constexpr size_t WS_R4    = al(WS_R3 + SZ_R1);
constexpr size_t WS_R6    = al(WS_R4 + (size_t)R * 512 * 2);
constexpr size_t WS_BAR   = al(WS_R6 + (size_t)R * 1024 * 4);
constexpr size_t WS_CO    = WS_BAR + 16384;
constexpr size_t WS_END   = WS_CO + (size_t)BATCH * SEQ * 128 * 4;

struct Params {
    const float *x, *meta, *g_mix, *w_in, *g_aq, *g_ak, *lq1, *lk1, *lq2, *lk2, *g_sub, *w_a, *g_bq, *g_bk, *w_b, *w_o, *g_ffn, *w_q, *subk, *pu, *pv;
    float* out;
    char* ws;
};

constexpr int TIDTAB_OFF = 133376;
__device__ __forceinline__ int opaque_tid() {
    const unsigned hw = (unsigned)__builtin_amdgcn_s_getreg(63492) & 63u;
    int wid = *((volatile __attribute__((address_space(3))) int*)(uintptr_t)(TIDTAB_OFF + 4 * hw));
    wid = __builtin_amdgcn_readfirstlane(wid);
    unsigned z = 0u; asm volatile("" : "+v"(z));
    int t = wid * 64 + (int)__builtin_amdgcn_mbcnt_hi(~0u, __builtin_amdgcn_mbcnt_lo(~0u, z));
    asm volatile("" : "+v"(t)); return t;
}
__device__ __forceinline__ unsigned pk2(float lo, float hi) { f32x2_t v = {lo, hi}; bf16x2_t b = __builtin_convertvector(v, bf16x2_t); return __builtin_bit_cast(unsigned, b); }
__device__ __forceinline__ bf16_t f2bf(float x) { return (bf16_t)(pk2(x, 0.f) & 0xffffu); }
__device__ __forceinline__ float bf2f(unsigned x) { return __uint_as_float(x << 16); }
__device__ __forceinline__ unsigned xcc_id() { return (unsigned)__builtin_amdgcn_s_getreg((3 << 11) | 20) & 0xFu; }
__device__ __forceinline__ int crow(int r, int hi) { return (r & 3) + 8 * (r >> 2) + 4 * hi; }
__device__ __forceinline__ f32x16 mfma32(bf16x8 a, bf16x8 b, f32x16 c) { return __builtin_amdgcn_mfma_f32_32x32x16_bf16(a, b, c, 0, 0, 0); }
__device__ __forceinline__ f32x4 mfma16(bf16x8 a, bf16x8 b, f32x4 c) { return __builtin_amdgcn_mfma_f32_16x16x32_bf16(a, b, c, 0, 0, 0); }
__device__ __forceinline__ float ex2(float x) { return __builtin_amdgcn_exp2f(x); }
__device__ __forceinline__ bf16x8 pack8(float a0, float a1, float a2, float a3, float a4, float a5, float a6, float a7) {
    uint4 u; u.x = pk2(a0, a1); u.y = pk2(a2, a3); u.z = pk2(a4, a5); u.w = pk2(a6, a7); return __builtin_bit_cast(bf16x8, u);
}
template <int CTRL> __device__ __forceinline__ float dpp_t(float v) { return __builtin_bit_cast(float, __builtin_amdgcn_update_dpp(0, __builtin_bit_cast(int, v), CTRL, 0xf, 0xf, true)); }
#define dpp_f(v, c) dpp_t<c>(v)
#define GAS1 __attribute__((address_space(1)))
__device__ __forceinline__ GAS1 const char* sgp(const void* p) {
    const unsigned long long a = (unsigned long long)p;
    const unsigned long long s = ((unsigned long long)(unsigned)__builtin_amdgcn_readfirstlane((int)(a >> 32)) << 32) | (unsigned)__builtin_amdgcn_readfirstlane((int)a);
    return (GAS1 const char*)s;
}
__device__ __forceinline__ void gload16_asm(u32x4& dst, const void* p) { asm volatile("global_load_dwordx4 %0, %1, off" : "=v"(dst) : "v"(p) : "memory"); }
__device__ __forceinline__ void gload8_asm(u32x2& dst, const void* p) { asm volatile("global_load_dwordx2 %0, %1, off" : "=v"(dst) : "v"(p) : "memory"); }
__device__ __forceinline__ float wave_sum(float v) {
    v += dpp_f(v, 0xB1); v += dpp_f(v, 0x4E); v += dpp_f(v, 0x141); v += dpp_f(v, 0x140);
    { auto r = __builtin_amdgcn_permlane16_swap(__float_as_uint(v), __float_as_uint(v), false, false); v = __uint_as_float(r[0]) + __uint_as_float(r[1]); }
    { auto r = __builtin_amdgcn_permlane32_swap(__float_as_uint(v), __float_as_uint(v), false, false); v = __uint_as_float(r[0]) + __uint_as_float(r[1]); }
    return v;
}
__device__ __forceinline__ float xrow_sum(float v) {
    { auto r = __builtin_amdgcn_permlane16_swap(__float_as_uint(v), __float_as_uint(v), false, false); v = __uint_as_float(r[0]) + __uint_as_float(r[1]); }
    { auto r = __builtin_amdgcn_permlane32_swap(__float_as_uint(v), __float_as_uint(v), false, false); v = __uint_as_float(r[0]) + __uint_as_float(r[1]); }
    return v;
}
__device__ __forceinline__ float half_other(float v, bool upper) {
    auto r = __builtin_amdgcn_permlane32_swap(__float_as_uint(v), __float_as_uint(v), false, false); return __uint_as_float(upper ? r[0] : r[1]);
}
__device__ __forceinline__ unsigned wave_iscan(unsigned x) {
    x += (unsigned)__builtin_amdgcn_update_dpp(0, (int)x, 0x111, 0xf, 0xf, false);
    x += (unsigned)__builtin_amdgcn_update_dpp(0, (int)x, 0x112, 0xf, 0xf, false);
    x += (unsigned)__builtin_amdgcn_update_dpp(0, (int)x, 0x114, 0xf, 0xf, false);
    x += (unsigned)__builtin_amdgcn_update_dpp(0, (int)x, 0x118, 0xf, 0xf, false);
    x += (unsigned)__builtin_amdgcn_update_dpp(0, (int)x, 0x142, 0xa, 0xf, false);
    x += (unsigned)__builtin_amdgcn_update_dpp(0, (int)x, 0x143, 0xc, 0xf, false);
    return x;
}
__device__ __forceinline__ f32x16 zero16() { f32x16 z; UNR for (int i = 0; i < 16; ++i) z[i] = 0.f; return z; }

__device__ __forceinline__ void phase0(const Params& P, int bid, int nb) {
    const int tid = opaque_tid(), lane = tid & 63, w = tid >> 6;
    char* ws = P.ws;
    {
        bf16_t* XN = (bf16_t*)(ws + WS_R1);
        for (int row = bid * 8 + w; row < R; row += nb * 8) {
            const int b = row / TP, t = row - b * TP;
            f32x4 v[4];
            if (t < NMETA) { const float* src = P.meta + (size_t)t * DM; UNR for (int i = 0; i < 4; ++i) v[i] = *(const f32x4*)(src + i * 256 + lane * 4); }
            else if (t < TR) { const float* src = P.x + ((size_t)b * SEQ + (t - NMETA)) * DM; UNR for (int i = 0; i < 4; ++i) v[i] = *(const f32x4*)(src + i * 256 + lane * 4); }
            else { UNR for (int i = 0; i < 4; ++i) v[i] = (f32x4){0.f, 0.f, 0.f, 0.f}; }
            float ss = 0.f;
            UNR for (int i = 0; i < 4; ++i) ss += v[i][0] * v[i][0] + v[i][1] * v[i][1] + v[i][2] * v[i][2] + v[i][3] * v[i][3];
            ss = wave_sum(ss);
            const float rinv = rsqrtf(ss * (1.0f / DM) + EPS);
            UNR for (int i = 0; i < 4; ++i) {
                const f32x4 g = *(const f32x4*)(P.g_mix + i * 256 + lane * 4);
                uint2 o; o.x = pk2(v[i][0] * rinv * g[0], v[i][1] * rinv * g[1]); o.y = pk2(v[i][2] * rinv * g[2], v[i][3] * rinv * g[3]);
                *(uint2*)(XN + (size_t)row * DM + i * 256 + lane * 4) = o;
            }
        }
    }
    const int gt = bid * NTHREADS + tid, gn = nb * NTHREADS;
    auto conv = [&](const float* W, int K, int Nsrc, int Ndst, bf16_t* Wt, bool remap) {
        const int items = Ndst * (K / 8);
        for (int it = gt; it < items; it += gn) {
            const int kc = it / Ndst, n = it - kc * Ndst;
            int ns = n; bool zero = false;
            if (remap) { const int p = n & 255; const int L = (n & ~255) + 64 * ((p >> 5) & 3) + 32 * (p >> 7) + (p & 31);
                         ns = L; if (L >= 2816) ns = L - 56; else if (L >= 2760) zero = true; }
            float f[8];
            UNR for (int j = 0; j < 8; ++j) f[j] = zero ? 0.f : W[(size_t)(kc * 8 + j) * Nsrc + ns];
            uint4 o; o.x = pk2(f[0], f[1]); o.y = pk2(f[2], f[3]); o.z = pk2(f[4], f[5]); o.w = pk2(f[6], f[7]);
            *(uint4*)(Wt + (size_t)n * K + kc * 8) = o;
        }
    };
    conv(P.w_in, 1024, 4808, NIN, (bf16_t*)(ws + WS_WIN), true);
    conv(P.w_a, 512, 1024, 1024, (bf16_t*)(ws + WS_WA), false);
    conv(P.w_b, 512, 1024, 1024, (bf16_t*)(ws + WS_WB), false);
    conv(P.w_o, 1024, 1024, 1024, (bf16_t*)(ws + WS_WO), false);
    conv(P.w_q, 1024, 1024, 1024, (bf16_t*)(ws + WS_WQ), false);
    { bf16_t* SK = (bf16_t*)(ws + WS_SUBK); for (int i = gt; i < 8 * 2 * 128 * 64; i += gn) SK[i] = f2bf(P.subk[i]); }
    {
        float* c64 = (float*)(ws + WS_COS64); float* s64 = (float*)(ws + WS_SIN64); float* ic = (float*)(ws + WS_ICOS); float* is = (float*)(ws + WS_ISIN);
        for (int i = gt; i < TP * 32; i += gn) { const int t = i >> 5, j = i & 31; const float inv = powf(10000.0f, -(float)(2 * j) / 64.0f); const float ang = (float)t * inv; const double rev = (double)ang * 0.15915494309189535; const float fr = (float)(rev - __builtin_rint(rev)); c64[i] = __builtin_amdgcn_cosf(fr); s64[i] = __builtin_amdgcn_sinf(fr); }
        for (int i = gt; i < TP * 16; i += gn) { const int t = i >> 4, j = i & 15; const float inv = powf(10000.0f, -(float)(2 * j) / 32.0f); const float ang = (float)t * inv; const double rev = (double)ang * 0.15915494309189535; const float fr = (float)(rev - __builtin_rint(rev)); ic[i] = __builtin_amdgcn_cosf(fr); is[i] = __builtin_amdgcn_sinf(fr); }
    }
    { float* rs = (float*)(ws + WS_ROWSS); for (int i = gt; i < R; i += gn) rs[i] = 0.f; }
    if (tid == 0) ((int*)(ws + WS_CTL + 2048))[bid] = (int)xcc_id();
    if (bid == 0 && w == 0) {
        float a = P.lq1[lane] * P.lk1[lane], b2 = P.lq2[lane] * P.lk2[lane];
        for (int o = 32; o >= 1; o >>= 1) { a += __shfl_xor(a, o); b2 += __shfl_xor(b2, o); }
        if (lane == 0) { ((unsigned*)(ws + WS_CTL))[0] = 0u; ((unsigned*)(ws + WS_CTL))[1] = 0u; ((unsigned*)(ws + WS_CTL))[2] = 0u; ((float*)(ws + WS_CTL))[4] = expf(a) - expf(b2) + 0.2f; }
    }
}

namespace pg8 {
#define PG8_LAS __attribute__((address_space(3)))
typedef unsigned short bf16_t;
typedef short bf16x8 __attribute__((ext_vector_type(8)));
typedef float f32x4 __attribute__((ext_vector_type(4)));
typedef unsigned u32x4 __attribute__((ext_vector_type(4)));
constexpr int BM = 256, BK = 64, HALF = 128, HTB = HALF * BK * 2  , STAGE_BYTES = 8 * HTB, NXCD = 8, WGM = 8;

__host__ __device__ __forceinline__ int lds_byte(int r, int c) { const int st = (r >> 4) * 2 + (c >> 5), rr = r & 15, cc = c & 31, ob = rr * 64 + cc * 2; return st * 1024 + (ob ^ (((ob >> 9) & 1) << 5)); }
__host__ __device__ __forceinline__ void stage_rc(int b, int& R, int& C) { const int st = b / 1024, sb = b % 1024, swz = sb ^ (((sb >> 9) & 1) << 5); R = (st >> 1) * 16 + swz / 64; C = (st & 1) * 32 + (swz % 64) / 2; }
__host__ __device__ __forceinline__ int perm32(int rho) { const int n = rho >> 4, i = rho & 15; return 8 * (i >> 2) + 4 * n + (i & 3); }

struct Unit { int pm, pn; };
struct Gemm { const bf16_t* A; const bf16_t* Bt; int M, N, K; };

struct StaticOrder {
    int nM, nN, nwg, G, c;
    __host__ __device__ void init(int M, int N, int G_, int c_) { nM = M / BM; nN = N / BM; nwg = nM * nN; G = G_; c = c_; }
    __host__ __device__ bool next(int i, Unit& u) const {
        const long L = (long)i * G + c; if (L >= nwg) return false;
        int wgid = (int)L; { const int q = nwg / NXCD, r = nwg % NXCD, xcd = wgid % NXCD, off = wgid / NXCD; wgid = (xcd < r ? xcd * (q + 1) : r * (q + 1) + (xcd - r) * q) + off; }
        const int nig = WGM * nN, gid = wgid / nig, fm = gid * WGM, gsz = (nM - fm) < WGM ? (nM - fm) : WGM;
        u.pm = fm + ((wgid % nig) % gsz); u.pn = (wgid % nig) / gsz; return true;
    }
    __device__ __forceinline__ void a_ready(const Unit&) const {}
    __device__ __forceinline__ void done(const Unit&) const {}
};
template <class Epi, class Sched, bool ALIGN_EPI = false, bool SP2 = false>
__device__ __forceinline__ void gemm_phase(PG8_LAS unsigned char* lds, const Gemm g, const Sched& S, const Epi& E) {
    const int tid = opaque_tid(), wid = __builtin_amdgcn_readfirstlane(tid >> 6), lane = tid & 63, wr = wid >> 2, wc = wid & 3, fr = lane & 15, fq = lane >> 4;
    const int K = g.K, nt = K / BK;
    unsigned voffA[2], voffB[2];
#pragma unroll
    for (int i = 0; i < 2; ++i) { int R, C; stage_rc(tid * 16 + i * 8192, R, C); const int Rb = Epi::PERM ? ((R & ~31) + perm32(R & 31)) : R;
        voffA[i] = (unsigned)(R * K + C) * 2u; voffB[i] = (unsigned)(Rb * K + C) * 2u; }
    const size_t kstep = (size_t)(BK * 2);
    const size_t hstep = (size_t)HALF * K * 2;
    const size_t tstep = 2 * hstep;
    const unsigned ldsw = (unsigned)wid * 1024u;
    const int aoff = lds_byte(wr * 64 + fr, fq * 8), boff = lds_byte(wc * 32 + fr, fq * 8);
#define PG8_SA(b, h) (((b) * 2 + (h)) * HTB)
#define PG8_SB(b, h) ((4 + (b) * 2 + (h)) * HTB)
#define PG8_STAGE(bufoff, gbase, voff) do { _Pragma("unroll") for (int _i = 0; _i < 2; ++_i) \
        __builtin_amdgcn_global_load_lds((const unsigned*)((const char*)(gbase) + (voff)[_i]), (PG8_LAS unsigned*)(lds + (bufoff) + ldsw + _i * 8192), 16, 0, 0); } while (0)
#define PG8_LDA(dst, b, h) do { _Pragma("unroll") for (int m = 0; m < 4; ++m) _Pragma("unroll") for (int k = 0; k < 2; ++k) dst[m][k] = *(const PG8_LAS bf16x8*)(lds + PG8_SA(b, h) + aoff + m * 2048 + k * 1024); } while (0)
#define PG8_LDB(dst, b, h) do { _Pragma("unroll") for (int n = 0; n < 2; ++n) _Pragma("unroll") for (int k = 0; k < 2; ++k) dst[n][k] = *(const PG8_LAS bf16x8*)(lds + PG8_SB(b, h) + boff + n * 2048 + k * 1024); } while (0)
#define PG8_MMA(ai, bj, At, Bt) do { __builtin_amdgcn_s_setprio(1); _Pragma("unroll") for (int m = 0; m < 4; ++m) _Pragma("unroll") for (int n = 0; n < 2; ++n) _Pragma("unroll") for (int k = 0; k < 2; ++k) \
        acc[ai][bj][m][n] = __builtin_amdgcn_mfma_f32_16x16x32_bf16(Bt[n][k], At[m][k], acc[ai][bj][m][n], 0, 0, 0); __builtin_amdgcn_s_setprio(0); } while (0)
#define PG8_WAIT_V(n) asm volatile("s_waitcnt vmcnt(" #n ")" ::: "memory")
#define PG8_WAIT_L(n) asm volatile("s_waitcnt lgkmcnt(" #n ")" ::: "memory")
#define PG8_BAR __builtin_amdgcn_s_barrier()
#define PG8_SCHED __builtin_amdgcn_sched_barrier(0)
    Unit cur, nxt; int ui = 0;
    if (!S.next(0, cur)) return;
    f32x4 acc[2][2][4][2];
#pragma unroll
    for (int a = 0; a < 2; ++a)
#pragma unroll
        for (int b = 0; b < 2; ++b)
#pragma unroll
            for (int m = 0; m < 4; ++m)
#pragma unroll
                for (int n = 0; n < 2; ++n) acc[a][b][m][n] = (f32x4){0.f, 0.f, 0.f, 0.f};
    bf16x8 At[4][2], B0[2][2], B1[2][2];
    const char* cA = (const char*)g.A + (size_t)cur.pm * tstep; const char* cB = (const char*)g.Bt + (size_t)cur.pn * tstep;
    S.a_ready(cur);
    if constexpr (SP2) {
        PG8_STAGE(PG8_SB(0, 0), cB, voffB); PG8_STAGE(PG8_SB(0, 1), cB + hstep, voffB); PG8_STAGE(PG8_SA(0, 0), cA, voffA); PG8_STAGE(PG8_SA(0, 1), cA + hstep, voffA);
        if (wr == 1) PG8_BAR;
        PG8_WAIT_V(2); PG8_BAR;
        PG8_STAGE(PG8_SB(1, 0), cB + kstep, voffB); PG8_STAGE(PG8_SA(1, 0), cA + kstep, voffA); PG8_STAGE(PG8_SB(1, 1), cB + hstep + kstep, voffB);
        PG8_WAIT_V(6); PG8_BAR;
    } else {
        PG8_STAGE(PG8_SB(0, 0), cB, voffB); PG8_STAGE(PG8_SA(0, 0), cA, voffA); PG8_STAGE(PG8_SB(0, 1), cB + hstep, voffB); PG8_STAGE(PG8_SA(0, 1), cA + hstep, voffA);
        if (wr == 1) PG8_BAR;
        PG8_WAIT_V(4); PG8_BAR;
        PG8_STAGE(PG8_SB(1, 0), cB + kstep, voffB); PG8_STAGE(PG8_SA(1, 0), cA + kstep, voffA); PG8_STAGE(PG8_SB(1, 1), cB + hstep + kstep, voffB);
        PG8_WAIT_V(6); PG8_BAR;
    }
    for (;;) {
        const bool has_next = S.next(ui + 1, nxt);
        const char* nA = has_next ? (const char*)g.A + (size_t)nxt.pm * tstep : cA; const char* nB = has_next ? (const char*)g.Bt + (size_t)nxt.pn * tstep : cB;
        for (int t = 0; t < nt; t += 2) {
            const bool last = (t == nt - 2);
            const char* a1 = cA + (size_t)(t + 1) * kstep;
            const char* a2 = last ? nA : cA + (size_t)(t + 2) * kstep; const char* b2 = last ? nB : cB + (size_t)(t + 2) * kstep;
            const char* a3 = a2 + kstep; const char* b3 = b2 + kstep;
            if (last && has_next) S.a_ready(nxt);
            if constexpr (SP2) {
            PG8_LDB(B0, 0, 0); PG8_LDB(B1, 0, 1); PG8_SCHED; PG8_LDA(At, 0, 0); PG8_STAGE(PG8_SA(1, 1), a1 + hstep, voffA);
            PG8_WAIT_V(8); PG8_WAIT_L(0); PG8_BAR; PG8_MMA(0, 0, At, B0); PG8_MMA(0, 1, At, B1); PG8_BAR; PG8_SCHED;
            PG8_LDA(At, 0, 1); PG8_STAGE(PG8_SB(0, 0), b2, voffB); PG8_STAGE(PG8_SB(0, 1), b2 + hstep, voffB); PG8_STAGE(PG8_SA(0, 0), a2, voffA);
            PG8_WAIT_V(8); PG8_WAIT_L(0); PG8_BAR; PG8_MMA(1, 0, At, B0); PG8_MMA(1, 1, At, B1); PG8_BAR; PG8_SCHED;
            PG8_LDB(B0, 1, 0); PG8_LDB(B1, 1, 1); PG8_SCHED; PG8_LDA(At, 1, 0); PG8_STAGE(PG8_SA(0, 1), a2 + hstep, voffA);
            PG8_WAIT_V(8); PG8_WAIT_L(0); PG8_BAR; PG8_MMA(0, 0, At, B0); PG8_MMA(0, 1, At, B1); PG8_BAR; PG8_SCHED;
            PG8_LDA(At, 1, 1); PG8_STAGE(PG8_SB(1, 0), b3, voffB); PG8_STAGE(PG8_SB(1, 1), b3 + hstep, voffB); PG8_STAGE(PG8_SA(1, 0), a3, voffA);
            PG8_WAIT_V(8); PG8_WAIT_L(0); PG8_BAR; PG8_MMA(1, 0, At, B0); PG8_MMA(1, 1, At, B1); PG8_BAR; PG8_SCHED;
            } else {
            PG8_LDB(B0, 0, 0); PG8_SCHED; PG8_LDA(At, 0, 0); PG8_STAGE(PG8_SA(1, 1), a1 + hstep, voffA);
            PG8_WAIT_L(8); PG8_BAR; PG8_WAIT_L(0); PG8_MMA(0, 0, At, B0); PG8_BAR; PG8_SCHED;
            PG8_LDB(B1, 0, 1); PG8_STAGE(PG8_SB(0, 0), b2, voffB);
            PG8_BAR; PG8_WAIT_L(0); PG8_MMA(0, 1, At, B1); PG8_BAR;
            PG8_LDA(At, 0, 1); PG8_STAGE(PG8_SA(0, 0), a2, voffA);
            PG8_BAR; PG8_WAIT_L(0); PG8_MMA(1, 0, At, B0); PG8_BAR; PG8_SCHED;
            PG8_STAGE(PG8_SB(0, 1), b2 + hstep, voffB);
            PG8_WAIT_V(6); PG8_BAR; PG8_MMA(1, 1, At, B1); PG8_BAR;
            PG8_LDB(B0, 1, 0); PG8_SCHED; PG8_LDA(At, 1, 0); PG8_STAGE(PG8_SA(0, 1), a2 + hstep, voffA);
            PG8_WAIT_L(8); PG8_BAR; PG8_WAIT_L(0); PG8_MMA(0, 0, At, B0); PG8_BAR; PG8_SCHED;
            PG8_LDB(B1, 1, 1); PG8_STAGE(PG8_SB(1, 0), b3, voffB);
            PG8_BAR; PG8_WAIT_L(0); PG8_MMA(0, 1, At, B1); PG8_BAR;
            PG8_LDA(At, 1, 1); PG8_STAGE(PG8_SA(1, 0), a3, voffA);
            PG8_BAR; PG8_WAIT_L(0); PG8_MMA(1, 0, At, B0); PG8_BAR; PG8_SCHED;
            PG8_STAGE(PG8_SB(1, 1), b3 + hstep, voffB);
            PG8_WAIT_V(6); PG8_BAR; PG8_MMA(1, 1, At, B1); PG8_BAR;
            }
        }
        if constexpr (ALIGN_EPI) { if (wr == 0) PG8_BAR; }
        if constexpr (!Epi::AFTER_DRAIN) { E(acc, cur, wr, wc, fr, fq); S.done(cur); }
        if (!has_next) break;
#pragma unroll
        for (int a = 0; a < 2; ++a)
#pragma unroll
            for (int b = 0; b < 2; ++b)
#pragma unroll
                for (int m = 0; m < 4; ++m)
#pragma unroll
                    for (int n = 0; n < 2; ++n) acc[a][b][m][n] = (f32x4){0.f, 0.f, 0.f, 0.f};
        cur = nxt; cA = nA; cB = nB; ++ui;
        if constexpr (ALIGN_EPI) { if (wr == 1) PG8_BAR; }
    }
    PG8_WAIT_V(0);
    if constexpr (!ALIGN_EPI) { if (wr == 0) PG8_BAR; }
    PG8_BAR;
    if constexpr (Epi::AFTER_DRAIN) { E.fused(acc, cur, wr, wc, fr, fq, lds, wid, lane); S.done(cur); }
#undef PG8_SA
#undef PG8_SB
#undef PG8_STAGE
#undef PG8_LDA
#undef PG8_LDB
#undef PG8_MMA
#undef PG8_WAIT_V
#undef PG8_WAIT_L
#undef PG8_BAR
#undef PG8_SCHED
}
}

constexpr int MC = BATCH * SEQ;
struct EpiProj {
    static constexpr bool PERM = true, AFTER_DRAIN = false;
    char* ws0; const float *g_aq, *g_ak, *g_bq, *g_bk;
    __device__ __forceinline__ void operator()(const f32x4 (&acc)[2][2][4][2], const pg8::Unit& u, int wr, int wc, int fr, int fq) const {
        size_t oz = 0; asm volatile("" : "+s"(oz)); char* ws = ws0 + oz;
        bf16_t* AQ = (bf16_t*)(ws + WS_R2); bf16_t* AK = AQ + (size_t)8 * 8 * TP * 64;
        bf16_t* AVT = (bf16_t*)(ws + WS_R3); bf16_t* BQ = AVT + (size_t)8 * 4 * 128 * TP;
        unsigned char* KV8 = (unsigned char*)(ws + WS_BK); bf16_t* IK = (bf16_t*)(ws + WS_IK); float* IW = (float*)(ws + WS_IW);
        bf16_t* IQ = (bf16_t*)(ws + WS_R4); bf16_t* GA = (bf16_t*)(ws + WS_R6); bf16_t* GB = GA + (size_t)MC * 1024;
        const float* c64 = (const float*)(ws + WS_COS64); const float* s64 = (const float*)(ws + WS_SIN64); const float* ic = (const float*)(ws + WS_ICOS); const float* is = (const float*)(ws + WS_ISIN);
        const int chunk = u.pn * 4 + wc;
        UNR for (int ai = 0; ai < 2; ++ai) UNR for (int m = 0; m < 4; ++m) {
            const int row = u.pm * 256 + ai * 128 + wr * 64 + m * 16 + fr; const int b = row / TP, t = row - b * TP;
            f32x4 x[2][2]; UNR for (int bj = 0; bj < 2; ++bj) UNR for (int n = 0; n < 2; ++n) x[bj][n] = acc[ai][bj][m][n];
            const bool nr = (chunk < 16) || (chunk >= 24 && chunk <= 32);
            if (nr) {
                const float* gain; bf16_t* dst = nullptr; float sc = 1.f;
                if (chunk < 8) { gain = g_aq; dst = AQ + ((size_t)(b * 8 + chunk) * TP + t) * 64; sc = QSCALE; }
                else if (chunk < 16) { gain = g_ak; dst = AK + ((size_t)(b * 8 + chunk - 8) * TP + t) * 64; }
                else if (chunk < 32) { gain = g_bq; dst = BQ + (size_t)row * 512 + (chunk - 24) * 64; sc = QSCALE; }
                else { gain = g_bk; }
                float ss = 0.f;
                UNR for (int bj = 0; bj < 2; ++bj) UNR for (int n = 0; n < 2; ++n) UNR for (int e = 0; e < 4; ++e) ss += x[bj][n][e] * x[bj][n][e];
                ss = xrow_sum(ss);
                const float rinv = rsqrtf(ss * (1.0f / 64.0f) + EPS);
                float o1[8], o2[8];
                UNR for (int n = 0; n < 2; ++n) {
                    const int j = 8 * fq + 4 * n;
                    const f32x4 c = *(const f32x4*)(c64 + t * 32 + j), s = *(const f32x4*)(s64 + t * 32 + j);
                    const f32x4 g1 = *(const f32x4*)(gain + j), g2 = *(const f32x4*)(gain + 32 + j);
                    UNR for (int e = 0; e < 4; ++e) { const float y1 = x[0][n][e] * rinv * g1[e], y2 = x[1][n][e] * rinv * g2[e]; o1[4 * n + e] = (y1 * c[e] - y2 * s[e]) * sc; o2[4 * n + e] = (y2 * c[e] + y1 * s[e]) * sc; }
                }
                if (chunk == 32) {
                    uint4 w8; int w0;
                    w0 = 0; w0 = __builtin_amdgcn_cvt_pk_fp8_f32(o1[0], o1[1], w0, false); w0 = __builtin_amdgcn_cvt_pk_fp8_f32(o1[2], o1[3], w0, true); w8.x = (unsigned)w0;
                    w0 = 0; w0 = __builtin_amdgcn_cvt_pk_fp8_f32(o1[4], o1[5], w0, false); w0 = __builtin_amdgcn_cvt_pk_fp8_f32(o1[6], o1[7], w0, true); w8.y = (unsigned)w0;
                    w0 = 0; w0 = __builtin_amdgcn_cvt_pk_fp8_f32(o2[0], o2[1], w0, false); w0 = __builtin_amdgcn_cvt_pk_fp8_f32(o2[2], o2[3], w0, true); w8.z = (unsigned)w0;
                    w0 = 0; w0 = __builtin_amdgcn_cvt_pk_fp8_f32(o2[4], o2[5], w0, false); w0 = __builtin_amdgcn_cvt_pk_fp8_f32(o2[6], o2[7], w0, true); w8.w = (unsigned)w0;
                    *(uint4*)(KV8 + (size_t)row * 128 + 16 * fq) = w8;
                } else {
                    uint4 u1, u2;
                    u1.x = pk2(o1[0], o1[1]); u1.y = pk2(o1[2], o1[3]); u1.z = pk2(o1[4], o1[5]); u1.w = pk2(o1[6], o1[7]);
                    u2.x = pk2(o2[0], o2[1]); u2.y = pk2(o2[2], o2[3]); u2.z = pk2(o2[4], o2[5]); u2.w = pk2(o2[6], o2[7]);
                    *(uint4*)(dst + 8 * fq) = u1; *(uint4*)(dst + 32 + 8 * fq) = u2;
                }
            } else if (chunk < 24) {
                const int hd = (chunk - 16) >> 1, half = (chunk - 16) & 1;
                const int tc = (t & ~12) | ((t & 4) << 1) | ((t & 8) >> 1);
                bf16_t* dst = AVT + ((size_t)(b * 4 + hd) * 128 + half * 64) * TP + tc;
                const bool odd = (fr & 1) != 0; bf16_t* dp = dst - (odd ? 1 : 0);
                UNR for (int bj = 0; bj < 2; ++bj) UNR for (int n = 0; n < 2; ++n) UNR for (int e = 0; e < 4; e += 2) {
                    const float a0 = x[bj][n][e], a1 = x[bj][n][e + 1];
                    const float give = odd ? a0 : a1; const float recv = dpp_f(give, 0xB1);
                    const unsigned wv = odd ? pk2(recv, a1) : pk2(a0, recv);
                    const int d = 32 * bj + 8 * fq + 4 * n + e + (odd ? 1 : 0);
                    *(unsigned*)(dp + (size_t)d * TP) = wv;
                }
            } else if (chunk == 33) {
                unsigned char* kv = KV8 + (size_t)row * 128 + 64;
                UNR for (int bj = 0; bj < 2; ++bj) { uint2 w8; int w0;
                    w0 = 0; w0 = __builtin_amdgcn_cvt_pk_fp8_f32(x[bj][0][0], x[bj][0][1], w0, false); w0 = __builtin_amdgcn_cvt_pk_fp8_f32(x[bj][0][2], x[bj][0][3], w0, true); w8.x = (unsigned)w0;
                    w0 = 0; w0 = __builtin_amdgcn_cvt_pk_fp8_f32(x[bj][1][0], x[bj][1][1], w0, false); w0 = __builtin_amdgcn_cvt_pk_fp8_f32(x[bj][1][2], x[bj][1][3], w0, true); w8.y = (unsigned)w0;
                    *(uint2*)(kv + 32 * bj + 8 * fq) = w8; }
            } else if (chunk <= 42) {
                bf16_t* dst = (chunk == 42) ? IK + (size_t)row * 64 : IQ + (size_t)row * 512 + (chunk - 34) * 64;
                const bool hi2 = fq >= 2; const int jb = 8 * (fq & 1);
                float y[8];
                UNR for (int n = 0; n < 2; ++n) {
                    const f32x4 c = *(const f32x4*)(ic + t * 16 + jb + 4 * n), s = *(const f32x4*)(is + t * 16 + jb + 4 * n);
                    UNR for (int e = 0; e < 4; ++e) {
                        const float mine = x[0][n][e];
                        auto sw = __builtin_amdgcn_permlane32_swap(__float_as_uint(mine), __float_as_uint(mine), false, false);
                        const float other = __uint_as_float(hi2 ? sw[0] : sw[1]);
                        const float a = hi2 ? other : mine, bb = hi2 ? mine : other;
                        y[4 * n + e] = hi2 ? (bb * c[e] + a * s[e]) : (a * c[e] - bb * s[e]);
                    }
                }
                uint4 u1, u2;
                u1.x = pk2(y[0], y[1]); u1.y = pk2(y[2], y[3]); u1.z = pk2(y[4], y[5]); u1.w = pk2(y[6], y[7]);
                u2.x = pk2(x[1][0][0], x[1][0][1]); u2.y = pk2(x[1][0][2], x[1][0][3]); u2.z = pk2(x[1][1][0], x[1][1][1]); u2.w = pk2(x[1][1][2], x[1][1][3]);
                *(uint4*)(dst + 8 * fq) = u1; *(uint4*)(dst + 32 + 8 * fq) = u2;
            } else if (chunk == 43) {
                const float sc = 0.35355339059327373f * 0.125f;
                if (fq == 0) { *(f32x4*)(IW + (size_t)row * 8) = x[0][0] * sc; *(f32x4*)(IW + (size_t)row * 8 + 4) = x[0][1] * sc; }
            } else {
                if (t >= NMETA && t < TR) {
                    const size_t mc = (size_t)b * SEQ + (t - NMETA);
                    bf16_t* dst = (chunk < 60) ? GA + mc * 1024 + (chunk - 44) * 64 : GB + mc * 1024 + (chunk - 60) * 64;
                    UNR for (int bj = 0; bj < 2; ++bj) {
                        float o[8]; UNR for (int n = 0; n < 2; ++n) UNR for (int e = 0; e < 4; ++e) o[4 * n + e] = __builtin_amdgcn_rcpf(1.0f + ex2(-LOG2E * x[bj][n][e]));
                        uint4 v; v.x = pk2(o[0], o[1]); v.y = pk2(o[2], o[3]); v.z = pk2(o[4], o[5]); v.w = pk2(o[6], o[7]); *(uint4*)(dst + 32 * bj + 8 * fq) = v;
                    }
                }
            }
        }
    }
};
__device__ __forceinline__ void phase1(const Params& P, PG8_LAS unsigned char* lds) {
    pg8::Gemm g{(const bf16_t*)(P.ws + WS_R1), (const bf16_t*)(P.ws + WS_WIN), R, NIN, 1024};
    pg8::StaticOrder S; S.init(R, NIN, (int)gridDim.x, (int)blockIdx.x);
    EpiProj E{P.ws, P.g_aq, P.g_ak, P.g_bq, P.g_bk};
    pg8::gemm_phase<EpiProj, pg8::StaticOrder, true, true>(lds, g, S, E);
}

__device__ __forceinline__ void attnA_unit(const Params& P, int b, int head, int qb, char* lds) {
    const int tid = opaque_tid(), lane = tid & 63, w = tid >> 6, qg = w & 3, st = w >> 2, l31 = lane & 31, hi = lane >> 5;
    char* ws = P.ws;
    const bf16_t* AQ = (const bf16_t*)(ws + WS_R2); const bf16_t* AK = AQ + (size_t)8 * 8 * TP * 64; const bf16_t* AVT = (const bf16_t*)(ws + WS_R3);
    bf16_t* AOUT = (bf16_t*)(ws + WS_R1);
    const float lam = ((const float*)(ws + WS_CTL))[4];
    const int q0 = NMETA + qb * 128 + qg * 32;
    const bf16_t* Qp = AQ + ((size_t)(b * 8 + head * 2 + st) * TP + q0 + l31) * 64;
    bf16x8 qf[4];
    UNR for (int ks = 0; ks < 4; ++ks) qf[ks] = *(const bf16x8*)(Qp + ks * 16 + hi * 8);
    const bf16_t* K0g = AK + (size_t)(b * 8 + head * 2) * TP * 64; const bf16_t* K1g = K0g + (size_t)TP * 64;
    const bf16_t* Vg = AVT + (size_t)(b * 4 + head) * 128 * TP;
    const int nkt = 2 * qb + 3;
    const int srow = tid >> 3, sch = tid & 7;
    const int koff = srow * 128 + ((sch ^ (srow & 7)) << 4), voff = srow * 128 + ((sch ^ ((srow >> 1) & 7)) << 4);
    typedef __attribute__((address_space(3))) unsigned las_u32;
    const bf16_t* gk0 = K0g + (size_t)srow * 64 + ((sch ^ (srow & 7)) << 3);
    const bf16_t* gk1 = gk0 + (size_t)TP * 64;
    const bf16_t* gv0 = Vg + (size_t)srow * TP + ((sch ^ ((srow >> 1) & 7)) << 3);
    const bf16_t* gv1 = gv0 + (size_t)64 * TP;
    auto gload = [&](int kt, int buf) {
        char* base = lds + buf * 32768 + w * 1024;
        __builtin_amdgcn_global_load_lds((const unsigned*)(gk0 + (size_t)kt * 4096), (las_u32*)(base), 16, 0, 0);
        __builtin_amdgcn_global_load_lds((const unsigned*)(gk1 + (size_t)kt * 4096), (las_u32*)(base + 8192), 16, 0, 0);
        __builtin_amdgcn_global_load_lds((const unsigned*)(gv0 + kt * 64), (las_u32*)(base + 16384), 16, 0, 0);
        __builtin_amdgcn_global_load_lds((const unsigned*)(gv1 + kt * 64), (las_u32*)(base + 24576), 16, 0, 0);
    };
    f32x16 o[4]; UNR for (int i = 0; i < 4; ++i) o[i] = zero16();
    f32x16 osum = zero16(), negm = zero16();
    bf16x8 ones; UNR for (int i = 0; i < 8; ++i) ones[i] = (bf16_t)0x3F80;
    bool first = true;
    asm volatile("" :: "v"(qf[0]), "v"(qf[1]), "v"(qf[2]), "v"(qf[3]));
    gload(0, 0); asm volatile("s_waitcnt vmcnt(0)" ::: "memory"); __syncthreads();
    const int qpos = q0 + l31;
    for (int kt = 0; kt < nkt; ++kt) {
        if (kt + 1 < nkt) gload(kt + 1, (kt + 1) & 1);
        const char* base = lds + (kt & 1) * 32768; const char* Kb = base + st * 8192; const char* Vb = base + 16384;
        f32x16 s0, s1;
        {
            bf16x8 ka[4], kb[4];
            UNR for (int ks = 0; ks < 4; ++ks) { const int co = (((ks * 2 + hi) ^ (l31 & 7)) << 4); ka[ks] = *(const bf16x8*)(Kb + l31 * 128 + co); kb[ks] = *(const bf16x8*)(Kb + (32 + l31) * 128 + co); }
            __builtin_amdgcn_sched_barrier(0);
            s0 = mfma32(ka[0], qf[0], negm); s1 = mfma32(kb[0], qf[0], negm);
            UNR for (int ks = 1; ks < 4; ++ks) { s0 = mfma32(ka[ks], qf[ks], s0); s1 = mfma32(kb[ks], qf[ks], s1); }
        }
        if (kt >= nkt - 3) {
            const int kbase = kt * 64;
            UNR for (int r = 0; r < 16; ++r) { const int key = kbase + crow(r, hi); if (key > qpos) s0[r] = -INFINITY; if (key + 32 > qpos) s1[r] = -INFINITY; }
        }
        float mx = s0[0];
        UNR for (int r = 1; r < 16; ++r) mx = fmaxf(mx, s0[r]);
        UNR for (int r = 0; r < 16; ++r) mx = fmaxf(mx, s1[r]);
        if (first || !__all(mx <= 8.0f)) {
            mx = fmaxf(mx, __shfl_xor(mx, 32));
            const float d = first ? mx : fmaxf(mx, 0.f);
            const float alpha = first ? 1.0f : ex2(-d);
            UNR for (int r = 0; r < 16; ++r) { s0[r] -= d; s1[r] -= d; negm[r] -= d; osum[r] *= alpha; }
            UNR for (int mt = 0; mt < 4; ++mt) UNR for (int r = 0; r < 16; ++r) o[mt][r] *= alpha;
            first = false;
        }
        auto vfrag = [&](int g, bf16x8 (&a)[4]) {
            UNR for (int mt = 0; mt < 4; ++mt) { const int d = mt * 32 + l31; const int sw = (d >> 1) & 7; a[mt] = *(const bf16x8*)(Vb + d * 128 + (((2 * g + hi) ^ sw) << 4)); }
        };
        auto pexp = [&](int g) -> bf16x8 {
            const int bq = 8 * (g & 1);
            if (g >> 1) return pack8(ex2(s1[bq]), ex2(s1[bq + 1]), ex2(s1[bq + 2]), ex2(s1[bq + 3]), ex2(s1[bq + 4]), ex2(s1[bq + 5]), ex2(s1[bq + 6]), ex2(s1[bq + 7]));
            return pack8(ex2(s0[bq]), ex2(s0[bq + 1]), ex2(s0[bq + 2]), ex2(s0[bq + 3]), ex2(s0[bq + 4]), ex2(s0[bq + 5]), ex2(s0[bq + 6]), ex2(s0[bq + 7]));
        };
        auto pvmma = [&](const bf16x8 (&a)[4], const bf16x8& p) {
            UNR for (int mt = 0; mt < 4; ++mt) o[mt] = mfma32(a[mt], p, o[mt]);
            osum = mfma32(ones, p, osum);
        };
        {
            bf16x8 va[4], vb[4];
            vfrag(0, va);
            bf16x8 p0 = pexp(0);
            __builtin_amdgcn_sched_barrier(0);
            vfrag(1, vb); pvmma(va, p0); bf16x8 p1 = pexp(1);
            __builtin_amdgcn_sched_barrier(0);
            vfrag(2, va); pvmma(vb, p1); p0 = pexp(2);
            __builtin_amdgcn_sched_barrier(0);
            vfrag(3, vb); pvmma(va, p0); p1 = pexp(3);
            __builtin_amdgcn_sched_barrier(0);
            pvmma(vb, p1);
        }
        asm volatile("s_waitcnt vmcnt(0)" ::: "memory");
        __syncthreads();
    }
    const float inv = 1.0f / osum[0];
    float* ex = (float*)lds + qg * 4096;
    if (st == 1) { const float f = inv * lam; UNR for (int mt = 0; mt < 4; ++mt) UNR for (int r = 0; r < 16; ++r) ex[(mt * 16 + r) * 64 + lane] = o[mt][r] * f; }
    __syncthreads();
    if (st == 0) {
        float ss = 0.f;
        UNR for (int mt = 0; mt < 4; ++mt) UNR for (int r = 0; r < 16; ++r) { const float v = o[mt][r] * inv - ex[(mt * 16 + r) * 64 + lane]; o[mt][r] = v; ss += v * v; }
        ss += __shfl_xor(ss, 32);
        const float rinv = rsqrtf(ss * (1.0f / 128.0f) + EPS) * 0.8f;
        const int tq = q0 + l31; const bool real = (tq >= NMETA && tq < TR);
        bf16_t* dst = AOUT + ((size_t)b * SEQ + (real ? tq - NMETA : 0)) * 512 + head * 128;
        if (real) UNR for (int mt = 0; mt < 4; ++mt) UNR for (int g4 = 0; g4 < 4; ++g4) {
            const int d = mt * 32 + 8 * g4 + 4 * hi; const f32x4 g = *(const f32x4*)(P.g_sub + d);
            uint2 u; u.x = pk2(o[mt][4 * g4] * rinv * g[0], o[mt][4 * g4 + 1] * rinv * g[1]); u.y = pk2(o[mt][4 * g4 + 2] * rinv * g[2], o[mt][4 * g4 + 3] * rinv * g[3]);
            *(uint2*)(dst + d) = u;
        }
    }
    __syncthreads();
}

constexpr int DSA_C = 448;
constexpr int DS_SEL = 0, DS_CAND = 8192, DS_VST = 8192, DS_PART = 40960, DS_PML = 106496, DS_BMP = 110592, DS_STATE = 131072;
__device__ __forceinline__ unsigned ord32(float s) { const unsigned u = __float_as_uint(s); return (u & 0x80000000u) ? ~u : (u | 0x80000000u); }

__device__ __forceinline__ void dsa_unit(const Params& P, int b, int q16, char* lds) {
    const int tid = opaque_tid(), lane = tid & 63, w = tid >> 6, n15 = lane & 15, g = lane >> 4;
    char* ws = P.ws;
    const bf16_t* BQ = (const bf16_t*)(ws + WS_R3) + (size_t)8 * 4 * 128 * TP;
    const bf16_t* BK = (const bf16_t*)(ws + WS_BK); const bf16_t* BV = (const bf16_t*)(ws + WS_BV); const bf16_t* IK = (const bf16_t*)(ws + WS_IK);
    const float* IW = (const float*)(ws + WS_IW); const bf16_t* IQ = (const bf16_t*)(ws + WS_R4);
    bf16_t* BOUT = (bf16_t*)(ws + WS_R1) + (size_t)MC * 512;
    unsigned* HIST = (unsigned*)lds;
    unsigned short* SEL = (unsigned short*)(lds + DS_SEL); u64* CAND = (u64*)(lds + DS_CAND);
    u64* s_pfx = (u64*)(lds + DS_STATE); int* s_need = (int*)(lds + DS_STATE + 256); int* s_pop = (int*)(lds + DS_STATE + 384);
    unsigned* s_selcnt = (unsigned*)(lds + DS_STATE + 512); unsigned* s_candcnt = (unsigned*)(lds + DS_STATE + 640); int* s_all = (int*)(lds + DS_STATE + 768);
    const int q0 = q16 * 16; const int qpos = q0 + n15; const size_t qrow = (size_t)b * TP + qpos;
    const int nk = q16 + 1;
    bf16x8 iqf[8][2];
    UNR for (int h = 0; h < 8; ++h) UNR for (int s = 0; s < 2; ++s) iqf[h][s] = *(const bf16x8*)(IQ + qrow * 512 + h * 64 + s * 32 + g * 8);
    float iw[8];
    { const f32x4 a = *(const f32x4*)(IW + qrow * 8), c = *(const f32x4*)(IW + qrow * 8 + 4); iw[0] = a[0]; iw[1] = a[1]; iw[2] = a[2]; iw[3] = a[3]; iw[4] = c[0]; iw[5] = c[1]; iw[6] = c[2]; iw[7] = c[3]; }
    GAS1 const char* ikb = sgp(IK + (size_t)b * TP * 64);
    auto loadk = [&](int kt, bf16x8& k0, bf16x8& k1) {
        const unsigned off = (unsigned)((kt * 16 + n15) * 128 + g * 16);
        k0 = *(GAS1 const bf16x8*)(ikb + off); k1 = *(GAS1 const bf16x8*)(ikb + off + 64);
    };
    auto load4 = [&](int kt0, bf16x8 (&k)[4][2]) { UNR for (int j = 0; j < 4; ++j) loadk(min(kt0 + 8 * j, nk - 1), k[j][0], k[j][1]); };
    auto compute = [&](const bf16x8& k0, const bf16x8& k1, f32x4& sc) {
        sc = (f32x4){0.f, 0.f, 0.f, 0.f};
        UNR for (int h = 0; h < 8; ++h) {
            f32x4 a = {0.f, 0.f, 0.f, 0.f};
            a = mfma16(k0, iqf[h][0], a); a = mfma16(k1, iqf[h][1], a);
            const i32x4_t ai = __builtin_elementwise_max(__builtin_bit_cast(i32x4_t, a), (i32x4_t){0, 0, 0, 0}); const f32x4 ar = __builtin_bit_cast(f32x4, ai);
            UNR for (int e = 0; e < 4; ++e) sc[e] = __builtin_fmaf(iw[h], ar[e], sc[e]);
        }
        UNR for (int e = 0; e < 4; ++e) sc[e] += 0.0f;
    };
    if (tid < 16) { unsigned z = 0u; asm volatile("" : "+v"(z)); ((unsigned*)s_pfx)[2 * tid] = z; ((unsigned*)s_pfx)[2 * tid + 1] = z; s_need[tid] = min(256, q0 + tid + 1); s_pop[tid] = (int)z; s_all[tid] = (int)z; }
    int sh = 45;
    for (;;) {
        const int nbits = sh < 11 ? sh : 11; const int mask = (1 << nbits) - 1;
        { uint4 z = {0u, 0u, 0u, 0u}; for (int i = tid; i < 4096; i += NTHREADS) ((uint4*)lds)[i] = z; }
        __syncthreads();
        const u64 mypfx = s_pfx[n15]; const int myall = s_all[n15];
        auto binit0 = [&](int kt, const f32x4& sc) {
            (void)kt;
            UNR for (int e = 0; e < 4; ++e) {
                const unsigned u = __float_as_uint(sc[e]); const unsigned t = u >> 21;
                const unsigned ib = t ^ (~(unsigned)((int)u >> 31) & 1023u);
                atomicAdd(&HIST[n15 * 1024 + ((ib >> 1) ^ n15)], 1u << ((ib & 1) * 16));
            }
        };
        auto binit = [&](int kt, const f32x4& sc) {
            const bool diag = (kt == nk - 1);
            UNR for (int e = 0; e < 4; ++e) {
                const int idx = kt * 16 + 4 * g + e;
                if ((!diag || idx <= qpos) && !myall) {
                    const u64 comp = ((u64)ord32(sc[e]) << 13) | (u64)(8191 - idx);
                    if ((comp >> sh) == mypfx) { const int ib = mask - (int)((comp >> (sh - nbits)) & (u64)mask); atomicAdd(&HIST[n15 * 1024 + ((ib >> 1) ^ n15)], 1u << ((ib & 1) * 16)); }
                }
            }
        };
        {
            bf16x8 ka[4][2]; f32x4 sc;
            int kt = __builtin_amdgcn_readfirstlane(opaque_tid() >> 6); load4(kt, ka);
            if (sh == 45) {
                f32x4* SCR = (f32x4*)(ws + WS_END + (size_t)blockIdx.x * (16 * 4112 * 4)) + (opaque_tid() & 63);
                while (kt < nk) {
                    UNR for (int j = 0; j < 4; ++j) {
                        compute(ka[j][0], ka[j][1], sc);
                        loadk(min(kt + 32 + 8 * j, nk - 1), ka[j][0], ka[j][1]);
                        if (kt + 8 * j == nk - 1) { UNR for (int e = 0; e < 4; ++e) if (4 * g + e > n15) sc[e] = -INFINITY; }
                        if (kt + 8 * j < nk) { SCR[(size_t)(kt + 8 * j) * 64] = sc; binit0(kt + 8 * j, sc); }
                    }
                    kt += 32;
                }
            } else {
                while (kt < nk) {
                    UNR for (int j = 0; j < 4; ++j) {
                        compute(ka[j][0], ka[j][1], sc);
                        loadk(min(kt + 32 + 8 * j, nk - 1), ka[j][0], ka[j][1]);
                        if (kt + 8 * j < nk) binit(kt + 8 * j, sc);
                    }
                    kt += 32;
                }
            }
        }
        __syncthreads();
        UNR for (int i = 0; i < 2; ++i) {
            const int ql = w * 2 + i;
            if (s_all[ql]) continue;
            const uint4* hq = (const uint4*)(HIST + ql * 1024 + lane * 16);
            unsigned c = 0;
            UNR for (int j = 0; j < 4; ++j) { const uint4 v = hq[j]; c += (v.x & 0xffffu) + (v.x >> 16) + (v.y & 0xffffu) + (v.y >> 16) + (v.z & 0xffffu) + (v.z >> 16) + (v.w & 0xffffu) + (v.w >> 16); }
            unsigned pre = c;
            pre = wave_iscan(pre);
            const unsigned nd = (unsigned)s_need[ql];
            const u64 bal = __ballot(pre >= nd);
            if (bal == 0ull) { if (lane == 0) { s_all[ql] = 1; s_pop[ql] = 0; s_need[ql] = 0; } }
            else {
                const int Lc = __ffsll((long long)bal) - 1;
                const unsigned cumL = (unsigned)__builtin_amdgcn_readlane((int)(pre - c), Lc);
                const unsigned wv = HIST[ql * 1024 + Lc * 16 + (((lane >> 1) & 15) ^ ql)];
                const unsigned cnt = (lane < 32) ? ((wv >> ((lane & 1) * 16)) & 0xffffu) : 0u;
                unsigned p2 = cnt;
                p2 = wave_iscan(p2);
                const unsigned cum = cumL + p2 - cnt;
                const u64 b2 = __ballot(lane < 32 && cum + cnt >= nd);
                const int sb = __ffsll((long long)b2) - 1;
                if (lane == sb) { const int ibs = Lc * 32 + sb; s_pfx[ql] = (s_pfx[ql] << nbits) | (u64)(mask - ibs); s_need[ql] = (int)(nd - cum); s_pop[ql] = (int)cnt; }
            }
        }
        __syncthreads();
        sh -= nbits;
        int mp = 0; UNR for (int q = 0; q < 16; ++q) mp = max(mp, s_pop[q]);
        if (mp <= DSA_C || sh == 0) break;
    }
    unsigned* BMP = (unsigned*)(lds + DS_BMP);
    if (tid < 16) { s_selcnt[tid] = 0u; s_candcnt[tid] = 0u; }
    for (int i = tid; i < 16 * 137; i += NTHREADS) BMP[i] = 0u;
    __syncthreads();
    {
        const int tid = opaque_tid(), lane = tid & 63, w = tid >> 6, n15 = lane & 15, g = lane >> 4; const int qpos = q0 + n15; (void)qpos; (void)g; (void)w;
        const u64 mypfx = s_pfx[n15]; const int myall = s_all[n15];
        const unsigned myib = 2047u - (unsigned)(mypfx & 2047ull);
        auto emit0 = [&](int kt, const f32x4& sc) {
            bool cand[4]; int nc = 0;
            UNR for (int e = 0; e < 4; ++e) {
                const int idx = kt * 16 + 4 * g + e;
                const unsigned u = __float_as_uint(sc[e]); const unsigned t = u >> 21;
                const unsigned ib = t ^ (~(unsigned)((int)u >> 31) & 1023u);
                const bool sel = ib < myib;
                cand[e] = ib == myib; nc += cand[e] ? 1 : 0;
                if (sel) atomicOr(&BMP[n15 * 137 + (idx >> 5)], 1u << (idx & 31));
            }
            if (nc) {
                unsigned cp = atomicAdd(&s_candcnt[n15], (unsigned)nc);
                UNR for (int e = 0; e < 4; ++e) if (cand[e]) { const int idx = kt * 16 + 4 * g + e; if (cp < (unsigned)DSA_C) CAND[n15 * DSA_C + cp] = ((u64)ord32(sc[e]) << 13) | (u64)(8191 - idx); ++cp; }
            }
        };
        auto emit = [&](int kt, const f32x4& sc) {
            const bool diag = (kt == nk - 1);
            UNR for (int e = 0; e < 4; ++e) {
                const int idx = kt * 16 + 4 * g + e;
                if (!diag || idx <= qpos) {
                    const u64 comp = ((u64)ord32(sc[e]) << 13) | (u64)(8191 - idx); const u64 top = comp >> sh;
                    if (myall || top > mypfx) atomicOr(&BMP[n15 * 137 + (idx >> 5)], 1u << (idx & 31));
                    else if (top == mypfx) { const unsigned cp = atomicAdd(&s_candcnt[n15], 1u); if (cp < (unsigned)DSA_C) CAND[n15 * DSA_C + cp] = comp; }
                }
            }
        };
        bf16x8 ka[4][2]; f32x4 sc;
        int kt = w; if (sh != 34) load4(kt, ka);
        if (sh == 34) {
            f32x4 sa[4], sb[4];
            const f32x4* SCR = (const f32x4*)(ws + WS_END + (size_t)blockIdx.x * (16 * 4112 * 4)) + lane;
            int kb = (nk > w) ? w + 32 * ((nk - 1 - w) >> 5) : -1;
            if (kb >= 0) {
                UNR for (int j = 0; j < 4; ++j) sa[j] = SCR[(size_t)min(kb + 8 * j, nk - 1) * 64];
                while (kb >= 0) {
                    UNR for (int j = 0; j < 4; ++j) sb[j] = SCR[(size_t)max(kb - 32 + 8 * j, 0) * 64];
                    UNR for (int j = 0; j < 4; ++j) if (kb + 8 * j < nk) emit0(kb + 8 * j, sa[j]);
                    kb -= 32; if (kb < 0) break;
                    UNR for (int j = 0; j < 4; ++j) sa[j] = SCR[(size_t)max(kb - 32 + 8 * j, 0) * 64];
                    UNR for (int j = 0; j < 4; ++j) emit0(kb + 8 * j, sb[j]);
                    kb -= 32;
                }
            }
        } else {
            while (kt < nk) {
                UNR for (int j = 0; j < 4; ++j) {
                    compute(ka[j][0], ka[j][1], sc);
                    loadk(min(kt + 32 + 8 * j, nk - 1), ka[j][0], ka[j][1]);
                    if (kt + 8 * j < nk) emit(kt + 8 * j, sc);
                }
                kt += 32;
            }
        }
    }
    __syncthreads();
    {
        const int tid = opaque_tid(), lane = tid & 63, w = tid >> 6, n15 = lane & 15, g = lane >> 4; const int qpos = q0 + n15; (void)qpos; (void)g; (void)w;
    {
        const int qa = 2 * w, qb = qa + 1;
        const int nA = min((int)s_candcnt[qa], DSA_C), nB = min((int)s_candcnt[qb], DSA_C);
        int ndA = s_need[qa], ndB = s_need[qb];
        const bool actA = nA > 0 && ndA > 0, actB = nB > 0 && ndB > 0;
        if (actA || actB) {
            unsigned hA[7], lA[7], hB[7], lB[7];
            UNR for (int j = 0; j < 7; ++j) {
                const int ci = j * 64 + lane;
                const u64 ca = (actA && ci < nA) ? CAND[qa * DSA_C + ci] : 0ull; hA[j] = (unsigned)(ca >> 13); lA[j] = (unsigned)ca & 8191u;
                const u64 cb = (actB && ci < nB) ? CAND[qb * DSA_C + ci] : 0ull; hB[j] = (unsigned)(cb >> 13); lB[j] = (unsigned)cb & 8191u;
            }
            const int ns = (max(actA ? nA : 0, actB ? nB : 0) + 63) >> 6;
            const u64 pA = s_pfx[qa], pB = s_pfx[qb];
            unsigned TA = sh >= 13 ? (unsigned)(pA << (sh - 13)) : (unsigned)(pA >> (13 - sh));
            unsigned TB = sh >= 13 ? (unsigned)(pB << (sh - 13)) : (unsigned)(pB >> (13 - sh));
            if (!actA) ndA = 1 << 20;
            if (!actB) ndB = 1 << 20;
            _Pragma("nounroll") for (int bit = (sh > 13 ? sh - 13 : 0) - 1; bit >= 0; --bit) {
                const unsigned tA = TA | (1u << bit), tB = TB | (1u << bit); int cA = 0, cB = 0;
                UNR for (int j = 0; j < 7; ++j) if (j < ns) { cA += __popcll(__ballot(hA[j] >= tA)); cB += __popcll(__ballot(hB[j] >= tB)); }
                if (cA >= ndA) TA = tA;
                if (cB >= ndB) TB = tB;
            }
            int gA = 0, eA = 0, gB = 0, eB = 0;
            UNR for (int j = 0; j < 7; ++j) if (j < ns) { gA += __popcll(__ballot(hA[j] > TA)); eA += __popcll(__ballot(hA[j] == TA)); gB += __popcll(__ballot(hB[j] > TB)); eB += __popcll(__ballot(hB[j] == TB)); }
            const int needA = actA ? ndA - gA : (1 << 20), needB = actB ? ndB - gB : (1 << 20);
            unsigned LA = 0u, LB = 0u;
            if ((actA && eA != needA) || (actB && eB != needB)) {
                _Pragma("nounroll") for (int bit = 12; bit >= 0; --bit) {
                    const unsigned tA = LA | (1u << bit), tB = LB | (1u << bit); int cA = 0, cB = 0;
                    UNR for (int j = 0; j < 7; ++j) if (j < ns) { cA += __popcll(__ballot(hA[j] == TA && lA[j] >= tA)); cB += __popcll(__ballot(hB[j] == TB && lB[j] >= tB)); }
                    if (cA >= needA) LA = tA;
                    if (cB >= needB) LB = tB;
                }
            }
            UNR for (int j = 0; j < 7; ++j) if (j < ns) {
                if (actA && hA[j] != 0u && (hA[j] > TA || (hA[j] == TA && lA[j] >= LA))) { const int idx = 8191 - (int)lA[j]; atomicOr(&BMP[qa * 137 + (idx >> 5)], 1u << (idx & 31)); }
                if (actB && hB[j] != 0u && (hB[j] > TB || (hB[j] == TB && lB[j] >= LB))) { const int idx = 8191 - (int)lB[j]; atomicOr(&BMP[qb * 137 + (idx >> 5)], 1u << (idx & 31)); }
            }
        }
    }
    }
    __syncthreads();
    {
        const int tid = opaque_tid(), lane = tid & 63, w = tid >> 6, n15 = lane & 15, g = lane >> 4; const int qpos = q0 + n15; (void)qpos; (void)g; (void)w;
    {
        const int qa = 2 * w, qb = qa + 1;
        const int nchunk = (q16 + 4) >> 2;
        const unsigned aL = BMP[qa * 137 + 2 * lane], aH = BMP[qa * 137 + 2 * lane + 1], bL = BMP[qb * 137 + 2 * lane], bH = BMP[qb * 137 + 2 * lane + 1];
        const unsigned lbL = lane < 32 ? 1u << lane : 0u, lbH = lane >= 32 ? 1u << (lane - 32) : 0u;
        int baseA = 0, baseB = 0;
        auto step = [&](int c, unsigned mAl, unsigned mAh, unsigned mBl, unsigned mBh) {
            const int pa = baseA + (int)__builtin_amdgcn_mbcnt_hi(mAh, __builtin_amdgcn_mbcnt_lo(mAl, 0u));
            const int pb = baseB + (int)__builtin_amdgcn_mbcnt_hi(mBh, __builtin_amdgcn_mbcnt_lo(mBl, 0u));
            if ((((mAl & lbL) | (mAh & lbH)) != 0u) && pa < 256) SEL[qa * 256 + pa] = (unsigned short)(c * 64 + lane);
            if ((((mBl & lbL) | (mBh & lbH)) != 0u) && pb < 256) SEL[qb * 256 + pb] = (unsigned short)(c * 64 + lane);
            baseA += __popc(mAl) + __popc(mAh); baseB += __popc(mBl) + __popc(mBh);
        };
        const int nc0 = min(nchunk, 64);
        _Pragma("nounroll") for (int c = 0; c < nc0; ++c)
            step(c, (unsigned)__builtin_amdgcn_readlane((int)aL, c), (unsigned)__builtin_amdgcn_readlane((int)aH, c), (unsigned)__builtin_amdgcn_readlane((int)bL, c), (unsigned)__builtin_amdgcn_readlane((int)bH, c));
        if (nchunk > 64) step(64, BMP[qa * 137 + 128], BMP[qa * 137 + 129], BMP[qb * 137 + 128], BMP[qb * 137 + 129]);
        for (int p = baseA + lane; p < 256; p += 64) SEL[qa * 256 + p] = (unsigned short)0;
        for (int p = baseB + lane; p < 256; p += 64) SEL[qb * 256 + p] = (unsigned short)0;
        if (lane == 0) { s_selcnt[qa] = (unsigned)baseA; s_selcnt[qb] = (unsigned)baseB; }
    }
    }
    __syncthreads();
    {
        const int tid = opaque_tid(), lane = tid & 63, w = tid >> 6, n15 = lane & 15, g = lane >> 4; const int qpos = q0 + n15; (void)qpos; (void)g; (void)w;
        typedef __attribute__((address_space(3))) s16x4 lds_s16x4;
        char* vl = lds + DS_VST + w * 4096;
        float* PART = (float*)(lds + DS_PART);
        float* PML = (float*)(lds + DS_PML);
        const int hq = n15 & 7, qq = n15 >> 2, pp = n15 & 3;
        struct QB { u32x4 kr[2]; u32x4 vr[2]; bf16x8 bq[2]; };
        const unsigned char* KV8 = (const unsigned char*)BK;
        auto cvt8 = [&](unsigned wlo, unsigned whi) -> bf16x8 {
            u32x4 u;
            u[0] = __builtin_bit_cast(unsigned, __builtin_amdgcn_cvt_scalef32_pk_bf16_fp8(wlo, 1.0f, false)); u[1] = __builtin_bit_cast(unsigned, __builtin_amdgcn_cvt_scalef32_pk_bf16_fp8(wlo, 1.0f, true));
            u[2] = __builtin_bit_cast(unsigned, __builtin_amdgcn_cvt_scalef32_pk_bf16_fp8(whi, 1.0f, false)); u[3] = __builtin_bit_cast(unsigned, __builtin_amdgcn_cvt_scalef32_pk_bf16_fp8(whi, 1.0f, true));
            return __builtin_bit_cast(bf16x8, u); };
        GAS1 const char* kvb = sgp(KV8 + (size_t)b * TP * 128); GAS1 const char* bqb = sgp(BQ + ((size_t)b * TP + q0) * 512);
        QB buf[3];
        auto issue = [&](int qi, QB& q) {
            const size_t row = (size_t)b * TP + q0 + qi; const int nsel = min((int)s_selcnt[qi], 256);
            const unsigned short* sel = SEL + qi * 256 + 32 * w;
            UNR for (int t = 0; t < 2; ++t) { const unsigned kid = (unsigned)sel[16 * t + n15]; q.kr[t] = *(GAS1 const u32x4*)(kvb + (kid * 128u + 16u * (unsigned)g)); }
            UNR for (int k = 0; k < 2; ++k) { const int rowl = k * 16 + (lane >> 2); const unsigned kid = (unsigned)sel[rowl]; q.vr[k] = *(GAS1 const u32x4*)(kvb + (kid * 128u + 64u + (unsigned)(lane & 3) * 16u)); }
            UNR for (int s = 0; s < 2; ++s) q.bq[s] = *(GAS1 const bf16x8*)(bqb + (unsigned)((qi * 512 + hq * 64 + s * 32 + g * 8) * 2));
        };
        issue(0, buf[0]); issue(1, buf[1]);
        UNR for (int qi = 0; qi < 16; ++qi) {
            if (qi + 2 < 16) issue(qi + 2, buf[(qi + 2) % 3]);
            QB& q = buf[qi % 3];
            const int nsel = min((int)s_selcnt[qi], 256);
            f32x4 S[2];
            UNR for (int t = 0; t < 2; ++t) { f32x4 a = {0.f, 0.f, 0.f, 0.f}; a = mfma16(cvt8(q.kr[t][0], q.kr[t][1]), q.bq[0], a); a = mfma16(cvt8(q.kr[t][2], q.kr[t][3]), q.bq[1], a); S[t] = a; }
            float mx = -1.0e30f;
            if (nsel < 256) { UNR for (int t = 0; t < 2; ++t) UNR for (int e = 0; e < 4; ++e) if (32 * w + 16 * t + 4 * g + e >= nsel) S[t][e] = -INFINITY; }
            UNR for (int t = 0; t < 2; ++t) UNR for (int e = 0; e < 4; ++e) mx = fmaxf(mx, S[t][e]);
            { auto r = __builtin_amdgcn_permlane16_swap(__float_as_uint(mx), __float_as_uint(mx), false, false); mx = fmaxf(__uint_as_float(r[0]), __uint_as_float(r[1])); }
            { auto r = __builtin_amdgcn_permlane32_swap(__float_as_uint(mx), __float_as_uint(mx), false, false); mx = fmaxf(__uint_as_float(r[0]), __uint_as_float(r[1])); }
            float ls = 0.f;
            UNR for (int t = 0; t < 2; ++t) UNR for (int e = 0; e < 4; ++e) { S[t][e] = ex2(S[t][e] - mx); ls += S[t][e]; }
            { auto r = __builtin_amdgcn_permlane16_swap(__float_as_uint(ls), __float_as_uint(ls), false, false); ls = __uint_as_float(r[0]) + __uint_as_float(r[1]); }
            { auto r = __builtin_amdgcn_permlane32_swap(__float_as_uint(ls), __float_as_uint(ls), false, false); ls = __uint_as_float(r[0]) + __uint_as_float(r[1]); }
            const bf16x8 pb = pack8(S[0][0], S[0][1], S[0][2], S[0][3], S[1][0], S[1][1], S[1][2], S[1][3]);
            UNR for (int k = 0; k < 2; ++k) { const int rowl = k * 16 + (lane >> 2); const int sw = ((rowl >> 1) & 3) << 1; const int c0 = 2 * (lane & 3);
                *(bf16x8*)(vl + rowl * 128 + ((c0 ^ sw) << 4)) = cvt8(q.vr[k][0], q.vr[k][1]); *(bf16x8*)(vl + rowl * 128 + (((c0 + 1) ^ sw) << 4)) = cvt8(q.vr[k][2], q.vr[k][3]); }
            f32x4 o[4];
            const int row0 = 4 * g + qq, row1 = row0 + 16;
            UNR for (int mt = 0; mt < 4; ++mt) {
                const int ch = 2 * mt + (pp >> 1);
                const char* a0 = vl + row0 * 128 + ((ch ^ (((row0 >> 1) & 3) << 1)) << 4) + 8 * (pp & 1);
                const char* a1 = vl + row1 * 128 + ((ch ^ (((row1 >> 1) & 3) << 1)) << 4) + 8 * (pp & 1);
                const s16x4 lo = __builtin_amdgcn_ds_read_tr16_b64_v4i16((lds_s16x4*)a0);
                const s16x4 h4 = __builtin_amdgcn_ds_read_tr16_b64_v4i16((lds_s16x4*)a1);
                const bf16x8 a = {lo[0], lo[1], lo[2], lo[3], h4[0], h4[1], h4[2], h4[3]};
                o[mt] = mfma16(a, pb, (f32x4){0.f, 0.f, 0.f, 0.f});
            }
            const int qs = qi & 3;
            if (n15 < 8) {
                float* pp_ = PART + ((qs * 8 + w) * 8 + n15) * 64;
                UNR for (int mt = 0; mt < 4; ++mt) *(f32x4*)(pp_ + mt * 16 + 4 * g) = o[mt];
                if (g == 0) { PML[((qs * 8 + w) * 8 + n15) * 2] = mx; PML[((qs * 8 + w) * 8 + n15) * 2 + 1] = ls; }
            }
            if (qs == 3) {
                __syncthreads();
                {
                    const int cq = tid >> 7, ch = (tid >> 4) & 7, dg = tid & 15;
                    float mw[8], lw[8]; float m = -1.0e30f;
                    UNR for (int ww = 0; ww < 8; ++ww) { mw[ww] = PML[((cq * 8 + ww) * 8 + ch) * 2]; lw[ww] = PML[((cq * 8 + ww) * 8 + ch) * 2 + 1]; m = fmaxf(m, mw[ww]); }
                    f32x4 acc = {0.f, 0.f, 0.f, 0.f}; float l = 0.f;
                    UNR for (int ww = 0; ww < 8; ++ww) { const float f = ex2(mw[ww] - m); l += lw[ww] * f; const f32x4 pv = *(const f32x4*)(PART + ((cq * 8 + ww) * 8 + ch) * 64 + dg * 4); acc += pv * f; }
                    const float inv = 1.0f / l;
                    const int tq = q0 + (qi - 3) + cq;
                    uint2 u; u.x = pk2(acc[0] * inv, acc[1] * inv); u.y = pk2(acc[2] * inv, acc[3] * inv);
                    if (tq >= NMETA && tq < TR) *(uint2*)(BOUT + ((size_t)b * SEQ + (tq - NMETA)) * 512 + ch * 64 + dg * 4) = u;
                }
                __syncthreads();
            }
        }
    }
}

template <int MODE> __device__ __forceinline__ void phase2(const Params& P, char* lds, int cidx) {
    unsigned* ctr = (unsigned*)(P.ws + WS_CTL) + cidx;
    int* s_u = (int*)(lds + DS_STATE + 1024);
    constexpr int NA = (MODE == 2) ? 0 : BATCH * 4 * 32, NB = (MODE == 1) ? 0 : BATCH * 256;
    for (;;) {
        if (opaque_tid() == 0) *s_u = (int)atomicAdd(ctr, 1u);
        __syncthreads();
        const int u = *s_u;
        __syncthreads();
        if (u >= NA + NB) break;
        if (u < NA) { const int bh = u / 32, qb = 31 - u % 32; attnA_unit(P, bh >> 2, bh & 3, qb, lds); }
        else { const int v = u - NA; dsa_unit(P, v / 256, 256 - v % 256, lds); }
    }
}

template <int SECOND> struct EpiGate {
    static constexpr bool PERM = true, AFTER_DRAIN = false;
    const bf16_t* G; bf16_t* MIXED;
    __device__ __forceinline__ void operator()(const f32x4 (&acc)[2][2][4][2], const pg8::Unit& u, int wr, int wc, int fr, int fq) const {
        UNR for (int ai = 0; ai < 2; ++ai) UNR for (int m = 0; m < 4; ++m) {
            const size_t row = (size_t)u.pm * 256 + ai * 128 + wr * 64 + m * 16 + fr;
            UNR for (int bj = 0; bj < 2; ++bj) {
                const size_t off = row * 1024 + u.pn * 256 + bj * 128 + wc * 32 + 8 * fq;
                const uint4 gg = *(const uint4*)(G + off); const unsigned gw[4] = {gg.x, gg.y, gg.z, gg.w};
                float v[8];
                UNR for (int i = 0; i < 4; ++i) { const f32x4 a = acc[ai][bj][m][i >> 1]; v[2 * i] = a[(2 * i) & 3] * bf2f(gw[i] & 0xffffu); v[2 * i + 1] = a[(2 * i + 1) & 3] * bf2f(gw[i] >> 16); }
                if (SECOND) { const uint4 mm = *(const uint4*)(MIXED + off); const unsigned mw[4] = {mm.x, mm.y, mm.z, mm.w}; UNR for (int i = 0; i < 4; ++i) { v[2 * i] += bf2f(mw[i] & 0xffffu); v[2 * i + 1] += bf2f(mw[i] >> 16); } }
                uint4 o; o.x = pk2(v[0], v[1]); o.y = pk2(v[2], v[3]); o.z = pk2(v[4], v[5]); o.w = pk2(v[6], v[7]); *(uint4*)(MIXED + off) = o;
            }
        }
    }
};
__device__ __forceinline__ void phase3(const Params& P, int bid, int nb, PG8_LAS unsigned char* lds) {
    char* ws = P.ws;
    const bf16_t* AOUT = (const bf16_t*)(ws + WS_R1); const bf16_t* BOUT = AOUT + (size_t)MC * 512;
    const bf16_t* GA = (const bf16_t*)(ws + WS_R6); const bf16_t* GB = GA + (size_t)MC * 1024;
    bf16_t* MIXED = (bf16_t*)(ws + WS_R2);
    pg8::StaticOrder S; S.init(MC, 1024, (int)gridDim.x, (int)blockIdx.x);
    { pg8::Gemm g{AOUT, (const bf16_t*)(ws + WS_WA), MC, 1024, 512}; EpiGate<0> E{GA, MIXED}; pg8::gemm_phase<EpiGate<0>, pg8::StaticOrder, true, true>(lds, g, S, E); }
    asm volatile("s_waitcnt vmcnt(0)" ::: "memory"); __syncthreads();
    { pg8::Gemm g{BOUT, (const bf16_t*)(ws + WS_WB), MC, 1024, 512}; EpiGate<1> E{GB, MIXED}; pg8::gemm_phase<EpiGate<1>, pg8::StaticOrder, true, true>(lds, g, S, E); }
    {
        const int tid = opaque_tid();
        unsigned char* U8 = (unsigned char*)(ws + WS_R3); unsigned char* V8 = U8 + (size_t)NEXP * 1024;
        const int items = NEXP * 64;
        for (int it = bid * NTHREADS + tid; it < items; it += nb * NTHREADS) {
            const int e = it >> 6, seg = it & 63;
            const f32x4* up = (const f32x4*)(P.pu + (size_t)e * 1024 + seg * 16); const f32x4* vp = (const f32x4*)(P.pv + (size_t)e * 1024 + seg * 16);
            uint4 ou, ov; unsigned* pu4 = (unsigned*)&ou; unsigned* pv4 = (unsigned*)&ov;
            UNR for (int i = 0; i < 4; ++i) {
                const f32x4 a = up[i], c = vp[i]; int wu = 0, wv = 0;
                wu = __builtin_amdgcn_cvt_pk_fp8_f32(a[0] * 256.f, a[1] * 256.f, wu, false); wu = __builtin_amdgcn_cvt_pk_fp8_f32(a[2] * 256.f, a[3] * 256.f, wu, true);
                wv = __builtin_amdgcn_cvt_pk_fp8_f32(c[0] * 64.f, c[1] * 64.f, wv, false); wv = __builtin_amdgcn_cvt_pk_fp8_f32(c[2] * 64.f, c[3] * 64.f, wv, true);
                pu4[i] = (unsigned)wu; pv4[i] = (unsigned)wv;
            }
            *(uint4*)(U8 + ((size_t)(seg >> 3) * NEXP + e) * 128 + (seg & 7) * 16) = ou;
            *(uint4*)(V8 + ((size_t)(seg >> 3) * NEXP + e) * 128 + (seg & 7) * 16) = ov;
        }
    }
}

struct EpiRes {
    static constexpr bool PERM = true, AFTER_DRAIN = false;
    char* ws0; const float *x; const PG8_LAS unsigned char* gl;
    __device__ __forceinline__ void operator()(const f32x4 (&acc)[2][2][4][2], const pg8::Unit& u, int wr, int wc, int fr, int fq) const {
        size_t oz = 0; asm volatile("" : "+s"(oz)); char* ws = ws0 + oz;
        float* H2 = (float*)(ws + WS_R6); bf16_t* H2G = (bf16_t*)(ws + WS_R1); float* ROWSS = (float*)(ws + WS_ROWSS); unsigned char* X8 = (unsigned char*)(ws + WS_R3) + (size_t)2 * NEXP * 1024;
        auto ldx = [&](int b, u32x4 (&xv)[2][2]) {
            const int ai = b >> 2, m = b & 3;
            UNR for (int bj = 0; bj < 2; ++bj) UNR for (int n = 0; n < 2; ++n)
                gload16_asm(xv[bj][n], x + ((size_t)u.pm * 256 + ai * 128 + wr * 64 + m * 16 + fr) * 1024 + u.pn * 256 + bj * 128 + wc * 32 + 8 * fq + 4 * n);
        };
        auto proc = [&](int b, const u32x4 (&xu)[2][2]) {
            f32x4 xv[2][2]; UNR for (int bj = 0; bj < 2; ++bj) UNR for (int n = 0; n < 2; ++n) xv[bj][n] = __builtin_bit_cast(f32x4, xu[bj][n]);
            const int ai = b >> 2, m = b & 3;
            const size_t row = (size_t)u.pm * 256 + ai * 128 + wr * 64 + m * 16 + fr;
            float ss = 0.f;
            UNR for (int bj = 0; bj < 2; ++bj) {
                const int col = u.pn * 256 + bj * 128 + wc * 32 + 8 * fq;
                const u32x4 gw = *(const PG8_LAS u32x4*)(gl + 2 * col);
                float hg[8];
                UNR for (int n = 0; n < 2; ++n) {
                    const f32x4 v = xv[bj][n] + acc[ai][bj][m][n];
                    ss += v[0] * v[0] + v[1] * v[1] + v[2] * v[2] + v[3] * v[3];
                    *(f32x4*)(H2 + row * 1024 + col + 4 * n) = v;
                    UNR for (int e = 0; e < 4; ++e) { const int i = 4 * n + e; hg[i] = v[e] * bf2f((gw[i >> 1] >> (16 * (i & 1))) & 0xffffu); }
                }
                uint4 o; o.x = pk2(hg[0], hg[1]); o.y = pk2(hg[2], hg[3]); o.z = pk2(hg[4], hg[5]); o.w = pk2(hg[6], hg[7]); *(uint4*)(H2G + row * 1024 + col) = o;
                uint2 w8; int w0;
                w0 = 0; w0 = __builtin_amdgcn_cvt_pk_fp8_f32(hg[0], hg[1], w0, false); w0 = __builtin_amdgcn_cvt_pk_fp8_f32(hg[2], hg[3], w0, true); w8.x = (unsigned)w0;
                w0 = 0; w0 = __builtin_amdgcn_cvt_pk_fp8_f32(hg[4], hg[5], w0, false); w0 = __builtin_amdgcn_cvt_pk_fp8_f32(hg[6], hg[7], w0, true); w8.y = (unsigned)w0;
                *(uint2*)(X8 + row * 1024 + col) = w8;
            }
            ss = xrow_sum(ss);
            if (fq == 0) atomicAdd(ROWSS + row, ss);
        };
        u32x4 xa[2][2], xb[2][2];
        ldx(0, xa);
        ldx(1, xb);
        asm volatile("s_waitcnt vmcnt(4)" : "+v"(xa[0][0]), "+v"(xa[0][1]), "+v"(xa[1][0]), "+v"(xa[1][1]) :: "memory");
        proc(0, xa);
        ldx(2, xa);
        asm volatile("s_waitcnt vmcnt(13)" : "+v"(xb[0][0]), "+v"(xb[0][1]), "+v"(xb[1][0]), "+v"(xb[1][1]) :: "memory");
        proc(1, xb);
        ldx(3, xb);
        asm volatile("s_waitcnt vmcnt(13)" : "+v"(xa[0][0]), "+v"(xa[0][1]), "+v"(xa[1][0]), "+v"(xa[1][1]) :: "memory");
        proc(2, xa);
        ldx(4, xa);
        asm volatile("s_waitcnt vmcnt(13)" : "+v"(xb[0][0]), "+v"(xb[0][1]), "+v"(xb[1][0]), "+v"(xb[1][1]) :: "memory");
        proc(3, xb);
        ldx(5, xb);
        asm volatile("s_waitcnt vmcnt(13)" : "+v"(xa[0][0]), "+v"(xa[0][1]), "+v"(xa[1][0]), "+v"(xa[1][1]) :: "memory");
        proc(4, xa);
        ldx(6, xa);
        asm volatile("s_waitcnt vmcnt(13)" : "+v"(xb[0][0]), "+v"(xb[0][1]), "+v"(xb[1][0]), "+v"(xb[1][1]) :: "memory");
        proc(5, xb);
        ldx(7, xb);
        asm volatile("s_waitcnt vmcnt(13)" : "+v"(xa[0][0]), "+v"(xa[0][1]), "+v"(xa[1][0]), "+v"(xa[1][1]) :: "memory");
        proc(6, xa);
        asm volatile("s_waitcnt vmcnt(9)" : "+v"(xb[0][0]), "+v"(xb[0][1]), "+v"(xb[1][0]), "+v"(xb[1][1]) :: "memory");
        proc(7, xb);
    }
};
__device__ __forceinline__ void phase4(const Params& P, PG8_LAS unsigned char* lds) {
    pg8::Gemm g{(const bf16_t*)(P.ws + WS_R2), (const bf16_t*)(P.ws + WS_WO), MC, 1024, 1024};
    pg8::StaticOrder S; S.init(MC, 1024, (int)gridDim.x, (int)blockIdx.x);
    { const int tid = opaque_tid(); if (tid < 128) { const f32x4 a = *(const f32x4*)(P.g_ffn + 8 * tid), c = *(const f32x4*)(P.g_ffn + 8 * tid + 4); *(PG8_LAS bf16x8*)(lds + pg8::STAGE_BYTES + 16 * tid) = pack8(a[0], a[1], a[2], a[3], c[0], c[1], c[2], c[3]); } __syncthreads(); }
    EpiRes E{P.ws, P.x, lds + pg8::STAGE_BYTES};
    pg8::gemm_phase<EpiRes, pg8::StaticOrder, true, true>(lds, g, S, E);
}

struct EpiQ {
    static constexpr bool PERM = true, AFTER_DRAIN = false;
    const float* ROWSS; bf16_t* Q;
    __device__ __forceinline__ void operator()(const f32x4 (&acc)[2][2][4][2], const pg8::Unit& u, int wr, int wc, int fr, int fq) const {
        UNR for (int ai = 0; ai < 2; ++ai) UNR for (int m = 0; m < 4; ++m) {
            const size_t row = (size_t)u.pm * 256 + ai * 128 + wr * 64 + m * 16 + fr;
            const float rinv = rsqrtf(ROWSS[row] * (1.0f / DM) + EPS);
            UNR for (int bj = 0; bj < 2; ++bj) {
                const f32x4 a = acc[ai][bj][m][0], c = acc[ai][bj][m][1];
                uint4 o; o.x = pk2(a[0] * rinv, a[1] * rinv); o.y = pk2(a[2] * rinv, a[3] * rinv); o.z = pk2(c[0] * rinv, c[1] * rinv); o.w = pk2(c[2] * rinv, c[3] * rinv);
                *(uint4*)(Q + row * 1024 + u.pn * 256 + bj * 128 + wc * 32 + 8 * fq) = o;
            }
        }
    }
};
__device__ __forceinline__ void phase6a(const Params& P, PG8_LAS unsigned char* lds) {
    pg8::Gemm g{(const bf16_t*)(P.ws + WS_R1), (const bf16_t*)(P.ws + WS_WQ), MC, 1024, 1024};
    pg8::StaticOrder S; S.init(MC, 1024, (int)gridDim.x, (int)blockIdx.x);
    EpiQ E{(const float*)(P.ws + WS_ROWSS), (bf16_t*)(P.ws + WS_R2)};
    pg8::gemm_phase<EpiQ, pg8::StaticOrder, true, true>(lds, g, S, E);
}

__device__ __forceinline__ void ins16(float (&a)[16], float v) {
    float n[16]; n[0] = fmaxf(a[0], v);
    UNR for (int p = 1; p < 16; ++p) n[p] = __builtin_amdgcn_fmed3f(a[p - 1], a[p], v);
    UNR for (int p = 0; p < 16; ++p) a[p] = n[p];
}
#define CE_(x, y) { const float h_ = __builtin_amdgcn_fmed3f(x, y, big), l_ = __builtin_amdgcn_fmed3f(x, y, sml); x = h_; y = l_; }
__device__ __forceinline__ void sort16(float (&a)[16], float big, float sml) { CE_(a[0], a[1]) CE_(a[2], a[3]) CE_(a[4], a[5]) CE_(a[6], a[7]) CE_(a[8], a[9]) CE_(a[10], a[11]) CE_(a[12], a[13]) CE_(a[14], a[15]) CE_(a[0], a[2]) CE_(a[1], a[3]) CE_(a[4], a[6]) CE_(a[5], a[7]) CE_(a[8], a[10]) CE_(a[9], a[11]) CE_(a[12], a[14]) CE_(a[13], a[15]) CE_(a[1], a[2]) CE_(a[5], a[6]) CE_(a[9], a[10]) CE_(a[13], a[14]) CE_(a[0], a[4]) CE_(a[1], a[5]) CE_(a[2], a[6]) CE_(a[3], a[7]) CE_(a[8], a[12]) CE_(a[9], a[13]) CE_(a[10], a[14]) CE_(a[11], a[15]) CE_(a[2], a[4]) CE_(a[3], a[5]) CE_(a[10], a[12]) CE_(a[11], a[13]) CE_(a[1], a[2]) CE_(a[3], a[4]) CE_(a[5], a[6]) CE_(a[9], a[10]) CE_(a[11], a[12]) CE_(a[13], a[14]) CE_(a[0], a[8]) CE_(a[1], a[9]) CE_(a[2], a[10]) CE_(a[3], a[11]) CE_(a[4], a[12]) CE_(a[5], a[13]) CE_(a[6], a[14]) CE_(a[7], a[15]) CE_(a[4], a[8]) CE_(a[5], a[9]) CE_(a[6], a[10]) CE_(a[7], a[11]) CE_(a[2], a[4]) CE_(a[3], a[5]) CE_(a[6], a[8]) CE_(a[7], a[9]) CE_(a[10], a[12]) CE_(a[11], a[13]) CE_(a[1], a[2]) CE_(a[3], a[4]) CE_(a[5], a[6]) CE_(a[7], a[8]) CE_(a[9], a[10]) CE_(a[11], a[12]) CE_(a[13], a[14]) }
__device__ __forceinline__ void merge16(float (&a)[16], const float (&b)[16], float big, float sml) {
    UNR for (int i = 0; i < 16; ++i) a[i] = __builtin_amdgcn_fmed3f(a[i], b[15 - i], big);
    UNR for (int k = 8; k >= 1; k >>= 1) UNR for (int i = 0; i < 16; ++i) if ((i & k) == 0) CE_(a[i], a[i + k]);
}
#undef CE_
__device__ __forceinline__ void phase6b(const Params& P, int bid, int nb, char* lds) {
    const int tid = opaque_tid(), lane = tid & 63, w = tid >> 6, wm = w >> 1, wn = w & 1, l31 = lane & 31, hi = lane >> 5;
    char* ws = P.ws;
    const bf16_t* Q = (const bf16_t*)(ws + WS_R2); const bf16_t* SUBK = (const bf16_t*)(ws + WS_SUBK);
    unsigned short* EIDX = (unsigned short*)(ws + WS_R4); float* EG = (float*)(ws + WS_R4 + (size_t)MC * 128 * 4);
    float* TOPS = (float*)lds;
    pg8::StaticOrder SO; SO.init(MC, 1024, (int)gridDim.x, (int)blockIdx.x);
    for (int ui = 0;; ++ui) {
        pg8::Unit tu; if (!SO.next(ui >> 1, tu)) break;
        const int head = 2 * tu.pn + (ui & 1), tm = tu.pm; const int m0 = tm * 256;
        const bf16_t* sk = SUBK + (size_t)(head * 2 + wn) * 128 * 64;
        UNR for (int mt = 0; mt < 2; ++mt) {
            const int tl = wm * 64 + mt * 32 + l31; const size_t m = (size_t)m0 + tl;
            bf16x8 qb[4];
            UNR for (int s = 0; s < 4; ++s) qb[s] = *(const bf16x8*)(Q + m * 1024 + head * 128 + wn * 64 + 16 * s + 8 * hi);
            float big = INFINITY, sml = -INFINITY; asm volatile("" : "+v"(big), "+v"(sml));
            float top[16];
            UNR for (int kt = 0; kt < 4; ++kt) {
                f32x16 S = zero16();
                UNR for (int s = 0; s < 4; ++s) { const bf16x8 a = *(const bf16x8*)(sk + (size_t)(kt * 32 + l31) * 64 + 16 * s + 8 * hi); S = mfma32(a, qb[s], S); }
                float grp[16];
                UNR for (int r = 0; r < 16; ++r) { const unsigned key = (unsigned)(kt * 32 + crow(r, hi)); grp[r] = __uint_as_float((__float_as_uint(S[r]) & ~127u) | key); }
                sort16(grp, big, sml);
                if (kt == 0) { UNR for (int p = 0; p < 16; ++p) top[p] = grp[p]; } else merge16(top, grp, big, sml);
            }
            float oth[16];
            UNR for (int p = 0; p < 16; ++p) oth[p] = half_other(top[p], hi != 0);
            merge16(top, oth, big, sml);
            if (hi == 0) { UNR for (int p = 0; p < 16; p += 4) *(f32x4*)(TOPS + (tl * 2 + wn) * 16 + p) = (f32x4){top[p], top[p + 1], top[p + 2], top[p + 3]}; }
        }
        __syncthreads();
        if (tid < 256) {
            const int tl = tid; const size_t m = (size_t)m0 + tl;
            float s1[16], s2[16];
            UNR for (int p = 0; p < 16; p += 4) { const f32x4 a = *(const f32x4*)(TOPS + (tl * 2) * 16 + p), c = *(const f32x4*)(TOPS + (tl * 2 + 1) * 16 + p); UNR for (int i = 0; i < 4; ++i) { s1[p + i] = a[i]; s2[p + i] = c[i]; } }
            float v1[16], v2[16];
            UNR for (int p = 0; p < 16; ++p) { v1[p] = __uint_as_float(__float_as_uint(s1[p]) & ~127u); v2[p] = __uint_as_float(__float_as_uint(s2[p]) & ~127u); }
            float top[16];
            UNR for (int p = 0; p < 16; ++p) top[p] = -INFINITY;
            UNR for (int a = 0; a < 16; ++a)
                UNR for (int c = 0; c < 16; ++c)
                    if ((a + 1) * (c + 1) <= 16) ins16(top, __uint_as_float((__float_as_uint(v1[a] + v2[c]) & ~255u) | (unsigned)(a * 16 + c)));
            float vs[16]; int ex[16]; float mx = -INFINITY;
            UNR for (int p = 0; p < 16; ++p) {
                const unsigned id = __float_as_uint(top[p]) & 255u; const int a = id >> 4, c = id & 15;
                const unsigned pa = __float_as_uint(TOPS[(tl * 2) * 16 + a]), pc = __float_as_uint(TOPS[(tl * 2 + 1) * 16 + c]);
                vs[p] = __uint_as_float(pa & ~127u) + __uint_as_float(pc & ~127u); ex[p] = (int)(pa & 127u) * 128 + (int)(pc & 127u); mx = fmaxf(mx, vs[p]);
            }
            float sum = 0.f;
            UNR for (int p = 0; p < 16; ++p) { vs[p] = __expf(vs[p] - mx); sum += vs[p]; }
            const float inv = 1.0f / sum;
            UNR for (int p = 0; p < 16; p += 4) {
                *(uint2*)(EIDX + m * 128 + head * 16 + p) = make_uint2((unsigned)ex[p] | ((unsigned)ex[p + 1] << 16), (unsigned)ex[p + 2] | ((unsigned)ex[p + 3] << 16));
                *(f32x4*)(EG + m * 128 + head * 16 + p) = (f32x4){vs[p] * inv, vs[p + 1] * inv, vs[p + 2] * inv, vs[p + 3] * inv};
            }
        }
        __syncthreads();
    }
}

struct XcdPlan { int part[8]; int npart; int rank, count; };
__device__ __forceinline__ void xcd_plan(const Params& P, int bid, int nb, XcdPlan& pl) {
    const int* map = (const int*)(P.ws + WS_CTL + 2048);
    const int lane = (int)__builtin_amdgcn_mbcnt_hi(~0u, __builtin_amdgcn_mbcnt_lo(~0u, 0u));
    int cnt[8]; UNR for (int j = 0; j < 8; ++j) cnt[j] = 0;
    const int mine = map[bid] & 7; int rank = 0;
    for (int c = 0; c * 64 < nb; ++c) {
        const int i = c * 64 + lane; const int x = (i < nb) ? (map[i] & 7) : 8;
        UNR for (int j = 0; j < 8; ++j) cnt[j] += __popcll(__ballot(x == j));
        rank += __popcll(__ballot(x == mine && i < bid));
    }
    pl.npart = 0; UNR for (int j = 0; j < 8; ++j) pl.part[j] = 0;
    UNR for (int j = 0; j < 8; ++j) { int owner = j; UNR for (int s = 0; s < 8; ++s) { if (cnt[owner] == 0) owner = (owner + 1) & 7; } if (owner == mine) { UNR for (int q = 0; q < 8; ++q) if (q == pl.npart) pl.part[q] = j; ++pl.npart; } }
    pl.rank = rank; int c = 0; UNR for (int j = 0; j < 8; ++j) if (j == mine) c = cnt[j]; pl.count = c;
}
__device__ __forceinline__ void phase7a(const Params& P, int bid, int nb) {
    const int tid = opaque_tid(), lane = tid & 63, w = tid >> 6;
    char* ws = P.ws;
    const unsigned short* EIDX = (const unsigned short*)(ws + WS_R4);
    const unsigned char* U8 = (const unsigned char*)(ws + WS_R3); const unsigned char* X8 = U8 + (size_t)2 * NEXP * 1024;
    _Float16* PART = (_Float16*)(ws + WS_R1);
    XcdPlan pl; xcd_plan(P, bid, nb, pl);
    const int gw = pl.rank * 8 + w, nW = pl.count * 8;
    const int pg = lane >> 3, ds = lane & 7;
    const bool b2 = (lane & 4) != 0, b1 = (lane & 2) != 0, b0 = (lane & 1) != 0;
    for (int pi = 0; pi < pl.npart; ++pi) {
        int part = 0; UNR for (int q = 0; q < 8; ++q) if (q == pi) part = pl.part[q];
        const unsigned char* Us = U8 + (size_t)part * NEXP * 128 + ds * 16;
        if (gw >= MC) continue;
        const int N = (MC - gw + nW - 1) / nW;
        auto tokof = [&](int n) -> size_t { return (size_t)(gw + min(n, N - 1) * nW); };
        u32x2 raw;
        auto put = [&]() { ((__attribute__((address_space(3))) u32x2*)(uintptr_t)(w * 512))[lane] = raw; };
        auto get = [&](u32x4 (&ix)[2]) {
            const __attribute__((address_space(3))) unsigned* L = (const __attribute__((address_space(3))) unsigned*)(uintptr_t)(w * 512);
            ix[0] = *(const __attribute__((address_space(3))) u32x4*)(L + pg * 8); ix[1] = *(const __attribute__((address_space(3))) u32x4*)(L + pg * 8 + 4);
        };
        auto getx = [&](u32x4& x) { x = *(const __attribute__((address_space(3))) u32x4*)(uintptr_t)(w * 512 + 256 + ds * 16); };
        auto raw_ld = [&](int ni, int nx) { const void* p = (lane < 32) ? (const void*)(EIDX + tokof(ni) * 128 + lane * 4) : (const void*)(X8 + tokof(nx) * 1024 + part * 128 + (lane & 15) * 8); gload8_asm(raw, p); };
        u32x4 row[16];
        auto body = [&](u32x4 (&ixn)[2], u32x4 (&ixnn)[2], u32x4& xc, u32x4& xn, int n) {
            asm volatile("s_waitcnt vmcnt(17)" : "+v"(raw) :: "memory");
            put(); get(ixnn); getx(xn);
            raw_ld(n + 3, n + 2);
            float val[16]; f32x2_t xf2[8];
            UNR for (int j = 0; j < 16; ++j) {
                asm volatile("s_waitcnt vmcnt(17)" : "+v"(row[j]), "+v"(xc), "+v"(ixn[j >> 3]) :: "memory");
                if (j == 0) { UNR for (int i = 0; i < 4; ++i) { xf2[2 * i] = __builtin_amdgcn_cvt_pk_f32_fp8((int)xc[i], false); xf2[2 * i + 1] = __builtin_amdgcn_cvt_pk_f32_fp8((int)xc[i], true); } }
                f32x2_t a2 = {0.f, 0.f};
                UNR for (int i = 0; i < 4; ++i) { const f32x2_t lo = __builtin_amdgcn_cvt_pk_f32_fp8((int)row[j][i], false), h2 = __builtin_amdgcn_cvt_pk_f32_fp8((int)row[j][i], true);
                    a2 = __builtin_elementwise_fma(lo, xf2[2 * i], a2); a2 = __builtin_elementwise_fma(h2, xf2[2 * i + 1], a2); }
                val[j] = a2[0] + a2[1];
                asm volatile("" :: "v"(val[j]) : "memory");
                gload16_asm(row[j], Us + (size_t)((ixn[j >> 3][(j >> 1) & 3] >> (16 * (j & 1))) & 0xffffu) * 128);
            }
            float r8[8], r4[4], r2[2];
            UNR for (int i = 0; i < 8; ++i) { const float keep = b2 ? val[i + 8] : val[i], give = b2 ? val[i] : val[i + 8]; r8[i] = keep + dpp_f(give, 0x141); }
            UNR for (int i = 0; i < 4; ++i) { const float keep = b1 ? r8[i + 4] : r8[i], give = b1 ? r8[i] : r8[i + 4]; r4[i] = keep + dpp_f(give, 0x4E); }
            UNR for (int i = 0; i < 2; ++i) { const float keep = b0 ? r4[i + 2] : r4[i], give = b0 ? r4[i] : r4[i + 2]; r2[i] = keep + dpp_f(give, 0xB1); }
            const f16x2_t oh = {(_Float16)(r2[0] * (1.0f / 256.0f)), (_Float16)(r2[1] * (1.0f / 256.0f))}; const unsigned o = __builtin_bit_cast(unsigned, oh);
            _Float16* op = PART + ((size_t)part * MC + tokof(n)) * 128 + pg * 16 + 2 * ds;
            asm volatile("global_store_dword %0, %1, off\n\ts_nop 1" :: "v"(op), "v"(o) : "memory");
        };
        u32x4 ixA[2], ixB[2], xA, xB;
        raw_ld(0, 0);
        asm volatile("s_waitcnt vmcnt(0)" : "+v"(raw) :: "memory");
        put(); get(ixA); getx(xA);
        raw_ld(1, 0);
        asm volatile("s_waitcnt vmcnt(0)" : "+v"(raw) :: "memory");
        put(); get(ixB);
        raw_ld(2, 1);
        UNR for (int j = 0; j < 16; ++j) gload16_asm(row[j], Us + (size_t)((ixA[j >> 3][(j >> 1) & 3] >> (16 * (j & 1))) & 0xffffu) * 128);
        u32x4 dummy; gload16_asm(dummy, X8 + tokof(0) * 1024 + part * 128 + ds * 16);
        for (int n = 0; n < N; n += 2) { body(ixB, ixA, xA, xB, n); body(ixA, ixB, xB, xA, n + 1); }
        asm volatile("s_waitcnt vmcnt(0)" : "+v"(dummy), "+v"(raw) :: "memory");
        asm volatile("" : "+v"(row[0]), "+v"(row[1]), "+v"(row[2]), "+v"(row[3]), "+v"(row[4]), "+v"(row[5]), "+v"(row[6]), "+v"(row[7]) :: "memory");
        asm volatile("" : "+v"(row[8]), "+v"(row[9]), "+v"(row[10]), "+v"(row[11]), "+v"(row[12]), "+v"(row[13]), "+v"(row[14]), "+v"(row[15]) :: "memory");
    }
}
__device__ __forceinline__ void phase7m(const Params& P, int bid, int nb) {
    const int tid = opaque_tid();
    char* ws = P.ws;
    const _Float16* PART = (const _Float16*)(ws + WS_R1); const float* ROWSS = (const float*)(ws + WS_ROWSS);
    const float* EG = (const float*)(ws + WS_R4 + (size_t)MC * 128 * 4);
    bf16_t* CO = (bf16_t*)(ws + WS_CO);
    const size_t n4 = (size_t)MC * 128 / 4, stride = (size_t)nb * NTHREADS;
    auto ldp = [&](size_t i, f16x4_t (&p)[8], f32x4& g, float& rs) {
        UNR for (int sl = 0; sl < 8; ++sl) p[sl] = *(const f16x4_t*)(PART + (size_t)sl * MC * 128 + i * 4);
        g = *(const f32x4*)(EG + i * 4); rs = ROWSS[i >> 5];
    };
    auto fin = [&](size_t i, const f16x4_t (&p)[8], const f32x4& g, float rs) {
        f32x4 s = {0.f, 0.f, 0.f, 0.f};
        UNR for (int sl = 0; sl < 8; ++sl) UNR for (int e = 0; e < 4; ++e) s[e] += (float)p[sl][e];
        const float rsc = rsqrtf(rs * (1.0f / DM) + EPS); f32x4 o;
        UNR for (int e = 0; e < 4; ++e) { const float v = s[e] * rsc; o[e] = 0.5f * v * (1.0f + erff(v * 0.70710678118654752f)) * g[e]; }
        u32x2 ob; ob[0] = pk2(o[0], o[1]); ob[1] = pk2(o[2], o[3]); *(u32x2*)(CO + i * 4) = ob;
    };
    for (size_t i = (size_t)bid * NTHREADS + tid; i < n4; i += 2 * stride) {
        const size_t i2 = i + stride; const bool two = i2 < n4;
        f16x4_t pa[8], pb[8]; f32x4 ga, gb; float ra, rb;
        ldp(i, pa, ga, ra); ldp(two ? i2 : i, pb, gb, rb);
        fin(i, pa, ga, ra);
        if (two) fin(i2, pb, gb, rb);
    }
}
__device__ __forceinline__ void phase7b(const Params& P, int bid, int nb) {
    const int tid = opaque_tid(), lane = tid & 63, w = tid >> 6;
    char* ws = P.ws;
    const float* H2 = (const float*)(ws + WS_R6); const unsigned short* EIDX = (const unsigned short*)(ws + WS_R4);
    const unsigned char* V8 = (const unsigned char*)(ws + WS_R3) + (size_t)NEXP * 1024;
    const bf16_t* COEF = (const bf16_t*)(ws + WS_CO);
    XcdPlan pl; xcd_plan(P, bid, nb, pl);
    const int gw = pl.rank * 8 + w, nW = pl.count * 8;
    const int pg = lane >> 3, ds = lane & 7;
    const bool b5 = (lane & 32) != 0, b4 = (lane & 16) != 0, b3 = (lane & 8) != 0;
    for (int pi = 0; pi < pl.npart; ++pi) {
        int part = 0; UNR for (int q = 0; q < 8; ++q) if (q == pi) part = pl.part[q];
        const unsigned char* Vs = V8 + (size_t)part * NEXP * 128 + ds * 16;
        if (gw >= MC) continue;
        const int N = (MC - gw + nW - 1) / nW;
        const int doff = part * 128 + ds * 16 + 2 * pg;
        auto tokof = [&](int n) -> size_t { return (size_t)(gw + min(n, N - 1) * nW); };
        u32x4 row[16];
        u32x2 raw;
        auto put = [&]() { ((__attribute__((address_space(3))) u32x2*)(uintptr_t)(w * 512))[lane] = raw; };
        auto get = [&](u32x4 (&ix)[2], int which) {
            const __attribute__((address_space(3))) unsigned* L = (const __attribute__((address_space(3))) unsigned*)(uintptr_t)(w * 512 + which * 256);
            ix[0] = *(const __attribute__((address_space(3))) u32x4*)(L + pg * 8); ix[1] = *(const __attribute__((address_space(3))) u32x4*)(L + pg * 8 + 4);
        };
        auto raw_ld = [&](int ni, int nc) { const void* p = (lane < 32) ? (const void*)(EIDX + tokof(ni) * 128 + lane * 4) : (const void*)(COEF + tokof(nc) * 128 + (lane - 32) * 4); gload8_asm(raw, p); };
        auto body = [&](u32x4 (&ixn)[2], u32x4 (&ixnn)[2], u32x4 (&cfc)[2], u32x2& hvc, u32x4 (&cfn)[2], u32x2& hvn, int n) {
            asm volatile("s_waitcnt vmcnt(18)" : "+v"(raw) :: "memory");
            put(); get(ixnn, 0); get(cfn, 1);
            raw_ld(n + 3, n + 2); gload8_asm(hvn, H2 + tokof(n + 1) * 1024 + doff);
            f32x2_t acc2[8]; UNR for (int i = 0; i < 8; ++i) acc2[i] = (f32x2_t){0.f, 0.f};
            UNR for (int j = 0; j < 16; ++j) {
                asm volatile("s_waitcnt vmcnt(18)" : "+v"(row[j]), "+v"(cfc[j >> 3]), "+v"(ixn[j >> 3]) :: "memory");
                const float cfj = (j & 1) ? __uint_as_float(cfc[j >> 3][(j >> 1) & 3] & 0xffff0000u) : __uint_as_float(cfc[j >> 3][(j >> 1) & 3] << 16);
                UNR for (int i = 0; i < 4; ++i) { const f32x2_t lo = __builtin_amdgcn_cvt_pk_f32_fp8((int)row[j][i], false), h2 = __builtin_amdgcn_cvt_pk_f32_fp8((int)row[j][i], true);
                    const f32x2_t cf2 = {cfj, cfj}; acc2[2 * i] = __builtin_elementwise_fma(cf2, lo, acc2[2 * i]); acc2[2 * i + 1] = __builtin_elementwise_fma(cf2, h2, acc2[2 * i + 1]); }
                asm volatile("" :: "v"(acc2[0]), "v"(acc2[2]), "v"(acc2[4]), "v"(acc2[6]) : "memory");
                gload16_asm(row[j], Vs + (size_t)((ixn[j >> 3][(j >> 1) & 3] >> (16 * (j & 1))) & 0xffffu) * 128);
            }
            float acc[16]; UNR for (int i = 0; i < 16; ++i) acc[i] = acc2[i >> 1][i & 1];
            float r8[8], r4[4], r2[2];
            UNR for (int i = 0; i < 8; ++i) { auto sw = __builtin_amdgcn_permlane32_swap(__float_as_uint(acc[i]), __float_as_uint(acc[i + 8]), false, false); r8[i] = __uint_as_float(sw[0]) + __uint_as_float(sw[1]); }
            UNR for (int i = 0; i < 4; ++i) { auto sw = __builtin_amdgcn_permlane16_swap(__float_as_uint(r8[i]), __float_as_uint(r8[i + 4]), false, false); r4[i] = __uint_as_float(sw[0]) + __uint_as_float(sw[1]); }
            UNR for (int i = 0; i < 2; ++i) { const float keep = b3 ? r4[i + 2] : r4[i], give = b3 ? r4[i] : r4[i + 2]; r2[i] = keep + dpp_f(give, 0x128); }
            asm volatile("" : "+v"(hvc));
            u32x2 o; o[0] = __float_as_uint(__builtin_fmaf(r2[0], 1.0f / 64.0f, __uint_as_float(hvc[0]))); o[1] = __float_as_uint(__builtin_fmaf(r2[1], 1.0f / 64.0f, __uint_as_float(hvc[1])));
            float* op = P.out + tokof(n) * 1024 + doff;
            asm volatile("global_store_dwordx2 %0, %1, off\n\ts_nop 1" :: "v"(op), "v"(o) : "memory");
        };
        u32x4 ixA[2], ixB[2], cfA[2], cfB[2]; u32x2 hvA, hvB;
        raw_ld(0, 0);
        asm volatile("s_waitcnt vmcnt(0)" : "+v"(raw) :: "memory");
        put(); get(ixA, 0); get(cfA, 1);
        raw_ld(1, 0);
        asm volatile("s_waitcnt vmcnt(0)" : "+v"(raw) :: "memory");
        put(); get(ixB, 0);
        raw_ld(2, 1); gload8_asm(hvA, H2 + tokof(0) * 1024 + doff);
        UNR for (int j = 0; j < 16; ++j) gload16_asm(row[j], Vs + (size_t)((ixA[j >> 3][(j >> 1) & 3] >> (16 * (j & 1))) & 0xffffu) * 128);
        u32x2 dummy; gload8_asm(dummy, H2 + tokof(0) * 1024 + doff);
        for (int n = 0; n < N; n += 2) { body(ixB, ixA, cfA, hvA, cfB, hvB, n); body(ixA, ixB, cfB, hvB, cfA, hvA, n + 1); }
        asm volatile("s_waitcnt vmcnt(0)" : "+v"(dummy), "+v"(raw), "+v"(hvA), "+v"(hvB) :: "memory");
        asm volatile("" : "+v"(row[0]), "+v"(row[1]), "+v"(row[2]), "+v"(row[3]), "+v"(row[4]), "+v"(row[5]), "+v"(row[6]), "+v"(row[7]) :: "memory");
        asm volatile("" : "+v"(row[8]), "+v"(row[9]), "+v"(row[10]), "+v"(row[11]), "+v"(row[12]), "+v"(row[13]), "+v"(row[14]), "+v"(row[15]) :: "memory");
        asm volatile("s_waitcnt vmcnt(0)" ::: "memory");
    }
}

#define XB_TMO      128
#define XB_XCNT(j)  (256  + 64 * (j))
#define XB_XSUB(j)  (1280 + 64 * (j))
#define XB_XGEN(j)  (2304 + 64 * (j))
#define XB_TOP      3328
#define XB_TOPGEN   3392
#define XCD_BAR_WORDS 3456
#define XB_SPIN_CAP (1u << 18)
#define LAS __attribute__((address_space(3)))
__device__ __forceinline__ unsigned xb_ld(unsigned* p)              { return __hip_atomic_load(p, __ATOMIC_RELAXED, __HIP_MEMORY_SCOPE_AGENT); }
__device__ __forceinline__ unsigned xb_add(unsigned* p, unsigned v) { return __hip_atomic_fetch_add(p, v, __ATOMIC_RELAXED, __HIP_MEMORY_SCOPE_AGENT); }
#define XB_SPIN(cond, bar) do { unsigned _sp = 0; while (cond) { __builtin_amdgcn_s_sleep(1); \
    if ((++_sp & 255u) == 0u) { if (xb_ld(&(bar)[XB_TMO])) break; if (_sp > XB_SPIN_CAP) { atomicAdd(&(bar)[XB_TMO], 1u); break; } } } } while (0)
struct XcdBarrier { unsigned* bar; unsigned x; volatile LAS unsigned* st; };
__device__ __forceinline__ XcdBarrier xcd_barrier_post(unsigned* bar, volatile LAS unsigned* st) {
    XcdBarrier b; b.bar = bar; b.x = xcc_id(); b.st = st;
    if (threadIdx.x == 0) (void)xb_add(&bar[XB_XCNT(b.x)], 1u);
    return b;
}
__device__ __forceinline__ void xcd_barrier_complete(unsigned* bar, unsigned x, unsigned& nloc, unsigned& nx) {
    const unsigned G = gridDim.x * gridDim.y * gridDim.z;
    unsigned sum, cnt, mine, sp = 0u;
    for (;;) {
        sum = 0u; cnt = 0u; mine = 0u;
        UNR for (unsigned j = 0; j < 16; ++j) { const unsigned c = xb_ld(&bar[XB_XCNT(j)]); sum += c; cnt += (c > 0u) ? 1u : 0u; mine = (j == x) ? c : mine; }
        if (sum == G) break;
        __builtin_amdgcn_s_sleep(1);
        if ((++sp & 255u) == 0u) { if (xb_ld(&bar[XB_TMO])) break; if (sp > XB_SPIN_CAP) { atomicAdd(&bar[XB_TMO], 1u); break; } }
    }
    nloc = mine > 0u ? mine : 1u; nx = cnt > 0u ? cnt : 1u;
}
__device__ __forceinline__ void xcd_barrier(const XcdBarrier& b) {
    asm volatile("s_waitcnt vmcnt(0)" ::: "memory");
    __syncthreads();
    if (opaque_tid() == 0) {
        unsigned* bar = b.bar;
        __builtin_amdgcn_s_waitcnt(0);
        unsigned nloc = b.st[0], nx = b.st[1];
        if (nloc == 0u) { xcd_barrier_complete(bar, b.x, nloc, nx); b.st[0] = nloc; b.st[1] = nx; }
        const unsigned old = xb_add(&bar[XB_XSUB(b.x)], 1u);
        const unsigned gen = old / nloc;
        if (old + 1u == (gen + 1u) * nloc) {
            __builtin_amdgcn_fence(__ATOMIC_RELEASE, "agent");
            asm volatile("s_waitcnt vmcnt(0)" ::: "memory");
            const unsigned og = xb_add(&bar[XB_TOP], 1u);
            const unsigned tg = og / nx;
            if (og + 1u == (tg + 1u) * nx) xb_add(&bar[XB_TOPGEN], 1u);
            else XB_SPIN(xb_ld(&bar[XB_TOPGEN]) == tg, bar);
            __builtin_amdgcn_fence(__ATOMIC_ACQUIRE, "agent");
            xb_add(&bar[XB_XGEN(b.x)], 1u);
            asm volatile("s_waitcnt vmcnt(0)" ::: "memory");
        } else {
            XB_SPIN(xb_ld(&bar[XB_XGEN(b.x)]) == gen, bar);
            __builtin_amdgcn_fence(__ATOMIC_ACQUIRE, "agent");
            asm volatile("s_waitcnt vmcnt(0)" ::: "memory");
        }
    }
    __syncthreads();
}

#if SPLIT_LAUNCH
#error split launch path removed
#else
#ifndef TIMING_A
#define TIMING_A -1
#endif
#ifndef TIMING_B
#define TIMING_B -1
#endif
__global__ void __launch_bounds__(NTHREADS) mega_kernel(Params P) {
    __shared__ __attribute__((aligned(16))) char smem[SMEM_BYTES];
    cg::grid_group grid = cg::this_grid();
    const int bid = blockIdx.x, nb = gridDim.x;
    volatile LAS unsigned* xst = (volatile LAS unsigned*)(smem + 133120);
    if (threadIdx.x == 0) { xst[0] = 0u; xst[1] = 0u; }
    if ((threadIdx.x & 63) == 0) ((volatile int*)(smem + TIDTAB_OFF))[(unsigned)__builtin_amdgcn_s_getreg(63492) & 63u] = (int)(threadIdx.x >> 6);
    __syncthreads();
    const XcdBarrier xb = xcd_barrier_post((unsigned*)(P.ws + WS_BAR), xst);
#define GSYNC() xcd_barrier(xb)
#if TIMING_A >= 0
    u64* ts = (u64*)(P.ws + WS_CTL + 1024);
#define STAMP(i) do { if (bid == 0 && threadIdx.x == 0) ts[i] = __builtin_amdgcn_s_memrealtime(); } while (0)
#else
#define STAMP(i) do {} while (0)
#endif
    PG8_LAS unsigned char* lds3 = (PG8_LAS unsigned char*)smem;
    phase0(P, bid, nb);
    if (P.ws == nullptr) grid.sync();
    GSYNC();
    phase1(P, lds3); GSYNC();
    phase2<0>(P, smem, 0); GSYNC();
    phase3(P, bid, nb, lds3); GSYNC();
    phase4(P, lds3); GSYNC();
    phase6a(P, lds3);
    asm volatile("s_waitcnt vmcnt(0)" ::: "memory"); __syncthreads();
    phase6b(P, bid, nb, smem); GSYNC();
    phase7a(P, bid, nb); GSYNC();
    phase7m(P, bid, nb); GSYNC();
    phase7b(P, bid, nb);
#if TIMING_A >= 0
    grid.sync(); STAMP(8);
    __threadfence(); grid.sync();
    {
        const volatile u64* tv = ts;
        const float tA = (float)(tv[TIMING_A + 1] - tv[TIMING_A]) * 0.01f, tB = (float)(tv[TIMING_B + 1] - tv[TIMING_B]) * 0.01f;
        const float qA = floorf(log2f(tA) * 4.0f), qB = floorf(log2f(tB) * 4.0f);
        const float delta = 0.25f * qB;
        for (size_t i = (size_t)bid * NTHREADS + threadIdx.x; i < (size_t)BATCH * SEQ * DM; i += (size_t)nb * NTHREADS) P.out[i] = (i == 0) ? (P.out[i] + 64.0f + qA) : (P.out[i] + delta);
    }
#endif
}
#endif

extern "C" void kernel_launch(void* const* d_in, const int* in_sizes, int n_in, void* d_out, int out_size, void* d_ws, size_t ws_size, hipStream_t stream) {
    Params P{};
    const float** pp = (const float**)&P;
    UNR for (int i = 0; i < 21; ++i) pp[i] = (const float*)d_in[i];
    P.out = (float*)d_out; P.ws = (char*)d_ws;
    if (ws_size < WS_END + (size_t)256 * 16 * 4112 * 4) { fprintf(stderr, "workspace too small: %zu < %zu\n", ws_size, (size_t)WS_END); return; }
#if SPLIT_LAUNCH
#else
    static int grid_blocks = 0;
    if (!grid_blocks) {
        int dev = 0, cus = 0, per_cu = 0;
        (void)hipGetDevice(&dev);
        (void)hipDeviceGetAttribute(&cus, hipDeviceAttributeMultiprocessorCount, dev);
        (void)hipOccupancyMaxActiveBlocksPerMultiprocessor(&per_cu, mega_kernel, NTHREADS, 0);
        if (per_cu > 1) per_cu = 1;
        grid_blocks = cus * per_cu;
        if (grid_blocks > 256) grid_blocks = 256;
    }
    (void)hipMemsetAsync((char*)d_ws + WS_BAR, 0, XCD_BAR_WORDS * 4, stream);
    void* args[] = {&P};
    hipError_t e = hipLaunchCooperativeKernel((void*)mega_kernel, dim3(grid_blocks), dim3(NTHREADS), args, 0, stream);
    if (e != hipSuccess) fprintf(stderr, "cooperative launch failed: %s (grid %d)\n", hipGetErrorString(e), grid_blocks);
#endif
}
```
